# Optimizing an MI355X kernel written in HIP

```python
import math
import jax, jax.numpy as jnp
from jax import lax
import numpy as np

D_MODEL = 1024
BATCH = 16
SEQ = 2048
DEPTH = 1

D_MIX = D_MODEL
D_SSM = D_MIX // 2
SSM_GROUP = 16
N_SSM_GROUPS = D_SSM // SSM_GROUP
SSM_STATE = 64
D_ATTN = D_MIX - D_SSM
N_HEADS = 8
QK_NOPE_DIM = 64
QK_ROPE_DIM = 32
QK_HEAD_DIM = QK_NOPE_DIM + QK_ROPE_DIM
V_HEAD_DIM = D_ATTN // N_HEADS
Q_LORA_RANK = 256
KV_LORA_RANK = 128
ROPE_THETA = 10000.0
Q_BLOCK = 128
D_IN_PROJ = D_SSM + Q_LORA_RANK + KV_LORA_RANK + QK_ROPE_DIM
PEER_HEADS = 8
PEER_N_KEYS = 128
PEER_N_EXPERTS = PEER_N_KEYS * PEER_N_KEYS
PEER_TOPK = 16
PEER_QUERY_DIM = 256
PEER_HALF = PEER_QUERY_DIM // 2
TOKEN_CHUNK = 128
N_ADA = 6
EPS = 1e-6

kernel_name = 'hybrid_s5_mla_peer_block'


def rms_norm(x, gain):
    xf = x.astype(jnp.float32)
    y = xf * lax.rsqrt(jnp.mean(xf * xf, axis=-1, keepdims=True) + EPS)
    return (y * gain.astype(jnp.float32)).astype(x.dtype)


def apply_rope(x, positions):
    half = QK_ROPE_DIM // 2
    inv_freq = ROPE_THETA ** (-jnp.arange(half, dtype=jnp.float32) / half)
    ang = positions.astype(jnp.float32)[:, :, None, None] * inv_freq
    cos, sin = jnp.cos(ang), jnp.sin(ang)
    xf = x.astype(jnp.float32)
    x1, x2 = xf[..., :half], xf[..., half:]
    return jnp.concatenate([x1 * cos - x2 * sin, x2 * cos + x1 * sin], axis=-1).astype(x.dtype)


def _complex_scan_combine(e1, e2):
    a1r, a1i, b1r, b1i = e1
    a2r, a2i, b2r, b2i = e2
    ar = a2r * a1r - a2i * a1i
    ai = a2r * a1i + a2i * a1r
    br = a2r * b1r - a2i * b1i + b2r
    bi = a2r * b1i + a2i * b1r + b2i
    return (ar, ai, br, bi)


def s5_group(u, lam_re, lam_im, log_dt, b_re, b_im, c_re, c_im, d_skip, w_glu, b_glu):
    dtype = u.dtype
    bsz, seq, _ = u.shape
    uf = u.astype(jnp.float32).reshape(bsz, seq, N_SSM_GROUPS, SSM_GROUP)
    lr = lam_re.astype(jnp.float32)
    li = lam_im.astype(jnp.float32)
    dt = jnp.exp(log_dt.astype(jnp.float32))[:, None]
    mag = jnp.exp(lr * dt)
    ar = mag * jnp.cos(li * dt)
    ai = mag * jnp.sin(li * dt)
    den = lr * lr + li * li
    nr, ni = ar - 1.0, ai
    coef_r = ((nr * lr + ni * li) / den)[..., None]
    coef_i = ((ni * lr - nr * li) / den)[..., None]
    br_, bi_ = b_re.astype(jnp.float32), b_im.astype(jnp.float32)
    bbar_r = coef_r * br_ - coef_i * bi_
    bbar_i = coef_r * bi_ + coef_i * br_
    bu_r = jnp.einsum('gpc,bsgc->bsgp', bbar_r, uf)
    bu_i = jnp.einsum('gpc,bsgc->bsgp', bbar_i, uf)
    a_r = jnp.broadcast_to(ar[None, None], (1, seq, N_SSM_GROUPS, SSM_STATE))
    a_i = jnp.broadcast_to(ai[None, None], (1, seq, N_SSM_GROUPS, SSM_STATE))
    _, _, xr, xi = lax.associative_scan(_complex_scan_combine, (a_r, a_i, bu_r, bu_i), axis=1)
    y = (jnp.einsum('gcp,bsgp->bsgc', c_re.astype(jnp.float32), xr)
         - jnp.einsum('gcp,bsgp->bsgc', c_im.astype(jnp.float32), xi)
         + d_skip.astype(jnp.float32) * uf)
    y = jax.nn.gelu(y.reshape(bsz, seq, D_SSM))
    y = y * jax.nn.sigmoid(y @ w_glu.astype(jnp.float32) + b_glu.astype(jnp.float32))
    return y.astype(dtype)


def mla_group(c_q, c_kv, k_rope_raw, positions, q_a_norm, w_uq, kv_a_norm, w_ukv, q_norm, k_norm):
    bsz, seq, _ = c_q.shape
    q = (rms_norm(c_q, q_a_norm) @ w_uq).reshape(bsz, seq, N_HEADS, QK_HEAD_DIM)
    kv = (rms_norm(c_kv, kv_a_norm) @ w_ukv).reshape(bsz, seq, N_HEADS, QK_NOPE_DIM + V_HEAD_DIM)
    k_nope, v = kv[..., :QK_NOPE_DIM], kv[..., QK_NOPE_DIM:]
    k_rope = jnp.broadcast_to(k_rope_raw[:, :, None, :], (bsz, seq, N_HEADS, QK_ROPE_DIM))
    k = jnp.concatenate([k_nope, k_rope], axis=-1)
    q = rms_norm(q, q_norm)
    k = rms_norm(k, k_norm)
    q = jnp.concatenate([q[..., :QK_NOPE_DIM], apply_rope(q[..., QK_NOPE_DIM:], positions)], axis=-1)
    k = jnp.concatenate([k[..., :QK_NOPE_DIM], apply_rope(k[..., QK_NOPE_DIM:], positions)], axis=-1)
    q = q.transpose(0, 2, 1, 3)
    k = k.transpose(0, 2, 1, 3)
    v = v.transpose(0, 2, 1, 3)
    scale = QK_HEAD_DIM ** -0.5
    kpos = jnp.arange(seq)

    def attend_block(i):
        start = i * Q_BLOCK
        qb = lax.dynamic_slice_in_dim(q, start, Q_BLOCK, axis=2)
        s = jnp.einsum('bhqd,bhkd->bhqk', qb, k, preferred_element_type=jnp.float32) * scale
        qpos = start + jnp.arange(Q_BLOCK)
        s = jnp.where(kpos[None, :] <= qpos[:, None], s, -jnp.inf)
        p = jax.nn.softmax(s, axis=-1).astype(v.dtype)
        return jnp.einsum('bhqk,bhkd->bhqd', p, v)

    out = lax.map(attend_block, jnp.arange(seq // Q_BLOCK))
    return out.transpose(1, 0, 3, 2, 4).reshape(bsz, seq, N_HEADS * V_HEAD_DIM)


def peer_ffn(h, w_query, sub_keys, expert_down, expert_up):
    bsz, seq, d = h.shape
    chunks = h.reshape((bsz * seq) // TOKEN_CHUNK, TOKEN_CHUNK, d)

    def chunk_fn(hc):
        q = (hc @ w_query).reshape(TOKEN_CHUNK, PEER_HEADS, 2, PEER_HALF)
        s = jnp.einsum('thpd,pkd->thpk', q, sub_keys, preferred_element_type=jnp.float32)
        s1, i1 = lax.top_k(s[:, :, 0], PEER_TOPK)
        s2, i2 = lax.top_k(s[:, :, 1], PEER_TOPK)
        cand = (s1[..., :, None] + s2[..., None, :]).reshape(TOKEN_CHUNK, PEER_HEADS, PEER_TOPK * PEER_TOPK)
        top_s, top_c = lax.top_k(cand, PEER_TOPK)
        e1 = jnp.take_along_axis(i1, top_c // PEER_TOPK, axis=-1)
        e2 = jnp.take_along_axis(i2, top_c % PEER_TOPK, axis=-1)
        idx = e1 * PEER_N_KEYS + e2
        g = jax.nn.softmax(top_s, axis=-1).astype(hc.dtype)
        u = expert_down[idx]
        a = jax.nn.gelu(jnp.einsum('thkd,td->thk', u, hc))
        return jnp.einsum('thk,thkd->td', g * a, expert_up[idx])

    return lax.map(chunk_fn, chunks).reshape(bsz, seq, d)


def hybrid_layer(x, c, positions, w_ada, b_ada, norm_mix, norm_ffn, w_in,
                 lam_re, lam_im, log_dt, b_re, b_im, c_re, c_im, d_skip, w_glu, b_glu,
                 q_a_norm, w_uq, kv_a_norm, w_ukv, q_norm, k_norm,
                 out_norm_ssm, out_norm_attn, w_out,
                 w_query, sub_keys, expert_down, expert_up):
    mod = (jax.nn.silu(c) @ w_ada + b_ada)[:, None, :]
    shift_m, scale_m, gate_m, shift_f, scale_f, gate_f = jnp.split(mod, N_ADA, axis=-1)
    h = rms_norm(x, norm_mix) * (1.0 + scale_m) + shift_m
    proj = h @ w_in
    u_ssm, c_q, c_kv, k_rope_raw = jnp.split(
        proj, [D_SSM, D_SSM + Q_LORA_RANK, D_SSM + Q_LORA_RANK + KV_LORA_RANK], axis=-1)
    y_ssm = s5_group(u_ssm, lam_re, lam_im, log_dt, b_re, b_im, c_re, c_im, d_skip, w_glu, b_glu)
    y_attn = mla_group(c_q, c_kv, k_rope_raw, positions, q_a_norm, w_uq, kv_a_norm, w_ukv, q_norm, k_norm)
    y = jnp.concatenate([rms_norm(y_ssm, out_norm_ssm), rms_norm(y_attn, out_norm_attn)], axis=-1) @ w_out
    x = x + gate_m * y
    h2 = rms_norm(x, norm_ffn) * (1.0 + scale_f) + shift_f
    return x + gate_f * peer_ffn(h2, w_query, sub_keys, expert_down, expert_up)


def setup_inputs(seed: int = 0) -> dict:
    key = jax.random.key(seed)
    ks = jax.random.split(key, 40)
    L = DEPTH

    def nrm(k, shape, scale):
        return jax.random.normal(k, shape, jnp.float32) * scale

    def gain(k, shape):
        return 1.0 + 0.01 * jax.random.normal(k, shape, jnp.float32)

    G, P, C = N_SSM_GROUPS, SSM_STATE, SSM_GROUP
    n_idx = jnp.arange(P, dtype=jnp.float32)
    lam_im = jnp.broadcast_to(math.pi * n_idx, (L, G, P)) + 0.01 * jax.random.normal(ks[8], (L, G, P), jnp.float32)
    log_dt = jax.random.uniform(ks[9], (L, G), jnp.float32, math.log(1e-3), math.log(1e-1))
    positions = jnp.tile(jnp.arange(SEQ, dtype=jnp.int32)[None, :], (BATCH, 1))
    return {
        'x': nrm(ks[0], (BATCH, SEQ, D_MODEL), 1.0),
        'c': nrm(ks[1], (BATCH, D_MODEL), 1.0),
        'positions': positions,
        'w_ada': nrm(ks[2], (L, D_MODEL, N_ADA * D_MODEL), 0.5 * D_MODEL ** -0.5),
        'b_ada': nrm(ks[3], (L, N_ADA * D_MODEL), 0.01),
        'norm_mix': gain(ks[4], (L, D_MODEL)),
        'norm_ffn': gain(ks[5], (L, D_MODEL)),
        'w_in': nrm(ks[6], (L, D_MODEL, D_IN_PROJ), D_MODEL ** -0.5),
        'lam_re': -0.5 + 0.01 * jax.random.normal(ks[7], (L, G, P), jnp.float32),
        'lam_im': lam_im,
        'log_dt': log_dt,
        'b_re': nrm(ks[10], (L, G, P, C), C ** -0.5),
        'b_im': nrm(ks[11], (L, G, P, C), C ** -0.5),
        'c_re': nrm(ks[12], (L, G, C, P), P ** -0.5),
        'c_im': nrm(ks[13], (L, G, C, P), P ** -0.5),
        'd_skip': nrm(ks[14], (L, G, C), 1.0),
        'w_glu': nrm(ks[15], (L, D_SSM, D_SSM), D_SSM ** -0.5),
        'b_glu': nrm(ks[16], (L, D_SSM), 0.01),
        'q_a_norm': gain(ks[17], (L, Q_LORA_RANK)),
        'w_uq': nrm(ks[18], (L, Q_LORA_RANK, N_HEADS * QK_HEAD_DIM), Q_LORA_RANK ** -0.5),
        'kv_a_norm': gain(ks[19], (L, KV_LORA_RANK)),
        'w_ukv': nrm(ks[20], (L, KV_LORA_RANK, N_HEADS * (QK_NOPE_DIM + V_HEAD_DIM)), KV_LORA_RANK ** -0.5),
        'q_norm': gain(ks[21], (L, QK_HEAD_DIM)),
        'k_norm': gain(ks[22], (L, QK_HEAD_DIM)),
        'out_norm_ssm': gain(ks[23], (L, D_SSM)),
        'out_norm_attn': gain(ks[24], (L, D_ATTN)),
        'w_out': nrm(ks[25], (L, D_MIX, D_MODEL), D_MIX ** -0.5),
        'w_query': nrm(ks[26], (L, D_MODEL, PEER_HEADS * PEER_QUERY_DIM), D_MODEL ** -0.5),
        'sub_keys': nrm(ks[27], (L, 2, PEER_N_KEYS, PEER_HALF), PEER_HALF ** -0.5),
        'expert_down': nrm(ks[28], (L, PEER_N_EXPERTS, D_MODEL), D_MODEL ** -0.5),
        'expert_up': nrm(ks[29], (L, PEER_N_EXPERTS, D_MODEL), 0.5),
    }


def reference(x, c, positions, w_ada, b_ada, norm_mix, norm_ffn, w_in,
              lam_re, lam_im, log_dt, b_re, b_im, c_re, c_im, d_skip, w_glu, b_glu,
              q_a_norm, w_uq, kv_a_norm, w_ukv, q_norm, k_norm,
              out_norm_ssm, out_norm_attn, w_out,
              w_query, sub_keys, expert_down, expert_up):
    for l in range(DEPTH):
        x = hybrid_layer(x, c, positions, w_ada[l], b_ada[l], norm_mix[l], norm_ffn[l], w_in[l],
                         lam_re[l], lam_im[l], log_dt[l], b_re[l], b_im[l], c_re[l], c_im[l],
                         d_skip[l], w_glu[l], b_glu[l],
                         q_a_norm[l], w_uq[l], kv_a_norm[l], w_ukv[l], q_norm[l], k_norm[l],
                         out_norm_ssm[l], out_norm_attn[l], w_out[l],
                         w_query[l], sub_keys[l], expert_down[l], expert_up[l])
    return x
```

```cpp
#include <hip/hip_runtime.h>
#include <hip/hip_cooperative_groups.h>
#include <cstdio>
#include <cstdint>
namespace cg = cooperative_groups;

#ifndef MK_COOP
#define MK_COOP 1
#endif

typedef unsigned short bf16_t;
typedef short bf16x8 __attribute__((ext_vector_type(8)));
typedef short s16x4 __attribute__((ext_vector_type(4)));
typedef float f32x16 __attribute__((ext_vector_type(16)));
typedef float f32x4 __attribute__((ext_vector_type(4)));
typedef float f32x2 __attribute__((ext_vector_type(2)));
typedef unsigned u32x4 __attribute__((ext_vector_type(4)));
typedef unsigned u32x2 __attribute__((ext_vector_type(2)));

constexpr int NTHR = 512, NWAVE = 8;
constexpr int T_TOK = 32768, DM = 1024, NB = 16, SEQ = 2048;
constexpr int LDS_BYTES = 155648;
constexpr float EPS = 1e-6f;
constexpr float QSCALE = 0.10206207261596575f * 1.4426950408889634f;

constexpr size_t OFF_PART  = 0;
constexpr size_t OFF_MODT  = 8u << 20;
constexpr size_t OFF_WINT  = 16u << 20;
constexpr size_t OFF_WGLUT = OFF_WINT + (2u << 20);
constexpr size_t OFF_WUQT  = OFF_WGLUT + (512u << 10);
constexpr size_t OFF_WUKVT = OFF_WUQT + 393216;
constexpr size_t OFF_WOUTT = OFF_WUKVT + 262144;
constexpr size_t OFF_WQT   = OFF_WOUTT + (2u << 20);
constexpr size_t OFF_SUBK  = OFF_WQT + (4u << 20);
constexpr size_t OFF_KMT   = OFF_SUBK + 65536;
constexpr size_t OFF_WZT   = OFF_KMT + 20971520;
constexpr size_t OFF_AL    = OFF_WZT + 4194304;
constexpr size_t OFF_HBUF  = OFF_AL + 16384;
constexpr size_t OFF_PROJ2 = OFF_HBUF + (64u << 20);
constexpr size_t OFF_UBUF  = OFF_PROJ2 + (32u << 20);
constexpr size_t OFF_Q     = OFF_UBUF + 41943040;
constexpr size_t OFF_K     = OFF_Q + 50331648;
constexpr size_t OFF_VT    = OFF_K + 50331648;
constexpr size_t OFF_YBUF  = OFF_VT + 33554432;
constexpr size_t OFF_IDX   = OFF_YBUF + (32u << 20);
constexpr size_t OFF_G     = OFF_IDX + (16u << 20);
constexpr size_t OFF_ED    = OFF_G + (16u << 20);
constexpr size_t OFF_EU    = OFF_ED + (32u << 20);
constexpr size_t WS_NEED   = OFF_EU + (32u << 20);

struct Params {
    const float* x; const float* c; const int* pos; const float* w_ada; const float* b_ada; const float* norm_mix; const float* norm_ffn; const float* w_in;
    const float* lam_re; const float* lam_im; const float* log_dt; const float* b_re; const float* b_im; const float* c_re; const float* c_im; const float* d_skip;
    const float* w_glu; const float* b_glu; const float* q_a_norm; const float* w_uq; const float* kv_a_norm; const float* w_ukv; const float* q_norm; const float* k_norm;
    const float* out_norm_ssm; const float* out_norm_attn; const float* w_out; const float* w_query; const float* sub_keys; const float* e_down; const float* e_up;
    float* out; unsigned char* ws; int ph_lo, ph_hi;
};

__device__ __forceinline__ unsigned f2bf(float f) { unsigned u = __float_as_uint(f); return (u + 0x7fffu + ((u >> 16) & 1u)) >> 16; }
__device__ __forceinline__ unsigned pk2(float lo, float hi) { return f2bf(lo) | (f2bf(hi) << 16); }
__device__ __forceinline__ float bf2f(unsigned short b) { return __uint_as_float(((unsigned)b) << 16); }
__device__ __forceinline__ float bflo(unsigned w) { return __uint_as_float(w << 16); }
__device__ __forceinline__ float bfhi(unsigned w) { return __uint_as_float(w & 0xffff0000u); }
__device__ __forceinline__ int opq_s(int x) { asm volatile("" : "+s"(x)); return x; }
__device__ __forceinline__ int opq_v(int x) { asm volatile("" : "+v"(x)); return x; }
__device__ __forceinline__ int crow(int r, int hi) { return (r & 3) + 8 * (r >> 2) + 4 * hi; }
__device__ __forceinline__ float wave_sum(float v) {
#pragma unroll
    for (int o = 1; o < 64; o <<= 1) v += __shfl_xor(v, o);
    return v;
}
__device__ __forceinline__ float gelu_tanh(float x) {
    const float u = 0.7978845608028654f * (x + 0.044715f * x * x * x);
    const float t = 1.0f - 2.0f / (1.0f + __expf(2.0f * u));
    return 0.5f * x * (1.0f + t);
}
__device__ __forceinline__ float sigmoidf_(float z) { return 1.0f / (1.0f + __expf(-z)); }

constexpr int G_STR = 144;
constexpr int G_ABYTES = 128 * G_STR;
template <int NT> struct GemmCfg { static constexpr int BN = 128 * NT, BBYTES = BN * G_STR, STAGE = G_ABYTES + BBYTES; };

template <int NT, class Epi>
__device__ __forceinline__ void gemm_128(const bf16_t* __restrict__ A, int lda, const bf16_t* __restrict__ Bt, int ldb, int K, unsigned char* lds, Epi epi) {
    typedef GemmCfg<NT> C;
    const int tid = threadIdx.x, lane = tid & 63, wid = __builtin_amdgcn_readfirstlane(tid >> 6), wm = wid >> 2, wn = wid & 3, r32 = lane & 31, hi = lane >> 5;
    f32x16 acc[2][NT];
#pragma unroll
    for (int i = 0; i < 2; ++i)
#pragma unroll
        for (int j = 0; j < NT; ++j)
#pragma unroll
            for (int r = 0; r < 16; ++r) acc[i][j][r] = 0.f;
    const int prow = tid >> 3, pc = tid & 7;
    const bf16_t* ga = A + (size_t)prow * lda + pc * 8;
    const bf16_t* gb = Bt + (size_t)prow * ldb + pc * 8;
    const int ldsoff = prow * G_STR + pc * 16;
    u32x4 ra[2], rb[2 * NT];
    const int nk = K >> 6;
#pragma unroll
    for (int q = 0; q < 2; ++q) ra[q] = *(const u32x4*)(ga + (size_t)(64 * q) * lda);
#pragma unroll
    for (int q = 0; q < 2 * NT; ++q) rb[q] = *(const u32x4*)(gb + (size_t)(64 * q) * ldb);
#pragma unroll
    for (int q = 0; q < 2; ++q) *(u32x4*)(lds + ldsoff + q * 64 * G_STR) = ra[q];
#pragma unroll
    for (int q = 0; q < 2 * NT; ++q) *(u32x4*)(lds + G_ABYTES + ldsoff + q * 64 * G_STR) = rb[q];
    __syncthreads();
    for (int kt = 0; kt < nk; ++kt) {
        unsigned char* st = lds + (kt & 1) * C::STAGE;
        if (kt + 1 < nk) {
#pragma unroll
            for (int q = 0; q < 2; ++q) ra[q] = *(const u32x4*)(ga + (size_t)(64 * q) * lda + (kt + 1) * 64);
#pragma unroll
            for (int q = 0; q < 2 * NT; ++q) rb[q] = *(const u32x4*)(gb + (size_t)(64 * q) * ldb + (kt + 1) * 64);
        }
        const unsigned char* pa = st + (wm * 64 + r32) * G_STR + hi * 16;
        const unsigned char* pb = st + G_ABYTES + (wn * 32 * NT + r32) * G_STR + hi * 16;
#pragma unroll
        for (int ks = 0; ks < 4; ++ks) {
            bf16x8 af[2], bfr[NT];
#pragma unroll
            for (int i = 0; i < 2; ++i) af[i] = *(const bf16x8*)(pa + i * 32 * G_STR + ks * 32);
#pragma unroll
            for (int j = 0; j < NT; ++j) bfr[j] = *(const bf16x8*)(pb + j * 32 * G_STR + ks * 32);
#pragma unroll
            for (int i = 0; i < 2; ++i)
#pragma unroll
                for (int j = 0; j < NT; ++j) acc[i][j] = __builtin_amdgcn_mfma_f32_32x32x16_bf16(af[i], bfr[j], acc[i][j], 0, 0, 0);
        }
        if (kt + 1 < nk) {
            unsigned char* sn = lds + ((kt + 1) & 1) * C::STAGE;
#pragma unroll
            for (int q = 0; q < 2; ++q) *(u32x4*)(sn + ldsoff + q * 64 * G_STR) = ra[q];
#pragma unroll
            for (int q = 0; q < 2 * NT; ++q) *(u32x4*)(sn + G_ABYTES + ldsoff + q * 64 * G_STR) = rb[q];
        }
        __syncthreads();
    }
#pragma unroll
    for (int i = 0; i < 2; ++i)
#pragma unroll
        for (int j = 0; j < NT; ++j)
#pragma unroll
            for (int r = 0; r < 16; ++r) epi(wm * 64 + i * 32 + crow(r, hi), wn * 32 * NT + j * 32 + r32, acc[i][j][r]);
}

__device__ __forceinline__ void p0_transpose(const float* __restrict__ W, int K, int N, int Npad, bf16_t* __restrict__ WT,
                                             const float* g0, const float* g1, int gsplit, float* scr, int item) {
    const int tid = threadIdx.x;
    const int nkb = K / 64, kb = item % nkb, nb = item / nkb, k0 = kb * 64, n0 = nb * 64;
#pragma unroll
    for (int r = 0; r < 8; ++r) {
        const int kk = r * 8 + (tid >> 6), nn = tid & 63, k = k0 + kk, n = n0 + nn;
        float v = (n < N) ? W[(size_t)k * N + n] : 0.f;
        if (g0) v *= (k < gsplit) ? g0[k] : g1[k - gsplit];
        scr[kk * 65 + nn] = v;
    }
    __syncthreads();
    {
        const int n = tid >> 3, kc = tid & 7; const float* s = scr + (kc * 8) * 65 + n;
        u32x4 o; o.x = pk2(s[0], s[65]); o.y = pk2(s[2 * 65], s[3 * 65]); o.z = pk2(s[4 * 65], s[5 * 65]); o.w = pk2(s[6 * 65], s[7 * 65]);
        *(u32x4*)(WT + (size_t)(n0 + n) * K + k0 + kc * 8) = o;
    }
    __syncthreads();
}

__device__ void phase0(const Params& p, unsigned char* lds) {
    const int tid = threadIdx.x, G = gridDim.x, bid = blockIdx.x;
    unsigned char* ws = p.ws;
    float* scr = (float*)lds;
    {
        float* part = (float*)(ws + OFF_PART);
        for (int it = bid; it < 24 * 16; it += G) {
            const int nb = it % 24, ks = it / 24, n = nb * 256 + (tid & 255), bh = tid >> 8;
            for (int i = tid; i < 16 * 64; i += NTHR) { const int b = i >> 6, kk = i & 63; const float cv = p.c[b * 1024 + ks * 64 + kk]; scr[i] = cv / (1.0f + __expf(-cv)); }
            __syncthreads();
            float acc[8];
#pragma unroll
            for (int j = 0; j < 8; ++j) acc[j] = 0.f;
            for (int kk = 0; kk < 64; ++kk) {
                const float w = p.w_ada[(size_t)(ks * 64 + kk) * 6144 + n];
#pragma unroll
                for (int j = 0; j < 8; ++j) acc[j] += w * scr[(bh * 8 + j) * 64 + kk];
            }
#pragma unroll
            for (int j = 0; j < 8; ++j) part[((size_t)ks * 16 + bh * 8 + j) * 6144 + n] = acc[j];
            __syncthreads();
        }
    }
    {
        constexpr int I_IN = 16 * 16, I_GLU = 8 * 8, I_UQ = 4 * 12, I_UKV = 2 * 16, I_OUT = 16 * 16, I_Q = 16 * 32;
        constexpr int NIT = I_IN + I_GLU + I_UQ + I_UKV + I_OUT + I_Q;
        for (int it = bid; it < NIT; it += G) {
            int r = it;
            if (r < I_IN) { p0_transpose(p.w_in, 1024, 928, 1024, (bf16_t*)(ws + OFF_WINT), nullptr, nullptr, 0, scr, r); continue; } r -= I_IN;
            if (r < I_GLU) { p0_transpose(p.w_glu, 512, 512, 512, (bf16_t*)(ws + OFF_WGLUT), nullptr, nullptr, 0, scr, r); continue; } r -= I_GLU;
            if (r < I_UQ) { p0_transpose(p.w_uq, 256, 768, 768, (bf16_t*)(ws + OFF_WUQT), p.q_a_norm, p.q_a_norm, 256, scr, r); continue; } r -= I_UQ;
            if (r < I_UKV) { p0_transpose(p.w_ukv, 128, 1024, 1024, (bf16_t*)(ws + OFF_WUKVT), p.kv_a_norm, p.kv_a_norm, 128, scr, r); continue; } r -= I_UKV;
            if (r < I_OUT) { p0_transpose(p.w_out, 1024, 1024, 1024, (bf16_t*)(ws + OFF_WOUTT), p.out_norm_ssm, p.out_norm_attn, 512, scr, r); continue; } r -= I_OUT;
            p0_transpose(p.w_query, 1024, 2048, 2048, (bf16_t*)(ws + OFF_WQT), nullptr, nullptr, 0, scr, r);
        }
    }
    {
        const size_t gt = (size_t)bid * NTHR + tid, gs = (size_t)G * NTHR;
        for (size_t i = gt; i < 32768 / 8; i += gs) { const f32x4 a = ((const f32x4*)p.sub_keys)[2 * i], b = ((const f32x4*)p.sub_keys)[2 * i + 1];
            u32x4 o; o.x = pk2(a.x, a.y); o.y = pk2(a.z, a.w); o.z = pk2(b.x, b.y); o.w = pk2(b.z, b.w); ((u32x4*)(ws + OFF_SUBK))[i] = o; }
        const size_t ne = (size_t)16384 * 1024 / 8;
        for (size_t i = gt; i < ne; i += gs) { const f32x4 a = ((const f32x4*)p.e_down)[2 * i], b = ((const f32x4*)p.e_down)[2 * i + 1];
            u32x4 o; o.x = pk2(a.x, a.y); o.y = pk2(a.z, a.w); o.z = pk2(b.x, b.y); o.w = pk2(b.z, b.w); ((u32x4*)(ws + OFF_ED))[i] = o; }
        for (size_t i = gt; i < ne; i += gs) { const f32x4 a = ((const f32x4*)p.e_up)[2 * i], b = ((const f32x4*)p.e_up)[2 * i + 1];
            u32x4 o; o.x = pk2(a.x, a.y); o.y = pk2(a.z, a.w); o.z = pk2(b.x, b.y); o.w = pk2(b.z, b.w); ((u32x4*)(ws + OFF_EU))[i] = o; }
    }
    {
        f32x2* apow = (f32x2*)lds;
        f32x2* Bb = (f32x2*)(lds + 16896);
        f32x2* Cc = (f32x2*)(lds + 16896 + 8192);
        float* Kt = (float*)(lds + 16896 + 16384);
        for (int g = G - 1 - bid; g < 32; g += G) {
            if (g < 0) break;
            const float dt = __expf(p.log_dt[g]);
            for (int i = tid; i < 33 * 64; i += NTHR) { const int j = i >> 6, pp = i & 63; const float lr = p.lam_re[g * 64 + pp], li = p.lam_im[g * 64 + pp];
                const float mag = expf((float)j * lr * dt); float sn, cs; sincosf((float)j * li * dt, &sn, &cs); apow[i] = (f32x2){mag * cs, mag * sn}; }
            for (int i = tid; i < 1024; i += NTHR) { const int pp = i >> 4; const float lr = p.lam_re[g * 64 + pp], li = p.lam_im[g * 64 + pp];
                const float mag = expf(lr * dt); float sn, cs; sincosf(li * dt, &sn, &cs); const float nr = mag * cs - 1.0f, ni = mag * sn, den = lr * lr + li * li;
                const float cr = (nr * lr + ni * li) / den, ci = (ni * lr - nr * li) / den; const float br = p.b_re[(size_t)g * 1024 + i], bi = p.b_im[(size_t)g * 1024 + i];
                Bb[i] = (f32x2){cr * br - ci * bi, cr * bi + ci * br}; }
            for (int i = tid; i < 1024; i += NTHR) Cc[i] = (f32x2){p.c_re[(size_t)g * 1024 + i], p.c_im[(size_t)g * 1024 + i]};
            __syncthreads();
            for (int i = tid; i < 8192; i += NTHR) { const int j = i >> 8, co = (i >> 4) & 15, ci = i & 15; float s = 0.f;
                for (int pp = 0; pp < 64; ++pp) { const f32x2 c = Cc[co * 64 + pp], a = apow[j * 64 + pp], b = Bb[pp * 16 + ci]; const float car = c.x * a.x - c.y * a.y, cai = c.x * a.y + c.y * a.x; s += car * b.x - cai * b.y; }
                if (j == 0 && co == ci) s += p.d_skip[g * 16 + co];
                Kt[i] = s; }
            __syncthreads();
            bf16_t* KmT = (bf16_t*)(ws + OFF_KMT) + (size_t)g * 512 * 640;
            for (int q = tid; q < 512 * 80; q += NTHR) { const int n = q / 80, kc = q % 80, k0 = kc * 8, t = n >> 4, co = n & 15; float v[8];
                if (k0 < 512) { const int s = k0 >> 4, ci0 = k0 & 15;
#pragma unroll
                    for (int i = 0; i < 8; ++i) v[i] = (t >= s) ? Kt[((t - s) * 16 + co) * 16 + ci0 + i] : 0.f;
                } else { const int kk0 = k0 - 512, ri = kk0 >> 6, p0 = kk0 & 63;
#pragma unroll
                    for (int i = 0; i < 8; ++i) { const f32x2 c = Cc[co * 64 + p0 + i], a = apow[(t + 1) * 64 + p0 + i]; v[i] = (ri == 0) ? (c.x * a.x - c.y * a.y) : -(c.x * a.y + c.y * a.x); } }
                u32x4 o; o.x = pk2(v[0], v[1]); o.y = pk2(v[2], v[3]); o.z = pk2(v[4], v[5]); o.w = pk2(v[6], v[7]); *(u32x4*)(KmT + (size_t)n * 640 + k0) = o; }
            bf16_t* WzT = (bf16_t*)(ws + OFF_WZT) + (size_t)g * 128 * 512;
            for (int q = tid; q < 128 * 64; q += NTHR) { const int n = q >> 6, kc = q & 63, k0 = kc * 8, s = k0 >> 4, ci0 = k0 & 15, ri = n >> 6, pp = n & 63; float v[8];
                const f32x2 a = apow[(31 - s) * 64 + pp];
#pragma unroll
                for (int i = 0; i < 8; ++i) { const f32x2 b = Bb[pp * 16 + ci0 + i]; v[i] = (ri == 0) ? (a.x * b.x - a.y * b.y) : (a.x * b.y + a.y * b.x); }
                u32x4 o; o.x = pk2(v[0], v[1]); o.y = pk2(v[2], v[3]); o.z = pk2(v[4], v[5]); o.w = pk2(v[6], v[7]); *(u32x4*)(WzT + (size_t)n * 512 + k0) = o; }
            if (tid < 64) ((f32x2*)(ws + OFF_AL))[g * 64 + tid] = apow[32 * 64 + tid];
            __syncthreads();
        }
    }
}


__device__ __forceinline__ void finalize_row(const float* nope, const float* ra, const float* rb, float rn, const float* __restrict__ gain, const float* cs, const float* sn, bf16_t* dst) {
#pragma unroll
    for (int j = 0; j < 8; ++j) { const f32x4 a = *(const f32x4*)(nope + 8 * j), c = *(const f32x4*)(nope + 8 * j + 4);
        u32x4 o; o.x = pk2(a.x * rn * gain[8 * j], a.y * rn * gain[8 * j + 1]); o.y = pk2(a.z * rn * gain[8 * j + 2], a.w * rn * gain[8 * j + 3]);
        o.z = pk2(c.x * rn * gain[8 * j + 4], c.y * rn * gain[8 * j + 5]); o.w = pk2(c.z * rn * gain[8 * j + 6], c.w * rn * gain[8 * j + 7]); *(u32x4*)(dst + 8 * j) = o; }
#pragma unroll
    for (int j = 0; j < 2; ++j) { float o1[8], o2[8];
#pragma unroll
        for (int i = 0; i < 8; ++i) { const int f = 8 * j + i; const float x1 = ra[f] * rn * gain[64 + f], x2 = rb[f] * rn * gain[80 + f]; o1[i] = x1 * cs[f] - x2 * sn[f]; o2[i] = x2 * cs[f] + x1 * sn[f]; }
        u32x4 o; o.x = pk2(o1[0], o1[1]); o.y = pk2(o1[2], o1[3]); o.z = pk2(o1[4], o1[5]); o.w = pk2(o1[6], o1[7]); *(u32x4*)(dst + 64 + 8 * j) = o;
        o.x = pk2(o2[0], o2[1]); o.y = pk2(o2[2], o2[3]); o.z = pk2(o2[4], o2[5]); o.w = pk2(o2[6], o2[7]); *(u32x4*)(dst + 80 + 8 * j) = o; }
}
constexpr int LX_OFF = 114688;

__device__ void phase1(const Params& p, unsigned char* lds) {
    const int tid = threadIdx.x, lane = tid & 63, wid = __builtin_amdgcn_readfirstlane(tid >> 6);
    unsigned char* ws = p.ws;
    bf16_t* hbuf = (bf16_t*)(ws + OFF_HBUF); bf16_t* proj2 = (bf16_t*)(ws + OFF_PROJ2); bf16_t* ubuf = (bf16_t*)(ws + OFF_UBUF);
    float* rsq = (float*)(lds + LX_OFF); float* rskv = rsq + 128; float* cst = rskv + 128; float* snt = cst + 2048;
    for (int tile = blockIdx.x; tile < 256; tile += gridDim.x) {
        const int row0_ = tile * 128; const int row0 = row0_, b = row0 >> 11;
        float* scr = p.out + (size_t)row0 * 1024;
        float* mod = (float*)(ws + OFF_MODT) + (size_t)tile * 6144 - (size_t)b * 6144;
        for (int i = tid; i < 6144; i += NTHR) { float s = p.b_ada[i]; const float* pp = (const float*)(ws + OFF_PART) + (size_t)b * 6144 + i;
            for (int ks = 0; ks < 16; ++ks) s += pp[(size_t)ks * 16 * 6144]; mod[b * 6144 + i] = s; }
        __threadfence_block(); __syncthreads();
        for (int r = wid; r < 128; r += NWAVE) {
            const f32x4* xr = (const f32x4*)(p.x + (size_t)(row0 + r) * 1024); f32x4 v[4]; float ss = 0.f;
#pragma unroll
            for (int j = 0; j < 4; ++j) { v[j] = xr[lane + 64 * j]; ss += v[j].x * v[j].x + v[j].y * v[j].y + v[j].z * v[j].z + v[j].w * v[j].w; }
            const float rs = rsqrtf(wave_sum(ss) * (1.0f / 1024.0f) + EPS);
#pragma unroll
            for (int j = 0; j < 4; ++j) { const int col = 4 * (lane + 64 * j);
                const f32x4 g = *(const f32x4*)(p.norm_mix + col), sc = *(const f32x4*)(mod + b * 6144 + 1024 + col), sh = *(const f32x4*)(mod + b * 6144 + col);
                u32x2 o; o.x = pk2(v[j].x * rs * g.x * (1.f + sc.x) + sh.x, v[j].y * rs * g.y * (1.f + sc.y) + sh.y); o.y = pk2(v[j].z * rs * g.z * (1.f + sc.z) + sh.z, v[j].w * rs * g.w * (1.f + sc.w) + sh.w);
                *(u32x2*)(hbuf + (size_t)(row0 + r) * 1024 + col) = o; }
        }
        for (int i = tid; i < 2048; i += NTHR) { const int r = i >> 4, f = i & 15; const float ang = (float)p.pos[row0 + r] * exp2f(-(float)f * (13.287712379549449f / 16.0f));
            float sn, cs; sincosf(ang, &sn, &cs); cst[i] = cs; snt[i] = sn; }
        __threadfence_block(); __syncthreads();
        for (int nc = 0; nc < 4; ++nc) {
            const bf16_t* Bt = (const bf16_t*)(ws + OFF_WINT) + (size_t)nc * 256 * 1024;
            if (nc < 2) gemm_128<2>(hbuf + (size_t)row0 * 1024, 1024, Bt, 1024, 1024, lds, [&](int row, int col, float v) {
                    const int cg_ = nc * 256 + col, g = cg_ >> 4, ci = cg_ & 15, tok = row0 + row;
                    ubuf[((size_t)g * 1024 + (tok >> 5)) * 640 + (tok & 31) * 16 + ci] = (bf16_t)f2bf(v); });
            else gemm_128<2>(hbuf + (size_t)row0 * 1024, 1024, Bt, 1024, 1024, lds, [&](int row, int col, float v) {
                    proj2[(size_t)(row0 + row) * 512 + (nc - 2) * 256 + col] = (bf16_t)f2bf(v); });
        }
        __threadfence_block(); __syncthreads();
        for (int r = wid; r < 128; r += NWAVE) {
            const u32x4 w = *(const u32x4*)(proj2 + (size_t)(row0 + r) * 512 + lane * 8);
            float ss = bflo(w.x) * bflo(w.x) + bfhi(w.x) * bfhi(w.x) + bflo(w.y) * bflo(w.y) + bfhi(w.y) * bfhi(w.y) + bflo(w.z) * bflo(w.z) + bfhi(w.z) * bfhi(w.z) + bflo(w.w) * bflo(w.w) + bfhi(w.w) * bfhi(w.w);
            const float sq = wave_sum(lane < 32 ? ss : 0.f), skv = wave_sum((lane >= 32 && lane < 48) ? ss : 0.f);
            if (lane == 0) { rsq[r] = rsqrtf(sq * (1.0f / 256.0f) + EPS); rskv[r] = rsqrtf(skv * (1.0f / 128.0f) + EPS); }
        }
        __syncthreads();
        for (int nc = 0; nc < 3; ++nc)
            gemm_128<2>(proj2 + (size_t)row0 * 512, 512, (const bf16_t*)(ws + OFF_WUQT) + (size_t)nc * 256 * 256, 256, 256, lds, [&](int row, int col, float v) { scr[row * 1024 + nc * 256 + col] = v * rsq[row]; });
        __threadfence_block(); __syncthreads();
#pragma unroll 1
        for (int it = 0; it < 2; ++it) {
            const int pair = opq_v(tid) + NTHR * it, row = pair >> 3, h = pair & 7; const int row0 = opq_s(row0_); const float* q = p.out + (size_t)row0 * 1024 + row * 1024 + h * 96; float ss = 0.f;
#pragma unroll
            for (int j = 0; j < 24; ++j) { const f32x4 t4 = *(const f32x4*)(q + 4 * j); ss += t4.x * t4.x + t4.y * t4.y + t4.z * t4.z + t4.w * t4.w; }
            const float rn = rsqrtf(ss * (1.0f / 96.0f) + EPS) * QSCALE;
            bf16_t* dst = (bf16_t*)(ws + OFF_Q) + ((size_t)(b * 8 + h) * 2048 + ((row0 + row) & 2047)) * 96;
            finalize_row(q, q + 64, q + 80, rn, p.q_norm, cst + row * 16, snt + row * 16, dst);
        }
        __syncthreads();
        for (int nc = 0; nc < 4; ++nc)
            gemm_128<2>(proj2 + (size_t)row0 * 512 + 256, 512, (const bf16_t*)(ws + OFF_WUKVT) + (size_t)nc * 256 * 128, 128, 128, lds, [&](int row, int col, float v) { scr[row * 1024 + nc * 256 + col] = v * rskv[row]; });
        __threadfence_block(); __syncthreads();
#pragma unroll 1
        for (int it = 0; it < 2; ++it) {
            const int pair = opq_v(tid) + NTHR * it, row = pair >> 3, h = pair & 7; const int row0 = opq_s(row0_); const float* kp = p.out + (size_t)row0 * 1024 + row * 1024 + h * 128; float ss = 0.f; float rp[32];
#pragma unroll
            for (int j = 0; j < 16; ++j) { const f32x4 t4 = *(const f32x4*)(kp + 4 * j); ss += t4.x * t4.x + t4.y * t4.y + t4.z * t4.z + t4.w * t4.w; }
#pragma unroll
            for (int j = 0; j < 4; ++j) { const u32x4 w = *(const u32x4*)(proj2 + (size_t)(row0 + row) * 512 + 384 + 8 * j);
                rp[8 * j] = bflo(w.x); rp[8 * j + 1] = bfhi(w.x); rp[8 * j + 2] = bflo(w.y); rp[8 * j + 3] = bfhi(w.y); rp[8 * j + 4] = bflo(w.z); rp[8 * j + 5] = bfhi(w.z); rp[8 * j + 6] = bflo(w.w); rp[8 * j + 7] = bfhi(w.w); }
#pragma unroll
            for (int d = 0; d < 32; ++d) ss += rp[d] * rp[d];
            const float rn = rsqrtf(ss * (1.0f / 96.0f) + EPS);
            bf16_t* dst = (bf16_t*)(ws + OFF_K) + ((size_t)(b * 8 + h) * 2048 + ((row0 + row) & 2047)) * 96;
            finalize_row(kp, rp, rp + 16, rn, p.k_norm, cst + row * 16, snt + row * 16, dst);
        }
        {
            const int tv = opq_v(tid), h = tv >> 6, d = tv & 63; const int row0 = opq_s(row0_); const float* scr = p.out + (size_t)row0 * 1024; bf16_t* dst = (bf16_t*)(ws + OFF_VT) + ((size_t)((row0 >> 11) * 8 + h) * 64 + d) * 2048 + (row0 & 2047);
#pragma unroll 1
            for (int r8 = 0; r8 < 16; ++r8) { float v[8];
#pragma unroll
                for (int i = 0; i < 8; ++i) v[i] = scr[(r8 * 8 + i) * 1024 + h * 128 + 64 + d];
                u32x4 o; o.x = pk2(v[0], v[1]); o.y = pk2(v[2], v[3]); o.z = pk2(v[4], v[5]); o.w = pk2(v[6], v[7]); *(u32x4*)(dst + r8 * 8) = o; }
        }
        __syncthreads();
    }
}

__device__ void s5_item(const Params& p, unsigned char* lds, int g, int bp) {
    const int tid = threadIdx.x;
    unsigned char* ws = p.ws;
    bf16_t* A = (bf16_t*)(ws + OFF_UBUF) + ((size_t)g * 1024 + bp * 128) * 640;
    float* Z = (float*)(lds + 73728);
    gemm_128<1>(A, 640, (const bf16_t*)(ws + OFF_WZT) + (size_t)g * 128 * 512, 512, 512, lds, [&](int row, int col, float v) { Z[row * 129 + col] = v; });
    __syncthreads();
    if (tid < 128) {
        const int bs = tid >> 6, pp = tid & 63; const f32x2 aL = ((const f32x2*)(ws + OFF_AL))[g * 64 + pp]; float xr = 0.f, xi = 0.f;
        for (int k = 0; k < 64; ++k) { const int row = bs * 64 + k; bf16_t* xin = A + (size_t)row * 640 + 512;
            xin[pp] = (bf16_t)f2bf(xr); xin[64 + pp] = (bf16_t)f2bf(xi);
            const float zr = Z[row * 129 + pp], zi = Z[row * 129 + 64 + pp], nr = aL.x * xr - aL.y * xi + zr, ni = aL.x * xi + aL.y * xr + zi; xr = nr; xi = ni; }
    }
    __threadfence_block(); __syncthreads();
    bf16_t* ybuf = (bf16_t*)(ws + OFF_YBUF);
    for (int nc = 0; nc < 2; ++nc)
        gemm_128<2>(A, 640, (const bf16_t*)(ws + OFF_KMT) + ((size_t)g * 512 + nc * 256) * 640, 640, 640, lds, [&](int row, int col, float v) {
            const int n = nc * 256 + col, t = n >> 4, co = n & 15; const size_t tok = (size_t)(bp * 128 + row) * 32 + t;
            ybuf[tok * 512 + g * 16 + co] = (bf16_t)f2bf(gelu_tanh(v)); });
    __syncthreads();
}

constexpr int AT_KSTR = 208, AT_VSTR = 136, AT_KB = 64 * AT_KSTR, AT_VB = 64 * AT_VSTR, AT_STAGE = AT_KB + AT_VB;

__device__ void attn_item(const Params& p, unsigned char* lds, int bh, int qb) {
    const int tid = threadIdx.x, lane = tid & 63, wid = __builtin_amdgcn_readfirstlane(tid >> 6), r32 = lane & 31, hi = lane >> 5;
    unsigned char* ws = p.ws;
    const int q0 = qb * 256, qw0 = q0 + wid * 32, qg = qw0 + r32;
    const bf16_t* Qp = (const bf16_t*)(ws + OFF_Q) + ((size_t)bh * 2048 + qw0) * 96;
    const bf16_t* Kp = (const bf16_t*)(ws + OFF_K) + (size_t)bh * 2048 * 96;
    const bf16_t* Vp = (const bf16_t*)(ws + OFF_VT) + (size_t)bh * 64 * 2048;
    bf16x8 qf[6];
#pragma unroll
    for (int ks = 0; ks < 6; ++ks) qf[ks] = *(const bf16x8*)(Qp + r32 * 96 + ks * 16 + hi * 8);
    f32x16 ot[2];
#pragma unroll
    for (int r = 0; r < 16; ++r) { ot[0][r] = 0.f; ot[1][r] = 0.f; }
    float m = -INFINITY, l = 0.f;
    const int nkv = (q0 + 256) / 64;
    const int kr0 = tid / 12, kc0 = tid % 12, kr1 = (tid + 512) / 12, kc1 = (tid + 512) % 12; const bool k2 = tid < 256;
    const int vd = tid >> 3, vc = tid & 7;
    u32x4 rk0, rk1, rv;
    rk0 = *(const u32x4*)(Kp + (size_t)kr0 * 96 + kc0 * 8); if (k2) rk1 = *(const u32x4*)(Kp + (size_t)kr1 * 96 + kc1 * 8);
    rv = *(const u32x4*)(Vp + (size_t)vd * 2048 + vc * 8);
    *(u32x4*)(lds + kr0 * AT_KSTR + kc0 * 16) = rk0; if (k2) *(u32x4*)(lds + kr1 * AT_KSTR + kc1 * 16) = rk1;
    { u32x2* d = (u32x2*)(lds + AT_KB + vd * AT_VSTR + vc * 16); d[0] = (u32x2){rv.x, rv.y}; d[1] = (u32x2){rv.z, rv.w}; }
    __syncthreads();
    for (int t = 0; t < nkv; ++t) {
        const unsigned char* st = lds + (t & 1) * AT_STAGE; const int kv0 = t * 64;
        if (t + 1 < nkv) {
            const int kn = kv0 + 64;
            rk0 = *(const u32x4*)(Kp + (size_t)(kn + kr0) * 96 + kc0 * 8); if (k2) rk1 = *(const u32x4*)(Kp + (size_t)(kn + kr1) * 96 + kc1 * 8);
            rv = *(const u32x4*)(Vp + (size_t)vd * 2048 + kn + vc * 8);
        }
        if (kv0 <= qw0 + 31) {
            f32x16 s0, s1;
#pragma unroll
            for (int r = 0; r < 16; ++r) { s0[r] = 0.f; s1[r] = 0.f; }
#pragma unroll
            for (int ks = 0; ks < 6; ++ks) {
                const bf16x8 k0f = *(const bf16x8*)(st + r32 * AT_KSTR + ks * 32 + hi * 16);
                const bf16x8 k1f = *(const bf16x8*)(st + (32 + r32) * AT_KSTR + ks * 32 + hi * 16);
                s0 = __builtin_amdgcn_mfma_f32_32x32x16_bf16(k0f, qf[ks], s0, 0, 0, 0);
                s1 = __builtin_amdgcn_mfma_f32_32x32x16_bf16(k1f, qf[ks], s1, 0, 0, 0);
            }
            if (kv0 + 63 > qw0) {
#pragma unroll
                for (int r = 0; r < 16; ++r) { const int key = kv0 + crow(r, hi); if (key > qg) s0[r] = -INFINITY; if (key + 32 > qg) s1[r] = -INFINITY; }
            }
            float mx = fmaxf(s0[0], s1[0]);
#pragma unroll
            for (int r = 1; r < 16; ++r) mx = fmaxf(mx, fmaxf(s0[r], s1[r]));
            mx = fmaxf(mx, __shfl_xor(mx, 32));
            const float mn = fmaxf(m, mx), alpha = __builtin_amdgcn_exp2f(m - mn);
            float ps = 0.f;
#pragma unroll
            for (int r = 0; r < 16; ++r) { s0[r] = __builtin_amdgcn_exp2f(s0[r] - mn); s1[r] = __builtin_amdgcn_exp2f(s1[r] - mn); ps += s0[r] + s1[r]; }
            l = l * alpha + ps; m = mn;
#pragma unroll
            for (int r = 0; r < 16; ++r) { ot[0][r] *= alpha; ot[1][r] *= alpha; }
            const unsigned char* vb = st + AT_KB + r32 * AT_VSTR + hi * 8;
#pragma unroll
            for (int kt2 = 0; kt2 < 2; ++kt2)
#pragma unroll
                for (int s = 0; s < 2; ++s) {
                    u32x4 pw;
                    if (kt2 == 0) { pw.x = pk2(s0[8 * s], s0[8 * s + 1]); pw.y = pk2(s0[8 * s + 2], s0[8 * s + 3]); pw.z = pk2(s0[8 * s + 4], s0[8 * s + 5]); pw.w = pk2(s0[8 * s + 6], s0[8 * s + 7]); }
                    else { pw.x = pk2(s1[8 * s], s1[8 * s + 1]); pw.y = pk2(s1[8 * s + 2], s1[8 * s + 3]); pw.z = pk2(s1[8 * s + 4], s1[8 * s + 5]); pw.w = pk2(s1[8 * s + 6], s1[8 * s + 7]); }
                    const bf16x8 pf = __builtin_bit_cast(bf16x8, pw);
#pragma unroll
                    for (int dt = 0; dt < 2; ++dt) {
                        const unsigned char* a = vb + dt * 32 * AT_VSTR + (kt2 * 32 + 16 * s) * 2;
                        const u32x2 lo = *(const u32x2*)a, hh = *(const u32x2*)(a + 16);
                        const bf16x8 vf = __builtin_bit_cast(bf16x8, (u32x4){lo.x, lo.y, hh.x, hh.y});
                        ot[dt] = __builtin_amdgcn_mfma_f32_32x32x16_bf16(vf, pf, ot[dt], 0, 0, 0);
                    }
                }
        }
        if (t + 1 < nkv) {
            unsigned char* sn = lds + ((t + 1) & 1) * AT_STAGE;
            *(u32x4*)(sn + kr0 * AT_KSTR + kc0 * 16) = rk0; if (k2) *(u32x4*)(sn + kr1 * AT_KSTR + kc1 * 16) = rk1;
            u32x2* d = (u32x2*)(sn + AT_KB + vd * AT_VSTR + vc * 16); d[0] = (u32x2){rv.x, rv.y}; d[1] = (u32x2){rv.z, rv.w};
        }
        __syncthreads();
    }
    l += __shfl_xor(l, 32);
    const float inv = 1.0f / l;
    bf16_t* dst = (bf16_t*)(ws + OFF_HBUF) + ((size_t)(bh >> 3) * 2048 + qg) * 1024 + 512 + (bh & 7) * 64;
#pragma unroll
    for (int dt = 0; dt < 2; ++dt)
#pragma unroll
        for (int g4 = 0; g4 < 4; ++g4) { u32x2 o; o.x = pk2(ot[dt][4 * g4] * inv, ot[dt][4 * g4 + 1] * inv); o.y = pk2(ot[dt][4 * g4 + 2] * inv, ot[dt][4 * g4 + 3] * inv);
            *(u32x2*)(dst + dt * 32 + 8 * g4 + 4 * hi) = o; }
}

__device__ void phase2(const Params& p, unsigned char* lds) {
    for (int it = blockIdx.x; it < 256; it += gridDim.x) s5_item(p, lds, it >> 3, it & 7);
    for (int v = blockIdx.x; v < 256; v += gridDim.x) {
        const int bh = v >> 1;
        for (int i = 0; i < 4; ++i) { const int qb = (v & 1) ? ((i == 0) ? 6 : (i == 1) ? 1 : (i == 2) ? 5 : 2) : ((i == 0) ? 7 : (i == 1) ? 0 : (i == 2) ? 4 : 3); attn_item(p, lds, bh, qb); }
    }
}

__device__ __forceinline__ void cex_desc(float& a, float& b) { const float mx = fmaxf(a, b), mn = fminf(a, b); a = mx; b = mn; }
__device__ __forceinline__ void sort16_desc(float (&v)[16]) {
#pragma unroll
    for (int k = 2; k <= 16; k <<= 1)
#pragma unroll
        for (int j = k >> 1; j > 0; j >>= 1)
#pragma unroll
            for (int i = 0; i < 16; ++i) { const int l = i ^ j; if (l > i) { if ((i & k) == 0) cex_desc(v[i], v[l]); else cex_desc(v[l], v[i]); } }
}
__device__ __forceinline__ void merge16(float (&top)[16], const float (&c)[16]) {
#pragma unroll
    for (int i = 0; i < 16; ++i) top[i] = fmaxf(top[i], c[15 - i]);
#pragma unroll
    for (int j = 8; j > 0; j >>= 1)
#pragma unroll
        for (int i = 0; i < 16; ++i) { const int l = i ^ j; if (l > i) cex_desc(top[i], top[l]); }
}
__device__ __forceinline__ float mkc(float a, float b, unsigned code) { return __uint_as_float((__float_as_uint(a + b) & 0xFFFFFF00u) | code); }

constexpr int QP_STR = 528, S_OFF = 128 * QP_STR, S_STR = 132, L_OFF = S_OFF + 128 * S_STR * 4;

__device__ void phase3(const Params& p, unsigned char* lds) {
    const int tid = threadIdx.x, lane = tid & 63, wid = __builtin_amdgcn_readfirstlane(tid >> 6), r32 = lane & 31, hi = lane >> 5, wm = wid >> 2, wn = wid & 3;
    unsigned char* ws = p.ws;
    bf16_t* hbuf = (bf16_t*)(ws + OFF_HBUF); const bf16_t* ybuf = (const bf16_t*)(ws + OFF_YBUF);
    int* idxb = (int*)(ws + OFF_IDX); float* gb = (float*)(ws + OFF_G);
    for (int tile = blockIdx.x; tile < 256; tile += gridDim.x) {
        const int row0 = tile * 128, b = row0 >> 11;
        const float* mod = (const float*)(ws + OFF_MODT) + (size_t)tile * 6144 - (size_t)b * 6144;
        for (int nc = 0; nc < 2; ++nc)
            gemm_128<2>(ybuf + (size_t)row0 * 512, 512, (const bf16_t*)(ws + OFF_WGLUT) + (size_t)nc * 256 * 512, 512, 512, lds, [&](int row, int col, float v) {
                const int c = nc * 256 + col; const float yv = bf2f(ybuf[(size_t)(row0 + row) * 512 + c]);
                hbuf[(size_t)(row0 + row) * 1024 + c] = (bf16_t)f2bf(yv * sigmoidf_(v + p.b_glu[c])); });
        __threadfence_block(); __syncthreads();
        for (int r = wid; r < 128; r += NWAVE) {
            bf16_t* hr = hbuf + (size_t)(row0 + r) * 1024;
#pragma unroll
            for (int half = 0; half < 2; ++half) {
                u32x4 w = *(const u32x4*)(hr + half * 512 + lane * 8); float v[8] = {bflo(w.x), bfhi(w.x), bflo(w.y), bfhi(w.y), bflo(w.z), bfhi(w.z), bflo(w.w), bfhi(w.w)}; float ss = 0.f;
#pragma unroll
                for (int i = 0; i < 8; ++i) ss += v[i] * v[i];
                const float rs = rsqrtf(wave_sum(ss) * (1.0f / 512.0f) + EPS);
                w.x = pk2(v[0] * rs, v[1] * rs); w.y = pk2(v[2] * rs, v[3] * rs); w.z = pk2(v[4] * rs, v[5] * rs); w.w = pk2(v[6] * rs, v[7] * rs);
                *(u32x4*)(hr + half * 512 + lane * 8) = w;
            }
        }
        __threadfence_block(); __syncthreads();
        for (int nc = 0; nc < 4; ++nc)
            gemm_128<2>(hbuf + (size_t)row0 * 1024, 1024, (const bf16_t*)(ws + OFF_WOUTT) + (size_t)nc * 256 * 1024, 1024, 1024, lds, [&](int row, int col, float v) {
                const int c = nc * 256 + col; const size_t o = (size_t)(row0 + row) * 1024 + c; p.out[o] = p.x[o] + mod[b * 6144 + 2048 + c] * v; });
        __threadfence_block(); __syncthreads();
        for (int r = wid; r < 128; r += NWAVE) {
            const f32x4* xr = (const f32x4*)(p.out + (size_t)(row0 + r) * 1024); f32x4 v[4]; float ss = 0.f;
#pragma unroll
            for (int j = 0; j < 4; ++j) { v[j] = xr[lane + 64 * j]; ss += v[j].x * v[j].x + v[j].y * v[j].y + v[j].z * v[j].z + v[j].w * v[j].w; }
            const float rs = rsqrtf(wave_sum(ss) * (1.0f / 1024.0f) + EPS);
#pragma unroll
            for (int j = 0; j < 4; ++j) { const int col = 4 * (lane + 64 * j);
                const f32x4 g = *(const f32x4*)(p.norm_ffn + col), sc = *(const f32x4*)(mod + b * 6144 + 4096 + col), sh = *(const f32x4*)(mod + b * 6144 + 3072 + col);
                u32x2 o; o.x = pk2(v[j].x * rs * g.x * (1.f + sc.x) + sh.x, v[j].y * rs * g.y * (1.f + sc.y) + sh.y); o.y = pk2(v[j].z * rs * g.z * (1.f + sc.z) + sh.z, v[j].w * rs * g.w * (1.f + sc.w) + sh.w);
                *(u32x2*)(hbuf + (size_t)(row0 + r) * 1024 + col) = o; }
        }
        __threadfence_block(); __syncthreads();
        float* Sx = (float*)(lds + S_OFF); float* Ls = (float*)(lds + L_OFF);
        for (int h = 0; h < 8; ++h) {
            gemm_128<2>(hbuf + (size_t)row0 * 1024, 1024, (const bf16_t*)(ws + OFF_WQT) + (size_t)h * 256 * 1024, 1024, 1024, lds, [&](int row, int col, float v) {
                *(bf16_t*)(lds + row * QP_STR + col * 2) = (bf16_t)f2bf(v); });
            __syncthreads();
            for (int ph = 0; ph < 2; ++ph) {
                f32x16 a0, a1;
#pragma unroll
                for (int r = 0; r < 16; ++r) { a0[r] = 0.f; a1[r] = 0.f; }
                const bf16_t* sk = (const bf16_t*)(ws + OFF_SUBK) + ((size_t)ph * 128 + wn * 32 + r32) * 128 + hi * 8;
                const unsigned char* qa = lds + (wm * 64 + r32) * QP_STR + (ph * 128 + hi * 8) * 2;
#pragma unroll
                for (int ks = 0; ks < 8; ++ks) {
                    const bf16x8 bfr = *(const bf16x8*)(sk + ks * 16);
                    const bf16x8 f0 = *(const bf16x8*)(qa + ks * 32), f1 = *(const bf16x8*)(qa + 32 * QP_STR + ks * 32);
                    a0 = __builtin_amdgcn_mfma_f32_32x32x16_bf16(f0, bfr, a0, 0, 0, 0);
                    a1 = __builtin_amdgcn_mfma_f32_32x32x16_bf16(f1, bfr, a1, 0, 0, 0);
                }
#pragma unroll
                for (int r = 0; r < 16; ++r) { Sx[(wm * 64 + crow(r, hi)) * S_STR + wn * 32 + r32] = a0[r]; Sx[(wm * 64 + 32 + crow(r, hi)) * S_STR + wn * 32 + r32] = a1[r]; }
                __syncthreads();
                if (wid < 2) {
                    const int row = wid * 64 + lane; float top[16];
#pragma unroll
                    for (int c8 = 0; c8 < 8; ++c8) { float c[16];
#pragma unroll
                        for (int q = 0; q < 4; ++q) { const f32x4 t4 = *(const f32x4*)(Sx + row * S_STR + c8 * 16 + q * 4);
                            c[4 * q] = __uint_as_float((__float_as_uint(t4.x) & 0xFFFFFF80u) | (unsigned)(127 - (c8 * 16 + 4 * q)));
                            c[4 * q + 1] = __uint_as_float((__float_as_uint(t4.y) & 0xFFFFFF80u) | (unsigned)(127 - (c8 * 16 + 4 * q + 1)));
                            c[4 * q + 2] = __uint_as_float((__float_as_uint(t4.z) & 0xFFFFFF80u) | (unsigned)(127 - (c8 * 16 + 4 * q + 2)));
                            c[4 * q + 3] = __uint_as_float((__float_as_uint(t4.w) & 0xFFFFFF80u) | (unsigned)(127 - (c8 * 16 + 4 * q + 3))); }
                        sort16_desc(c);
                        if (c8 == 0) {
#pragma unroll
                            for (int k = 0; k < 16; ++k) top[k] = c[k];
                        } else merge16(top, c); }
#pragma unroll
                    for (int q = 0; q < 4; ++q) *(f32x4*)(Ls + (ph * 128 + row) * 16 + 4 * q) = (f32x4){top[4 * q], top[4 * q + 1], top[4 * q + 2], top[4 * q + 3]};
                }
                __syncthreads();
            }
            if (wid < 2) {
                const int row = wid * 64 + lane; float a1[16], a2[16], top[16];
#pragma unroll
                for (int k = 0; k < 16; ++k) { a1[k] = __uint_as_float(__float_as_uint(Ls[row * 16 + k]) & 0xFFFFFF80u); a2[k] = __uint_as_float(__float_as_uint(Ls[(128 + row) * 16 + k]) & 0xFFFFFF80u); }
    { float c[16];
      c[0] = mkc(a1[0], a2[0], 255u);
      c[1] = mkc(a1[0], a2[1], 254u);
      c[2] = mkc(a1[0], a2[2], 253u);
      c[3] = mkc(a1[0], a2[3], 252u);
      c[4] = mkc(a1[0], a2[4], 251u);
      c[5] = mkc(a1[0], a2[5], 250u);
      c[6] = mkc(a1[0], a2[6], 249u);
      c[7] = mkc(a1[0], a2[7], 248u);
      c[8] = mkc(a1[0], a2[8], 247u);
      c[9] = mkc(a1[0], a2[9], 246u);
      c[10] = mkc(a1[0], a2[10], 245u);
      c[11] = mkc(a1[0], a2[11], 244u);
      c[12] = mkc(a1[0], a2[12], 243u);
      c[13] = mkc(a1[0], a2[13], 242u);
      c[14] = mkc(a1[0], a2[14], 241u);
      c[15] = mkc(a1[0], a2[15], 240u);
      sort16_desc(c); _Pragma("unroll") for (int k = 0; k < 16; ++k) top[k] = c[k];
    }
    { float c[16];
      c[0] = mkc(a1[1], a2[0], 239u);
      c[1] = mkc(a1[1], a2[1], 238u);
      c[2] = mkc(a1[1], a2[2], 237u);
      c[3] = mkc(a1[1], a2[3], 236u);
      c[4] = mkc(a1[1], a2[4], 235u);
      c[5] = mkc(a1[1], a2[5], 234u);
      c[6] = mkc(a1[1], a2[6], 233u);
      c[7] = mkc(a1[1], a2[7], 232u);
      c[8] = mkc(a1[2], a2[0], 223u);
      c[9] = mkc(a1[2], a2[1], 222u);
      c[10] = mkc(a1[2], a2[2], 221u);
      c[11] = mkc(a1[2], a2[3], 220u);
      c[12] = mkc(a1[2], a2[4], 219u);
      c[13] = mkc(a1[3], a2[0], 207u);
      c[14] = mkc(a1[3], a2[1], 206u);
      c[15] = mkc(a1[3], a2[2], 205u);
      sort16_desc(c); merge16(top, c);
    }
    { float c[16];
      c[0] = mkc(a1[3], a2[3], 204u);
      c[1] = mkc(a1[4], a2[0], 191u);
      c[2] = mkc(a1[4], a2[1], 190u);
      c[3] = mkc(a1[4], a2[2], 189u);
      c[4] = mkc(a1[5], a2[0], 175u);
      c[5] = mkc(a1[5], a2[1], 174u);
      c[6] = mkc(a1[6], a2[0], 159u);
      c[7] = mkc(a1[6], a2[1], 158u);
      c[8] = mkc(a1[7], a2[0], 143u);
      c[9] = mkc(a1[7], a2[1], 142u);
      c[10] = mkc(a1[8], a2[0], 127u);
      c[11] = mkc(a1[9], a2[0], 111u);
      c[12] = mkc(a1[10], a2[0], 95u);
      c[13] = mkc(a1[11], a2[0], 79u);
      c[14] = mkc(a1[12], a2[0], 63u);
      c[15] = mkc(a1[13], a2[0], 47u);
      sort16_desc(c); merge16(top, c);
    }
    { float c[16];
      c[0] = mkc(a1[14], a2[0], 31u);
      c[1] = mkc(a1[15], a2[0], 15u);
      c[2] = -3.0e38f;
      c[3] = -3.0e38f;
      c[4] = -3.0e38f;
      c[5] = -3.0e38f;
      c[6] = -3.0e38f;
      c[7] = -3.0e38f;
      c[8] = -3.0e38f;
      c[9] = -3.0e38f;
      c[10] = -3.0e38f;
      c[11] = -3.0e38f;
      c[12] = -3.0e38f;
      c[13] = -3.0e38f;
      c[14] = -3.0e38f;
      c[15] = -3.0e38f;
      sort16_desc(c); merge16(top, c);
    }
                float e[16], es = 0.f; const float m0 = __uint_as_float(__float_as_uint(top[0]) & 0xFFFFFF00u);
#pragma unroll
                for (int k = 0; k < 16; ++k) { e[k] = __expf(__uint_as_float(__float_as_uint(top[k]) & 0xFFFFFF00u) - m0); es += e[k]; }
                const float inv = 1.0f / es; const size_t ob = (size_t)(row0 + row) * 128 + h * 16;
#pragma unroll
                for (int k = 0; k < 16; ++k) { const unsigned code = 255u - (__float_as_uint(top[k]) & 0xFFu); const int i = code >> 4, j = code & 15;
                    const int i1 = 127 - (int)(__float_as_uint(Ls[row * 16 + i]) & 0x7Fu), i2 = 127 - (int)(__float_as_uint(Ls[(128 + row) * 16 + j]) & 0x7Fu);
                    idxb[ob + k] = i1 * 128 + i2; gb[ob + k] = e[k] * inv; }
            }
            __syncthreads();
        }
        __threadfence_block(); __syncthreads();
        for (int r = wid; r < 128; r += NWAVE) {
            const size_t tok = row0 + r; float hv[16], acc[16];
            { const u32x4 w0 = *(const u32x4*)(hbuf + tok * 1024 + lane * 8), w1 = *(const u32x4*)(hbuf + tok * 1024 + 512 + lane * 8);
              hv[0] = bflo(w0.x); hv[1] = bfhi(w0.x); hv[2] = bflo(w0.y); hv[3] = bfhi(w0.y); hv[4] = bflo(w0.z); hv[5] = bfhi(w0.z); hv[6] = bflo(w0.w); hv[7] = bfhi(w0.w);
              hv[8] = bflo(w1.x); hv[9] = bfhi(w1.x); hv[10] = bflo(w1.y); hv[11] = bfhi(w1.y); hv[12] = bflo(w1.z); hv[13] = bfhi(w1.z); hv[14] = bflo(w1.w); hv[15] = bfhi(w1.w); }
#pragma unroll
            for (int i = 0; i < 16; ++i) acc[i] = 0.f;
            const int id0 = idxb[tok * 128 + lane], id1 = idxb[tok * 128 + 64 + lane]; const float g0 = gb[tok * 128 + lane], g1 = gb[tok * 128 + 64 + lane];
            const bf16_t* Ed = (const bf16_t*)(ws + OFF_ED); const bf16_t* Eu = (const bf16_t*)(ws + OFF_EU);
#pragma unroll
            for (int half_ = 0; half_ < 2; ++half_) {
                const int idv = half_ ? id1 : id0; const float gv = half_ ? g1 : g0;
#pragma unroll 4
                for (int k = 0; k < 64; ++k) {
                    const int e = __builtin_amdgcn_readlane(idv, k);
                    const float gk = __int_as_float(__builtin_amdgcn_readlane(__float_as_int(gv), k));
                    const u32x4 d0 = *(const u32x4*)(Ed + (size_t)e * 1024 + lane * 8), d1 = *(const u32x4*)(Ed + (size_t)e * 1024 + 512 + lane * 8);
                    const u32x4 u0 = *(const u32x4*)(Eu + (size_t)e * 1024 + lane * 8), u1 = *(const u32x4*)(Eu + (size_t)e * 1024 + 512 + lane * 8);
                    float s = hv[0] * bflo(d0.x) + hv[1] * bfhi(d0.x) + hv[2] * bflo(d0.y) + hv[3] * bfhi(d0.y) + hv[4] * bflo(d0.z) + hv[5] * bfhi(d0.z) + hv[6] * bflo(d0.w) + hv[7] * bfhi(d0.w)
                            + hv[8] * bflo(d1.x) + hv[9] * bfhi(d1.x) + hv[10] * bflo(d1.y) + hv[11] * bfhi(d1.y) + hv[12] * bflo(d1.z) + hv[13] * bfhi(d1.z) + hv[14] * bflo(d1.w) + hv[15] * bfhi(d1.w);
                    s = wave_sum(s);
                    const float w = gk * gelu_tanh(s);
                    acc[0] += w * bflo(u0.x); acc[1] += w * bfhi(u0.x); acc[2] += w * bflo(u0.y); acc[3] += w * bfhi(u0.y); acc[4] += w * bflo(u0.z); acc[5] += w * bfhi(u0.z); acc[6] += w * bflo(u0.w); acc[7] += w * bfhi(u0.w);
                    acc[8] += w * bflo(u1.x); acc[9] += w * bfhi(u1.x); acc[10] += w * bflo(u1.y); acc[11] += w * bfhi(u1.y); acc[12] += w * bflo(u1.z); acc[13] += w * bfhi(u1.z); acc[14] += w * bflo(u1.w); acc[15] += w * bfhi(u1.w);
                }
            }
            float* orow = p.out + tok * 1024; const float* gf = mod + b * 6144 + 5120;
#pragma unroll
            for (int half = 0; half < 2; ++half)
#pragma unroll
                for (int q = 0; q < 2; ++q) { const int col = half * 512 + lane * 8 + q * 4; f32x4 o = *(const f32x4*)(orow + col); const f32x4 gg = *(const f32x4*)(gf + col);
                    o.x += gg.x * acc[half * 8 + q * 4]; o.y += gg.y * acc[half * 8 + q * 4 + 1]; o.z += gg.z * acc[half * 8 + q * 4 + 2]; o.w += gg.w * acc[half * 8 + q * 4 + 3]; *(f32x4*)(orow + col) = o; }
        }
        __syncthreads();
    }
}

__global__ void __launch_bounds__(NTHR, 2) fwd_kernel(Params p) {
    extern __shared__ __attribute__((aligned(16))) unsigned char lds[];
    if (p.ph_lo <= 0 && 0 < p.ph_hi) phase0(p, lds);
#if MK_COOP
    if (p.ph_lo <= 0 && 1 < p.ph_hi) cg::this_grid().sync();
#endif
    if (p.ph_lo <= 1 && 1 < p.ph_hi) phase1(p, lds);
#if MK_COOP
    if (p.ph_lo <= 1 && 2 < p.ph_hi) cg::this_grid().sync();
#endif
    if (p.ph_lo <= 2 && 2 < p.ph_hi) phase2(p, lds);
#if MK_COOP
    if (p.ph_lo <= 2 && 3 < p.ph_hi) cg::this_grid().sync();
#endif
    if (p.ph_lo <= 3 && 3 < p.ph_hi) phase3(p, lds);
}

extern "C" void kernel_launch(void* const* d_in, const int* in_sizes, int n_in, void* d_out, int out_size, void* d_ws, size_t ws_size, hipStream_t stream) {
    static int grid = 0;
    if (grid == 0) {
        if (n_in != 31 || ws_size < WS_NEED) { fprintf(stderr, "kernel_launch: bad inputs (n_in %d, ws %zu < %zu)\n", n_in, ws_size, (size_t)WS_NEED); grid = -1; return; }
        int dev = 0, cus = 0, per_cu = 0;
        hipGetDevice(&dev); hipDeviceGetAttribute(&cus, hipDeviceAttributeMultiprocessorCount, dev);
        if (hipFuncSetAttribute((const void*)fwd_kernel, hipFuncAttributeMaxDynamicSharedMemorySize, LDS_BYTES) != hipSuccess) { fprintf(stderr, "kernel_launch: hipFuncSetAttribute failed\n"); grid = -1; return; }
        hipOccupancyMaxActiveBlocksPerMultiprocessor(&per_cu, (const void*)fwd_kernel, NTHR, LDS_BYTES);
        if (per_cu < 1) { fprintf(stderr, "kernel_launch: occupancy query says %d blocks/CU\n", per_cu); per_cu = 1; }
        grid = cus;
        (void)hipGetLastError();
    }
    if (grid < 0) return;
    Params p{};
    const float** f = (const float**)&p;
    for (int i = 0; i < 31; ++i) f[i] = (const float*)d_in[i];
    p.out = (float*)d_out; p.ws = (unsigned char*)d_ws;
#if MK_COOP
    p.ph_lo = 0; p.ph_hi = 4;
    void* args[] = {&p};
    hipError_t e = hipLaunchCooperativeKernel((const void*)fwd_kernel, dim3(grid), dim3(NTHR), args, LDS_BYTES, stream);
    if (e != hipSuccess) fprintf(stderr, "cooperative launch failed: %s (grid %d)\n", hipGetErrorString(e), grid);
#else
    for (int ph = 0; ph < 4; ++ph) { p.ph_lo = ph; p.ph_hi = ph + 1; hipLaunchKernelGGL(fwd_kernel, dim3(grid), dim3(NTHR), LDS_BYTES, stream, p); }
#endif
}
```

```cpp
#include <hip/hip_runtime.h>
#include <hip/hip_cooperative_groups.h>
#include <cstdio>
#include <cstdint>
namespace cg = cooperative_groups;

#ifndef PROBE_REP
#define PROBE_REP 0
#endif
#ifndef MK_COOP
#define MK_COOP 1
#endif

typedef unsigned short bf16_t;
typedef short bf16x8 __attribute__((ext_vector_type(8)));
typedef short s16x4 __attribute__((ext_vector_type(4)));
typedef float f32x16 __attribute__((ext_vector_type(16)));
typedef float f32x4 __attribute__((ext_vector_type(4)));
typedef float f32x2 __attribute__((ext_vector_type(2)));
typedef unsigned u32x4 __attribute__((ext_vector_type(4)));
typedef unsigned u32x2 __attribute__((ext_vector_type(2)));

constexpr int NTHR = 512, NWAVE = 8;
constexpr int T_TOK = 32768, DM = 1024, NB = 16, SEQ = 2048;
constexpr int LDS_BYTES = 155648;
constexpr float EPS = 1e-6f;
constexpr float QSCALE = 0.10206207261596575f * 1.4426950408889634f;

constexpr size_t OFF_PART  = 0;
constexpr size_t OFF_MODT  = 8u << 20;
constexpr size_t OFF_WINT  = 16u << 20;
constexpr size_t OFF_WGLUT = OFF_WINT + (2u << 20);
constexpr size_t OFF_WUQT  = OFF_WGLUT + (512u << 10);
constexpr size_t OFF_WUKVT = OFF_WUQT + 393216;
constexpr size_t OFF_WOUTT = OFF_WUKVT + 262144;
constexpr size_t OFF_WQT   = OFF_WOUTT + (2u << 20);
constexpr size_t OFF_SUBK  = OFF_WQT + (4u << 20);
constexpr size_t OFF_KMT   = OFF_SUBK + 65536;
constexpr size_t OFF_WZT   = OFF_KMT + 20971520;
constexpr size_t OFF_AL    = OFF_WZT + 4194304;
constexpr size_t OFF_HBUF  = OFF_AL + 16384;
constexpr size_t OFF_PROJ2 = OFF_HBUF + (64u << 20);
constexpr size_t OFF_UBUF  = OFF_PROJ2 + (32u << 20);
constexpr size_t OFF_Q     = OFF_UBUF + 41943040;
constexpr size_t OFF_K     = OFF_Q + 50331648;
constexpr size_t OFF_VT    = OFF_K + 50331648;
constexpr size_t OFF_YBUF  = OFF_VT + 33554432;
constexpr size_t OFF_IDX   = OFF_YBUF + (32u << 20);
constexpr size_t OFF_G     = OFF_IDX + (16u << 20);
constexpr size_t OFF_E8    = OFF_G + (16u << 20);
constexpr size_t OFF_ESC   = OFF_E8 + (32u << 20);
constexpr size_t WS_NEED   = OFF_ESC + (1u << 20);

struct Params {
    const float* x; const float* c; const int* pos; const float* w_ada; const float* b_ada; const float* norm_mix; const float* norm_ffn; const float* w_in;
    const float* lam_re; const float* lam_im; const float* log_dt; const float* b_re; const float* b_im; const float* c_re; const float* c_im; const float* d_skip;
    const float* w_glu; const float* b_glu; const float* q_a_norm; const float* w_uq; const float* kv_a_norm; const float* w_ukv; const float* q_norm; const float* k_norm;
    const float* out_norm_ssm; const float* out_norm_attn; const float* w_out; const float* w_query; const float* sub_keys; const float* e_down; const float* e_up;
    float* out; unsigned char* ws; int ph_lo, ph_hi;
};

__device__ __forceinline__ unsigned f2bf(float f) { unsigned u = __float_as_uint(f); return (u + 0x7fffu + ((u >> 16) & 1u)) >> 16; }
__device__ __forceinline__ unsigned pk2(float lo, float hi) { return f2bf(lo) | (f2bf(hi) << 16); }
__device__ __forceinline__ float bf2f(unsigned short b) { return __uint_as_float(((unsigned)b) << 16); }
__device__ __forceinline__ float bflo(unsigned w) { return __uint_as_float(w << 16); }
__device__ __forceinline__ float bfhi(unsigned w) { return __uint_as_float(w & 0xffff0000u); }
__device__ __forceinline__ int opq_s(int x) { asm volatile("" : "+s"(x)); return x; }
__device__ __forceinline__ int opq_v(int x) { asm volatile("" : "+v"(x)); return x; }
__device__ __forceinline__ int crow(int r, int hi) { return (r & 3) + 8 * (r >> 2) + 4 * hi; }
__device__ __forceinline__ float wave_sum(float v) {
#pragma unroll
    for (int o = 1; o < 64; o <<= 1) v += __shfl_xor(v, o);
    return v;
}
__device__ __forceinline__ float gelu_tanh(float x) {
    const float u = 0.7978845608028654f * (x + 0.044715f * x * x * x);
    const float t = 1.0f - 2.0f / (1.0f + __expf(2.0f * u));
    return 0.5f * x * (1.0f + t);
}
__device__ __forceinline__ float sigmoidf_(float z) { return 1.0f / (1.0f + __expf(-z)); }

constexpr int G_STR = 144;
constexpr int G_ABYTES = 128 * G_STR;
template <int NT> struct GemmCfg { static constexpr int BN = 128 * NT, BBYTES = BN * G_STR, STAGE = G_ABYTES + BBYTES; };

template <int NT, class Epi>
__device__ __forceinline__ void gemm_128(const bf16_t* __restrict__ A, int lda, const bf16_t* __restrict__ Bt, int ldb, int K, unsigned char* lds, Epi epi) {
    typedef GemmCfg<NT> C;
    const int tid = threadIdx.x, lane = tid & 63, wid = __builtin_amdgcn_readfirstlane(tid >> 6), wm = wid >> 2, wn = wid & 3, r32 = lane & 31, hi = lane >> 5;
    f32x16 acc[2][NT];
#pragma unroll
    for (int i = 0; i < 2; ++i)
#pragma unroll
        for (int j = 0; j < NT; ++j)
#pragma unroll
            for (int r = 0; r < 16; ++r) acc[i][j][r] = 0.f;
    const int prow = tid >> 3, pc = tid & 7;
    const bf16_t* ga = A + (size_t)prow * lda + pc * 8;
    const bf16_t* gb = Bt + (size_t)prow * ldb + pc * 8;
    const int ldsoff = prow * G_STR + pc * 16;
    u32x4 ra[2], rb[2 * NT];
    const int nk = K >> 6;
#pragma unroll
    for (int q = 0; q < 2; ++q) ra[q] = *(const u32x4*)(ga + (size_t)(64 * q) * lda);
#pragma unroll
    for (int q = 0; q < 2 * NT; ++q) rb[q] = *(const u32x4*)(gb + (size_t)(64 * q) * ldb);
#pragma unroll
    for (int q = 0; q < 2; ++q) *(u32x4*)(lds + ldsoff + q * 64 * G_STR) = ra[q];
#pragma unroll
    for (int q = 0; q < 2 * NT; ++q) *(u32x4*)(lds + G_ABYTES + ldsoff + q * 64 * G_STR) = rb[q];
    __syncthreads();
    for (int rep_k = 0; rep_k < ((PROBE_REP & 256) ? 2 : 1); ++rep_k) {
    if (rep_k) {
#pragma unroll
        for (int q = 0; q < 2; ++q) ra[q] = *(const u32x4*)(ga + (size_t)(64 * q) * lda);
#pragma unroll
        for (int q = 0; q < 2 * NT; ++q) rb[q] = *(const u32x4*)(gb + (size_t)(64 * q) * ldb);
#pragma unroll
        for (int q = 0; q < 2; ++q) *(u32x4*)(lds + ldsoff + q * 64 * G_STR) = ra[q];
#pragma unroll
        for (int q = 0; q < 2 * NT; ++q) *(u32x4*)(lds + G_ABYTES + ldsoff + q * 64 * G_STR) = rb[q];
        __syncthreads();
    }
    for (int kt = 0; kt < nk; ++kt) {
        unsigned char* st = lds + (kt & 1) * C::STAGE;
        if (kt + 1 < nk) {
#pragma unroll
            for (int q = 0; q < 2; ++q) ra[q] = *(const u32x4*)(ga + (size_t)(64 * q) * lda + (kt + 1) * 64);
#pragma unroll
            for (int q = 0; q < 2 * NT; ++q) rb[q] = *(const u32x4*)(gb + (size_t)(64 * q) * ldb + (kt + 1) * 64);
        }
        const unsigned char* pa = st + (wm * 64 + r32) * G_STR + hi * 16;
        const unsigned char* pb = st + G_ABYTES + (wn * 32 * NT + r32) * G_STR + hi * 16;
#pragma unroll
        for (int ks = 0; ks < 4; ++ks) {
            bf16x8 af[2], bfr[NT];
#pragma unroll
            for (int i = 0; i < 2; ++i) af[i] = *(const bf16x8*)(pa + i * 32 * G_STR + ks * 32);
#pragma unroll
            for (int j = 0; j < NT; ++j) bfr[j] = *(const bf16x8*)(pb + j * 32 * G_STR + ks * 32);
#pragma unroll
            for (int i = 0; i < 2; ++i)
#pragma unroll
                for (int j = 0; j < NT; ++j) acc[i][j] = __builtin_amdgcn_mfma_f32_32x32x16_bf16(af[i], bfr[j], acc[i][j], 0, 0, 0);
        }
        if (kt + 1 < nk) {
            unsigned char* sn = lds + ((kt + 1) & 1) * C::STAGE;
#pragma unroll
            for (int q = 0; q < 2; ++q) *(u32x4*)(sn + ldsoff + q * 64 * G_STR) = ra[q];
#pragma unroll
            for (int q = 0; q < 2 * NT; ++q) *(u32x4*)(sn + G_ABYTES + ldsoff + q * 64 * G_STR) = rb[q];
        }
        __syncthreads();
    }
    }
    if (PROBE_REP & 256) {
#pragma unroll
        for (int i = 0; i < 2; ++i)
#pragma unroll
            for (int j = 0; j < NT; ++j)
#pragma unroll
                for (int r = 0; r < 16; ++r) acc[i][j][r] *= 0.5f;
    }
    for (int rep_e2 = 0; rep_e2 < ((PROBE_REP & 512) ? 2 : 1); ++rep_e2)
#pragma unroll
    for (int i = 0; i < 2; ++i)
#pragma unroll
        for (int j = 0; j < NT; ++j)
#pragma unroll
            for (int r = 0; r < 16; ++r) epi(wm * 64 + i * 32 + crow(r, hi), wn * 32 * NT + j * 32 + r32, acc[i][j][r]);
}

__device__ __forceinline__ void p0_transpose(const float* __restrict__ W, int K, int N, int Npad, bf16_t* __restrict__ WT,
                                             const float* g0, const float* g1, int gsplit, float* scr, int item) {
    const int tid = threadIdx.x;
    const int nkb = K / 64, kb = item % nkb, nb = item / nkb, k0 = kb * 64, n0 = nb * 64;
#pragma unroll
    for (int r = 0; r < 8; ++r) {
        const int kk = r * 8 + (tid >> 6), nn = tid & 63, k = k0 + kk, n = n0 + nn;
        float v = (n < N) ? W[(size_t)k * N + n] : 0.f;
        if (g0) v *= (k < gsplit) ? g0[k] : g1[k - gsplit];
        scr[kk * 65 + nn] = v;
    }
    __syncthreads();
    {
        const int n = tid >> 3, kc = tid & 7; const float* s = scr + (kc * 8) * 65 + n;
        u32x4 o; o.x = pk2(s[0], s[65]); o.y = pk2(s[2 * 65], s[3 * 65]); o.z = pk2(s[4 * 65], s[5 * 65]); o.w = pk2(s[6 * 65], s[7 * 65]);
        *(u32x4*)(WT + (size_t)(n0 + n) * K + k0 + kc * 8) = o;
    }
    __syncthreads();
}


__device__ __forceinline__ void quant_row(const f32x4 (&a)[4], unsigned char* dst, float* scale_out, int lane) {
    float am = 0.f;
#pragma unroll
    for (int q = 0; q < 4; ++q) am = fmaxf(am, fmaxf(fmaxf(fabsf(a[q].x), fabsf(a[q].y)), fmaxf(fabsf(a[q].z), fabsf(a[q].w))));
#pragma unroll
    for (int o = 1; o < 64; o <<= 1) am = fmaxf(am, __shfl_xor(am, o));
    const float sc = (am > 0.f) ? am * (1.0f / 224.0f) : 1.0f, inv = 1.0f / sc;
    u32x4 o;
    { int w = __builtin_amdgcn_cvt_pk_fp8_f32(a[0].x * inv, a[0].y * inv, 0, false); w = __builtin_amdgcn_cvt_pk_fp8_f32(a[0].z * inv, a[0].w * inv, w, true); o.x = (unsigned)w; }
    { int w = __builtin_amdgcn_cvt_pk_fp8_f32(a[1].x * inv, a[1].y * inv, 0, false); w = __builtin_amdgcn_cvt_pk_fp8_f32(a[1].z * inv, a[1].w * inv, w, true); o.y = (unsigned)w; }
    { int w = __builtin_amdgcn_cvt_pk_fp8_f32(a[2].x * inv, a[2].y * inv, 0, false); w = __builtin_amdgcn_cvt_pk_fp8_f32(a[2].z * inv, a[2].w * inv, w, true); o.z = (unsigned)w; }
    { int w = __builtin_amdgcn_cvt_pk_fp8_f32(a[3].x * inv, a[3].y * inv, 0, false); w = __builtin_amdgcn_cvt_pk_fp8_f32(a[3].z * inv, a[3].w * inv, w, true); o.w = (unsigned)w; }
    *(u32x4*)dst = o;
    if (lane == 0) *scale_out = sc;
}
__device__ void phase0(const Params& p, unsigned char* lds) {
    const int tid = threadIdx.x, G = gridDim.x, bid = blockIdx.x;
    unsigned char* ws = p.ws;
    float* scr = (float*)lds;
    {
        float* part = (float*)(ws + OFF_PART);
        for (int it = bid; it < 24 * 16; it += G) {
            const int nb = it % 24, ks = it / 24, n = nb * 256 + (tid & 255), bh = tid >> 8;
            for (int i = tid; i < 16 * 64; i += NTHR) { const int b = i >> 6, kk = i & 63; const float cv = p.c[b * 1024 + ks * 64 + kk]; scr[i] = cv / (1.0f + __expf(-cv)); }
            __syncthreads();
            float acc[8];
#pragma unroll
            for (int j = 0; j < 8; ++j) acc[j] = 0.f;
            for (int kk = 0; kk < 64; ++kk) {
                const float w = p.w_ada[(size_t)(ks * 64 + kk) * 6144 + n];
#pragma unroll
                for (int j = 0; j < 8; ++j) acc[j] += w * scr[(bh * 8 + j) * 64 + kk];
            }
#pragma unroll
            for (int j = 0; j < 8; ++j) part[((size_t)ks * 16 + bh * 8 + j) * 6144 + n] = acc[j];
            __syncthreads();
        }
    }
    {
        constexpr int I_IN = 16 * 16, I_GLU = 8 * 8, I_UQ = 4 * 12, I_UKV = 2 * 16, I_OUT = 16 * 16, I_Q = 16 * 32;
        constexpr int NIT = I_IN + I_GLU + I_UQ + I_UKV + I_OUT + I_Q;
        for (int it = bid; it < NIT; it += G) {
            int r = it;
            if (r < I_IN) { p0_transpose(p.w_in, 1024, 928, 1024, (bf16_t*)(ws + OFF_WINT), nullptr, nullptr, 0, scr, r); continue; } r -= I_IN;
            if (r < I_GLU) { p0_transpose(p.w_glu, 512, 512, 512, (bf16_t*)(ws + OFF_WGLUT), nullptr, nullptr, 0, scr, r); continue; } r -= I_GLU;
            if (r < I_UQ) { p0_transpose(p.w_uq, 256, 768, 768, (bf16_t*)(ws + OFF_WUQT), p.q_a_norm, p.q_a_norm, 256, scr, r); continue; } r -= I_UQ;
            if (r < I_UKV) { p0_transpose(p.w_ukv, 128, 1024, 1024, (bf16_t*)(ws + OFF_WUKVT), p.kv_a_norm, p.kv_a_norm, 128, scr, r); continue; } r -= I_UKV;
            if (r < I_OUT) { p0_transpose(p.w_out, 1024, 1024, 1024, (bf16_t*)(ws + OFF_WOUTT), p.out_norm_ssm, p.out_norm_attn, 512, scr, r); continue; } r -= I_OUT;
            p0_transpose(p.w_query, 1024, 2048, 2048, (bf16_t*)(ws + OFF_WQT), nullptr, nullptr, 0, scr, r);
        }
    }
    {
        const size_t gt = (size_t)bid * NTHR + tid, gs = (size_t)G * NTHR;
        for (size_t i = gt; i < 32768 / 8; i += gs) { const f32x4 a = ((const f32x4*)p.sub_keys)[2 * i], b = ((const f32x4*)p.sub_keys)[2 * i + 1];
            u32x4 o; o.x = pk2(a.x, a.y); o.y = pk2(a.z, a.w); o.z = pk2(b.x, b.y); o.w = pk2(b.z, b.w); ((u32x4*)(ws + OFF_SUBK))[i] = o; }
    }
    {
        const int lane = tid & 63, gw = bid * NWAVE + (tid >> 6), NGW = G * NWAVE;
        unsigned char* E8 = ws + OFF_E8; float* esc = (float*)(ws + OFF_ESC);
        for (int r = gw; r < 32768; r += 2 * NGW) {
            const int r2 = r + NGW; const bool has2 = r2 < 32768;
            const float* s0p = ((r < 16384) ? p.e_down : p.e_up) + (size_t)(r & 16383) * 1024 + lane * 16;
            const float* s1p = ((r2 < 16384) ? p.e_down : p.e_up) + (size_t)(r2 & 16383) * 1024 + lane * 16;
            f32x4 a[4], b[4];
#pragma unroll
            for (int q = 0; q < 4; ++q) a[q] = ((const f32x4*)s0p)[q];
            if (has2) {
#pragma unroll
                for (int q = 0; q < 4; ++q) b[q] = ((const f32x4*)s1p)[q]; }
            quant_row(a, E8 + (size_t)r * 1024 + lane * 16, esc + r, lane);
            if (has2) quant_row(b, E8 + (size_t)r2 * 1024 + lane * 16, esc + r2, lane);
        }
    }
    {
        f32x2* apow = (f32x2*)lds;
        f32x2* Bb = (f32x2*)(lds + 16896);
        f32x2* Cc = (f32x2*)(lds + 16896 + 8192);
        float* Kt = (float*)(lds + 16896 + 16384);
        for (int g = G - 1 - bid; g < 32; g += G) {
            if (g < 0) break;
            const float dt = __expf(p.log_dt[g]);
            for (int i = tid; i < 33 * 64; i += NTHR) { const int j = i >> 6, pp = i & 63; const float lr = p.lam_re[g * 64 + pp], li = p.lam_im[g * 64 + pp];
                const float mag = expf((float)j * lr * dt); float sn, cs; sincosf((float)j * li * dt, &sn, &cs); apow[i] = (f32x2){mag * cs, mag * sn}; }
            for (int i = tid; i < 1024; i += NTHR) { const int pp = i >> 4; const float lr = p.lam_re[g * 64 + pp], li = p.lam_im[g * 64 + pp];
                const float mag = expf(lr * dt); float sn, cs; sincosf(li * dt, &sn, &cs); const float nr = mag * cs - 1.0f, ni = mag * sn, den = lr * lr + li * li;
                const float cr = (nr * lr + ni * li) / den, ci = (ni * lr - nr * li) / den; const float br = p.b_re[(size_t)g * 1024 + i], bi = p.b_im[(size_t)g * 1024 + i];
                Bb[i] = (f32x2){cr * br - ci * bi, cr * bi + ci * br}; }
            for (int i = tid; i < 1024; i += NTHR) Cc[i] = (f32x2){p.c_re[(size_t)g * 1024 + i], p.c_im[(size_t)g * 1024 + i]};
            __syncthreads();
            for (int i = tid; i < 8192; i += NTHR) { const int j = i >> 8, co = (i >> 4) & 15, ci = i & 15; float s = 0.f;
                for (int pp = 0; pp < 64; ++pp) { const f32x2 c = Cc[co * 64 + pp], a = apow[j * 64 + pp], b = Bb[pp * 16 + ci]; const float car = c.x * a.x - c.y * a.y, cai = c.x * a.y + c.y * a.x; s += car * b.x - cai * b.y; }
                if (j == 0 && co == ci) s += p.d_skip[g * 16 + co];
                Kt[i] = s; }
            __syncthreads();
            bf16_t* KmT = (bf16_t*)(ws + OFF_KMT) + (size_t)g * 512 * 640;
            for (int q = tid; q < 512 * 80; q += NTHR) { const int n = q / 80, kc = q % 80, k0 = kc * 8, t = n >> 4, co = n & 15; float v[8];
                if (k0 < 512) { const int s = k0 >> 4, ci0 = k0 & 15;
#pragma unroll
                    for (int i = 0; i < 8; ++i) v[i] = (t >= s) ? Kt[((t - s) * 16 + co) * 16 + ci0 + i] : 0.f;
                } else { const int kk0 = k0 - 512, ri = kk0 >> 6, p0 = kk0 & 63;
#pragma unroll
                    for (int i = 0; i < 8; ++i) { const f32x2 c = Cc[co * 64 + p0 + i], a = apow[(t + 1) * 64 + p0 + i]; v[i] = (ri == 0) ? (c.x * a.x - c.y * a.y) : -(c.x * a.y + c.y * a.x); } }
                u32x4 o; o.x = pk2(v[0], v[1]); o.y = pk2(v[2], v[3]); o.z = pk2(v[4], v[5]); o.w = pk2(v[6], v[7]); *(u32x4*)(KmT + (size_t)n * 640 + k0) = o; }
            bf16_t* WzT = (bf16_t*)(ws + OFF_WZT) + (size_t)g * 128 * 512;
            for (int q = tid; q < 128 * 64; q += NTHR) { const int n = q >> 6, kc = q & 63, k0 = kc * 8, s = k0 >> 4, ci0 = k0 & 15, ri = n >> 6, pp = n & 63; float v[8];
                const f32x2 a = apow[(31 - s) * 64 + pp];
#pragma unroll
                for (int i = 0; i < 8; ++i) { const f32x2 b = Bb[pp * 16 + ci0 + i]; v[i] = (ri == 0) ? (a.x * b.x - a.y * b.y) : (a.x * b.y + a.y * b.x); }
                u32x4 o; o.x = pk2(v[0], v[1]); o.y = pk2(v[2], v[3]); o.z = pk2(v[4], v[5]); o.w = pk2(v[6], v[7]); *(u32x4*)(WzT + (size_t)n * 512 + k0) = o; }
            if (tid < 64) ((f32x2*)(ws + OFF_AL))[g * 64 + tid] = apow[32 * 64 + tid];
            __syncthreads();
        }
    }
}


__device__ __forceinline__ void finalize_row(const float* nope, const float* ra, const float* rb, float rn, const float* __restrict__ gain, const float* cs, const float* sn, bf16_t* dst) {
#pragma unroll
    for (int j = 0; j < 8; ++j) { const f32x4 a = *(const f32x4*)(nope + 8 * j), c = *(const f32x4*)(nope + 8 * j + 4);
        u32x4 o; o.x = pk2(a.x * rn * gain[8 * j], a.y * rn * gain[8 * j + 1]); o.y = pk2(a.z * rn * gain[8 * j + 2], a.w * rn * gain[8 * j + 3]);
        o.z = pk2(c.x * rn * gain[8 * j + 4], c.y * rn * gain[8 * j + 5]); o.w = pk2(c.z * rn * gain[8 * j + 6], c.w * rn * gain[8 * j + 7]); *(u32x4*)(dst + 8 * j) = o; }
#pragma unroll
    for (int j = 0; j < 2; ++j) { float o1[8], o2[8];
#pragma unroll
        for (int i = 0; i < 8; ++i) { const int f = 8 * j + i; const float x1 = ra[f] * rn * gain[64 + f], x2 = rb[f] * rn * gain[80 + f]; o1[i] = x1 * cs[f] - x2 * sn[f]; o2[i] = x2 * cs[f] + x1 * sn[f]; }
        u32x4 o; o.x = pk2(o1[0], o1[1]); o.y = pk2(o1[2], o1[3]); o.z = pk2(o1[4], o1[5]); o.w = pk2(o1[6], o1[7]); *(u32x4*)(dst + 64 + 8 * j) = o;
        o.x = pk2(o2[0], o2[1]); o.y = pk2(o2[2], o2[3]); o.z = pk2(o2[4], o2[5]); o.w = pk2(o2[6], o2[7]); *(u32x4*)(dst + 80 + 8 * j) = o; }
}
constexpr int LX_OFF = 114688;

__device__ void phase1(const Params& p, unsigned char* lds) {
    const int tid = threadIdx.x, lane = tid & 63, wid = __builtin_amdgcn_readfirstlane(tid >> 6);
    unsigned char* ws = p.ws;
    bf16_t* hbuf = (bf16_t*)(ws + OFF_HBUF); bf16_t* proj2 = (bf16_t*)(ws + OFF_PROJ2); bf16_t* ubuf = (bf16_t*)(ws + OFF_UBUF);
    float* rsq = (float*)(lds + LX_OFF); float* rskv = rsq + 128; float* cst = rskv + 128; float* snt = cst + 2048;
    for (int tile = blockIdx.x; tile < 256; tile += gridDim.x) {
        const int row0_ = tile * 128; const int row0 = row0_, b = row0 >> 11;
        float* scr = p.out + (size_t)row0 * 1024;
        float* mod = (float*)(ws + OFF_MODT) + (size_t)tile * 6144 - (size_t)b * 6144;
        for (int i = tid; i < 6144; i += NTHR) { float s = p.b_ada[i]; const float* pp = (const float*)(ws + OFF_PART) + (size_t)b * 6144 + i;
            for (int ks = 0; ks < 16; ++ks) s += pp[(size_t)ks * 16 * 6144]; mod[b * 6144 + i] = s; }
        __threadfence_block(); __syncthreads();
        for (int r = wid; r < 128; r += NWAVE) {
            const f32x4* xr = (const f32x4*)(p.x + (size_t)(row0 + r) * 1024); f32x4 v[4]; float ss = 0.f;
#pragma unroll
            for (int j = 0; j < 4; ++j) { v[j] = xr[lane + 64 * j]; ss += v[j].x * v[j].x + v[j].y * v[j].y + v[j].z * v[j].z + v[j].w * v[j].w; }
            const float rs = rsqrtf(wave_sum(ss) * (1.0f / 1024.0f) + EPS);
#pragma unroll
            for (int j = 0; j < 4; ++j) { const int col = 4 * (lane + 64 * j);
                const f32x4 g = *(const f32x4*)(p.norm_mix + col), sc = *(const f32x4*)(mod + b * 6144 + 1024 + col), sh = *(const f32x4*)(mod + b * 6144 + col);
                u32x2 o; o.x = pk2(v[j].x * rs * g.x * (1.f + sc.x) + sh.x, v[j].y * rs * g.y * (1.f + sc.y) + sh.y); o.y = pk2(v[j].z * rs * g.z * (1.f + sc.z) + sh.z, v[j].w * rs * g.w * (1.f + sc.w) + sh.w);
                *(u32x2*)(hbuf + (size_t)(row0 + r) * 1024 + col) = o; }
        }
        for (int i = tid; i < 2048; i += NTHR) { const int r = i >> 4, f = i & 15; const float ang = (float)p.pos[row0 + r] * exp2f(-(float)f * (13.287712379549449f / 16.0f));
            float sn, cs; sincosf(ang, &sn, &cs); cst[i] = cs; snt[i] = sn; }
        __threadfence_block(); __syncthreads();
        for (int nc = 0; nc < 4; ++nc) {
            const bf16_t* Bt = (const bf16_t*)(ws + OFF_WINT) + (size_t)nc * 256 * 1024;
            if (nc < 2) gemm_128<2>(hbuf + (size_t)row0 * 1024, 1024, Bt, 1024, 1024, lds, [&](int row, int col, float v) {
                    const int cg_ = nc * 256 + col, g = cg_ >> 4, ci = cg_ & 15, tok = row0 + row;
                    ubuf[((size_t)g * 1024 + (tok >> 5)) * 640 + (tok & 31) * 16 + ci] = (bf16_t)f2bf(v); });
            else gemm_128<2>(hbuf + (size_t)row0 * 1024, 1024, Bt, 1024, 1024, lds, [&](int row, int col, float v) {
                    proj2[(size_t)(row0 + row) * 512 + (nc - 2) * 256 + col] = (bf16_t)f2bf(v); });
        }
        __threadfence_block(); __syncthreads();
        for (int r = wid; r < 128; r += NWAVE) {
            const u32x4 w = *(const u32x4*)(proj2 + (size_t)(row0 + r) * 512 + lane * 8);
            float ss = bflo(w.x) * bflo(w.x) + bfhi(w.x) * bfhi(w.x) + bflo(w.y) * bflo(w.y) + bfhi(w.y) * bfhi(w.y) + bflo(w.z) * bflo(w.z) + bfhi(w.z) * bfhi(w.z) + bflo(w.w) * bflo(w.w) + bfhi(w.w) * bfhi(w.w);
            const float sq = wave_sum(lane < 32 ? ss : 0.f), skv = wave_sum((lane >= 32 && lane < 48) ? ss : 0.f);
            if (lane == 0) { rsq[r] = rsqrtf(sq * (1.0f / 256.0f) + EPS); rskv[r] = rsqrtf(skv * (1.0f / 128.0f) + EPS); }
        }
        __syncthreads();
        for (int nc = 0; nc < 3; ++nc)
            gemm_128<2>(proj2 + (size_t)row0 * 512, 512, (const bf16_t*)(ws + OFF_WUQT) + (size_t)nc * 256 * 256, 256, 256, lds, [&](int row, int col, float v) { scr[row * 1024 + nc * 256 + col] = v * rsq[row]; });
        __threadfence_block(); __syncthreads();
#pragma unroll 1
        for (int it = 0; it < 2; ++it) {
            const int pair = opq_v(tid) + NTHR * it, row = pair >> 3, h = pair & 7; const int row0 = opq_s(row0_); const float* q = p.out + (size_t)row0 * 1024 + row * 1024 + h * 96; float ss = 0.f;
#pragma unroll
            for (int j = 0; j < 24; ++j) { const f32x4 t4 = *(const f32x4*)(q + 4 * j); ss += t4.x * t4.x + t4.y * t4.y + t4.z * t4.z + t4.w * t4.w; }
            const float rn = rsqrtf(ss * (1.0f / 96.0f) + EPS) * QSCALE;
            bf16_t* dst = (bf16_t*)(ws + OFF_Q) + ((size_t)(b * 8 + h) * 2048 + ((row0 + row) & 2047)) * 96;
            finalize_row(q, q + 64, q + 80, rn, p.q_norm, cst + row * 16, snt + row * 16, dst);
        }
        __syncthreads();
        for (int nc = 0; nc < 4; ++nc)
            gemm_128<2>(proj2 + (size_t)row0 * 512 + 256, 512, (const bf16_t*)(ws + OFF_WUKVT) + (size_t)nc * 256 * 128, 128, 128, lds, [&](int row, int col, float v) { scr[row * 1024 + nc * 256 + col] = v * rskv[row]; });
        __threadfence_block(); __syncthreads();
#pragma unroll 1
        for (int it = 0; it < 2; ++it) {
            const int pair = opq_v(tid) + NTHR * it, row = pair >> 3, h = pair & 7; const int row0 = opq_s(row0_); const float* kp = p.out + (size_t)row0 * 1024 + row * 1024 + h * 128; float ss = 0.f; float rp[32];
#pragma unroll
            for (int j = 0; j < 16; ++j) { const f32x4 t4 = *(const f32x4*)(kp + 4 * j); ss += t4.x * t4.x + t4.y * t4.y + t4.z * t4.z + t4.w * t4.w; }
#pragma unroll
            for (int j = 0; j < 4; ++j) { const u32x4 w = *(const u32x4*)(proj2 + (size_t)(row0 + row) * 512 + 384 + 8 * j);
                rp[8 * j] = bflo(w.x); rp[8 * j + 1] = bfhi(w.x); rp[8 * j + 2] = bflo(w.y); rp[8 * j + 3] = bfhi(w.y); rp[8 * j + 4] = bflo(w.z); rp[8 * j + 5] = bfhi(w.z); rp[8 * j + 6] = bflo(w.w); rp[8 * j + 7] = bfhi(w.w); }
#pragma unroll
            for (int d = 0; d < 32; ++d) ss += rp[d] * rp[d];
            const float rn = rsqrtf(ss * (1.0f / 96.0f) + EPS);
            bf16_t* dst = (bf16_t*)(ws + OFF_K) + ((size_t)(b * 8 + h) * 2048 + ((row0 + row) & 2047)) * 96;
            finalize_row(kp, rp, rp + 16, rn, p.k_norm, cst + row * 16, snt + row * 16, dst);
        }
        {
            const int tv = opq_v(tid), h = tv >> 6, d = tv & 63; const int row0 = opq_s(row0_); const float* scr = p.out + (size_t)row0 * 1024; bf16_t* dst = (bf16_t*)(ws + OFF_VT) + ((size_t)((row0 >> 11) * 8 + h) * 64 + d) * 2048 + (row0 & 2047);
#pragma unroll 1
            for (int r8 = 0; r8 < 16; ++r8) { float v[8];
#pragma unroll
                for (int i = 0; i < 8; ++i) v[i] = scr[(r8 * 8 + i) * 1024 + h * 128 + 64 + d];
                u32x4 o; o.x = pk2(v[0], v[1]); o.y = pk2(v[2], v[3]); o.z = pk2(v[4], v[5]); o.w = pk2(v[6], v[7]); *(u32x4*)(dst + r8 * 8) = o; }
        }
        __syncthreads();
    }
}

__device__ void s5_item(const Params& p, unsigned char* lds, int g, int bp) {
    const int tid = threadIdx.x;
    unsigned char* ws = p.ws;
    bf16_t* A = (bf16_t*)(ws + OFF_UBUF) + ((size_t)g * 1024 + bp * 128) * 640;
    float* Z = (float*)(lds + 73728);
    gemm_128<1>(A, 640, (const bf16_t*)(ws + OFF_WZT) + (size_t)g * 128 * 512, 512, 512, lds, [&](int row, int col, float v) { Z[row * 129 + col] = v; });
    __syncthreads();
    if (tid < 128) {
        const int bs = tid >> 6, pp = tid & 63; const f32x2 aL = ((const f32x2*)(ws + OFF_AL))[g * 64 + pp]; float xr = 0.f, xi = 0.f;
        for (int k = 0; k < 64; ++k) { const int row = bs * 64 + k; bf16_t* xin = A + (size_t)row * 640 + 512;
            xin[pp] = (bf16_t)f2bf(xr); xin[64 + pp] = (bf16_t)f2bf(xi);
            const float zr = Z[row * 129 + pp], zi = Z[row * 129 + 64 + pp], nr = aL.x * xr - aL.y * xi + zr, ni = aL.x * xi + aL.y * xr + zi; xr = nr; xi = ni; }
    }
    __threadfence_block(); __syncthreads();
    bf16_t* ybuf = (bf16_t*)(ws + OFF_YBUF);
    for (int nc = 0; nc < 2; ++nc)
        gemm_128<2>(A, 640, (const bf16_t*)(ws + OFF_KMT) + ((size_t)g * 512 + nc * 256) * 640, 640, 640, lds, [&](int row, int col, float v) {
            const int n = nc * 256 + col, t = n >> 4, co = n & 15; const size_t tok = (size_t)(bp * 128 + row) * 32 + t;
            ybuf[tok * 512 + g * 16 + co] = (bf16_t)f2bf(gelu_tanh(v)); });
    __syncthreads();
}

constexpr int AT_KSTR = 208, AT_VSTR = 136, AT_KB = 64 * AT_KSTR, AT_VB = 64 * AT_VSTR, AT_STAGE = AT_KB + AT_VB;

__device__ void attn_item(const Params& p, unsigned char* lds, int bh, int qb) {
    const int tid = threadIdx.x, lane = tid & 63, wid = __builtin_amdgcn_readfirstlane(tid >> 6), r32 = lane & 31, hi = lane >> 5;
    unsigned char* ws = p.ws;
    const int q0 = qb * 256, qw0 = q0 + wid * 32, qg = qw0 + r32;
    const bf16_t* Qp = (const bf16_t*)(ws + OFF_Q) + ((size_t)bh * 2048 + qw0) * 96;
    const bf16_t* Kp = (const bf16_t*)(ws + OFF_K) + (size_t)bh * 2048 * 96;
    const bf16_t* Vp = (const bf16_t*)(ws + OFF_VT) + (size_t)bh * 64 * 2048;
    bf16x8 qf[6];
#pragma unroll
    for (int ks = 0; ks < 6; ++ks) qf[ks] = *(const bf16x8*)(Qp + r32 * 96 + ks * 16 + hi * 8);
    f32x16 ot[2];
#pragma unroll
    for (int r = 0; r < 16; ++r) { ot[0][r] = 0.f; ot[1][r] = 0.f; }
    float m = -INFINITY, l = 0.f;
    const int nkv = (q0 + 256) / 64;
    const int kr0 = tid / 12, kc0 = tid % 12, kr1 = (tid + 512) / 12, kc1 = (tid + 512) % 12; const bool k2 = tid < 256;
    const int vd = tid >> 3, vc = tid & 7;
    u32x4 rk0, rk1, rv;
    rk0 = *(const u32x4*)(Kp + (size_t)kr0 * 96 + kc0 * 8); if (k2) rk1 = *(const u32x4*)(Kp + (size_t)kr1 * 96 + kc1 * 8);
    rv = *(const u32x4*)(Vp + (size_t)vd * 2048 + vc * 8);
    *(u32x4*)(lds + kr0 * AT_KSTR + kc0 * 16) = rk0; if (k2) *(u32x4*)(lds + kr1 * AT_KSTR + kc1 * 16) = rk1;
    { u32x2* d = (u32x2*)(lds + AT_KB + vd * AT_VSTR + vc * 16); d[0] = (u32x2){rv.x, rv.y}; d[1] = (u32x2){rv.z, rv.w}; }
    __syncthreads();
    for (int t = 0; t < nkv; ++t) {
        const unsigned char* st = lds + (t & 1) * AT_STAGE; const int kv0 = t * 64;
        if (t + 1 < nkv) {
            const int kn = kv0 + 64;
            rk0 = *(const u32x4*)(Kp + (size_t)(kn + kr0) * 96 + kc0 * 8); if (k2) rk1 = *(const u32x4*)(Kp + (size_t)(kn + kr1) * 96 + kc1 * 8);
            rv = *(const u32x4*)(Vp + (size_t)vd * 2048 + kn + vc * 8);
        }
        if (kv0 <= qw0 + 31) {
            f32x16 s0, s1;
#pragma unroll
            for (int r = 0; r < 16; ++r) { s0[r] = 0.f; s1[r] = 0.f; }
#pragma unroll
            for (int ks = 0; ks < 6; ++ks) {
                const bf16x8 k0f = *(const bf16x8*)(st + r32 * AT_KSTR + ks * 32 + hi * 16);
                const bf16x8 k1f = *(const bf16x8*)(st + (32 + r32) * AT_KSTR + ks * 32 + hi * 16);
                s0 = __builtin_amdgcn_mfma_f32_32x32x16_bf16(k0f, qf[ks], s0, 0, 0, 0);
                s1 = __builtin_amdgcn_mfma_f32_32x32x16_bf16(k1f, qf[ks], s1, 0, 0, 0);
            }
            if (kv0 + 63 > qw0) {
#pragma unroll
                for (int r = 0; r < 16; ++r) { const int key = kv0 + crow(r, hi); if (key > qg) s0[r] = -INFINITY; if (key + 32 > qg) s1[r] = -INFINITY; }
            }
            float mx = fmaxf(s0[0], s1[0]);
#pragma unroll
            for (int r = 1; r < 16; ++r) mx = fmaxf(mx, fmaxf(s0[r], s1[r]));
            mx = fmaxf(mx, __shfl_xor(mx, 32));
            const float mn = fmaxf(m, mx), alpha = __builtin_amdgcn_exp2f(m - mn);
            float ps = 0.f;
#pragma unroll
            for (int r = 0; r < 16; ++r) { s0[r] = __builtin_amdgcn_exp2f(s0[r] - mn); s1[r] = __builtin_amdgcn_exp2f(s1[r] - mn); ps += s0[r] + s1[r]; }
            l = l * alpha + ps; m = mn;
#pragma unroll
            for (int r = 0; r < 16; ++r) { ot[0][r] *= alpha; ot[1][r] *= alpha; }
            const unsigned char* vb = st + AT_KB + r32 * AT_VSTR + hi * 8;
#pragma unroll
            for (int kt2 = 0; kt2 < 2; ++kt2)
#pragma unroll
                for (int s = 0; s < 2; ++s) {
                    u32x4 pw;
                    if (kt2 == 0) { pw.x = pk2(s0[8 * s], s0[8 * s + 1]); pw.y = pk2(s0[8 * s + 2], s0[8 * s + 3]); pw.z = pk2(s0[8 * s + 4], s0[8 * s + 5]); pw.w = pk2(s0[8 * s + 6], s0[8 * s + 7]); }
                    else { pw.x = pk2(s1[8 * s], s1[8 * s + 1]); pw.y = pk2(s1[8 * s + 2], s1[8 * s + 3]); pw.z = pk2(s1[8 * s + 4], s1[8 * s + 5]); pw.w = pk2(s1[8 * s + 6], s1[8 * s + 7]); }
                    const bf16x8 pf = __builtin_bit_cast(bf16x8, pw);
#pragma unroll
                    for (int dt = 0; dt < 2; ++dt) {
                        const unsigned char* a = vb + dt * 32 * AT_VSTR + (kt2 * 32 + 16 * s) * 2;
                        const u32x2 lo = *(const u32x2*)a, hh = *(const u32x2*)(a + 16);
                        const bf16x8 vf = __builtin_bit_cast(bf16x8, (u32x4){lo.x, lo.y, hh.x, hh.y});
                        ot[dt] = __builtin_amdgcn_mfma_f32_32x32x16_bf16(vf, pf, ot[dt], 0, 0, 0);
                    }
                }
        }
        if (t + 1 < nkv) {
            unsigned char* sn = lds + ((t + 1) & 1) * AT_STAGE;
            *(u32x4*)(sn + kr0 * AT_KSTR + kc0 * 16) = rk0; if (k2) *(u32x4*)(sn + kr1 * AT_KSTR + kc1 * 16) = rk1;
            u32x2* d = (u32x2*)(sn + AT_KB + vd * AT_VSTR + vc * 16); d[0] = (u32x2){rv.x, rv.y}; d[1] = (u32x2){rv.z, rv.w};
        }
        __syncthreads();
    }
    l += __shfl_xor(l, 32);
    const float inv = 1.0f / l;
    bf16_t* dst = (bf16_t*)(ws + OFF_HBUF) + ((size_t)(bh >> 3) * 2048 + qg) * 1024 + 512 + (bh & 7) * 64;
#pragma unroll
    for (int dt = 0; dt < 2; ++dt)
#pragma unroll
        for (int g4 = 0; g4 < 4; ++g4) { u32x2 o; o.x = pk2(ot[dt][4 * g4] * inv, ot[dt][4 * g4 + 1] * inv); o.y = pk2(ot[dt][4 * g4 + 2] * inv, ot[dt][4 * g4 + 3] * inv);
            *(u32x2*)(dst + dt * 32 + 8 * g4 + 4 * hi) = o; }
}

__device__ void phase2(const Params& p, unsigned char* lds) {
    for (int it = blockIdx.x; it < 256; it += gridDim.x) s5_item(p, lds, it >> 3, it & 7);
    for (int v = blockIdx.x; v < 256; v += gridDim.x) {
        const int bh = v >> 1;
        for (int i = 0; i < 4; ++i) { const int qb = (v & 1) ? ((i == 0) ? 6 : (i == 1) ? 1 : (i == 2) ? 5 : 2) : ((i == 0) ? 7 : (i == 1) ? 0 : (i == 2) ? 4 : 3); attn_item(p, lds, bh, qb); }
    }
}

__device__ __forceinline__ void cex_desc(float& a, float& b) { const float mx = fmaxf(a, b), mn = fminf(a, b); a = mx; b = mn; }
__device__ __forceinline__ void sort16_desc(float (&v)[16]) {
#pragma unroll
    for (int k = 2; k <= 16; k <<= 1)
#pragma unroll
        for (int j = k >> 1; j > 0; j >>= 1)
#pragma unroll
            for (int i = 0; i < 16; ++i) { const int l = i ^ j; if (l > i) { if ((i & k) == 0) cex_desc(v[i], v[l]); else cex_desc(v[l], v[i]); } }
}
__device__ __forceinline__ void merge16(float (&top)[16], const float (&c)[16]) {
#pragma unroll
    for (int i = 0; i < 16; ++i) top[i] = fmaxf(top[i], c[15 - i]);
#pragma unroll
    for (int j = 8; j > 0; j >>= 1)
#pragma unroll
        for (int i = 0; i < 16; ++i) { const int l = i ^ j; if (l > i) cex_desc(top[i], top[l]); }
}
__device__ __forceinline__ float mkc(float a, float b, unsigned code) { return __uint_as_float((__float_as_uint(a + b) & 0xFFFFFF00u) | code); }


struct RowBuf { u32x4 d[4], u[4]; };
__device__ __forceinline__ void g_load(RowBuf& B, const unsigned char* __restrict__ E8, int idv, int kbase, int lane) {
#pragma unroll
    for (int j = 0; j < 4; ++j) { const int e = __builtin_amdgcn_readlane(idv, kbase + j);
        B.d[j] = *(const u32x4*)(E8 + (size_t)e * 1024 + lane * 16); B.u[j] = *(const u32x4*)(E8 + (size_t)(16384 + e) * 1024 + lane * 16); }
}
__device__ __forceinline__ float dpp_add(float t, const int ctrl_sel) {
    if (ctrl_sel == 0) return t + __int_as_float(__builtin_amdgcn_update_dpp(0, __float_as_int(t), 0xB1, 0xF, 0xF, false));
    if (ctrl_sel == 1) return t + __int_as_float(__builtin_amdgcn_update_dpp(0, __float_as_int(t), 0x4E, 0xF, 0xF, false));
    if (ctrl_sel == 2) return t + __int_as_float(__builtin_amdgcn_update_dpp(0, __float_as_int(t), 0x141, 0xF, 0xF, false));
    return t + __int_as_float(__builtin_amdgcn_update_dpp(0, __float_as_int(t), 0x140, 0xF, 0xF, false));
}
__device__ __forceinline__ void g_compute(const RowBuf& B, const f32x2 (&hv)[8], f32x2 (&acc)[8], float sdv, float gwv, int kbase, int lane) {
    float s[4];
#pragma unroll
    for (int j = 0; j < 4; ++j) { f32x2 a = {0.f, 0.f};
#pragma unroll
        for (int q = 0; q < 4; ++q) { const int w = (int)B.d[j][q]; const f32x2 lo = __builtin_amdgcn_cvt_pk_f32_fp8(w, false), hi = __builtin_amdgcn_cvt_pk_f32_fp8(w, true);
            a = __builtin_elementwise_fma(lo, hv[2 * q], a); a = __builtin_elementwise_fma(hi, hv[2 * q + 1], a); }
        s[j] = a.x + a.y; }
    auto r0 = __builtin_amdgcn_permlane32_swap(__float_as_uint(s[0]), __float_as_uint(s[1]), false, false);
    auto r1 = __builtin_amdgcn_permlane32_swap(__float_as_uint(s[2]), __float_as_uint(s[3]), false, false);
    const float r01 = __uint_as_float(r0[0]) + __uint_as_float(r0[1]), r23 = __uint_as_float(r1[0]) + __uint_as_float(r1[1]);
    auto r2 = __builtin_amdgcn_permlane16_swap(__float_as_uint(r01), __float_as_uint(r23), false, false);
    float t = __uint_as_float(r2[0]) + __uint_as_float(r2[1]);
    t = dpp_add(t, 0); t = dpp_add(t, 1); t = dpp_add(t, 2); t = dpp_add(t, 3);
    const int jl = kbase + ((lane >> 4) & 1) * 2 + (lane >> 5);
    const float sdl = __shfl(sdv, jl), gwl = __shfl(gwv, jl);
    const float w = gwl * gelu_tanh(sdl * t);
    float wj[4];
    wj[0] = __int_as_float(__builtin_amdgcn_readlane(__float_as_int(w), 0)); wj[1] = __int_as_float(__builtin_amdgcn_readlane(__float_as_int(w), 32));
    wj[2] = __int_as_float(__builtin_amdgcn_readlane(__float_as_int(w), 16)); wj[3] = __int_as_float(__builtin_amdgcn_readlane(__float_as_int(w), 48));
#pragma unroll
    for (int j = 0; j < 4; ++j) { const f32x2 ws = {wj[j], wj[j]};
#pragma unroll
        for (int q = 0; q < 4; ++q) { const int w2 = (int)B.u[j][q]; const f32x2 lo = __builtin_amdgcn_cvt_pk_f32_fp8(w2, false), hi = __builtin_amdgcn_cvt_pk_f32_fp8(w2, true);
            acc[2 * q] = __builtin_elementwise_fma(lo, ws, acc[2 * q]); acc[2 * q + 1] = __builtin_elementwise_fma(hi, ws, acc[2 * q + 1]); } }
}

constexpr int QP_STR = 528, S_OFF = 128 * QP_STR, S_STR = 132, L_OFF = S_OFF + 128 * S_STR * 4;

__device__ void phase3(const Params& p, unsigned char* lds) {
    const int tid = threadIdx.x, lane = tid & 63, wid = __builtin_amdgcn_readfirstlane(tid >> 6), r32 = lane & 31, hi = lane >> 5, wm = wid >> 2, wn = wid & 3;
    unsigned char* ws = p.ws;
    bf16_t* hbuf = (bf16_t*)(ws + OFF_HBUF); const bf16_t* ybuf = (const bf16_t*)(ws + OFF_YBUF);
    int* idxb = (int*)(ws + OFF_IDX); float* gb = (float*)(ws + OFF_G);
    for (int tile = blockIdx.x; tile < 256; tile += gridDim.x) {
        const int row0 = tile * 128, b = row0 >> 11;
        const float* mod = (const float*)(ws + OFF_MODT) + (size_t)tile * 6144 - (size_t)b * 6144;
        for (int rep_a = 0; rep_a < ((PROBE_REP & 16) ? 2 : 1); ++rep_a) {
        for (int nc = 0; nc < 2; ++nc)
            gemm_128<2>(ybuf + (size_t)row0 * 512, 512, (const bf16_t*)(ws + OFF_WGLUT) + (size_t)nc * 256 * 512, 512, 512, lds, [&](int row, int col, float v) {
                const int c = nc * 256 + col; const float yv = bf2f(ybuf[(size_t)(row0 + row) * 512 + c]);
                hbuf[(size_t)(row0 + row) * 1024 + c] = (bf16_t)f2bf(yv * sigmoidf_(v + p.b_glu[c])); });
        __threadfence_block(); __syncthreads();
        for (int r = wid; r < 128; r += NWAVE) {
            bf16_t* hr = hbuf + (size_t)(row0 + r) * 1024;
#pragma unroll
            for (int half = 0; half < 2; ++half) {
                u32x4 w = *(const u32x4*)(hr + half * 512 + lane * 8); float v[8] = {bflo(w.x), bfhi(w.x), bflo(w.y), bfhi(w.y), bflo(w.z), bfhi(w.z), bflo(w.w), bfhi(w.w)}; float ss = 0.f;
#pragma unroll
                for (int i = 0; i < 8; ++i) ss += v[i] * v[i];
                const float rs = rsqrtf(wave_sum(ss) * (1.0f / 512.0f) + EPS);
                w.x = pk2(v[0] * rs, v[1] * rs); w.y = pk2(v[2] * rs, v[3] * rs); w.z = pk2(v[4] * rs, v[5] * rs); w.w = pk2(v[6] * rs, v[7] * rs);
                *(u32x4*)(hr + half * 512 + lane * 8) = w;
            }
        }
        __threadfence_block(); __syncthreads();
        for (int rep_c = 0; rep_c < ((PROBE_REP & 128) ? 2 : 1); ++rep_c)
        for (int nc = 0; nc < 4; ++nc)
            gemm_128<2>(hbuf + (size_t)row0 * 1024, 1024, (const bf16_t*)(ws + OFF_WOUTT) + (size_t)nc * 256 * 1024, 1024, 1024, lds, [&](int row, int col, float v) {
                const int c = nc * 256 + col; const size_t o = (size_t)(row0 + row) * 1024 + c; p.out[o] = p.x[o] + mod[b * 6144 + 2048 + c] * v; });
        if (PROBE_REP & 1024) for (int nc = 0; nc < 4; ++nc)
            gemm_128<2>(hbuf + (size_t)row0 * 1024, 1024, (const bf16_t*)(ws + OFF_WOUTT) + (size_t)nc * 256 * 1024, 1024, 1024, lds, [&](int row, int col, float v) { asm volatile("" :: "v"(v), "v"(row), "v"(col)); });
        __threadfence_block(); __syncthreads();
        for (int r = wid; r < 128; r += NWAVE) {
            const f32x4* xr = (const f32x4*)(p.out + (size_t)(row0 + r) * 1024); f32x4 v[4]; float ss = 0.f;
#pragma unroll
            for (int j = 0; j < 4; ++j) { v[j] = xr[lane + 64 * j]; ss += v[j].x * v[j].x + v[j].y * v[j].y + v[j].z * v[j].z + v[j].w * v[j].w; }
            const float rs = rsqrtf(wave_sum(ss) * (1.0f / 1024.0f) + EPS);
#pragma unroll
            for (int j = 0; j < 4; ++j) { const int col = 4 * (lane + 64 * j);
                const f32x4 g = *(const f32x4*)(p.norm_ffn + col), sc = *(const f32x4*)(mod + b * 6144 + 4096 + col), sh = *(const f32x4*)(mod + b * 6144 + 3072 + col);
                u32x2 o; o.x = pk2(v[j].x * rs * g.x * (1.f + sc.x) + sh.x, v[j].y * rs * g.y * (1.f + sc.y) + sh.y); o.y = pk2(v[j].z * rs * g.z * (1.f + sc.z) + sh.z, v[j].w * rs * g.w * (1.f + sc.w) + sh.w);
                *(u32x2*)(hbuf + (size_t)(row0 + r) * 1024 + col) = o; }
        }
        __threadfence_block(); __syncthreads();
        }
        for (int rep_e = 0; rep_e < ((PROBE_REP & 32) ? 2 : 1); ++rep_e) {
        float* Sx = (float*)(lds + S_OFF); float* Ls = (float*)(lds + L_OFF);
        for (int h = 0; h < 8; ++h) {
            gemm_128<2>(hbuf + (size_t)row0 * 1024, 1024, (const bf16_t*)(ws + OFF_WQT) + (size_t)h * 256 * 1024, 1024, 1024, lds, [&](int row, int col, float v) {
                *(bf16_t*)(lds + row * QP_STR + col * 2) = (bf16_t)f2bf(v); });
            __syncthreads();
            for (int ph = 0; ph < 2; ++ph) {
                f32x16 a0, a1;
#pragma unroll
                for (int r = 0; r < 16; ++r) { a0[r] = 0.f; a1[r] = 0.f; }
                const bf16_t* sk = (const bf16_t*)(ws + OFF_SUBK) + ((size_t)ph * 128 + wn * 32 + r32) * 128 + hi * 8;
                const unsigned char* qa = lds + (wm * 64 + r32) * QP_STR + (ph * 128 + hi * 8) * 2;
#pragma unroll
                for (int ks = 0; ks < 8; ++ks) {
                    const bf16x8 bfr = *(const bf16x8*)(sk + ks * 16);
                    const bf16x8 f0 = *(const bf16x8*)(qa + ks * 32), f1 = *(const bf16x8*)(qa + 32 * QP_STR + ks * 32);
                    a0 = __builtin_amdgcn_mfma_f32_32x32x16_bf16(f0, bfr, a0, 0, 0, 0);
                    a1 = __builtin_amdgcn_mfma_f32_32x32x16_bf16(f1, bfr, a1, 0, 0, 0);
                }
#pragma unroll
                for (int r = 0; r < 16; ++r) { Sx[(wm * 64 + crow(r, hi)) * S_STR + wn * 32 + r32] = a0[r]; Sx[(wm * 64 + 32 + crow(r, hi)) * S_STR + wn * 32 + r32] = a1[r]; }
                __syncthreads();
                if (wid < 2) {
                    const int row = wid * 64 + lane; float top[16];
#pragma unroll
                    for (int c8 = 0; c8 < 8; ++c8) { float c[16];
#pragma unroll
                        for (int q = 0; q < 4; ++q) { const f32x4 t4 = *(const f32x4*)(Sx + row * S_STR + c8 * 16 + q * 4);
                            c[4 * q] = __uint_as_float((__float_as_uint(t4.x) & 0xFFFFFF80u) | (unsigned)(127 - (c8 * 16 + 4 * q)));
                            c[4 * q + 1] = __uint_as_float((__float_as_uint(t4.y) & 0xFFFFFF80u) | (unsigned)(127 - (c8 * 16 + 4 * q + 1)));
                            c[4 * q + 2] = __uint_as_float((__float_as_uint(t4.z) & 0xFFFFFF80u) | (unsigned)(127 - (c8 * 16 + 4 * q + 2)));
                            c[4 * q + 3] = __uint_as_float((__float_as_uint(t4.w) & 0xFFFFFF80u) | (unsigned)(127 - (c8 * 16 + 4 * q + 3))); }
                        sort16_desc(c);
                        if (c8 == 0) {
#pragma unroll
                            for (int k = 0; k < 16; ++k) top[k] = c[k];
                        } else merge16(top, c); }
#pragma unroll
                    for (int q = 0; q < 4; ++q) *(f32x4*)(Ls + (ph * 128 + row) * 16 + 4 * q) = (f32x4){top[4 * q], top[4 * q + 1], top[4 * q + 2], top[4 * q + 3]};
                }
                __syncthreads();
            }
            if (wid < 2) {
                const int row = wid * 64 + lane; float a1[16], a2[16], top[16];
#pragma unroll
                for (int k = 0; k < 16; ++k) { a1[k] = __uint_as_float(__float_as_uint(Ls[row * 16 + k]) & 0xFFFFFF80u); a2[k] = __uint_as_float(__float_as_uint(Ls[(128 + row) * 16 + k]) & 0xFFFFFF80u); }
    { float c[16];
      c[0] = mkc(a1[0], a2[0], 255u);
      c[1] = mkc(a1[0], a2[1], 254u);
      c[2] = mkc(a1[0], a2[2], 253u);
      c[3] = mkc(a1[0], a2[3], 252u);
      c[4] = mkc(a1[0], a2[4], 251u);
      c[5] = mkc(a1[0], a2[5], 250u);
      c[6] = mkc(a1[0], a2[6], 249u);
      c[7] = mkc(a1[0], a2[7], 248u);
      c[8] = mkc(a1[0], a2[8], 247u);
      c[9] = mkc(a1[0], a2[9], 246u);
      c[10] = mkc(a1[0], a2[10], 245u);
      c[11] = mkc(a1[0], a2[11], 244u);
      c[12] = mkc(a1[0], a2[12], 243u);
      c[13] = mkc(a1[0], a2[13], 242u);
      c[14] = mkc(a1[0], a2[14], 241u);
      c[15] = mkc(a1[0], a2[15], 240u);
      sort16_desc(c); _Pragma("unroll") for (int k = 0; k < 16; ++k) top[k] = c[k];
    }
    { float c[16];
      c[0] = mkc(a1[1], a2[0], 239u);
      c[1] = mkc(a1[1], a2[1], 238u);
      c[2] = mkc(a1[1], a2[2], 237u);
      c[3] = mkc(a1[1], a2[3], 236u);
      c[4] = mkc(a1[1], a2[4], 235u);
      c[5] = mkc(a1[1], a2[5], 234u);
      c[6] = mkc(a1[1], a2[6], 233u);
      c[7] = mkc(a1[1], a2[7], 232u);
      c[8] = mkc(a1[2], a2[0], 223u);
      c[9] = mkc(a1[2], a2[1], 222u);
      c[10] = mkc(a1[2], a2[2], 221u);
      c[11] = mkc(a1[2], a2[3], 220u);
      c[12] = mkc(a1[2], a2[4], 219u);
      c[13] = mkc(a1[3], a2[0], 207u);
      c[14] = mkc(a1[3], a2[1], 206u);
      c[15] = mkc(a1[3], a2[2], 205u);
      sort16_desc(c); merge16(top, c);
    }
    { float c[16];
      c[0] = mkc(a1[3], a2[3], 204u);
      c[1] = mkc(a1[4], a2[0], 191u);
      c[2] = mkc(a1[4], a2[1], 190u);
      c[3] = mkc(a1[4], a2[2], 189u);
      c[4] = mkc(a1[5], a2[0], 175u);
      c[5] = mkc(a1[5], a2[1], 174u);
      c[6] = mkc(a1[6], a2[0], 159u);
      c[7] = mkc(a1[6], a2[1], 158u);
      c[8] = mkc(a1[7], a2[0], 143u);
      c[9] = mkc(a1[7], a2[1], 142u);
      c[10] = mkc(a1[8], a2[0], 127u);
      c[11] = mkc(a1[9], a2[0], 111u);
      c[12] = mkc(a1[10], a2[0], 95u);
      c[13] = mkc(a1[11], a2[0], 79u);
      c[14] = mkc(a1[12], a2[0], 63u);
      c[15] = mkc(a1[13], a2[0], 47u);
      sort16_desc(c); merge16(top, c);
    }
    { float c[16];
      c[0] = mkc(a1[14], a2[0], 31u);
      c[1] = mkc(a1[15], a2[0], 15u);
      c[2] = -3.0e38f;
      c[3] = -3.0e38f;
      c[4] = -3.0e38f;
      c[5] = -3.0e38f;
      c[6] = -3.0e38f;
      c[7] = -3.0e38f;
      c[8] = -3.0e38f;
      c[9] = -3.0e38f;
      c[10] = -3.0e38f;
      c[11] = -3.0e38f;
      c[12] = -3.0e38f;
      c[13] = -3.0e38f;
      c[14] = -3.0e38f;
      c[15] = -3.0e38f;
      sort16_desc(c); merge16(top, c);
    }
                float e[16], es = 0.f; const float m0 = __uint_as_float(__float_as_uint(top[0]) & 0xFFFFFF00u);
#pragma unroll
                for (int k = 0; k < 16; ++k) { e[k] = __expf(__uint_as_float(__float_as_uint(top[k]) & 0xFFFFFF00u) - m0); es += e[k]; }
                const float inv = 1.0f / es; const size_t ob = (size_t)(row0 + row) * 128 + h * 16;
#pragma unroll
                for (int k = 0; k < 16; ++k) { const unsigned code = 255u - (__float_as_uint(top[k]) & 0xFFu); const int i = code >> 4, j = code & 15;
                    const int i1 = 127 - (int)(__float_as_uint(Ls[row * 16 + i]) & 0x7Fu), i2 = 127 - (int)(__float_as_uint(Ls[(128 + row) * 16 + j]) & 0x7Fu);
                    idxb[ob + k] = i1 * 128 + i2; gb[ob + k] = e[k] * inv; }
            }
            __syncthreads();
        }
        }
        __threadfence_block(); __syncthreads();
        {
            const unsigned char* E8 = ws + OFF_E8; const float* esc = (const float*)(ws + OFF_ESC);
            for (int r = wid; r < 128; r += NWAVE) {
                const size_t tok = row0 + r; f32x2 hv[8], acc[8];
                { const u32x4 w0 = *(const u32x4*)(hbuf + tok * 1024 + lane * 16), w1 = *(const u32x4*)(hbuf + tok * 1024 + lane * 16 + 8);
                  hv[0] = (f32x2){bflo(w0.x), bfhi(w0.x)}; hv[1] = (f32x2){bflo(w0.y), bfhi(w0.y)}; hv[2] = (f32x2){bflo(w0.z), bfhi(w0.z)}; hv[3] = (f32x2){bflo(w0.w), bfhi(w0.w)};
                  hv[4] = (f32x2){bflo(w1.x), bfhi(w1.x)}; hv[5] = (f32x2){bflo(w1.y), bfhi(w1.y)}; hv[6] = (f32x2){bflo(w1.z), bfhi(w1.z)}; hv[7] = (f32x2){bflo(w1.w), bfhi(w1.w)}; }
#pragma unroll
                for (int i = 0; i < 8; ++i) acc[i] = (f32x2){0.f, 0.f};
                for (int rep_g = 0; rep_g < ((PROBE_REP & 64) ? 2 : 1); ++rep_g)
                for (int half_ = 0; half_ < 2; ++half_) {
                    const int idv = idxb[tok * 128 + half_ * 64 + lane]; const float sdv = esc[idv], gwv = gb[tok * 128 + half_ * 64 + lane] * esc[16384 + idv];
                    RowBuf A, B;
                    g_load(A, E8, idv, 0, lane);
#pragma unroll 1
                    for (int kb = 0; kb < 64; kb += 8) {
                        g_load(B, E8, idv, kb + 4, lane);
                        g_compute(A, hv, acc, sdv, gwv, kb, lane);
                        if (kb + 8 < 64) g_load(A, E8, idv, kb + 8, lane);
                        g_compute(B, hv, acc, sdv, gwv, kb + 4, lane);
                    }
                }
                if (PROBE_REP & 64) {
#pragma unroll
                    for (int i = 0; i < 8; ++i) acc[i] *= 0.5f; }
                float* orow = p.out + tok * 1024 + lane * 16; const float* gf = mod + b * 6144 + 5120 + lane * 16;
#pragma unroll
                for (int q = 0; q < 4; ++q) { f32x4 o = *(const f32x4*)(orow + 4 * q); const f32x4 gg = *(const f32x4*)(gf + 4 * q);
                    o.x += gg.x * acc[2 * q].x; o.y += gg.y * acc[2 * q].y; o.z += gg.z * acc[2 * q + 1].x; o.w += gg.w * acc[2 * q + 1].y; *(f32x4*)(orow + 4 * q) = o; }
            }
        }
        __syncthreads();
    }
}

__global__ void __launch_bounds__(NTHR, 2) fwd_kernel(Params p) {
    extern __shared__ __attribute__((aligned(16))) unsigned char lds[];
    if (p.ph_lo <= 0 && 0 < p.ph_hi) { phase0(p, lds); if (PROBE_REP & 1) { __syncthreads(); phase0(p, lds); } }
#if MK_COOP
    if (p.ph_lo <= 0 && 1 < p.ph_hi) cg::this_grid().sync();
#endif
    if (p.ph_lo <= 1 && 1 < p.ph_hi) { phase1(p, lds); if (PROBE_REP & 2) { __syncthreads(); phase1(p, lds); } }
#if MK_COOP
    if (p.ph_lo <= 1 && 2 < p.ph_hi) cg::this_grid().sync();
#endif
    if (p.ph_lo <= 2 && 2 < p.ph_hi) { phase2(p, lds); if (PROBE_REP & 4) { __syncthreads(); phase2(p, lds); } }
#if MK_COOP
    if (p.ph_lo <= 2 && 3 < p.ph_hi) cg::this_grid().sync();
#endif
    if (p.ph_lo <= 3 && 3 < p.ph_hi) phase3(p, lds);
}

extern "C" void kernel_launch(void* const* d_in, const int* in_sizes, int n_in, void* d_out, int out_size, void* d_ws, size_t ws_size, hipStream_t stream) {
    static int grid = 0;
    if (grid == 0) {
        if (n_in != 31 || ws_size < WS_NEED) { fprintf(stderr, "kernel_launch: bad inputs (n_in %d, ws %zu < %zu)\n", n_in, ws_size, (size_t)WS_NEED); grid = -1; return; }
        int dev = 0, cus = 0, per_cu = 0;
        hipGetDevice(&dev); hipDeviceGetAttribute(&cus, hipDeviceAttributeMultiprocessorCount, dev);
        if (hipFuncSetAttribute((const void*)fwd_kernel, hipFuncAttributeMaxDynamicSharedMemorySize, LDS_BYTES) != hipSuccess) { fprintf(stderr, "kernel_launch: hipFuncSetAttribute failed\n"); grid = -1; return; }
        hipOccupancyMaxActiveBlocksPerMultiprocessor(&per_cu, (const void*)fwd_kernel, NTHR, LDS_BYTES);
        if (per_cu < 1) { fprintf(stderr, "kernel_launch: occupancy query says %d blocks/CU\n", per_cu); per_cu = 1; }
        grid = cus;
        (void)hipGetLastError();
    }
    if (grid < 0) return;
    Params p{};
    const float** f = (const float**)&p;
    for (int i = 0; i < 31; ++i) f[i] = (const float*)d_in[i];
    p.out = (float*)d_out; p.ws = (unsigned char*)d_ws;
#if MK_COOP
    p.ph_lo = 0; p.ph_hi = 4;
    void* args[] = {&p};
    hipError_t e = hipLaunchCooperativeKernel((const void*)fwd_kernel, dim3(grid), dim3(NTHR), args, LDS_BYTES, stream);
    if (e != hipSuccess) fprintf(stderr, "cooperative launch failed: %s (grid %d)\n", hipGetErrorString(e), grid);
#else
    for (int ph = 0; ph < 4; ++ph) { p.ph_lo = ph; p.ph_hi = ph + 1; hipLaunchKernelGGL(fwd_kernel, dim3(grid), dim3(NTHR), LDS_BYTES, stream, p); }
#endif
}
```

```cpp
#include <hip/hip_runtime.h>
#include <hip/hip_cooperative_groups.h>
#include <cstdio>
#include <cstdint>
namespace cg = cooperative_groups;

#ifndef PROBE_REP
#define PROBE_REP 0
#endif
#ifndef MK_COOP
#define MK_COOP 1
#endif

typedef unsigned short bf16_t;
typedef short bf16x8 __attribute__((ext_vector_type(8)));
typedef short s16x4 __attribute__((ext_vector_type(4)));
typedef float f32x16 __attribute__((ext_vector_type(16)));
typedef float f32x4 __attribute__((ext_vector_type(4)));
typedef float f32x2 __attribute__((ext_vector_type(2)));
typedef unsigned u32x4 __attribute__((ext_vector_type(4)));
typedef unsigned u32x2 __attribute__((ext_vector_type(2)));

constexpr int NTHR = 512, NWAVE = 8;
constexpr int T_TOK = 32768, DM = 1024, NB = 16, SEQ = 2048;
constexpr int LDS_BYTES = 163840;
constexpr float EPS = 1e-6f;
constexpr float QSCALE = 0.10206207261596575f * 1.4426950408889634f;

constexpr size_t OFF_PART  = 0;
constexpr size_t OFF_MODT  = 8u << 20;
constexpr size_t OFF_WINT  = 16u << 20;
constexpr size_t OFF_WGLUT = OFF_WINT + (2u << 20);
constexpr size_t OFF_WUQT  = OFF_WGLUT + (512u << 10);
constexpr size_t OFF_WUKVT = OFF_WUQT + 524288;
constexpr size_t OFF_WOUTT = OFF_WUKVT + 262144;
constexpr size_t OFF_WQT   = OFF_WOUTT + (2u << 20);
constexpr size_t OFF_SUBK  = OFF_WQT + (4u << 20);
constexpr size_t OFF_KMT   = OFF_SUBK + 65536;
constexpr size_t OFF_WZT   = OFF_KMT + 20971520;
constexpr size_t OFF_AL    = OFF_WZT + 4194304;
constexpr size_t OFF_HBUF  = OFF_AL + 16384;
constexpr size_t OFF_PROJ2 = OFF_HBUF + (64u << 20);
constexpr size_t OFF_UBUF  = OFF_PROJ2 + (32u << 20);
constexpr size_t OFF_Q     = OFF_UBUF + 41943040;
constexpr size_t OFF_K     = OFF_Q + 50331648;
constexpr size_t OFF_VT    = OFF_K + 50331648;
constexpr size_t OFF_YBUF  = OFF_VT + 33554432;
constexpr size_t OFF_IDX   = OFF_YBUF + (32u << 20);
constexpr size_t OFF_G     = OFF_IDX + (16u << 20);
constexpr size_t OFF_E8    = OFF_G + (16u << 20);
constexpr size_t OFF_ESC   = OFF_E8 + (32u << 20);
constexpr size_t WS_NEED   = OFF_ESC + (1u << 20);

struct Params {
    const float* x; const float* c; const int* pos; const float* w_ada; const float* b_ada; const float* norm_mix; const float* norm_ffn; const float* w_in;
    const float* lam_re; const float* lam_im; const float* log_dt; const float* b_re; const float* b_im; const float* c_re; const float* c_im; const float* d_skip;
    const float* w_glu; const float* b_glu; const float* q_a_norm; const float* w_uq; const float* kv_a_norm; const float* w_ukv; const float* q_norm; const float* k_norm;
    const float* out_norm_ssm; const float* out_norm_attn; const float* w_out; const float* w_query; const float* sub_keys; const float* e_down; const float* e_up;
    float* out; unsigned char* ws; int ph_lo, ph_hi;
};

__device__ __forceinline__ unsigned f2bf(float f) { unsigned u = __float_as_uint(f); return (u + 0x7fffu + ((u >> 16) & 1u)) >> 16; }
__device__ __forceinline__ unsigned pk2(float lo, float hi) { return f2bf(lo) | (f2bf(hi) << 16); }
__device__ __forceinline__ float bf2f(unsigned short b) { return __uint_as_float(((unsigned)b) << 16); }
__device__ __forceinline__ float bflo(unsigned w) { return __uint_as_float(w << 16); }
__device__ __forceinline__ float bfhi(unsigned w) { return __uint_as_float(w & 0xffff0000u); }
__device__ __forceinline__ int opq_s(int x) { asm volatile("" : "+s"(x)); return x; }
__device__ __forceinline__ int opq_v(int x) { asm volatile("" : "+v"(x)); return x; }
template <class T> __device__ __forceinline__ T* opq_p(T* x) { asm volatile("" : "+s"(x)); return x; }
__device__ __forceinline__ int crow(int r, int hi) { return (r & 3) + 8 * (r >> 2) + 4 * hi; }
__device__ __forceinline__ float wave_sum(float v) {
#pragma unroll
    for (int o = 1; o < 64; o <<= 1) v += __shfl_xor(v, o);
    return v;
}
__device__ __forceinline__ float gelu_tanh(float x) {
    const float u = 0.7978845608028654f * (x + 0.044715f * x * x * x);
    const float t = 1.0f - 2.0f / (1.0f + __expf(2.0f * u));
    return 0.5f * x * (1.0f + t);
}
__device__ __forceinline__ float sigmoidf_(float z) { return 1.0f / (1.0f + __expf(-z)); }

constexpr int G_STR = 144;
constexpr int G_ABYTES = 128 * G_STR;
template <int NT> struct GemmCfg { static constexpr int BN = 128 * NT, BBYTES = BN * G_STR, STAGE = G_ABYTES + BBYTES; };

struct ARow { const bf16_t* A; int lda; __device__ __forceinline__ const bf16_t* operator()(int row, int k) const { return A + (size_t)row * lda + k; } };
struct AGrp { const bf16_t* Y; __device__ __forceinline__ const bf16_t* operator()(int row, int k) const { return Y + ((size_t)(k >> 4) * T_TOK + row) * 16 + (k & 15); } };
constexpr int CSTR = 260;

template <int NT, int MODE, int MID, class AL, class Epi>
__device__ __forceinline__ void gemm_128(const AL aload, const bf16_t* __restrict__ Bt, int ldb, int K, unsigned char* lds, const float* midscale, Epi epi) {
    typedef GemmCfg<NT> C;
    const int tid = opq_v((int)threadIdx.x), lane = tid & 63, wid = __builtin_amdgcn_readfirstlane(tid >> 6), wm = wid >> 2, wn = wid & 3, r32 = lane & 31, hi = lane >> 5;
    f32x16 acc[2][NT];
#pragma unroll
    for (int i = 0; i < 2; ++i)
#pragma unroll
        for (int j = 0; j < NT; ++j)
#pragma unroll
            for (int r = 0; r < 16; ++r) acc[i][j][r] = 0.f;
    const int prow = tid >> 3, pc = tid & 7;
    const bf16_t* gb = Bt + (size_t)prow * ldb + pc * 8;
    const int ldsoff = prow * G_STR + pc * 16;
    u32x4 ra[2], rb[2 * NT];
    const int nk = K >> 6;
#pragma unroll
    for (int q = 0; q < 2; ++q) ra[q] = *(const u32x4*)aload(prow + 64 * q, pc * 8);
#pragma unroll
    for (int q = 0; q < 2 * NT; ++q) rb[q] = *(const u32x4*)(gb + (size_t)(64 * q) * ldb);
#pragma unroll
    for (int q = 0; q < 2; ++q) *(u32x4*)(lds + ldsoff + q * 64 * G_STR) = ra[q];
#pragma unroll
    for (int q = 0; q < 2 * NT; ++q) *(u32x4*)(lds + G_ABYTES + ldsoff + q * 64 * G_STR) = rb[q];
    __syncthreads();
    for (int kt = 0; kt < nk; ++kt) {
        unsigned char* st = lds + (kt & 1) * C::STAGE;
        if (kt + 1 < nk) {
#pragma unroll
            for (int q = 0; q < 2; ++q) ra[q] = *(const u32x4*)aload(prow + 64 * q, (kt + 1) * 64 + pc * 8);
#pragma unroll
            for (int q = 0; q < 2 * NT; ++q) rb[q] = *(const u32x4*)(gb + (size_t)(64 * q) * ldb + (kt + 1) * 64);
        }
        if (MID > 0 && kt == MID) {
#pragma unroll
            for (int i = 0; i < 2; ++i)
#pragma unroll
                for (int r = 0; r < 16; ++r) { const float sc = midscale[wm * 64 + i * 32 + crow(r, hi)];
#pragma unroll
                    for (int j = 0; j < NT; ++j) acc[i][j][r] *= sc; }
        }
        const unsigned char* pa = st + (wm * 64 + r32) * G_STR + hi * 16;
        const unsigned char* pb = st + G_ABYTES + (wn * 32 * NT + r32) * G_STR + hi * 16;
#pragma unroll
        for (int ks = 0; ks < 4; ++ks) {
            bf16x8 af[2], bfr[NT];
#pragma unroll
            for (int i = 0; i < 2; ++i) af[i] = *(const bf16x8*)(pa + i * 32 * G_STR + ks * 32);
#pragma unroll
            for (int j = 0; j < NT; ++j) bfr[j] = *(const bf16x8*)(pb + j * 32 * G_STR + ks * 32);
#pragma unroll
            for (int i = 0; i < 2; ++i)
#pragma unroll
                for (int j = 0; j < NT; ++j) acc[i][j] = __builtin_amdgcn_mfma_f32_32x32x16_bf16(af[i], bfr[j], acc[i][j], 0, 0, 0);
        }
        if (kt + 1 < nk) {
            unsigned char* sn = lds + ((kt + 1) & 1) * C::STAGE;
#pragma unroll
            for (int q = 0; q < 2; ++q) *(u32x4*)(sn + ldsoff + q * 64 * G_STR) = ra[q];
#pragma unroll
            for (int q = 0; q < 2 * NT; ++q) *(u32x4*)(sn + G_ABYTES + ldsoff + q * 64 * G_STR) = rb[q];
        }
        __syncthreads();
    }
    if constexpr (MODE == 0) {
#pragma unroll
        for (int i = 0; i < 2; ++i)
#pragma unroll
            for (int j = 0; j < NT; ++j)
#pragma unroll
                for (int r = 0; r < 16; ++r) epi(wm * 64 + i * 32 + crow(r, hi), wn * 32 * NT + j * 32 + r32, acc[i][j][r]);
    } else {
        float* Ct = (float*)lds;
#pragma unroll
        for (int i = 0; i < 2; ++i)
#pragma unroll
            for (int j = 0; j < NT; ++j)
#pragma unroll
                for (int r = 0; r < 16; ++r) Ct[(wm * 64 + i * 32 + crow(r, hi)) * CSTR + wn * 32 * NT + j * 32 + r32] = acc[i][j][r];
        __syncthreads();
        epi((const float*)Ct);
        __syncthreads();
    }
}

__device__ __forceinline__ void p0_transpose(const float* __restrict__ W, int K, int N, int Npad, bf16_t* __restrict__ WT,
                                             const float* g0, const float* g1, int gsplit, float* scr, int item, int cmap = 0) {
    const int tid = threadIdx.x;
    const int nkb = K / 64, kb = item % nkb, nb = item / nkb, k0 = kb * 64, n0 = nb * 64;
#pragma unroll
    for (int r = 0; r < 8; ++r) {
        const int kk = r * 8 + (tid >> 6), nn = tid & 63, k = k0 + kk; int n = n0 + nn;
        if (cmap) n = ((n & 255) < 192) ? (n >> 8) * 192 + (n & 255) : N;
        float v = (n < N) ? W[(size_t)k * N + n] : 0.f;
        if (g0) v *= (k < gsplit) ? g0[k] : g1[k - gsplit];
        scr[kk * 65 + nn] = v;
    }
    __syncthreads();
    {
        const int n = tid >> 3, kc = tid & 7; const float* s = scr + (kc * 8) * 65 + n;
        u32x4 o; o.x = pk2(s[0], s[65]); o.y = pk2(s[2 * 65], s[3 * 65]); o.z = pk2(s[4 * 65], s[5 * 65]); o.w = pk2(s[6 * 65], s[7 * 65]);
        *(u32x4*)(WT + (size_t)(n0 + n) * K + k0 + kc * 8) = o;
    }
    __syncthreads();
}


__device__ __forceinline__ void quant_row(const f32x4 (&a)[4], unsigned char* dst, float* scale_out, int lane) {
    float am = 0.f;
#pragma unroll
    for (int q = 0; q < 4; ++q) am = fmaxf(am, fmaxf(fmaxf(fabsf(a[q].x), fabsf(a[q].y)), fmaxf(fabsf(a[q].z), fabsf(a[q].w))));
#pragma unroll
    for (int o = 1; o < 64; o <<= 1) am = fmaxf(am, __shfl_xor(am, o));
    const float sc = (am > 0.f) ? am * (1.0f / 224.0f) : 1.0f, inv = 1.0f / sc;
    u32x4 o;
    { int w = __builtin_amdgcn_cvt_pk_fp8_f32(a[0].x * inv, a[0].y * inv, 0, false); w = __builtin_amdgcn_cvt_pk_fp8_f32(a[0].z * inv, a[0].w * inv, w, true); o.x = (unsigned)w; }
    { int w = __builtin_amdgcn_cvt_pk_fp8_f32(a[1].x * inv, a[1].y * inv, 0, false); w = __builtin_amdgcn_cvt_pk_fp8_f32(a[1].z * inv, a[1].w * inv, w, true); o.y = (unsigned)w; }
    { int w = __builtin_amdgcn_cvt_pk_fp8_f32(a[2].x * inv, a[2].y * inv, 0, false); w = __builtin_amdgcn_cvt_pk_fp8_f32(a[2].z * inv, a[2].w * inv, w, true); o.z = (unsigned)w; }
    { int w = __builtin_amdgcn_cvt_pk_fp8_f32(a[3].x * inv, a[3].y * inv, 0, false); w = __builtin_amdgcn_cvt_pk_fp8_f32(a[3].z * inv, a[3].w * inv, w, true); o.w = (unsigned)w; }
    *(u32x4*)dst = o;
    if (lane == 0) *scale_out = sc;
}

__device__ __forceinline__ void quant_row_i8(const f32x4 (&a)[4], unsigned char* dst, float* scale_out, int lane) {
    float am = 0.f;
#pragma unroll
    for (int q = 0; q < 4; ++q) am = fmaxf(am, fmaxf(fmaxf(fabsf(a[q].x), fabsf(a[q].y)), fmaxf(fabsf(a[q].z), fabsf(a[q].w))));
#pragma unroll
    for (int o = 1; o < 64; o <<= 1) am = fmaxf(am, __shfl_xor(am, o));
    const float sc = (am > 0.f) ? am * (1.0f / 127.0f) : 1.0f, inv = 1.0f / sc;
    u32x4 o;
#pragma unroll
    for (int q = 0; q < 4; ++q) { const int b0 = (int)rintf(a[q].x * inv), b1 = (int)rintf(a[q].y * inv), b2 = (int)rintf(a[q].z * inv), b3 = (int)rintf(a[q].w * inv);
        o[q] = (unsigned)(b0 & 0xFF) | ((unsigned)(b1 & 0xFF) << 8) | ((unsigned)(b2 & 0xFF) << 16) | ((unsigned)(b3 & 0xFF) << 24); }
    *(u32x4*)dst = o;
    if (lane == 0) *scale_out = sc;
}
__device__ void phase0(const Params& p, unsigned char* lds) {
    const int tid = threadIdx.x, G = gridDim.x, bid = blockIdx.x;
    unsigned char* ws = p.ws;
    float* scr = (float*)lds;
    {
        float* part = (float*)(ws + OFF_PART);
        for (int it = bid; it < 24 * 16; it += G) {
            const int nb = it % 24, ks = it / 24, n = nb * 256 + (tid & 255), bh = tid >> 8;
            for (int i = tid; i < 16 * 64; i += NTHR) { const int b = i >> 6, kk = i & 63; const float cv = p.c[b * 1024 + ks * 64 + kk]; scr[i] = cv / (1.0f + __expf(-cv)); }
            __syncthreads();
            float acc[8];
#pragma unroll
            for (int j = 0; j < 8; ++j) acc[j] = 0.f;
            for (int kk = 0; kk < 64; ++kk) {
                const float w = p.w_ada[(size_t)(ks * 64 + kk) * 6144 + n];
#pragma unroll
                for (int j = 0; j < 8; ++j) acc[j] += w * scr[(bh * 8 + j) * 64 + kk];
            }
#pragma unroll
            for (int j = 0; j < 8; ++j) part[((size_t)ks * 16 + bh * 8 + j) * 6144 + n] = acc[j];
            __syncthreads();
        }
    }
    {
        constexpr int I_IN = 16 * 16, I_GLU = 8 * 8, I_UQ = 4 * 16, I_UKV = 2 * 16, I_OUT = 16 * 16, I_Q = 16 * 32;
        constexpr int NIT = I_IN + I_GLU + I_UQ + I_UKV + I_OUT + I_Q;
        for (int it = bid; it < NIT; it += G) {
            int r = it;
            if (r < I_IN) { p0_transpose(p.w_in, 1024, 928, 1024, (bf16_t*)(ws + OFF_WINT), nullptr, nullptr, 0, scr, r); continue; } r -= I_IN;
            if (r < I_GLU) { p0_transpose(p.w_glu, 512, 512, 512, (bf16_t*)(ws + OFF_WGLUT), nullptr, nullptr, 0, scr, r); continue; } r -= I_GLU;
            if (r < I_UQ) { p0_transpose(p.w_uq, 256, 768, 1024, (bf16_t*)(ws + OFF_WUQT), p.q_a_norm, p.q_a_norm, 256, scr, r, 1); continue; } r -= I_UQ;
            if (r < I_UKV) { p0_transpose(p.w_ukv, 128, 1024, 1024, (bf16_t*)(ws + OFF_WUKVT), p.kv_a_norm, p.kv_a_norm, 128, scr, r); continue; } r -= I_UKV;
            if (r < I_OUT) { p0_transpose(p.w_out, 1024, 1024, 1024, (bf16_t*)(ws + OFF_WOUTT), p.out_norm_ssm, p.out_norm_attn, 512, scr, r); continue; } r -= I_OUT;
            p0_transpose(p.w_query, 1024, 2048, 2048, (bf16_t*)(ws + OFF_WQT), nullptr, nullptr, 0, scr, r);
        }
    }
    {
        const size_t gt = (size_t)bid * NTHR + tid, gs = (size_t)G * NTHR;
        for (size_t i = gt; i < 32768 / 8; i += gs) { const f32x4 a = ((const f32x4*)p.sub_keys)[2 * i], b = ((const f32x4*)p.sub_keys)[2 * i + 1];
            u32x4 o; o.x = pk2(a.x, a.y); o.y = pk2(a.z, a.w); o.z = pk2(b.x, b.y); o.w = pk2(b.z, b.w); ((u32x4*)(ws + OFF_SUBK))[i] = o; }
    }
    {
        const int lane = tid & 63, gw = bid * NWAVE + (tid >> 6), NGW = G * NWAVE;
        unsigned char* E8 = ws + OFF_E8; float* esc = (float*)(ws + OFF_ESC);
        for (int r = gw; r < 32768; r += 2 * NGW) {
            const int r2 = r + NGW; const bool has2 = r2 < 32768;
            const float* s0p = ((r < 16384) ? p.e_down : p.e_up) + (size_t)(r & 16383) * 1024 + lane * 16;
            const float* s1p = ((r2 < 16384) ? p.e_down : p.e_up) + (size_t)(r2 & 16383) * 1024 + lane * 16;
            f32x4 a[4], b[4];
#pragma unroll
            for (int q = 0; q < 4; ++q) a[q] = ((const f32x4*)s0p)[q];
            if (has2) {
#pragma unroll
                for (int q = 0; q < 4; ++q) b[q] = ((const f32x4*)s1p)[q]; }
            if (r < 16384) quant_row_i8(a, E8 + (size_t)r * 1024 + lane * 16, esc + r, lane); else quant_row(a, E8 + (size_t)r * 1024 + lane * 16, esc + r, lane);
            if (has2) { if (r2 < 16384) quant_row_i8(b, E8 + (size_t)r2 * 1024 + lane * 16, esc + r2, lane); else quant_row(b, E8 + (size_t)r2 * 1024 + lane * 16, esc + r2, lane); }
        }
    }
    {
        f32x2* apow = (f32x2*)lds;
        f32x2* Bb = (f32x2*)(lds + 16896);
        f32x2* Cc = (f32x2*)(lds + 16896 + 8192);
        float* Kt = (float*)(lds + 16896 + 16384);
        for (int g = G - 1 - bid; g < 32; g += G) {
            if (g < 0) break;
            const float dt = __expf(p.log_dt[g]);
            for (int i = tid; i < 33 * 64; i += NTHR) { const int j = i >> 6, pp = i & 63; const float lr = p.lam_re[g * 64 + pp], li = p.lam_im[g * 64 + pp];
                const float mag = expf((float)j * lr * dt); float sn, cs; sincosf((float)j * li * dt, &sn, &cs); apow[i] = (f32x2){mag * cs, mag * sn}; }
            for (int i = tid; i < 1024; i += NTHR) { const int pp = i >> 4; const float lr = p.lam_re[g * 64 + pp], li = p.lam_im[g * 64 + pp];
                const float mag = expf(lr * dt); float sn, cs; sincosf(li * dt, &sn, &cs); const float nr = mag * cs - 1.0f, ni = mag * sn, den = lr * lr + li * li;
                const float cr = (nr * lr + ni * li) / den, ci = (ni * lr - nr * li) / den; const float br = p.b_re[(size_t)g * 1024 + i], bi = p.b_im[(size_t)g * 1024 + i];
                Bb[i] = (f32x2){cr * br - ci * bi, cr * bi + ci * br}; }
            for (int i = tid; i < 1024; i += NTHR) Cc[i] = (f32x2){p.c_re[(size_t)g * 1024 + i], p.c_im[(size_t)g * 1024 + i]};
            __syncthreads();
            for (int i = tid; i < 8192; i += NTHR) { const int j = i >> 8, co = (i >> 4) & 15, ci = i & 15; float s = 0.f;
                for (int pp = 0; pp < 64; ++pp) { const f32x2 c = Cc[co * 64 + pp], a = apow[j * 64 + pp], b = Bb[pp * 16 + ci]; const float car = c.x * a.x - c.y * a.y, cai = c.x * a.y + c.y * a.x; s += car * b.x - cai * b.y; }
                if (j == 0 && co == ci) s += p.d_skip[g * 16 + co];
                Kt[i] = s; }
            __syncthreads();
            bf16_t* KmT = (bf16_t*)(ws + OFF_KMT) + (size_t)g * 512 * 640;
            for (int q = tid; q < 512 * 80; q += NTHR) { const int n = q / 80, kc = q % 80, k0 = kc * 8, t = n >> 4, co = n & 15; float v[8];
                if (k0 < 512) { const int s = k0 >> 4, ci0 = k0 & 15;
#pragma unroll
                    for (int i = 0; i < 8; ++i) v[i] = (t >= s) ? Kt[((t - s) * 16 + co) * 16 + ci0 + i] : 0.f;
                } else { const int kk0 = k0 - 512, ri = kk0 >> 6, p0 = kk0 & 63;
#pragma unroll
                    for (int i = 0; i < 8; ++i) { const f32x2 c = Cc[co * 64 + p0 + i], a = apow[(t + 1) * 64 + p0 + i]; v[i] = (ri == 0) ? (c.x * a.x - c.y * a.y) : -(c.x * a.y + c.y * a.x); } }
                u32x4 o; o.x = pk2(v[0], v[1]); o.y = pk2(v[2], v[3]); o.z = pk2(v[4], v[5]); o.w = pk2(v[6], v[7]); *(u32x4*)(KmT + (size_t)n * 640 + k0) = o; }
            bf16_t* WzT = (bf16_t*)(ws + OFF_WZT) + (size_t)g * 128 * 512;
            for (int q = tid; q < 128 * 64; q += NTHR) { const int n = q >> 6, kc = q & 63, k0 = kc * 8, s = k0 >> 4, ci0 = k0 & 15, ri = n >> 6, pp = n & 63; float v[8];
                const f32x2 a = apow[(31 - s) * 64 + pp];
#pragma unroll
                for (int i = 0; i < 8; ++i) { const f32x2 b = Bb[pp * 16 + ci0 + i]; v[i] = (ri == 0) ? (a.x * b.x - a.y * b.y) : (a.x * b.y + a.y * b.x); }
                u32x4 o; o.x = pk2(v[0], v[1]); o.y = pk2(v[2], v[3]); o.z = pk2(v[4], v[5]); o.w = pk2(v[6], v[7]); *(u32x4*)(WzT + (size_t)n * 512 + k0) = o; }
            if (tid < 64) ((f32x2*)(ws + OFF_AL))[g * 64 + tid] = apow[32 * 64 + tid];
            __syncthreads();
        }
    }
}


__device__ __forceinline__ void finalize_row(const float* nope, const float* ra, const float* rb, float rn, float rnr, const float* __restrict__ gain, const float* cs, const float* sn, bf16_t* dst) {
#pragma unroll
    for (int j = 0; j < 8; ++j) { const f32x4 a = *(const f32x4*)(nope + 8 * j), c = *(const f32x4*)(nope + 8 * j + 4);
        u32x4 o; o.x = pk2(a.x * rn * gain[8 * j], a.y * rn * gain[8 * j + 1]); o.y = pk2(a.z * rn * gain[8 * j + 2], a.w * rn * gain[8 * j + 3]);
        o.z = pk2(c.x * rn * gain[8 * j + 4], c.y * rn * gain[8 * j + 5]); o.w = pk2(c.z * rn * gain[8 * j + 6], c.w * rn * gain[8 * j + 7]); *(u32x4*)(dst + 8 * j) = o; }
#pragma unroll
    for (int j = 0; j < 2; ++j) { float o1[8], o2[8];
#pragma unroll
        for (int i = 0; i < 8; ++i) { const int f = 8 * j + i; const float x1 = ra[f] * rnr * gain[64 + f], x2 = rb[f] * rnr * gain[80 + f]; o1[i] = x1 * cs[f] - x2 * sn[f]; o2[i] = x2 * cs[f] + x1 * sn[f]; }
        u32x4 o; o.x = pk2(o1[0], o1[1]); o.y = pk2(o1[2], o1[3]); o.z = pk2(o1[4], o1[5]); o.w = pk2(o1[6], o1[7]); *(u32x4*)(dst + 64 + 8 * j) = o;
        o.x = pk2(o2[0], o2[1]); o.y = pk2(o2[2], o2[3]); o.z = pk2(o2[4], o2[5]); o.w = pk2(o2[6], o2[7]); *(u32x4*)(dst + 80 + 8 * j) = o; }
}
constexpr int CT_BYTES = 128 * CSTR * 4;
constexpr int P1_RSQ = CT_BYTES, P1_RSKV = P1_RSQ + 512, P1_CS = P1_RSKV + 512, P1_SN = P1_CS + 8192, P1_KR = P1_SN + 8192;

__device__ void phase1(const Params& p, unsigned char* lds) {
    const int tid = threadIdx.x, lane = tid & 63, wid = __builtin_amdgcn_readfirstlane(tid >> 6);
    unsigned char* ws = p.ws;
    bf16_t* hbuf = (bf16_t*)(ws + OFF_HBUF); bf16_t* proj2 = (bf16_t*)(ws + OFF_PROJ2); bf16_t* ubuf = (bf16_t*)(ws + OFF_UBUF);
    float* rsq = (float*)(lds + P1_RSQ); float* rskv = (float*)(lds + P1_RSKV); float* cst = (float*)(lds + P1_CS); float* snt = (float*)(lds + P1_SN); bf16_t* krl = (bf16_t*)(lds + P1_KR);
    for (int tile = blockIdx.x; tile < 256; tile += gridDim.x) {
        const int row0 = tile * 128, b = row0 >> 11;
        float* mod = (float*)(ws + OFF_MODT) + (size_t)tile * 6144 - (size_t)b * 6144;
        for (int i = tid; i < 6144; i += NTHR) { float s = p.b_ada[i]; const float* pp = (const float*)(ws + OFF_PART) + (size_t)b * 6144 + i;
            for (int ks = 0; ks < 16; ++ks) s += pp[(size_t)ks * 16 * 6144]; mod[b * 6144 + i] = s; }
        for (int i = tid; i < 2048; i += NTHR) { const int r = i >> 4, f = i & 15; const float ang = (float)p.pos[row0 + r] * exp2f(-(float)f * (13.287712379549449f / 16.0f));
            float sn, cs; sincosf(ang, &sn, &cs); cst[i] = cs; snt[i] = sn; }
        __threadfence_block(); __syncthreads();
        for (int r = wid; r < 128; r += NWAVE) {
            const f32x4* xr = (const f32x4*)(p.x + (size_t)(row0 + r) * 1024); f32x4 v[4]; float ss = 0.f;
#pragma unroll
            for (int j = 0; j < 4; ++j) { v[j] = xr[lane + 64 * j]; ss += v[j].x * v[j].x + v[j].y * v[j].y + v[j].z * v[j].z + v[j].w * v[j].w; }
            const float rs = rsqrtf(wave_sum(ss) * (1.0f / 1024.0f) + EPS);
#pragma unroll
            for (int j = 0; j < 4; ++j) { const int col = 4 * (lane + 64 * j);
                const f32x4 g = *(const f32x4*)(p.norm_mix + col), sc = *(const f32x4*)(mod + b * 6144 + 1024 + col), sh = *(const f32x4*)(mod + b * 6144 + col);
                u32x2 o; o.x = pk2(v[j].x * rs * g.x * (1.f + sc.x) + sh.x, v[j].y * rs * g.y * (1.f + sc.y) + sh.y); o.y = pk2(v[j].z * rs * g.z * (1.f + sc.z) + sh.z, v[j].w * rs * g.w * (1.f + sc.w) + sh.w);
                *(u32x2*)(hbuf + (size_t)(row0 + r) * 1024 + col) = o; }
        }
        __threadfence_block(); __syncthreads();
        const ARow ah{hbuf + (size_t)row0 * 1024, 1024};
        for (int nc = 0; nc < 4; ++nc) {
            const bf16_t* Bt = (const bf16_t*)(ws + OFF_WINT) + (size_t)nc * 256 * 1024;
            if (nc < 2) gemm_128<2, 1, 0>(ah, Bt, 1024, 1024, lds, nullptr, [&](const float* Ct) {
                    const int ln = opq_v(lane), r0u = opq_s(row0), ncu = opq_s(nc); bf16_t* ub = opq_p(ubuf);
                    for (int tk = wid; tk < 32; tk += NWAVE) { const int gi = tk >> 1, r = (tk & 1) * 64 + ln, g = ncu * 16 + gi, tok = r0u + r;
                        const float* c = Ct + r * CSTR + gi * 16; const f32x4 a0 = *(const f32x4*)c, a1 = *(const f32x4*)(c + 4), a2 = *(const f32x4*)(c + 8), a3 = *(const f32x4*)(c + 12);
                        bf16_t* d = ub + ((size_t)g * 1024 + (tok >> 5)) * 640 + (tok & 31) * 16;
                        *(u32x4*)d = (u32x4){pk2(a0.x, a0.y), pk2(a0.z, a0.w), pk2(a1.x, a1.y), pk2(a1.z, a1.w)}; *(u32x4*)(d + 8) = (u32x4){pk2(a2.x, a2.y), pk2(a2.z, a2.w), pk2(a3.x, a3.y), pk2(a3.z, a3.w)}; } });
            else if (nc == 2) gemm_128<2, 1, 0>(ah, Bt, 1024, 1024, lds, nullptr, [&](const float* Ct) {
                    const int ln = opq_v(lane), r0u = opq_s(row0); bf16_t* pj = opq_p(proj2);
                    for (int r = wid; r < 128; r += NWAVE) { const f32x4 v = *(const f32x4*)(Ct + r * CSTR + ln * 4);
                        const float sq = wave_sum(v.x * v.x + v.y * v.y + v.z * v.z + v.w * v.w); if (ln == 0) rsq[r] = rsqrtf(sq * (1.0f / 256.0f) + EPS);
                        *(u32x2*)(pj + (size_t)(r0u + r) * 512 + ln * 4) = (u32x2){pk2(v.x, v.y), pk2(v.z, v.w)}; } });
            else gemm_128<2, 1, 0>(ah, Bt, 1024, 1024, lds, nullptr, [&](const float* Ct) {
                    const int ln = opq_v(lane), r0u = opq_s(row0); bf16_t* pj = opq_p(proj2);
                    for (int r = wid; r < 128; r += NWAVE) { const f32x4 v = (ln < 40) ? *(const f32x4*)(Ct + r * CSTR + ln * 4) : (f32x4){0.f, 0.f, 0.f, 0.f};
                        const float sq = wave_sum((ln < 32) ? (v.x * v.x + v.y * v.y + v.z * v.z + v.w * v.w) : 0.f); if (ln == 0) rskv[r] = rsqrtf(sq * (1.0f / 128.0f) + EPS);
                        const u32x2 o = (u32x2){pk2(v.x, v.y), pk2(v.z, v.w)};
                        if (ln < 32) *(u32x2*)(pj + (size_t)(r0u + r) * 512 + 256 + ln * 4) = o; else if (ln < 40) *(u32x2*)(krl + r * 32 + (ln - 32) * 4) = o; } });
        }
        const ARow aq{proj2 + (size_t)row0 * 512, 512};
        for (int nc = 0; nc < 4; ++nc)
            gemm_128<2, 1, 0>(aq, (const bf16_t*)(ws + OFF_WUQT) + (size_t)nc * 256 * 256, 256, 256, lds, nullptr, [&](const float* Ct) {
                const int tq = opq_v(tid); const float* gq = opq_p(p.q_norm);
                if (tq < 256) { const int row = tq & 127, hh = tq >> 7, h = opq_s(nc) * 2 + hh; const float* q = Ct + row * CSTR + hh * 96; float ss = 0.f;
#pragma unroll
                    for (int j = 0; j < 24; ++j) { const f32x4 t4 = *(const f32x4*)(q + 4 * j); ss += t4.x * t4.x + t4.y * t4.y + t4.z * t4.z + t4.w * t4.w; }
                    const float rq = rsq[row], rn = rsqrtf(ss * rq * rq * (1.0f / 96.0f) + EPS) * rq * QSCALE;
                    const int r0q = opq_s(row0); bf16_t* dst = (bf16_t*)(ws + OFF_Q) + ((size_t)((r0q >> 11) * 8 + h) * 2048 + ((r0q + row) & 2047)) * 96;
                    finalize_row(q, q + 64, q + 80, rn, rn, gq, cst + row * 16, snt + row * 16, dst); } });
        const ARow akv{proj2 + (size_t)row0 * 512 + 256, 512};
        for (int nc = 0; nc < 4; ++nc)
            gemm_128<2, 1, 0>(akv, (const bf16_t*)(ws + OFF_WUKVT) + (size_t)nc * 256 * 128, 128, 128, lds, nullptr, [&](const float* Ct) {
                const int tq = opq_v(tid); const float* gk = opq_p(p.k_norm); const int r0k = opq_s(row0), nck = opq_s(nc);
                if (tq < 256) { const int row = tq & 127, hh = tq >> 7, h = nck * 2 + hh; const float* kp = Ct + row * CSTR + hh * 128; float ss = 0.f, sr = 0.f; float rp[32];
#pragma unroll
                    for (int j = 0; j < 16; ++j) { const f32x4 t4 = *(const f32x4*)(kp + 4 * j); ss += t4.x * t4.x + t4.y * t4.y + t4.z * t4.z + t4.w * t4.w; }
#pragma unroll
                    for (int j = 0; j < 4; ++j) { const u32x4 w = *(const u32x4*)(krl + row * 32 + 8 * j);
                        rp[8 * j] = bflo(w.x); rp[8 * j + 1] = bfhi(w.x); rp[8 * j + 2] = bflo(w.y); rp[8 * j + 3] = bfhi(w.y); rp[8 * j + 4] = bflo(w.z); rp[8 * j + 5] = bfhi(w.z); rp[8 * j + 6] = bflo(w.w); rp[8 * j + 7] = bfhi(w.w); }
#pragma unroll
                    for (int d = 0; d < 32; ++d) sr += rp[d] * rp[d];
                    const float rk = rskv[row], rn = rsqrtf((ss * rk * rk + sr) * (1.0f / 96.0f) + EPS);
                    bf16_t* dst = (bf16_t*)(ws + OFF_K) + ((size_t)((r0k >> 11) * 8 + h) * 2048 + ((r0k + row) & 2047)) * 96;
                    finalize_row(kp, rp, rp + 16, rn * rk, rn, gk, cst + row * 16, snt + row * 16, dst);
                } else { const int t = tq - 256, d = t & 63, hh = (t >> 6) & 1, rh = t >> 7, h = nck * 2 + hh;
                    bf16_t* dst = (bf16_t*)(ws + OFF_VT) + ((size_t)((r0k >> 11) * 8 + h) * 64 + d) * 2048 + (r0k & 2047) + rh * 64;
                    const float* vp = Ct + (rh * 64) * CSTR + hh * 128 + 64 + d;
#pragma unroll 2
                    for (int r8 = 0; r8 < 8; ++r8) { float v[8];
#pragma unroll
                        for (int i = 0; i < 8; ++i) v[i] = vp[(r8 * 8 + i) * CSTR] * rskv[rh * 64 + r8 * 8 + i];
                        *(u32x4*)(dst + r8 * 8) = (u32x4){pk2(v[0], v[1]), pk2(v[2], v[3]), pk2(v[4], v[5]), pk2(v[6], v[7])}; } } });
    }
}

__device__ void s5_item(const Params& p, unsigned char* lds, int g, int bp) {
    const int tid = threadIdx.x;
    unsigned char* ws = p.ws;
    bf16_t* A = (bf16_t*)(ws + OFF_UBUF) + ((size_t)g * 1024 + bp * 128) * 640;
    float* Z = (float*)(lds + 73728);
    const ARow au{A, 640};
    gemm_128<1, 0, 0>(au, (const bf16_t*)(ws + OFF_WZT) + (size_t)g * 128 * 512, 512, 512, lds, nullptr, [&](int row, int col, float v) { Z[row * 129 + col] = v; });
    __syncthreads();
    if (tid < 128) {
        const int bs = tid >> 6, pp = tid & 63; const f32x2 aL = ((const f32x2*)(ws + OFF_AL))[g * 64 + pp]; float xr = 0.f, xi = 0.f;
        for (int k = 0; k < 64; ++k) { const int row = bs * 64 + k; bf16_t* xin = A + (size_t)row * 640 + 512;
            xin[pp] = (bf16_t)f2bf(xr); xin[64 + pp] = (bf16_t)f2bf(xi);
            const float zr = Z[row * 129 + pp], zi = Z[row * 129 + 64 + pp], nr = aL.x * xr - aL.y * xi + zr, ni = aL.x * xi + aL.y * xr + zi; xr = nr; xi = ni; }
    }
    __threadfence_block(); __syncthreads();
    bf16_t* ybT = (bf16_t*)(ws + OFF_YBUF) + (size_t)g * T_TOK * 16;
    for (int nc = 0; nc < 2; ++nc)
        gemm_128<2, 1, 0>(au, (const bf16_t*)(ws + OFF_KMT) + ((size_t)g * 512 + nc * 256) * 640, 640, 640, lds, nullptr, [&](const float* Ct) {
#pragma unroll
            for (int i = 0; i < 4; ++i) { const int pidx = tid + NTHR * i, row = pidx >> 4, tt = pidx & 15; const float* c = Ct + row * CSTR + tt * 16;
                const f32x4 a0 = *(const f32x4*)c, a1 = *(const f32x4*)(c + 4), a2 = *(const f32x4*)(c + 8), a3 = *(const f32x4*)(c + 12);
                bf16_t* d = ybT + ((size_t)(bp * 128 + row) * 32 + nc * 16 + tt) * 16;
                *(u32x4*)d = (u32x4){pk2(gelu_tanh(a0.x), gelu_tanh(a0.y)), pk2(gelu_tanh(a0.z), gelu_tanh(a0.w)), pk2(gelu_tanh(a1.x), gelu_tanh(a1.y)), pk2(gelu_tanh(a1.z), gelu_tanh(a1.w))};
                *(u32x4*)(d + 8) = (u32x4){pk2(gelu_tanh(a2.x), gelu_tanh(a2.y)), pk2(gelu_tanh(a2.z), gelu_tanh(a2.w)), pk2(gelu_tanh(a3.x), gelu_tanh(a3.y)), pk2(gelu_tanh(a3.z), gelu_tanh(a3.w))}; } });
}

constexpr int AT_KSTR = 208, AT_VSTR = 136, AT_KB = 64 * AT_KSTR, AT_VB = 64 * AT_VSTR, AT_STAGE = AT_KB + AT_VB;

__device__ void attn_item(const Params& p, unsigned char* lds, int bh, int qb) {
    const int tid = threadIdx.x, lane = tid & 63, wid = __builtin_amdgcn_readfirstlane(tid >> 6), r32 = lane & 31, hi = lane >> 5;
    unsigned char* ws = p.ws;
    const int q0 = qb * 256, qw0 = q0 + wid * 32, qg = qw0 + r32;
    const bf16_t* Qp = (const bf16_t*)(ws + OFF_Q) + ((size_t)bh * 2048 + qw0) * 96;
    const bf16_t* Kp = (const bf16_t*)(ws + OFF_K) + (size_t)bh * 2048 * 96;
    const bf16_t* Vp = (const bf16_t*)(ws + OFF_VT) + (size_t)bh * 64 * 2048;
    bf16x8 qf[6];
#pragma unroll
    for (int ks = 0; ks < 6; ++ks) qf[ks] = *(const bf16x8*)(Qp + r32 * 96 + ks * 16 + hi * 8);
    f32x16 ot[2];
#pragma unroll
    for (int r = 0; r < 16; ++r) { ot[0][r] = 0.f; ot[1][r] = 0.f; }
    float m = -INFINITY, l = 0.f;
    const int nkv = (q0 + 256) / 64;
    const int kr0 = tid / 12, kc0 = tid % 12, kr1 = (tid + 512) / 12, kc1 = (tid + 512) % 12; const bool k2 = tid < 256;
    const int vd = tid >> 3, vc = tid & 7;
    u32x4 rk0, rk1, rv;
    rk0 = *(const u32x4*)(Kp + (size_t)kr0 * 96 + kc0 * 8); if (k2) rk1 = *(const u32x4*)(Kp + (size_t)kr1 * 96 + kc1 * 8);
    rv = *(const u32x4*)(Vp + (size_t)vd * 2048 + vc * 8);
    *(u32x4*)(lds + kr0 * AT_KSTR + kc0 * 16) = rk0; if (k2) *(u32x4*)(lds + kr1 * AT_KSTR + kc1 * 16) = rk1;
    { u32x2* d = (u32x2*)(lds + AT_KB + vd * AT_VSTR + vc * 16); d[0] = (u32x2){rv.x, rv.y}; d[1] = (u32x2){rv.z, rv.w}; }
    __syncthreads();
    for (int t = 0; t < nkv; ++t) {
        const unsigned char* st = lds + (t & 1) * AT_STAGE; const int kv0 = t * 64;
        if (t + 1 < nkv) {
            const int kn = kv0 + 64;
            rk0 = *(const u32x4*)(Kp + (size_t)(kn + kr0) * 96 + kc0 * 8); if (k2) rk1 = *(const u32x4*)(Kp + (size_t)(kn + kr1) * 96 + kc1 * 8);
            rv = *(const u32x4*)(Vp + (size_t)vd * 2048 + kn + vc * 8);
        }
        if (kv0 <= qw0 + 31) {
            f32x16 s0, s1;
#pragma unroll
            for (int r = 0; r < 16; ++r) { s0[r] = 0.f; s1[r] = 0.f; }
#pragma unroll
            for (int ks = 0; ks < 6; ++ks) {
                const bf16x8 k0f = *(const bf16x8*)(st + r32 * AT_KSTR + ks * 32 + hi * 16);
                const bf16x8 k1f = *(const bf16x8*)(st + (32 + r32) * AT_KSTR + ks * 32 + hi * 16);
                s0 = __builtin_amdgcn_mfma_f32_32x32x16_bf16(k0f, qf[ks], s0, 0, 0, 0);
                s1 = __builtin_amdgcn_mfma_f32_32x32x16_bf16(k1f, qf[ks], s1, 0, 0, 0);
            }
            if (kv0 + 63 > qw0) {
#pragma unroll
                for (int r = 0; r < 16; ++r) { const int key = kv0 + crow(r, hi); if (key > qg) s0[r] = -INFINITY; if (key + 32 > qg) s1[r] = -INFINITY; }
            }
            float mx = fmaxf(s0[0], s1[0]);
#pragma unroll
            for (int r = 1; r < 16; ++r) mx = fmaxf(mx, fmaxf(s0[r], s1[r]));
            mx = fmaxf(mx, __shfl_xor(mx, 32));
            const float mn = fmaxf(m, mx), alpha = __builtin_amdgcn_exp2f(m - mn);
            float ps = 0.f;
#pragma unroll
            for (int r = 0; r < 16; ++r) { s0[r] = __builtin_amdgcn_exp2f(s0[r] - mn); s1[r] = __builtin_amdgcn_exp2f(s1[r] - mn); ps += s0[r] + s1[r]; }
            l = l * alpha + ps; m = mn;
#pragma unroll
            for (int r = 0; r < 16; ++r) { ot[0][r] *= alpha; ot[1][r] *= alpha; }
            const unsigned char* vb = st + AT_KB + r32 * AT_VSTR + hi * 8;
#pragma unroll
            for (int kt2 = 0; kt2 < 2; ++kt2)
#pragma unroll
                for (int s = 0; s < 2; ++s) {
                    u32x4 pw;
                    if (kt2 == 0) { pw.x = pk2(s0[8 * s], s0[8 * s + 1]); pw.y = pk2(s0[8 * s + 2], s0[8 * s + 3]); pw.z = pk2(s0[8 * s + 4], s0[8 * s + 5]); pw.w = pk2(s0[8 * s + 6], s0[8 * s + 7]); }
                    else { pw.x = pk2(s1[8 * s], s1[8 * s + 1]); pw.y = pk2(s1[8 * s + 2], s1[8 * s + 3]); pw.z = pk2(s1[8 * s + 4], s1[8 * s + 5]); pw.w = pk2(s1[8 * s + 6], s1[8 * s + 7]); }
                    const bf16x8 pf = __builtin_bit_cast(bf16x8, pw);
#pragma unroll
                    for (int dt = 0; dt < 2; ++dt) {
                        const unsigned char* a = vb + dt * 32 * AT_VSTR + (kt2 * 32 + 16 * s) * 2;
                        const u32x2 lo = *(const u32x2*)a, hh = *(const u32x2*)(a + 16);
                        const bf16x8 vf = __builtin_bit_cast(bf16x8, (u32x4){lo.x, lo.y, hh.x, hh.y});
                        ot[dt] = __builtin_amdgcn_mfma_f32_32x32x16_bf16(vf, pf, ot[dt], 0, 0, 0);
                    }
                }
        }
        if (t + 1 < nkv) {
            unsigned char* sn = lds + ((t + 1) & 1) * AT_STAGE;
            *(u32x4*)(sn + kr0 * AT_KSTR + kc0 * 16) = rk0; if (k2) *(u32x4*)(sn + kr1 * AT_KSTR + kc1 * 16) = rk1;
            u32x2* d = (u32x2*)(sn + AT_KB + vd * AT_VSTR + vc * 16); d[0] = (u32x2){rv.x, rv.y}; d[1] = (u32x2){rv.z, rv.w};
        }
        __syncthreads();
    }
    l += __shfl_xor(l, 32);
    const float inv = 1.0f / l;
    bf16_t* dst = (bf16_t*)(ws + OFF_HBUF) + ((size_t)(bh >> 3) * 2048 + qg) * 1024 + 512 + (bh & 7) * 64;
#pragma unroll
    for (int dt = 0; dt < 2; ++dt)
#pragma unroll
        for (int g4 = 0; g4 < 4; ++g4) { u32x2 o; o.x = pk2(ot[dt][4 * g4] * inv, ot[dt][4 * g4 + 1] * inv); o.y = pk2(ot[dt][4 * g4 + 2] * inv, ot[dt][4 * g4 + 3] * inv);
            *(u32x2*)(dst + dt * 32 + 8 * g4 + 4 * hi) = o; }
}

__device__ void phase2(const Params& p, unsigned char* lds) {
    for (int it = blockIdx.x; it < 256; it += gridDim.x) s5_item(p, lds, it >> 3, it & 7);
    for (int v = blockIdx.x; v < 256; v += gridDim.x) {
        const int bh = v >> 1;
        for (int i = 0; i < 4; ++i) { const int qb = (v & 1) ? ((i == 0) ? 6 : (i == 1) ? 1 : (i == 2) ? 5 : 2) : ((i == 0) ? 7 : (i == 1) ? 0 : (i == 2) ? 4 : 3); attn_item(p, lds, bh, qb); }
    }
}

__device__ __forceinline__ void cex_desc(float& a, float& b) { const float mx = fmaxf(a, b), mn = fminf(a, b); a = mx; b = mn; }
__device__ __forceinline__ void sort16_desc(float (&v)[16]) {
#pragma unroll
    for (int k = 2; k <= 16; k <<= 1)
#pragma unroll
        for (int j = k >> 1; j > 0; j >>= 1)
#pragma unroll
            for (int i = 0; i < 16; ++i) { const int l = i ^ j; if (l > i) { if ((i & k) == 0) cex_desc(v[i], v[l]); else cex_desc(v[l], v[i]); } }
}
__device__ __forceinline__ void merge16(float (&top)[16], const float (&c)[16]) {
#pragma unroll
    for (int i = 0; i < 16; ++i) top[i] = fmaxf(top[i], c[15 - i]);
#pragma unroll
    for (int j = 8; j > 0; j >>= 1)
#pragma unroll
        for (int i = 0; i < 16; ++i) { const int l = i ^ j; if (l > i) cex_desc(top[i], top[l]); }
}
__device__ __forceinline__ float mkc(float a, float b, unsigned code) { return __uint_as_float((__float_as_uint(a + b) & 0xFFFFFF00u) | code); }


struct RowBuf { u32x4 d[4], u[4]; };
__device__ __forceinline__ void g_load(RowBuf& B, const unsigned char* __restrict__ E8, int idv, int kbase, int lane) {
#pragma unroll
    for (int j = 0; j < 4; ++j) { const int e = __builtin_amdgcn_readlane(idv, kbase + j);
        B.d[j] = *(const u32x4*)(E8 + (size_t)e * 1024 + lane * 16); B.u[j] = *(const u32x4*)(E8 + (size_t)(16384 + e) * 1024 + lane * 16); }
}
__device__ __forceinline__ float dpp_add(float t, const int ctrl_sel) {
    if (ctrl_sel == 0) return t + __int_as_float(__builtin_amdgcn_update_dpp(0, __float_as_int(t), 0xB1, 0xF, 0xF, false));
    if (ctrl_sel == 1) return t + __int_as_float(__builtin_amdgcn_update_dpp(0, __float_as_int(t), 0x4E, 0xF, 0xF, false));
    if (ctrl_sel == 2) return t + __int_as_float(__builtin_amdgcn_update_dpp(0, __float_as_int(t), 0x141, 0xF, 0xF, false));
    return t + __int_as_float(__builtin_amdgcn_update_dpp(0, __float_as_int(t), 0x140, 0xF, 0xF, false));
}
__device__ __forceinline__ void g_compute(const RowBuf& B, const f32x2 (&hv)[8], f32x2 (&acc)[8], float sdv, float gwv, int kbase, int lane) {
    float s[4];
#pragma unroll
    for (int j = 0; j < 4; ++j) { f32x2 a = {0.f, 0.f};
#pragma unroll
        for (int q = 0; q < 4; ++q) { const int w = (int)B.d[j][q]; const f32x2 lo = __builtin_amdgcn_cvt_pk_f32_fp8(w, false), hi = __builtin_amdgcn_cvt_pk_f32_fp8(w, true);
            a = __builtin_elementwise_fma(lo, hv[2 * q], a); a = __builtin_elementwise_fma(hi, hv[2 * q + 1], a); }
        s[j] = a.x + a.y; }
    auto r0 = __builtin_amdgcn_permlane32_swap(__float_as_uint(s[0]), __float_as_uint(s[1]), false, false);
    auto r1 = __builtin_amdgcn_permlane32_swap(__float_as_uint(s[2]), __float_as_uint(s[3]), false, false);
    const float r01 = __uint_as_float(r0[0]) + __uint_as_float(r0[1]), r23 = __uint_as_float(r1[0]) + __uint_as_float(r1[1]);
    auto r2 = __builtin_amdgcn_permlane16_swap(__float_as_uint(r01), __float_as_uint(r23), false, false);
    float t = __uint_as_float(r2[0]) + __uint_as_float(r2[1]);
    t = dpp_add(t, 0); t = dpp_add(t, 1); t = dpp_add(t, 2); t = dpp_add(t, 3);
    const int jl = kbase + ((lane >> 4) & 1) * 2 + (lane >> 5);
    const float sdl = __shfl(sdv, jl), gwl = __shfl(gwv, jl);
    const float w = gwl * gelu_tanh(sdl * t);
    float wj[4];
    wj[0] = __int_as_float(__builtin_amdgcn_readlane(__float_as_int(w), 0)); wj[1] = __int_as_float(__builtin_amdgcn_readlane(__float_as_int(w), 32));
    wj[2] = __int_as_float(__builtin_amdgcn_readlane(__float_as_int(w), 16)); wj[3] = __int_as_float(__builtin_amdgcn_readlane(__float_as_int(w), 48));
#pragma unroll
    for (int j = 0; j < 4; ++j) { const f32x2 ws = {wj[j], wj[j]};
#pragma unroll
        for (int q = 0; q < 4; ++q) { const int w2 = (int)B.u[j][q]; const f32x2 lo = __builtin_amdgcn_cvt_pk_f32_fp8(w2, false), hi = __builtin_amdgcn_cvt_pk_f32_fp8(w2, true);
            acc[2 * q] = __builtin_elementwise_fma(lo, ws, acc[2 * q]); acc[2 * q + 1] = __builtin_elementwise_fma(hi, ws, acc[2 * q + 1]); } }
}

constexpr int QP_STR = 528, S_OFF = 128 * QP_STR, S_STR = 132, L_OFF = S_OFF + 128 * S_STR * 4;

__device__ void phase3(const Params& p, unsigned char* lds) {
    const int tid = threadIdx.x, lane = tid & 63, wid = __builtin_amdgcn_readfirstlane(tid >> 6), r32 = lane & 31, hi = lane >> 5, wm = wid >> 2, wn = wid & 3;
    unsigned char* ws = p.ws;
    bf16_t* hbuf = (bf16_t*)(ws + OFF_HBUF); const bf16_t* ybuf = (const bf16_t*)(ws + OFF_YBUF);
    int* idxb = (int*)(ws + OFF_IDX); float* gb = (float*)(ws + OFF_G);
    for (int tile = blockIdx.x; tile < 256; tile += gridDim.x) {
        const int row0 = tile * 128, b = row0 >> 11;
        const float* mod = (const float*)(ws + OFF_MODT) + (size_t)tile * 6144 - (size_t)b * 6144;
        float* ssum = (float*)(lds + CT_BYTES); float* ratio = ssum + 128; float* rsat = ratio + 128; float* ss1 = rsat + 128;
        const bf16_t* ybT = ybuf + (size_t)row0 * 16;
        for (int nc = 0; nc < 2; ++nc)
            gemm_128<2, 1, 0>(AGrp{ybT}, (const bf16_t*)(ws + OFF_WGLUT) + (size_t)nc * 256 * 512, 512, 512, lds, nullptr, [&](const float* Ct) {
#pragma unroll 2
                for (int i = 0; i < 8; ++i) { const int pidx = tid + NTHR * i, row = pidx >> 5, c8 = (pidx & 31) * 8, col = nc * 256 + c8;
                    const f32x4 a0 = *(const f32x4*)(Ct + row * CSTR + c8), a1 = *(const f32x4*)(Ct + row * CSTR + c8 + 4);
                    const u32x4 yw = *(const u32x4*)(ybT + ((size_t)(col >> 4) * T_TOK + row) * 16 + (col & 15));
                    const f32x4 b0 = *(const f32x4*)(p.b_glu + col), b1 = *(const f32x4*)(p.b_glu + col + 4);
                    float o[8];
                    o[0] = bflo(yw.x) * sigmoidf_(a0.x + b0.x); o[1] = bfhi(yw.x) * sigmoidf_(a0.y + b0.y); o[2] = bflo(yw.y) * sigmoidf_(a0.z + b0.z); o[3] = bfhi(yw.y) * sigmoidf_(a0.w + b0.w);
                    o[4] = bflo(yw.z) * sigmoidf_(a1.x + b1.x); o[5] = bfhi(yw.z) * sigmoidf_(a1.y + b1.y); o[6] = bflo(yw.w) * sigmoidf_(a1.z + b1.z); o[7] = bfhi(yw.w) * sigmoidf_(a1.w + b1.w);
                    float ss = 0.f;
#pragma unroll
                    for (int k = 0; k < 8; ++k) ss += o[k] * o[k];
                    *(u32x4*)(hbuf + (size_t)(row0 + row) * 1024 + col) = (u32x4){pk2(o[0], o[1]), pk2(o[2], o[3]), pk2(o[4], o[5]), pk2(o[6], o[7])};
#pragma unroll
                    for (int of = 1; of < 32; of <<= 1) ss += __shfl_xor(ss, of);
                    if ((lane & 31) == 0) { if (nc == 0) ssum[row] = ss; else ssum[row] += ss; } } });
        for (int r = wid; r < 128; r += NWAVE) {
            const u32x4 w = *(const u32x4*)(hbuf + (size_t)(row0 + r) * 1024 + 512 + lane * 8);
            float ss = bflo(w.x) * bflo(w.x) + bfhi(w.x) * bfhi(w.x) + bflo(w.y) * bflo(w.y) + bfhi(w.y) * bfhi(w.y) + bflo(w.z) * bflo(w.z) + bfhi(w.z) * bfhi(w.z) + bflo(w.w) * bflo(w.w) + bfhi(w.w) * bfhi(w.w);
            ss = wave_sum(ss);
            if (lane == 0) { const float ra = rsqrtf(ss * (1.0f / 512.0f) + EPS), rs = rsqrtf(ssum[r] * (1.0f / 512.0f) + EPS); rsat[r] = ra; ratio[r] = rs / ra; }
        }
        __threadfence_block(); __syncthreads();
        for (int rep_c = 0; rep_c < ((PROBE_REP & 128) ? 2 : 1); ++rep_c)
        for (int nc = 0; nc < 4; ++nc)
            gemm_128<2, 1, 8>(ARow{hbuf + (size_t)row0 * 1024, 1024}, (const bf16_t*)(ws + OFF_WOUTT) + (size_t)nc * 256 * 1024, 1024, 1024, lds, ratio, [&](const float* Ct) {
#pragma unroll 4
                for (int i = 0; i < 16; ++i) { const int row = wid + NWAVE * i, col = nc * 256 + lane * 4; const size_t o = (size_t)(row0 + row) * 1024 + col;
                    const f32x4 v = *(const f32x4*)(Ct + row * CSTR + lane * 4), xv = *(const f32x4*)(p.x + o), gm = *(const f32x4*)(mod + b * 6144 + 2048 + col); const float ra = rsat[row];
                    f32x4 r; r.x = xv.x + gm.x * v.x * ra; r.y = xv.y + gm.y * v.y * ra; r.z = xv.z + gm.z * v.z * ra; r.w = xv.w + gm.w * v.w * ra;
                    *(f32x4*)(p.out + o) = r;
                    const float ss = wave_sum(r.x * r.x + r.y * r.y + r.z * r.z + r.w * r.w);
                    if (lane == 0) { if (nc == 0) ss1[row] = ss; else ss1[row] += ss; } } });
        __threadfence_block(); __syncthreads();
        for (int r = wid; r < 128; r += NWAVE) {
            const f32x4* xr = (const f32x4*)(p.out + (size_t)(row0 + r) * 1024); const float rs = rsqrtf(ss1[r] * (1.0f / 1024.0f) + EPS);
#pragma unroll
            for (int j = 0; j < 4; ++j) { const int col = 4 * (lane + 64 * j); const f32x4 v = xr[lane + 64 * j];
                const f32x4 g = *(const f32x4*)(p.norm_ffn + col), sc = *(const f32x4*)(mod + b * 6144 + 4096 + col), sh = *(const f32x4*)(mod + b * 6144 + 3072 + col);
                u32x2 o; o.x = pk2(v.x * rs * g.x * (1.f + sc.x) + sh.x, v.y * rs * g.y * (1.f + sc.y) + sh.y); o.y = pk2(v.z * rs * g.z * (1.f + sc.z) + sh.z, v.w * rs * g.w * (1.f + sc.w) + sh.w);
                *(u32x2*)(hbuf + (size_t)(row0 + r) * 1024 + col) = o; }
        }
        __threadfence_block(); __syncthreads();
        for (int rep_e = 0; rep_e < ((PROBE_REP & 32) ? 2 : 1); ++rep_e) {
        float* Sx = (float*)(lds + S_OFF); float* Ls = (float*)(lds + L_OFF);
        for (int h = 0; h < 8; ++h) {
            gemm_128<2, 0, 0>(ARow{hbuf + (size_t)row0 * 1024, 1024}, (const bf16_t*)(ws + OFF_WQT) + (size_t)h * 256 * 1024, 1024, 1024, lds, nullptr, [&](int row, int col, float v) {
                *(bf16_t*)(lds + row * QP_STR + col * 2) = (bf16_t)f2bf(v); });
            __syncthreads();
            for (int ph = 0; ph < 2; ++ph) {
                f32x16 a0, a1;
#pragma unroll
                for (int r = 0; r < 16; ++r) { a0[r] = 0.f; a1[r] = 0.f; }
                const bf16_t* sk = (const bf16_t*)(ws + OFF_SUBK) + ((size_t)ph * 128 + wn * 32 + r32) * 128 + hi * 8;
                const unsigned char* qa = lds + (wm * 64 + r32) * QP_STR + (ph * 128 + hi * 8) * 2;
#pragma unroll
                for (int ks = 0; ks < 8; ++ks) {
                    const bf16x8 bfr = *(const bf16x8*)(sk + ks * 16);
                    const bf16x8 f0 = *(const bf16x8*)(qa + ks * 32), f1 = *(const bf16x8*)(qa + 32 * QP_STR + ks * 32);
                    a0 = __builtin_amdgcn_mfma_f32_32x32x16_bf16(f0, bfr, a0, 0, 0, 0);
                    a1 = __builtin_amdgcn_mfma_f32_32x32x16_bf16(f1, bfr, a1, 0, 0, 0);
                }
#pragma unroll
                for (int r = 0; r < 16; ++r) { Sx[(wm * 64 + crow(r, hi)) * S_STR + wn * 32 + r32] = a0[r]; Sx[(wm * 64 + 32 + crow(r, hi)) * S_STR + wn * 32 + r32] = a1[r]; }
                __syncthreads();
                if (wid < 2) {
                    const int row = wid * 64 + lane; float top[16];
#pragma unroll
                    for (int c8 = 0; c8 < 8; ++c8) { float c[16];
#pragma unroll
                        for (int q = 0; q < 4; ++q) { const f32x4 t4 = *(const f32x4*)(Sx + row * S_STR + c8 * 16 + q * 4);
                            c[4 * q] = __uint_as_float((__float_as_uint(t4.x) & 0xFFFFFF80u) | (unsigned)(127 - (c8 * 16 + 4 * q)));
                            c[4 * q + 1] = __uint_as_float((__float_as_uint(t4.y) & 0xFFFFFF80u) | (unsigned)(127 - (c8 * 16 + 4 * q + 1)));
                            c[4 * q + 2] = __uint_as_float((__float_as_uint(t4.z) & 0xFFFFFF80u) | (unsigned)(127 - (c8 * 16 + 4 * q + 2)));
                            c[4 * q + 3] = __uint_as_float((__float_as_uint(t4.w) & 0xFFFFFF80u) | (unsigned)(127 - (c8 * 16 + 4 * q + 3))); }
                        sort16_desc(c);
                        if (c8 == 0) {
#pragma unroll
                            for (int k = 0; k < 16; ++k) top[k] = c[k];
                        } else merge16(top, c); }
#pragma unroll
                    for (int q = 0; q < 4; ++q) *(f32x4*)(Ls + (ph * 128 + row) * 16 + 4 * q) = (f32x4){top[4 * q], top[4 * q + 1], top[4 * q + 2], top[4 * q + 3]};
                }
                __syncthreads();
            }
            if (wid < 2) {
                const int row = wid * 64 + lane; float a1[16], a2[16], top[16];
#pragma unroll
                for (int k = 0; k < 16; ++k) { a1[k] = __uint_as_float(__float_as_uint(Ls[row * 16 + k]) & 0xFFFFFF80u); a2[k] = __uint_as_float(__float_as_uint(Ls[(128 + row) * 16 + k]) & 0xFFFFFF80u); }
    { float c[16];
      c[0] = mkc(a1[0], a2[0], 255u);
      c[1] = mkc(a1[0], a2[1], 254u);
      c[2] = mkc(a1[0], a2[2], 253u);
      c[3] = mkc(a1[0], a2[3], 252u);
      c[4] = mkc(a1[0], a2[4], 251u);
      c[5] = mkc(a1[0], a2[5], 250u);
      c[6] = mkc(a1[0], a2[6], 249u);
      c[7] = mkc(a1[0], a2[7], 248u);
      c[8] = mkc(a1[0], a2[8], 247u);
      c[9] = mkc(a1[0], a2[9], 246u);
      c[10] = mkc(a1[0], a2[10], 245u);
      c[11] = mkc(a1[0], a2[11], 244u);
      c[12] = mkc(a1[0], a2[12], 243u);
      c[13] = mkc(a1[0], a2[13], 242u);
      c[14] = mkc(a1[0], a2[14], 241u);
      c[15] = mkc(a1[0], a2[15], 240u);
      sort16_desc(c); _Pragma("unroll") for (int k = 0; k < 16; ++k) top[k] = c[k];
    }
    { float c[16];
      c[0] = mkc(a1[1], a2[0], 239u);
      c[1] = mkc(a1[1], a2[1], 238u);
      c[2] = mkc(a1[1], a2[2], 237u);
      c[3] = mkc(a1[1], a2[3], 236u);
      c[4] = mkc(a1[1], a2[4], 235u);
      c[5] = mkc(a1[1], a2[5], 234u);
      c[6] = mkc(a1[1], a2[6], 233u);
      c[7] = mkc(a1[1], a2[7], 232u);
      c[8] = mkc(a1[2], a2[0], 223u);
      c[9] = mkc(a1[2], a2[1], 222u);
      c[10] = mkc(a1[2], a2[2], 221u);
      c[11] = mkc(a1[2], a2[3], 220u);
      c[12] = mkc(a1[2], a2[4], 219u);
      c[13] = mkc(a1[3], a2[0], 207u);
      c[14] = mkc(a1[3], a2[1], 206u);
      c[15] = mkc(a1[3], a2[2], 205u);
      sort16_desc(c); merge16(top, c);
    }
    { float c[16];
      c[0] = mkc(a1[3], a2[3], 204u);
      c[1] = mkc(a1[4], a2[0], 191u);
      c[2] = mkc(a1[4], a2[1], 190u);
      c[3] = mkc(a1[4], a2[2], 189u);
      c[4] = mkc(a1[5], a2[0], 175u);
      c[5] = mkc(a1[5], a2[1], 174u);
      c[6] = mkc(a1[6], a2[0], 159u);
      c[7] = mkc(a1[6], a2[1], 158u);
      c[8] = mkc(a1[7], a2[0], 143u);
      c[9] = mkc(a1[7], a2[1], 142u);
      c[10] = mkc(a1[8], a2[0], 127u);
      c[11] = mkc(a1[9], a2[0], 111u);
      c[12] = mkc(a1[10], a2[0], 95u);
      c[13] = mkc(a1[11], a2[0], 79u);
      c[14] = mkc(a1[12], a2[0], 63u);
      c[15] = mkc(a1[13], a2[0], 47u);
      sort16_desc(c); merge16(top, c);
    }
    { float c[16];
      c[0] = mkc(a1[14], a2[0], 31u);
      c[1] = mkc(a1[15], a2[0], 15u);
      c[2] = -3.0e38f;
      c[3] = -3.0e38f;
      c[4] = -3.0e38f;
      c[5] = -3.0e38f;
      c[6] = -3.0e38f;
      c[7] = -3.0e38f;
      c[8] = -3.0e38f;
      c[9] = -3.0e38f;
      c[10] = -3.0e38f;
      c[11] = -3.0e38f;
      c[12] = -3.0e38f;
      c[13] = -3.0e38f;
      c[14] = -3.0e38f;
      c[15] = -3.0e38f;
      sort16_desc(c); merge16(top, c);
    }
                float e[16], es = 0.f; const float m0 = __uint_as_float(__float_as_uint(top[0]) & 0xFFFFFF00u);
#pragma unroll
                for (int k = 0; k < 16; ++k) { e[k] = __expf(__uint_as_float(__float_as_uint(top[k]) & 0xFFFFFF00u) - m0); es += e[k]; }
                const float inv = 1.0f / es; const size_t ob = (size_t)(row0 + row) * 128 + h * 16;
#pragma unroll
                for (int k = 0; k < 16; ++k) { const unsigned code = 255u - (__float_as_uint(top[k]) & 0xFFu); const int i = code >> 4, j = code & 15;
                    const int i1 = 127 - (int)(__float_as_uint(Ls[row * 16 + i]) & 0x7Fu), i2 = 127 - (int)(__float_as_uint(Ls[(128 + row) * 16 + j]) & 0x7Fu);
                    idxb[ob + k] = i1 * 128 + i2; gb[ob + k] = e[k] * inv; }
            }
            __syncthreads();
        }
        }
        __syncthreads();
    }
}

constexpr int P4_LIST = 192;
struct TokState { f32x2 acc[8]; int offv; float sh; };

__device__ __forceinline__ void g_loadb(RowBuf& B, const unsigned char* __restrict__ E8, const int* sidp, int lane) {
    const u32x4 ids = *(const u32x4*)sidp;
    const int e0 = __builtin_amdgcn_readfirstlane((int)ids.x), e1 = __builtin_amdgcn_readfirstlane((int)ids.y), e2 = __builtin_amdgcn_readfirstlane((int)ids.z), e3 = __builtin_amdgcn_readfirstlane((int)ids.w);
    B.d[0] = *(const u32x4*)(E8 + (size_t)e0 * 1024 + lane * 16); B.u[0] = *(const u32x4*)(E8 + (size_t)(16384 + e0) * 1024 + lane * 16);
    B.d[1] = *(const u32x4*)(E8 + (size_t)e1 * 1024 + lane * 16); B.u[1] = *(const u32x4*)(E8 + (size_t)(16384 + e1) * 1024 + lane * 16);
    B.d[2] = *(const u32x4*)(E8 + (size_t)e2 * 1024 + lane * 16); B.u[2] = *(const u32x4*)(E8 + (size_t)(16384 + e2) * 1024 + lane * 16);
    B.d[3] = *(const u32x4*)(E8 + (size_t)e3 * 1024 + lane * 16); B.u[3] = *(const u32x4*)(E8 + (size_t)(16384 + e3) * 1024 + lane * 16);
}
__device__ __forceinline__ int dpp_addi(int t, const int ctrl_sel) {
    if (ctrl_sel == 0) return t + __builtin_amdgcn_update_dpp(0, t, 0xB1, 0xF, 0xF, false);
    if (ctrl_sel == 1) return t + __builtin_amdgcn_update_dpp(0, t, 0x4E, 0xF, 0xF, false);
    if (ctrl_sel == 2) return t + __builtin_amdgcn_update_dpp(0, t, 0x141, 0xF, 0xF, false);
    return t + __builtin_amdgcn_update_dpp(0, t, 0x140, 0xF, 0xF, false);
}
__device__ __forceinline__ void g_compute2(const RowBuf& B, const u32x4 hq, TokState& T, float sdl, float gwl) {
    int s[4];
#pragma unroll
    for (int j = 0; j < 4; ++j) { int a = 0;
#pragma unroll
        for (int q = 0; q < 4; ++q) a = __builtin_amdgcn_sdot4((int)B.d[j][q], (int)hq[q], a, false);
        s[j] = a; }
    auto r0 = __builtin_amdgcn_permlane32_swap((unsigned)s[0], (unsigned)s[1], false, false);
    auto r1 = __builtin_amdgcn_permlane32_swap((unsigned)s[2], (unsigned)s[3], false, false);
    const int r01 = (int)r0[0] + (int)r0[1], r23 = (int)r1[0] + (int)r1[1];
    auto r2 = __builtin_amdgcn_permlane16_swap((unsigned)r01, (unsigned)r23, false, false);
    int ti = (int)r2[0] + (int)r2[1];
    ti = dpp_addi(ti, 0); ti = dpp_addi(ti, 1); ti = dpp_addi(ti, 2); ti = dpp_addi(ti, 3);
    const float t = (float)ti * T.sh;
    const float w = gwl * gelu_tanh(sdl * t);
    float wj[4];
    wj[0] = __int_as_float(__builtin_amdgcn_readlane(__float_as_int(w), 0)); wj[1] = __int_as_float(__builtin_amdgcn_readlane(__float_as_int(w), 32));
    wj[2] = __int_as_float(__builtin_amdgcn_readlane(__float_as_int(w), 16)); wj[3] = __int_as_float(__builtin_amdgcn_readlane(__float_as_int(w), 48));
#pragma unroll
    for (int j = 0; j < 4; ++j) { const f32x2 ws = {wj[j], wj[j]};
#pragma unroll
        for (int q = 0; q < 4; ++q) { const int w2 = (int)B.u[j][q]; const f32x2 lo = __builtin_amdgcn_cvt_pk_f32_fp8(w2, false), hi = __builtin_amdgcn_cvt_pk_f32_fp8(w2, true);
            T.acc[2 * q] = __builtin_elementwise_fma(lo, ws, T.acc[2 * q]); T.acc[2 * q + 1] = __builtin_elementwise_fma(hi, ws, T.acc[2 * q + 1]); } }
}

template <int FAKE> __device__ void phase4(const Params& p, unsigned char* lds) {
    const int tid = threadIdx.x, lane = tid & 63, wid = __builtin_amdgcn_readfirstlane(tid >> 6);
    unsigned char* ws = p.ws;
    const bf16_t* hbuf = (const bf16_t*)(ws + OFF_HBUF); const int* idxb = (const int*)(ws + OFF_IDX); const float* gb = (const float*)(ws + OFF_G);
    const unsigned char* E8 = ws + OFF_E8; const float* esc = (const float*)(ws + OFF_ESC);
    int* sid = (int*)(lds + wid * (3 * 4 * P4_LIST * 4)); float* sgw = (float*)(sid + 4 * P4_LIST); float* ssd = sgw + 4 * P4_LIST;
    unsigned char* hql = lds + 8 * (3 * 4 * P4_LIST * 4) + wid * 4096;
    const int jl = ((lane >> 4) & 1) * 2 + (lane >> 5);
    for (int tile = blockIdx.x; tile < 256; tile += gridDim.x) {
        const int row0 = tile * 128, b = row0 >> 11;
        const float* gf = (const float*)(ws + OFF_MODT) + (size_t)tile * 6144 + 5120 + lane * 16;
#pragma unroll 1
        for (int st = 0; st < 4; ++st) {
            const int tokb = row0 + st * 32 + wid * 4;
            TokState T0, T1, T2, T3;
#define P4_PRO(T, j) { const size_t tok = tokb + (j); \
                int id0 = idxb[tok * 128 + lane], id1 = idxb[tok * 128 + 64 + lane]; if (FAKE) { id0 = (id0 & ~1023) | (id0 & 31); id1 = (id1 & ~1023) | (id1 & 31); } \
                const float sd0 = esc[id0], sd1 = esc[id1], gw0 = gb[tok * 128 + lane] * esc[16384 + id0], gw1 = gb[tok * 128 + 64 + lane] * esc[16384 + id1]; \
                _Pragma("unroll") for (int i = 0; i < 8; ++i) T.acc[i] = (f32x2){0.f, 0.f}; \
                { const u32x4 w0 = *(const u32x4*)(hbuf + tok * 1024 + lane * 16), w1 = *(const u32x4*)(hbuf + tok * 1024 + lane * 16 + 8); \
                  float hv[16] = {bflo(w0.x), bfhi(w0.x), bflo(w0.y), bfhi(w0.y), bflo(w0.z), bfhi(w0.z), bflo(w0.w), bfhi(w0.w), bflo(w1.x), bfhi(w1.x), bflo(w1.y), bfhi(w1.y), bflo(w1.z), bfhi(w1.z), bflo(w1.w), bfhi(w1.w)}; \
                  float am = 0.f; _Pragma("unroll") for (int i = 0; i < 16; ++i) am = fmaxf(am, fabsf(hv[i])); \
                  _Pragma("unroll") for (int o = 1; o < 64; o <<= 1) am = fmaxf(am, __shfl_xor(am, o)); \
                  const float sc = (am > 0.f) ? am * (1.0f / 127.0f) : 1.0f, inv = 1.0f / sc; T.sh = sc; u32x4 hq; \
                  _Pragma("unroll") for (int q = 0; q < 4; ++q) { const int b0 = (int)rintf(hv[4 * q] * inv), b1 = (int)rintf(hv[4 * q + 1] * inv), b2 = (int)rintf(hv[4 * q + 2] * inv), b3 = (int)rintf(hv[4 * q + 3] * inv); \
                      hq[q] = (unsigned)(b0 & 0xFF) | ((unsigned)(b1 & 0xFF) << 8) | ((unsigned)(b2 & 0xFF) << 16) | ((unsigned)(b3 & 0xFF) << 24); } \
                  *(u32x4*)(hql + (j) * 1024 + lane * 16) = hq; } \
                const int sl0 = id0 >> 10, sl1 = id1 >> 10; int po = 0, offv = 0, pos0 = 0, pos1 = 0; \
                _Pragma("unroll 1") for (int s = 0; s < 16; ++s) { \
                    const unsigned long long m0 = __ballot(sl0 == s), m1 = __ballot(sl1 == s); const int c0 = __popcll(m0), c = c0 + __popcll(m1); \
                    if (lane == s) offv = po; \
                    if (sl0 == s) pos0 = po + (int)__builtin_amdgcn_mbcnt_hi((unsigned)(m0 >> 32), __builtin_amdgcn_mbcnt_lo((unsigned)m0, 0u)); \
                    if (sl1 == s) pos1 = po + c0 + (int)__builtin_amdgcn_mbcnt_hi((unsigned)(m1 >> 32), __builtin_amdgcn_mbcnt_lo((unsigned)m1, 0u)); \
                    if (c > 0) { const int fid = m0 ? __builtin_amdgcn_readlane(id0, __ffsll((long long)m0) - 1) : __builtin_amdgcn_readlane(id1, __ffsll((long long)m1) - 1); \
                        const int pad = (4 - (c & 3)) & 3; if (lane < pad) { sid[(j) * P4_LIST + po + c + lane] = fid; sgw[(j) * P4_LIST + po + c + lane] = 0.f; ssd[(j) * P4_LIST + po + c + lane] = 1.f; } } \
                    po += (c + 3) & ~3; } \
                if (lane == 16) offv = po; T.offv = offv; \
                sid[(j) * P4_LIST + pos0] = id0; sgw[(j) * P4_LIST + pos0] = gw0; ssd[(j) * P4_LIST + pos0] = sd0; \
                sid[(j) * P4_LIST + pos1] = id1; sgw[(j) * P4_LIST + pos1] = gw1; ssd[(j) * P4_LIST + pos1] = sd1; }
            P4_PRO(T0, 0) P4_PRO(T1, 1) P4_PRO(T2, 2) P4_PRO(T3, 3)
#undef P4_PRO
            asm volatile("s_waitcnt lgkmcnt(0)" ::: "memory");
#define P4_ITEM(T, j) { const int st_ = __builtin_amdgcn_readlane(T.offv, s), en_ = __builtin_amdgcn_readlane(T.offv, s + 1); \
                if (st_ < en_) { const u32x4 hq = *(const u32x4*)(hql + (j) * 1024 + lane * 16); \
                    _Pragma("unroll 1") for (int i = st_; i < en_; i += 4) { RowBuf A; g_loadb(A, E8, sid + (j) * P4_LIST + i, lane); \
                        g_compute2(A, hq, T, ssd[(j) * P4_LIST + i + jl], sgw[(j) * P4_LIST + i + jl]); } } }
#pragma unroll 1
            for (int s = 0; s < 16; ++s) { P4_ITEM(T0, 0) P4_ITEM(T1, 1) P4_ITEM(T2, 2) P4_ITEM(T3, 3) }
#undef P4_ITEM
#define P4_EPI(T, j) { float* orow = p.out + (size_t)(tokb + (j)) * 1024 + lane * 16; \
                _Pragma("unroll") for (int q = 0; q < 4; ++q) { f32x4 o = *(const f32x4*)(orow + 4 * q); const f32x4 gg = *(const f32x4*)(gf + 4 * q); \
                    o.x += gg.x * T.acc[2 * q].x; o.y += gg.y * T.acc[2 * q].y; o.z += gg.z * T.acc[2 * q + 1].x; o.w += gg.w * T.acc[2 * q + 1].y; if (FAKE) asm volatile("" :: "v"(o.x), "v"(o.y), "v"(o.z), "v"(o.w)); else *(f32x4*)(orow + 4 * q) = o; } }
            P4_EPI(T0, 0) P4_EPI(T1, 1) P4_EPI(T2, 2) P4_EPI(T3, 3)
#undef P4_EPI
        }
    }
}

__global__ void __launch_bounds__(NTHR, 2) fwd_kernel(Params p) {
    extern __shared__ __attribute__((aligned(16))) unsigned char lds[];
    if (p.ph_lo <= 0 && 0 < p.ph_hi) { phase0(p, lds); if (PROBE_REP & 1) { __syncthreads(); phase0(p, lds); } }
#if MK_COOP
    if (p.ph_lo <= 0 && 1 < p.ph_hi) cg::this_grid().sync();
#endif
    if (p.ph_lo <= 1 && 1 < p.ph_hi) { phase1(p, lds); if (PROBE_REP & 2) { __syncthreads(); phase1(p, lds); } }
#if MK_COOP
    if (p.ph_lo <= 1 && 2 < p.ph_hi) cg::this_grid().sync();
#endif
    if (p.ph_lo <= 2 && 2 < p.ph_hi) { phase2(p, lds); if (PROBE_REP & 4) { __syncthreads(); phase2(p, lds); } }
#if MK_COOP
    if (p.ph_lo <= 2 && 3 < p.ph_hi) cg::this_grid().sync();
#endif
    if (p.ph_lo <= 3 && 3 < p.ph_hi) phase3(p, lds);
#if MK_COOP
    if (p.ph_lo <= 3 && 4 < p.ph_hi) cg::this_grid().sync();
#endif
    if (p.ph_lo <= 4 && 4 < p.ph_hi) { if (PROBE_REP & 2048) { phase4<1>(p, lds); __syncthreads(); } phase4<0>(p, lds); }
}

extern "C" void kernel_launch(void* const* d_in, const int* in_sizes, int n_in, void* d_out, int out_size, void* d_ws, size_t ws_size, hipStream_t stream) {
    static int grid = 0;
    if (grid == 0) {
        if (n_in != 31 || ws_size < WS_NEED) { fprintf(stderr, "kernel_launch: bad inputs (n_in %d, ws %zu < %zu)\n", n_in, ws_size, (size_t)WS_NEED); grid = -1; return; }
        int dev = 0, cus = 0, per_cu = 0;
        hipGetDevice(&dev); hipDeviceGetAttribute(&cus, hipDeviceAttributeMultiprocessorCount, dev);
        if (hipFuncSetAttribute((const void*)fwd_kernel, hipFuncAttributeMaxDynamicSharedMemorySize, LDS_BYTES) != hipSuccess) { fprintf(stderr, "kernel_launch: hipFuncSetAttribute failed\n"); grid = -1; return; }
        hipOccupancyMaxActiveBlocksPerMultiprocessor(&per_cu, (const void*)fwd_kernel, NTHR, LDS_BYTES);
        if (per_cu < 1) { fprintf(stderr, "kernel_launch: occupancy query says %d blocks/CU\n", per_cu); per_cu = 1; }
        grid = cus;
        (void)hipGetLastError();
    }
    if (grid < 0) return;
    Params p{};
    const float** f = (const float**)&p;
    for (int i = 0; i < 31; ++i) f[i] = (const float*)d_in[i];
    p.out = (float*)d_out; p.ws = (unsigned char*)d_ws;
#if MK_COOP
    p.ph_lo = 0; p.ph_hi = 5;
    void* args[] = {&p};
    hipError_t e = hipLaunchCooperativeKernel((const void*)fwd_kernel, dim3(grid), dim3(NTHR), args, LDS_BYTES, stream);
    if (e != hipSuccess) fprintf(stderr, "cooperative launch failed: %s (grid %d)\n", hipGetErrorString(e), grid);
#else
    for (int ph = 0; ph < 5; ++ph) { p.ph_lo = ph; p.ph_hi = ph + 1; hipLaunchKernelGGL(fwd_kernel, dim3(grid), dim3(NTHR), LDS_BYTES, stream, p); }
#endif
}
```

```cpp
#include <hip/hip_runtime.h>
#include <hip/hip_cooperative_groups.h>
#include <cstdio>
#include <cstdint>
namespace cg = cooperative_groups;

#ifndef PROBE_REP
#define PROBE_REP 0
#endif
#ifndef MK_COOP
#define MK_COOP 1
#endif

typedef unsigned short bf16_t;
typedef short bf16x8 __attribute__((ext_vector_type(8)));
typedef short s16x4 __attribute__((ext_vector_type(4)));
typedef float f32x16 __attribute__((ext_vector_type(16)));
typedef float f32x4 __attribute__((ext_vector_type(4)));
typedef float f32x2 __attribute__((ext_vector_type(2)));
typedef unsigned u32x4 __attribute__((ext_vector_type(4)));
typedef unsigned u32x2 __attribute__((ext_vector_type(2)));

constexpr int NTHR = 512, NWAVE = 8;
constexpr int T_TOK = 32768, DM = 1024, NB = 16, SEQ = 2048;
constexpr int LDS_BYTES = 163840;
constexpr float EPS = 1e-6f;
constexpr float QSCALE = 0.10206207261596575f * 1.4426950408889634f;

constexpr size_t OFF_PART  = 0;
constexpr size_t OFF_MODT  = 8u << 20;
constexpr size_t OFF_WINT  = 16u << 20;
constexpr size_t OFF_WGLUT = OFF_WINT + (2u << 20);
constexpr size_t OFF_WUQT  = OFF_WGLUT + (512u << 10);
constexpr size_t OFF_WUKVT = OFF_WUQT + 524288;
constexpr size_t OFF_WOUTT = OFF_WUKVT + 262144;
constexpr size_t OFF_WQT   = OFF_WOUTT + (2u << 20);
constexpr size_t OFF_SUBK  = OFF_WQT + (4u << 20);
constexpr size_t OFF_KMT   = OFF_SUBK + 65536;
constexpr size_t OFF_WZT   = OFF_KMT + 20971520;
constexpr size_t OFF_AL    = OFF_WZT + 4194304;
constexpr size_t OFF_HBUF  = OFF_AL + 16384;
constexpr size_t OFF_PROJ2 = OFF_HBUF + (64u << 20);
constexpr size_t OFF_UBUF  = OFF_PROJ2 + (32u << 20);
constexpr size_t OFF_Q     = OFF_UBUF + 41943040;
constexpr size_t OFF_K     = OFF_Q + 50331648;
constexpr size_t OFF_VT    = OFF_K + 50331648;
constexpr size_t OFF_YBUF  = OFF_VT + 33554432;
constexpr size_t OFF_IDX   = OFF_YBUF + (32u << 20);
constexpr size_t OFF_G     = OFF_IDX + (16u << 20);
constexpr size_t OFF_E8    = OFF_G + (16u << 20);
constexpr size_t OFF_ESC   = OFF_E8 + (32u << 20);
constexpr size_t OFF_BAR   = OFF_ESC + (1u << 20);
constexpr size_t WS_NEED   = OFF_BAR + (1u << 20);

struct Params {
    const float* x; const float* c; const int* pos; const float* w_ada; const float* b_ada; const float* norm_mix; const float* norm_ffn; const float* w_in;
    const float* lam_re; const float* lam_im; const float* log_dt; const float* b_re; const float* b_im; const float* c_re; const float* c_im; const float* d_skip;
    const float* w_glu; const float* b_glu; const float* q_a_norm; const float* w_uq; const float* kv_a_norm; const float* w_ukv; const float* q_norm; const float* k_norm;
    const float* out_norm_ssm; const float* out_norm_attn; const float* w_out; const float* w_query; const float* sub_keys; const float* e_down; const float* e_up;
    float* out; unsigned char* ws; int ph_lo, ph_hi;
};

__device__ __forceinline__ unsigned f2bf(float f) { unsigned u = __float_as_uint(f); return (u + 0x7fffu + ((u >> 16) & 1u)) >> 16; }
__device__ __forceinline__ unsigned pk2(float lo, float hi) { return f2bf(lo) | (f2bf(hi) << 16); }
__device__ __forceinline__ float bf2f(unsigned short b) { return __uint_as_float(((unsigned)b) << 16); }
__device__ __forceinline__ float bflo(unsigned w) { return __uint_as_float(w << 16); }
__device__ __forceinline__ float bfhi(unsigned w) { return __uint_as_float(w & 0xffff0000u); }
__device__ __forceinline__ int opq_s(int x) { asm volatile("" : "+s"(x)); return x; }
__device__ __forceinline__ int opq_v(int x) { asm volatile("" : "+v"(x)); return x; }
template <class T> __device__ __forceinline__ T* opq_p(T* x) { asm volatile("" : "+s"(x)); return x; }
__device__ __forceinline__ int crow(int r, int hi) { return (r & 3) + 8 * (r >> 2) + 4 * hi; }
__device__ __forceinline__ float wave_sum(float v) {
#pragma unroll
    for (int o = 1; o < 64; o <<= 1) v += __shfl_xor(v, o);
    return v;
}
__device__ __forceinline__ float gelu_tanh(float x) {
    const float u = 0.7978845608028654f * (x + 0.044715f * x * x * x);
    const float t = 1.0f - 2.0f * __builtin_amdgcn_rcpf(1.0f + __expf(2.0f * u));
    return 0.5f * x * (1.0f + t);
}
__device__ __forceinline__ float sigmoidf_(float z) { return __builtin_amdgcn_rcpf(1.0f + __expf(-z)); }

constexpr int G_STR = 144;
constexpr int G_ABYTES = 128 * G_STR;
template <int NT> struct GemmCfg { static constexpr int BN = 128 * NT, BBYTES = BN * G_STR, STAGE = G_ABYTES + BBYTES; };

struct ARow { const bf16_t* A; int lda; __device__ __forceinline__ const bf16_t* operator()(int row, int k) const { return A + (size_t)row * lda + k; } };
struct AGrp { const bf16_t* Y; __device__ __forceinline__ const bf16_t* operator()(int row, int k) const { return Y + ((size_t)(k >> 4) * T_TOK + row) * 16 + (k & 15); } };
constexpr int CSTR = 260;

template <int NT, int MODE, int MID, class AL, class Epi>
__device__ __forceinline__ void gemm_128(const AL aload, const bf16_t* __restrict__ Bt, int ldb, int K, unsigned char* lds, const float* midscale, Epi epi) {
    typedef GemmCfg<NT> C;
    const int tid = opq_v((int)threadIdx.x), lane = tid & 63, wid = __builtin_amdgcn_readfirstlane(tid >> 6), wm = wid >> 2, wn = wid & 3, r32 = lane & 31, hi = lane >> 5;
    f32x16 acc[2][NT];
#pragma unroll
    for (int i = 0; i < 2; ++i)
#pragma unroll
        for (int j = 0; j < NT; ++j)
#pragma unroll
            for (int r = 0; r < 16; ++r) acc[i][j][r] = 0.f;
    const int prow = tid >> 3, pc = tid & 7;
    const bf16_t* gb = Bt + (size_t)prow * ldb + pc * 8;
    const int ldsoff = prow * G_STR + pc * 16;
    u32x4 ra[2], rb[2 * NT];
    const int nk = K >> 6;
#pragma unroll
    for (int q = 0; q < 2; ++q) ra[q] = *(const u32x4*)aload(prow + 64 * q, pc * 8);
#pragma unroll
    for (int q = 0; q < 2 * NT; ++q) rb[q] = *(const u32x4*)(gb + (size_t)(64 * q) * ldb);
#pragma unroll
    for (int q = 0; q < 2; ++q) *(u32x4*)(lds + ldsoff + q * 64 * G_STR) = ra[q];
#pragma unroll
    for (int q = 0; q < 2 * NT; ++q) *(u32x4*)(lds + G_ABYTES + ldsoff + q * 64 * G_STR) = rb[q];
    __syncthreads();
    for (int kt = 0; kt < nk; ++kt) {
        unsigned char* st = lds + (kt & 1) * C::STAGE;
        if (kt + 1 < nk) {
#pragma unroll
            for (int q = 0; q < 2; ++q) ra[q] = *(const u32x4*)aload(prow + 64 * q, (kt + 1) * 64 + pc * 8);
#pragma unroll
            for (int q = 0; q < 2 * NT; ++q) rb[q] = *(const u32x4*)(gb + (size_t)(64 * q) * ldb + (kt + 1) * 64);
        }
        if (MID > 0 && kt == MID) {
#pragma unroll
            for (int i = 0; i < 2; ++i)
#pragma unroll
                for (int r = 0; r < 16; ++r) { const float sc = midscale[wm * 64 + i * 32 + crow(r, hi)];
#pragma unroll
                    for (int j = 0; j < NT; ++j) acc[i][j][r] *= sc; }
        }
        const unsigned char* pa = st + (wm * 64 + r32) * G_STR + hi * 16;
        const unsigned char* pb = st + G_ABYTES + (wn * 32 * NT + r32) * G_STR + hi * 16;
#pragma unroll
        for (int ks = 0; ks < 4; ++ks) {
            bf16x8 af[2], bfr[NT];
#pragma unroll
            for (int i = 0; i < 2; ++i) af[i] = *(const bf16x8*)(pa + i * 32 * G_STR + ks * 32);
#pragma unroll
            for (int j = 0; j < NT; ++j) bfr[j] = *(const bf16x8*)(pb + j * 32 * G_STR + ks * 32);
#pragma unroll
            for (int i = 0; i < 2; ++i)
#pragma unroll
                for (int j = 0; j < NT; ++j) acc[i][j] = __builtin_amdgcn_mfma_f32_32x32x16_bf16(af[i], bfr[j], acc[i][j], 0, 0, 0);
        }
        if (kt + 1 < nk) {
            unsigned char* sn = lds + ((kt + 1) & 1) * C::STAGE;
#pragma unroll
            for (int q = 0; q < 2; ++q) *(u32x4*)(sn + ldsoff + q * 64 * G_STR) = ra[q];
#pragma unroll
            for (int q = 0; q < 2 * NT; ++q) *(u32x4*)(sn + G_ABYTES + ldsoff + q * 64 * G_STR) = rb[q];
        }
        __syncthreads();
    }
    if constexpr (MODE == 0) {
#pragma unroll
        for (int i = 0; i < 2; ++i)
#pragma unroll
            for (int j = 0; j < NT; ++j)
#pragma unroll
                for (int r = 0; r < 16; ++r) epi(wm * 64 + i * 32 + crow(r, hi), wn * 32 * NT + j * 32 + r32, acc[i][j][r]);
    } else {
        float* Ct = (float*)lds;
#pragma unroll
        for (int i = 0; i < 2; ++i)
#pragma unroll
            for (int j = 0; j < NT; ++j)
#pragma unroll
                for (int r = 0; r < 16; ++r) Ct[(wm * 64 + i * 32 + crow(r, hi)) * CSTR + wn * 32 * NT + j * 32 + r32] = acc[i][j][r];
        __syncthreads();
        epi((const float*)Ct);
        __syncthreads();
    }
}

__device__ __forceinline__ void p0_transpose(const float* __restrict__ W, int K, int N, int Npad, bf16_t* __restrict__ WT,
                                             const float* g0, const float* g1, int gsplit, float* scr, int item, int cmap = 0) {
    const int tid = threadIdx.x;
    const int nkb = K / 64, kb = item % nkb, nb = item / nkb, k0 = kb * 64, n0 = nb * 64;
#pragma unroll
    for (int r = 0; r < 8; ++r) {
        const int kk = r * 8 + (tid >> 6), nn = tid & 63, k = k0 + kk; int n = n0 + nn;
        if (cmap) n = ((n & 255) < 192) ? (n >> 8) * 192 + (n & 255) : N;
        float v = (n < N) ? W[(size_t)k * N + n] : 0.f;
        if (g0) v *= (k < gsplit) ? g0[k] : g1[k - gsplit];
        scr[kk * 65 + nn] = v;
    }
    __syncthreads();
    {
        const int n = tid >> 3, kc = tid & 7; const float* s = scr + (kc * 8) * 65 + n;
        u32x4 o; o.x = pk2(s[0], s[65]); o.y = pk2(s[2 * 65], s[3 * 65]); o.z = pk2(s[4 * 65], s[5 * 65]); o.w = pk2(s[6 * 65], s[7 * 65]);
        *(u32x4*)(WT + (size_t)(n0 + n) * K + k0 + kc * 8) = o;
    }
    __syncthreads();
}


__device__ __forceinline__ void quant_row(const f32x4 (&a)[4], unsigned char* dst, float* scale_out, int lane) {
    float am = 0.f;
#pragma unroll
    for (int q = 0; q < 4; ++q) am = fmaxf(am, fmaxf(fmaxf(fabsf(a[q].x), fabsf(a[q].y)), fmaxf(fabsf(a[q].z), fabsf(a[q].w))));
#pragma unroll
    for (int o = 1; o < 64; o <<= 1) am = fmaxf(am, __shfl_xor(am, o));
    const float sc = (am > 0.f) ? am * (1.0f / 224.0f) : 1.0f, inv = 1.0f / sc;
    u32x4 o;
    { int w = __builtin_amdgcn_cvt_pk_fp8_f32(a[0].x * inv, a[0].y * inv, 0, false); w = __builtin_amdgcn_cvt_pk_fp8_f32(a[0].z * inv, a[0].w * inv, w, true); o.x = (unsigned)w; }
    { int w = __builtin_amdgcn_cvt_pk_fp8_f32(a[1].x * inv, a[1].y * inv, 0, false); w = __builtin_amdgcn_cvt_pk_fp8_f32(a[1].z * inv, a[1].w * inv, w, true); o.y = (unsigned)w; }
    { int w = __builtin_amdgcn_cvt_pk_fp8_f32(a[2].x * inv, a[2].y * inv, 0, false); w = __builtin_amdgcn_cvt_pk_fp8_f32(a[2].z * inv, a[2].w * inv, w, true); o.z = (unsigned)w; }
    { int w = __builtin_amdgcn_cvt_pk_fp8_f32(a[3].x * inv, a[3].y * inv, 0, false); w = __builtin_amdgcn_cvt_pk_fp8_f32(a[3].z * inv, a[3].w * inv, w, true); o.w = (unsigned)w; }
    *(u32x4*)dst = o;
    if (lane == 0) *scale_out = sc;
}

__device__ __forceinline__ void quant_row_i8(const f32x4 (&a)[4], unsigned char* dst, float* scale_out, int lane) {
    float am = 0.f;
#pragma unroll
    for (int q = 0; q < 4; ++q) am = fmaxf(am, fmaxf(fmaxf(fabsf(a[q].x), fabsf(a[q].y)), fmaxf(fabsf(a[q].z), fabsf(a[q].w))));
#pragma unroll
    for (int o = 1; o < 64; o <<= 1) am = fmaxf(am, __shfl_xor(am, o));
    const float sc = (am > 0.f) ? am * (1.0f / 127.0f) : 1.0f, inv = 1.0f / sc;
    u32x4 o;
#pragma unroll
    for (int q = 0; q < 4; ++q) { const int b0 = (int)rintf(a[q].x * inv), b1 = (int)rintf(a[q].y * inv), b2 = (int)rintf(a[q].z * inv), b3 = (int)rintf(a[q].w * inv);
        o[q] = (unsigned)(b0 & 0xFF) | ((unsigned)(b1 & 0xFF) << 8) | ((unsigned)(b2 & 0xFF) << 16) | ((unsigned)(b3 & 0xFF) << 24); }
    *(u32x4*)dst = o;
    if (lane == 0) *scale_out = sc;
}
__device__ void phase0(const Params& p, unsigned char* lds) {
    const int tid = threadIdx.x, G = gridDim.x, bid = blockIdx.x;
    unsigned char* ws = p.ws;
    float* scr = (float*)lds;
    {
        float* part = (float*)(ws + OFF_PART);
        for (int it = bid; it < 24 * 16; it += G) {
            const int nb = it % 24, ks = it / 24, n = nb * 256 + (tid & 255), bh = tid >> 8;
            for (int i = tid; i < 16 * 64; i += NTHR) { const int b = i >> 6, kk = i & 63; const float cv = p.c[b * 1024 + ks * 64 + kk]; scr[i] = cv / (1.0f + __expf(-cv)); }
            __syncthreads();
            float acc[8];
#pragma unroll
            for (int j = 0; j < 8; ++j) acc[j] = 0.f;
            for (int kk = 0; kk < 64; ++kk) {
                const float w = p.w_ada[(size_t)(ks * 64 + kk) * 6144 + n];
#pragma unroll
                for (int j = 0; j < 8; ++j) acc[j] += w * scr[(bh * 8 + j) * 64 + kk];
            }
#pragma unroll
            for (int j = 0; j < 8; ++j) part[((size_t)ks * 16 + bh * 8 + j) * 6144 + n] = acc[j];
            __syncthreads();
        }
    }
    {
        constexpr int I_IN = 16 * 16, I_GLU = 8 * 8, I_UQ = 4 * 16, I_UKV = 2 * 16, I_OUT = 16 * 16, I_Q = 16 * 32;
        constexpr int NIT = I_IN + I_GLU + I_UQ + I_UKV + I_OUT + I_Q;
        for (int it = bid; it < NIT; it += G) {
            int r = it;
            if (r < I_IN) { p0_transpose(p.w_in, 1024, 928, 1024, (bf16_t*)(ws + OFF_WINT), nullptr, nullptr, 0, scr, r); continue; } r -= I_IN;
            if (r < I_GLU) { p0_transpose(p.w_glu, 512, 512, 512, (bf16_t*)(ws + OFF_WGLUT), nullptr, nullptr, 0, scr, r); continue; } r -= I_GLU;
            if (r < I_UQ) { p0_transpose(p.w_uq, 256, 768, 1024, (bf16_t*)(ws + OFF_WUQT), p.q_a_norm, p.q_a_norm, 256, scr, r, 1); continue; } r -= I_UQ;
            if (r < I_UKV) { p0_transpose(p.w_ukv, 128, 1024, 1024, (bf16_t*)(ws + OFF_WUKVT), p.kv_a_norm, p.kv_a_norm, 128, scr, r); continue; } r -= I_UKV;
            if (r < I_OUT) { p0_transpose(p.w_out, 1024, 1024, 1024, (bf16_t*)(ws + OFF_WOUTT), p.out_norm_ssm, p.out_norm_attn, 512, scr, r); continue; } r -= I_OUT;
            p0_transpose(p.w_query, 1024, 2048, 2048, (bf16_t*)(ws + OFF_WQT), nullptr, nullptr, 0, scr, r);
        }
    }
    {
        const size_t gt = (size_t)bid * NTHR + tid, gs = (size_t)G * NTHR;
        for (size_t i = gt; i < 32768 / 8; i += gs) { const f32x4 a = ((const f32x4*)p.sub_keys)[2 * i], b = ((const f32x4*)p.sub_keys)[2 * i + 1];
            u32x4 o; o.x = pk2(a.x, a.y); o.y = pk2(a.z, a.w); o.z = pk2(b.x, b.y); o.w = pk2(b.z, b.w); ((u32x4*)(ws + OFF_SUBK))[i] = o; }
    }
    {
        const int lane = tid & 63, gw = bid * NWAVE + (tid >> 6), NGW = G * NWAVE;
        unsigned char* E8 = ws + OFF_E8; float* esc = (float*)(ws + OFF_ESC);
        for (int r = gw; r < 32768; r += 2 * NGW) {
            const int r2 = r + NGW; const bool has2 = r2 < 32768;
            const float* s0p = ((r < 16384) ? p.e_down : p.e_up) + (size_t)(r & 16383) * 1024 + lane * 16;
            const float* s1p = ((r2 < 16384) ? p.e_down : p.e_up) + (size_t)(r2 & 16383) * 1024 + lane * 16;
            f32x4 a[4], b[4];
#pragma unroll
            for (int q = 0; q < 4; ++q) a[q] = ((const f32x4*)s0p)[q];
            if (has2) {
#pragma unroll
                for (int q = 0; q < 4; ++q) b[q] = ((const f32x4*)s1p)[q]; }
            if (r < 16384) quant_row_i8(a, E8 + (size_t)r * 1024 + lane * 16, esc + r, lane); else quant_row(a, E8 + (size_t)r * 1024 + lane * 16, esc + r, lane);
            if (has2) { if (r2 < 16384) quant_row_i8(b, E8 + (size_t)r2 * 1024 + lane * 16, esc + r2, lane); else quant_row(b, E8 + (size_t)r2 * 1024 + lane * 16, esc + r2, lane); }
        }
    }
    {
        f32x2* apow = (f32x2*)lds;
        f32x2* Bb = (f32x2*)(lds + 16896);
        f32x2* Cc = (f32x2*)(lds + 16896 + 8192);
        float* Kt = (float*)(lds + 16896 + 16384);
        for (int it = ((bid >= G / 2) ? bid - G / 2 : bid + G / 2); it < 128; it += G) {
            const int g = it >> 2, cq = it & 3;
            const float dt = __expf(p.log_dt[g]);
            for (int i = tid; i < 33 * 64; i += NTHR) { const int j = i >> 6, pp = i & 63; const float lr = p.lam_re[g * 64 + pp], li = p.lam_im[g * 64 + pp];
                const float mag = expf((float)j * lr * dt); float sn, cs; sincosf((float)j * li * dt, &sn, &cs); apow[i] = (f32x2){mag * cs, mag * sn}; }
            for (int i = tid; i < 1024; i += NTHR) { const int pp = i >> 4; const float lr = p.lam_re[g * 64 + pp], li = p.lam_im[g * 64 + pp];
                const float mag = expf(lr * dt); float sn, cs; sincosf(li * dt, &sn, &cs); const float nr = mag * cs - 1.0f, ni = mag * sn, den = lr * lr + li * li;
                const float cr = (nr * lr + ni * li) / den, ci = (ni * lr - nr * li) / den; const float br = p.b_re[(size_t)g * 1024 + i], bi = p.b_im[(size_t)g * 1024 + i];
                Bb[i] = (f32x2){cr * br - ci * bi, cr * bi + ci * br}; }
            for (int i = tid; i < 1024; i += NTHR) Cc[i] = (f32x2){p.c_re[(size_t)g * 1024 + i], p.c_im[(size_t)g * 1024 + i]};
            __syncthreads();
            for (int i2 = tid; i2 < 2048; i2 += NTHR) { const int j = i2 >> 6, co = cq * 4 + ((i2 >> 4) & 3), ci = i2 & 15, i = (j << 8) | (co << 4) | ci; float s = 0.f;
                for (int pp = 0; pp < 64; ++pp) { const f32x2 c = Cc[co * 64 + pp], a = apow[j * 64 + pp], b = Bb[pp * 16 + ci]; const float car = c.x * a.x - c.y * a.y, cai = c.x * a.y + c.y * a.x; s += car * b.x - cai * b.y; }
                if (j == 0 && co == ci) s += p.d_skip[g * 16 + co];
                Kt[i] = s; }
            __syncthreads();
            bf16_t* KmT = (bf16_t*)(ws + OFF_KMT) + (size_t)g * 512 * 640;
            for (int q = tid; q < 128 * 80; q += NTHR) { const int nn = q / 80, kc = q % 80, k0 = kc * 8, t = nn >> 2, co = cq * 4 + (nn & 3), n = t * 16 + co; float v[8];
                if (k0 < 512) { const int s = k0 >> 4, ci0 = k0 & 15;
#pragma unroll
                    for (int i = 0; i < 8; ++i) v[i] = (t >= s) ? Kt[((t - s) * 16 + co) * 16 + ci0 + i] : 0.f;
                } else { const int kk0 = k0 - 512, ri = kk0 >> 6, p0 = kk0 & 63;
#pragma unroll
                    for (int i = 0; i < 8; ++i) { const f32x2 c = Cc[co * 64 + p0 + i], a = apow[(t + 1) * 64 + p0 + i]; v[i] = (ri == 0) ? (c.x * a.x - c.y * a.y) : -(c.x * a.y + c.y * a.x); } }
                u32x4 o; o.x = pk2(v[0], v[1]); o.y = pk2(v[2], v[3]); o.z = pk2(v[4], v[5]); o.w = pk2(v[6], v[7]); *(u32x4*)(KmT + (size_t)n * 640 + k0) = o; }
            bf16_t* WzT = (bf16_t*)(ws + OFF_WZT) + (size_t)g * 128 * 512;
            for (int q = tid; q < 32 * 64; q += NTHR) { const int n = cq * 32 + (q >> 6), kc = q & 63, k0 = kc * 8, s = k0 >> 4, ci0 = k0 & 15, ri = n >> 6, pp = n & 63; float v[8];
                const f32x2 a = apow[(31 - s) * 64 + pp];
#pragma unroll
                for (int i = 0; i < 8; ++i) { const f32x2 b = Bb[pp * 16 + ci0 + i]; v[i] = (ri == 0) ? (a.x * b.x - a.y * b.y) : (a.x * b.y + a.y * b.x); }
                u32x4 o; o.x = pk2(v[0], v[1]); o.y = pk2(v[2], v[3]); o.z = pk2(v[4], v[5]); o.w = pk2(v[6], v[7]); *(u32x4*)(WzT + (size_t)n * 512 + k0) = o; }
            if (cq == 0 && tid < 64) ((f32x2*)(ws + OFF_AL))[g * 64 + tid] = apow[32 * 64 + tid];
            __syncthreads();
        }
    }
}


__device__ __forceinline__ void finalize_row(const float* nope, const float* ra, const float* rb, float rn, float rnr, const float* __restrict__ gain, const float* cs, const float* sn, bf16_t* dst) {
#pragma unroll
    for (int j = 0; j < 8; ++j) { const f32x4 a = *(const f32x4*)(nope + 8 * j), c = *(const f32x4*)(nope + 8 * j + 4);
        u32x4 o; o.x = pk2(a.x * rn * gain[8 * j], a.y * rn * gain[8 * j + 1]); o.y = pk2(a.z * rn * gain[8 * j + 2], a.w * rn * gain[8 * j + 3]);
        o.z = pk2(c.x * rn * gain[8 * j + 4], c.y * rn * gain[8 * j + 5]); o.w = pk2(c.z * rn * gain[8 * j + 6], c.w * rn * gain[8 * j + 7]); *(u32x4*)(dst + 8 * j) = o; }
#pragma unroll
    for (int j = 0; j < 2; ++j) { float o1[8], o2[8];
#pragma unroll
        for (int i = 0; i < 8; ++i) { const int f = 8 * j + i; const float x1 = ra[f] * rnr * gain[64 + f], x2 = rb[f] * rnr * gain[80 + f]; o1[i] = x1 * cs[f] - x2 * sn[f]; o2[i] = x2 * cs[f] + x1 * sn[f]; }
        u32x4 o; o.x = pk2(o1[0], o1[1]); o.y = pk2(o1[2], o1[3]); o.z = pk2(o1[4], o1[5]); o.w = pk2(o1[6], o1[7]); *(u32x4*)(dst + 64 + 8 * j) = o;
        o.x = pk2(o2[0], o2[1]); o.y = pk2(o2[2], o2[3]); o.z = pk2(o2[4], o2[5]); o.w = pk2(o2[6], o2[7]); *(u32x4*)(dst + 80 + 8 * j) = o; }
}
constexpr int CT_BYTES = 128 * CSTR * 4;
constexpr int P1_RSQ = CT_BYTES, P1_RSKV = P1_RSQ + 512, P1_CS = P1_RSKV + 512, P1_SN = P1_CS + 8192, P1_KR = P1_SN + 8192;

__device__ void phase1(const Params& p, unsigned char* lds) {
    const int tid = threadIdx.x, lane = tid & 63, wid = __builtin_amdgcn_readfirstlane(tid >> 6);
    unsigned char* ws = p.ws;
    bf16_t* hbuf = (bf16_t*)(ws + OFF_HBUF); bf16_t* proj2 = (bf16_t*)(ws + OFF_PROJ2); bf16_t* ubuf = (bf16_t*)(ws + OFF_UBUF);
    float* rsq = (float*)(lds + P1_RSQ); float* rskv = (float*)(lds + P1_RSKV); float* cst = (float*)(lds + P1_CS); float* snt = (float*)(lds + P1_SN); bf16_t* krl = (bf16_t*)(lds + P1_KR);
    for (int tile = blockIdx.x; tile < 256; tile += gridDim.x) {
        const int row0 = tile * 128, b = row0 >> 11;
        float* mod = (float*)(ws + OFF_MODT) + (size_t)tile * 6144 - (size_t)b * 6144;
        for (int i = tid; i < 6144; i += NTHR) { float s = p.b_ada[i]; const float* pp = (const float*)(ws + OFF_PART) + (size_t)b * 6144 + i;
            for (int ks = 0; ks < 16; ++ks) s += pp[(size_t)ks * 16 * 6144]; mod[b * 6144 + i] = s; }
        for (int i = tid; i < 2048; i += NTHR) { const int r = i >> 4, f = i & 15; const float ang = (float)p.pos[row0 + r] * exp2f(-(float)f * (13.287712379549449f / 16.0f));
            float sn, cs; sincosf(ang, &sn, &cs); cst[i] = cs; snt[i] = sn; }
        __threadfence_block(); __syncthreads();
        for (int rp1a = 0; rp1a < ((PROBE_REP & 8192) ? 2 : 1); ++rp1a) {
        for (int r = wid; r < 128; r += NWAVE) {
            const f32x4* xr = (const f32x4*)(p.x + (size_t)(row0 + r) * 1024); f32x4 v[4]; float ss = 0.f;
#pragma unroll
            for (int j = 0; j < 4; ++j) { v[j] = xr[lane + 64 * j]; ss += v[j].x * v[j].x + v[j].y * v[j].y + v[j].z * v[j].z + v[j].w * v[j].w; }
            const float rs = rsqrtf(wave_sum(ss) * (1.0f / 1024.0f) + EPS);
#pragma unroll
            for (int j = 0; j < 4; ++j) { const int col = 4 * (lane + 64 * j);
                const f32x4 g = *(const f32x4*)(p.norm_mix + col), sc = *(const f32x4*)(mod + b * 6144 + 1024 + col), sh = *(const f32x4*)(mod + b * 6144 + col);
                u32x2 o; o.x = pk2(v[j].x * rs * g.x * (1.f + sc.x) + sh.x, v[j].y * rs * g.y * (1.f + sc.y) + sh.y); o.y = pk2(v[j].z * rs * g.z * (1.f + sc.z) + sh.z, v[j].w * rs * g.w * (1.f + sc.w) + sh.w);
                *(u32x2*)(hbuf + (size_t)(row0 + r) * 1024 + col) = o; }
        }
        __threadfence_block(); __syncthreads();
        }
        for (int rp1b = 0; rp1b < ((PROBE_REP & 16384) ? 2 : 1); ++rp1b) {
        const ARow ah{hbuf + (size_t)row0 * 1024, 1024};
        for (int nc = 0; nc < 4; ++nc) {
            const bf16_t* Bt = (const bf16_t*)(ws + OFF_WINT) + (size_t)nc * 256 * 1024;
            if (nc < 2) gemm_128<2, 1, 0>(ah, Bt, 1024, 1024, lds, nullptr, [&](const float* Ct) {
                    const int ln = opq_v(lane), r0u = opq_s(row0), ncu = opq_s(nc); bf16_t* ub = opq_p(ubuf);
                    for (int tk = wid; tk < 32; tk += NWAVE) { const int gi = tk >> 1, r = (tk & 1) * 64 + ln, g = ncu * 16 + gi, tok = r0u + r;
                        const float* c = Ct + r * CSTR + gi * 16; const f32x4 a0 = *(const f32x4*)c, a1 = *(const f32x4*)(c + 4), a2 = *(const f32x4*)(c + 8), a3 = *(const f32x4*)(c + 12);
                        bf16_t* d = ub + ((size_t)g * 1024 + (tok >> 5)) * 640 + (tok & 31) * 16;
                        *(u32x4*)d = (u32x4){pk2(a0.x, a0.y), pk2(a0.z, a0.w), pk2(a1.x, a1.y), pk2(a1.z, a1.w)}; *(u32x4*)(d + 8) = (u32x4){pk2(a2.x, a2.y), pk2(a2.z, a2.w), pk2(a3.x, a3.y), pk2(a3.z, a3.w)}; } });
            else if (nc == 2) gemm_128<2, 1, 0>(ah, Bt, 1024, 1024, lds, nullptr, [&](const float* Ct) {
                    const int ln = opq_v(lane), r0u = opq_s(row0); bf16_t* pj = opq_p(proj2);
                    for (int r = wid; r < 128; r += NWAVE) { const f32x4 v = *(const f32x4*)(Ct + r * CSTR + ln * 4);
                        const float sq = wave_sum(v.x * v.x + v.y * v.y + v.z * v.z + v.w * v.w); if (ln == 0) rsq[r] = rsqrtf(sq * (1.0f / 256.0f) + EPS);
                        *(u32x2*)(pj + (size_t)(r0u + r) * 512 + ln * 4) = (u32x2){pk2(v.x, v.y), pk2(v.z, v.w)}; } });
            else gemm_128<2, 1, 0>(ah, Bt, 1024, 1024, lds, nullptr, [&](const float* Ct) {
                    const int ln = opq_v(lane), r0u = opq_s(row0); bf16_t* pj = opq_p(proj2);
                    for (int r = wid; r < 128; r += NWAVE) { const f32x4 v = (ln < 40) ? *(const f32x4*)(Ct + r * CSTR + ln * 4) : (f32x4){0.f, 0.f, 0.f, 0.f};
                        const float sq = wave_sum((ln < 32) ? (v.x * v.x + v.y * v.y + v.z * v.z + v.w * v.w) : 0.f); if (ln == 0) rskv[r] = rsqrtf(sq * (1.0f / 128.0f) + EPS);
                        const u32x2 o = (u32x2){pk2(v.x, v.y), pk2(v.z, v.w)};
                        if (ln < 32) *(u32x2*)(pj + (size_t)(r0u + r) * 512 + 256 + ln * 4) = o; else if (ln < 40) *(u32x2*)(krl + r * 32 + (ln - 32) * 4) = o; } });
        }
        }
        for (int rp1d = 0; rp1d < ((PROBE_REP & 32768) ? 2 : 1); ++rp1d) {
        const ARow aq{proj2 + (size_t)row0 * 512, 512};
        for (int nc = 0; nc < 4; ++nc)
            gemm_128<2, 1, 0>(aq, (const bf16_t*)(ws + OFF_WUQT) + (size_t)nc * 256 * 256, 256, 256, lds, nullptr, [&](const float* Ct) {
                const int tq = opq_v(tid); const float* gq = opq_p(p.q_norm);
                if (tq < 256) { const int row = tq & 127, hh = tq >> 7, h = opq_s(nc) * 2 + hh; const float* q = Ct + row * CSTR + hh * 96; float ss = 0.f;
#pragma unroll
                    for (int j = 0; j < 24; ++j) { const f32x4 t4 = *(const f32x4*)(q + 4 * j); ss += t4.x * t4.x + t4.y * t4.y + t4.z * t4.z + t4.w * t4.w; }
                    const float rq = rsq[row], rn = rsqrtf(ss * rq * rq * (1.0f / 96.0f) + EPS) * rq * QSCALE;
                    const int r0q = opq_s(row0); bf16_t* dst = (bf16_t*)(ws + OFF_Q) + ((size_t)((r0q >> 11) * 8 + h) * 2048 + ((r0q + row) & 2047)) * 96;
                    finalize_row(q, q + 64, q + 80, rn, rn, gq, cst + row * 16, snt + row * 16, dst); } });
        }
        for (int rp1e = 0; rp1e < ((PROBE_REP & 65536) ? 2 : 1); ++rp1e) {
        const ARow akv{proj2 + (size_t)row0 * 512 + 256, 512};
        for (int nc = 0; nc < 4; ++nc)
            gemm_128<2, 1, 0>(akv, (const bf16_t*)(ws + OFF_WUKVT) + (size_t)nc * 256 * 128, 128, 128, lds, nullptr, [&](const float* Ct) {
                const int tq = opq_v(tid); const float* gk = opq_p(p.k_norm); const int r0k = opq_s(row0), nck = opq_s(nc);
                if (tq < 256) { const int row = tq & 127, hh = tq >> 7, h = nck * 2 + hh; const float* kp = Ct + row * CSTR + hh * 128; float ss = 0.f, sr = 0.f; float rp[32];
#pragma unroll
                    for (int j = 0; j < 16; ++j) { const f32x4 t4 = *(const f32x4*)(kp + 4 * j); ss += t4.x * t4.x + t4.y * t4.y + t4.z * t4.z + t4.w * t4.w; }
#pragma unroll
                    for (int j = 0; j < 4; ++j) { const u32x4 w = *(const u32x4*)(krl + row * 32 + 8 * j);
                        rp[8 * j] = bflo(w.x); rp[8 * j + 1] = bfhi(w.x); rp[8 * j + 2] = bflo(w.y); rp[8 * j + 3] = bfhi(w.y); rp[8 * j + 4] = bflo(w.z); rp[8 * j + 5] = bfhi(w.z); rp[8 * j + 6] = bflo(w.w); rp[8 * j + 7] = bfhi(w.w); }
#pragma unroll
                    for (int d = 0; d < 32; ++d) sr += rp[d] * rp[d];
                    const float rk = rskv[row], rn = rsqrtf((ss * rk * rk + sr) * (1.0f / 96.0f) + EPS);
                    bf16_t* dst = (bf16_t*)(ws + OFF_K) + ((size_t)((r0k >> 11) * 8 + h) * 2048 + ((r0k + row) & 2047)) * 96;
                    finalize_row(kp, rp, rp + 16, rn * rk, rn, gk, cst + row * 16, snt + row * 16, dst);
                } else { const int t = tq - 256, d = t & 63, hh = (t >> 6) & 1, rh = t >> 7, h = nck * 2 + hh;
                    bf16_t* dst = (bf16_t*)(ws + OFF_VT) + ((size_t)((r0k >> 11) * 8 + h) * 64 + d) * 2048 + (r0k & 2047) + rh * 64;
                    const float* vp = Ct + (rh * 64) * CSTR + hh * 128 + 64 + d;
#pragma unroll 2
                    for (int r8 = 0; r8 < 8; ++r8) { float v[8];
#pragma unroll
                        for (int i = 0; i < 8; ++i) v[i] = vp[(r8 * 8 + i) * CSTR] * rskv[rh * 64 + r8 * 8 + i];
                        *(u32x4*)(dst + r8 * 8) = (u32x4){pk2(v[0], v[1]), pk2(v[2], v[3]), pk2(v[4], v[5]), pk2(v[6], v[7])}; } } });
        }
    }
}

__device__ void s5_item(const Params& p, unsigned char* lds, int g, int bp) {
    const int tid = threadIdx.x;
    unsigned char* ws = p.ws;
    bf16_t* A = (bf16_t*)(ws + OFF_UBUF) + ((size_t)g * 1024 + bp * 128) * 640;
    float* Z = (float*)(lds + 73728);
    const ARow au{A, 640};
    gemm_128<1, 0, 0>(au, (const bf16_t*)(ws + OFF_WZT) + (size_t)g * 128 * 512, 512, 512, lds, nullptr, [&](int row, int col, float v) { Z[row * 129 + col] = v; });
    __syncthreads();
    if (tid < 128) {
        const int bs = tid >> 6, pp = tid & 63; const f32x2 aL = ((const f32x2*)(ws + OFF_AL))[g * 64 + pp]; float xr = 0.f, xi = 0.f;
        for (int k = 0; k < 64; ++k) { const int row = bs * 64 + k; bf16_t* xin = A + (size_t)row * 640 + 512;
            xin[pp] = (bf16_t)f2bf(xr); xin[64 + pp] = (bf16_t)f2bf(xi);
            const float zr = Z[row * 129 + pp], zi = Z[row * 129 + 64 + pp], nr = aL.x * xr - aL.y * xi + zr, ni = aL.x * xi + aL.y * xr + zi; xr = nr; xi = ni; }
    }
    __threadfence_block(); __syncthreads();
    bf16_t* ybT = (bf16_t*)(ws + OFF_YBUF) + (size_t)g * T_TOK * 16;
    for (int nc = 0; nc < 2; ++nc)
        gemm_128<2, 1, 0>(au, (const bf16_t*)(ws + OFF_KMT) + ((size_t)g * 512 + nc * 256) * 640, 640, 640, lds, nullptr, [&](const float* Ct) {
#pragma unroll
            for (int i = 0; i < 4; ++i) { const int pidx = tid + NTHR * i, row = pidx >> 4, tt = pidx & 15; const float* c = Ct + row * CSTR + tt * 16;
                const f32x4 a0 = *(const f32x4*)c, a1 = *(const f32x4*)(c + 4), a2 = *(const f32x4*)(c + 8), a3 = *(const f32x4*)(c + 12);
                bf16_t* d = ybT + ((size_t)(bp * 128 + row) * 32 + nc * 16 + tt) * 16;
                *(u32x4*)d = (u32x4){pk2(gelu_tanh(a0.x), gelu_tanh(a0.y)), pk2(gelu_tanh(a0.z), gelu_tanh(a0.w)), pk2(gelu_tanh(a1.x), gelu_tanh(a1.y)), pk2(gelu_tanh(a1.z), gelu_tanh(a1.w))};
                *(u32x4*)(d + 8) = (u32x4){pk2(gelu_tanh(a2.x), gelu_tanh(a2.y)), pk2(gelu_tanh(a2.z), gelu_tanh(a2.w)), pk2(gelu_tanh(a3.x), gelu_tanh(a3.y)), pk2(gelu_tanh(a3.z), gelu_tanh(a3.w))}; } });
}

constexpr int AT_KSTR = 208, AT_VSTR = 136, AT_KB = 64 * AT_KSTR, AT_VB = 64 * AT_VSTR, AT_STAGE = AT_KB + AT_VB;

__device__ void attn_item(const Params& p, unsigned char* lds, int bh, int qb) {
    const int tid = threadIdx.x, lane = tid & 63, wid = __builtin_amdgcn_readfirstlane(tid >> 6), r32 = lane & 31, hi = lane >> 5;
    unsigned char* ws = p.ws;
    const int q0 = qb * 256, qw0 = q0 + wid * 32, qg = qw0 + r32;
    const bf16_t* Qp = (const bf16_t*)(ws + OFF_Q) + ((size_t)bh * 2048 + qw0) * 96;
    const bf16_t* Kp = (const bf16_t*)(ws + OFF_K) + (size_t)bh * 2048 * 96;
    const bf16_t* Vp = (const bf16_t*)(ws + OFF_VT) + (size_t)bh * 64 * 2048;
    bf16x8 qf[6];
#pragma unroll
    for (int ks = 0; ks < 6; ++ks) qf[ks] = *(const bf16x8*)(Qp + r32 * 96 + ks * 16 + hi * 8);
    f32x16 ot[2];
#pragma unroll
    for (int r = 0; r < 16; ++r) { ot[0][r] = 0.f; ot[1][r] = 0.f; }
    float m = -INFINITY, l = 0.f;
    const int nkv = (q0 + 256) / 64;
    const int kr0 = tid / 12, kc0 = tid % 12, kr1 = (tid + 512) / 12, kc1 = (tid + 512) % 12; const bool k2 = tid < 256;
    const int vd = tid >> 3, vc = tid & 7;
    u32x4 rk0, rk1, rv;
    rk0 = *(const u32x4*)(Kp + (size_t)kr0 * 96 + kc0 * 8); if (k2) rk1 = *(const u32x4*)(Kp + (size_t)kr1 * 96 + kc1 * 8);
    rv = *(const u32x4*)(Vp + (size_t)vd * 2048 + vc * 8);
    *(u32x4*)(lds + kr0 * AT_KSTR + kc0 * 16) = rk0; if (k2) *(u32x4*)(lds + kr1 * AT_KSTR + kc1 * 16) = rk1;
    { u32x2* d = (u32x2*)(lds + AT_KB + vd * AT_VSTR + vc * 16); d[0] = (u32x2){rv.x, rv.y}; d[1] = (u32x2){rv.z, rv.w}; }
    __syncthreads();
    for (int t = 0; t < nkv; ++t) {
        const unsigned char* st = lds + (t & 1) * AT_STAGE; const int kv0 = t * 64;
        if (t + 1 < nkv) {
            const int kn = kv0 + 64;
            rk0 = *(const u32x4*)(Kp + (size_t)(kn + kr0) * 96 + kc0 * 8); if (k2) rk1 = *(const u32x4*)(Kp + (size_t)(kn + kr1) * 96 + kc1 * 8);
            rv = *(const u32x4*)(Vp + (size_t)vd * 2048 + kn + vc * 8);
        }
        if (kv0 <= qw0 + 31) {
            f32x16 s0, s1;
#pragma unroll
            for (int r = 0; r < 16; ++r) { s0[r] = 0.f; s1[r] = 0.f; }
#pragma unroll
            for (int ks = 0; ks < 6; ++ks) {
                const bf16x8 k0f = *(const bf16x8*)(st + r32 * AT_KSTR + ks * 32 + hi * 16);
                const bf16x8 k1f = *(const bf16x8*)(st + (32 + r32) * AT_KSTR + ks * 32 + hi * 16);
                s0 = __builtin_amdgcn_mfma_f32_32x32x16_bf16(k0f, qf[ks], s0, 0, 0, 0);
                s1 = __builtin_amdgcn_mfma_f32_32x32x16_bf16(k1f, qf[ks], s1, 0, 0, 0);
            }
            if (kv0 + 63 > qw0) {
#pragma unroll
                for (int r = 0; r < 16; ++r) { const int key = kv0 + crow(r, hi); if (key > qg) s0[r] = -INFINITY; if (key + 32 > qg) s1[r] = -INFINITY; }
            }
            float mx = fmaxf(s0[0], s1[0]);
#pragma unroll
            for (int r = 1; r < 16; ++r) mx = fmaxf(mx, fmaxf(s0[r], s1[r]));
            mx = fmaxf(mx, __shfl_xor(mx, 32));
            const float mn = fmaxf(m, mx), alpha = __builtin_amdgcn_exp2f(m - mn);
            float ps = 0.f;
#pragma unroll
            for (int r = 0; r < 16; ++r) { s0[r] = __builtin_amdgcn_exp2f(s0[r] - mn); s1[r] = __builtin_amdgcn_exp2f(s1[r] - mn); ps += s0[r] + s1[r]; }
            l = l * alpha + ps; m = mn;
#pragma unroll
            for (int r = 0; r < 16; ++r) { ot[0][r] *= alpha; ot[1][r] *= alpha; }
            const unsigned char* vb = st + AT_KB + r32 * AT_VSTR + hi * 8;
#pragma unroll
            for (int kt2 = 0; kt2 < 2; ++kt2)
#pragma unroll
                for (int s = 0; s < 2; ++s) {
                    u32x4 pw;
                    if (kt2 == 0) { pw.x = pk2(s0[8 * s], s0[8 * s + 1]); pw.y = pk2(s0[8 * s + 2], s0[8 * s + 3]); pw.z = pk2(s0[8 * s + 4], s0[8 * s + 5]); pw.w = pk2(s0[8 * s + 6], s0[8 * s + 7]); }
                    else { pw.x = pk2(s1[8 * s], s1[8 * s + 1]); pw.y = pk2(s1[8 * s + 2], s1[8 * s + 3]); pw.z = pk2(s1[8 * s + 4], s1[8 * s + 5]); pw.w = pk2(s1[8 * s + 6], s1[8 * s + 7]); }
                    const bf16x8 pf = __builtin_bit_cast(bf16x8, pw);
#pragma unroll
                    for (int dt = 0; dt < 2; ++dt) {
                        const unsigned char* a = vb + dt * 32 * AT_VSTR + (kt2 * 32 + 16 * s) * 2;
                        const u32x2 lo = *(const u32x2*)a, hh = *(const u32x2*)(a + 16);
                        const bf16x8 vf = __builtin_bit_cast(bf16x8, (u32x4){lo.x, lo.y, hh.x, hh.y});
                        ot[dt] = __builtin_amdgcn_mfma_f32_32x32x16_bf16(vf, pf, ot[dt], 0, 0, 0);
                    }
                }
        }
        if (t + 1 < nkv) {
            unsigned char* sn = lds + ((t + 1) & 1) * AT_STAGE;
            *(u32x4*)(sn + kr0 * AT_KSTR + kc0 * 16) = rk0; if (k2) *(u32x4*)(sn + kr1 * AT_KSTR + kc1 * 16) = rk1;
            u32x2* d = (u32x2*)(sn + AT_KB + vd * AT_VSTR + vc * 16); d[0] = (u32x2){rv.x, rv.y}; d[1] = (u32x2){rv.z, rv.w};
        }
        __syncthreads();
    }
    l += __shfl_xor(l, 32);
    const float inv = 1.0f / l;
    bf16_t* dst = (bf16_t*)(ws + OFF_HBUF) + ((size_t)(bh >> 3) * 2048 + qg) * 1024 + 512 + (bh & 7) * 64;
#pragma unroll
    for (int dt = 0; dt < 2; ++dt)
#pragma unroll
        for (int g4 = 0; g4 < 4; ++g4) { u32x2 o; o.x = pk2(ot[dt][4 * g4] * inv, ot[dt][4 * g4 + 1] * inv); o.y = pk2(ot[dt][4 * g4 + 2] * inv, ot[dt][4 * g4 + 3] * inv);
            *(u32x2*)(dst + dt * 32 + 8 * g4 + 4 * hi) = o; }
}

__device__ void phase2(const Params& p, unsigned char* lds) {
    for (int rp = 0; rp < ((PROBE_REP & 131072) ? 2 : 1); ++rp)
    for (int it = blockIdx.x; it < 256; it += gridDim.x) s5_item(p, lds, it >> 3, it & 7);
    for (int rp2 = 0; rp2 < ((PROBE_REP & 262144) ? 2 : 1); ++rp2)
    for (int v = blockIdx.x; v < 256; v += gridDim.x) {
        const int bh = v >> 1;
        for (int i = 0; i < 4; ++i) { const int qb = (v & 1) ? ((i == 0) ? 6 : (i == 1) ? 1 : (i == 2) ? 5 : 2) : ((i == 0) ? 7 : (i == 1) ? 0 : (i == 2) ? 4 : 3); attn_item(p, lds, bh, qb); }
    }
}

__device__ __forceinline__ void cex_desc(float& a, float& b) { const float mx = fmaxf(a, b), mn = fminf(a, b); a = mx; b = mn; }
__device__ __forceinline__ void sort16_desc(float (&v)[16]) {
#pragma unroll
    for (int k = 2; k <= 16; k <<= 1)
#pragma unroll
        for (int j = k >> 1; j > 0; j >>= 1)
#pragma unroll
            for (int i = 0; i < 16; ++i) { const int l = i ^ j; if (l > i) { if ((i & k) == 0) cex_desc(v[i], v[l]); else cex_desc(v[l], v[i]); } }
}
__device__ __forceinline__ void merge16(float (&top)[16], const float (&c)[16]) {
#pragma unroll
    for (int i = 0; i < 16; ++i) top[i] = fmaxf(top[i], c[15 - i]);
#pragma unroll
    for (int j = 8; j > 0; j >>= 1)
#pragma unroll
        for (int i = 0; i < 16; ++i) { const int l = i ^ j; if (l > i) cex_desc(top[i], top[l]); }
}
__device__ __forceinline__ float mkc(float a, float b, unsigned code) { return __uint_as_float((__float_as_uint(a + b) & 0xFFFFFF00u) | code); }


struct RowBuf { u32x4 d[4], u[4]; };
__device__ __forceinline__ void g_load(RowBuf& B, const unsigned char* __restrict__ E8, int idv, int kbase, int lane) {
#pragma unroll
    for (int j = 0; j < 4; ++j) { const int e = __builtin_amdgcn_readlane(idv, kbase + j);
        B.d[j] = *(const u32x4*)(E8 + (size_t)e * 1024 + lane * 16); B.u[j] = *(const u32x4*)(E8 + (size_t)(16384 + e) * 1024 + lane * 16); }
}
__device__ __forceinline__ float dpp_add(float t, const int ctrl_sel) {
    if (ctrl_sel == 0) return t + __int_as_float(__builtin_amdgcn_update_dpp(0, __float_as_int(t), 0xB1, 0xF, 0xF, false));
    if (ctrl_sel == 1) return t + __int_as_float(__builtin_amdgcn_update_dpp(0, __float_as_int(t), 0x4E, 0xF, 0xF, false));
    if (ctrl_sel == 2) return t + __int_as_float(__builtin_amdgcn_update_dpp(0, __float_as_int(t), 0x141, 0xF, 0xF, false));
    return t + __int_as_float(__builtin_amdgcn_update_dpp(0, __float_as_int(t), 0x140, 0xF, 0xF, false));
}
__device__ __forceinline__ void g_compute(const RowBuf& B, const f32x2 (&hv)[8], f32x2 (&acc)[8], float sdv, float gwv, int kbase, int lane) {
    float s[4];
#pragma unroll
    for (int j = 0; j < 4; ++j) { f32x2 a = {0.f, 0.f};
#pragma unroll
        for (int q = 0; q < 4; ++q) { const int w = (int)B.d[j][q]; const f32x2 lo = __builtin_amdgcn_cvt_pk_f32_fp8(w, false), hi = __builtin_amdgcn_cvt_pk_f32_fp8(w, true);
            a = __builtin_elementwise_fma(lo, hv[2 * q], a); a = __builtin_elementwise_fma(hi, hv[2 * q + 1], a); }
        s[j] = a.x + a.y; }
    auto r0 = __builtin_amdgcn_permlane32_swap(__float_as_uint(s[0]), __float_as_uint(s[1]), false, false);
    auto r1 = __builtin_amdgcn_permlane32_swap(__float_as_uint(s[2]), __float_as_uint(s[3]), false, false);
    const float r01 = __uint_as_float(r0[0]) + __uint_as_float(r0[1]), r23 = __uint_as_float(r1[0]) + __uint_as_float(r1[1]);
    auto r2 = __builtin_amdgcn_permlane16_swap(__float_as_uint(r01), __float_as_uint(r23), false, false);
    float t = __uint_as_float(r2[0]) + __uint_as_float(r2[1]);
    t = dpp_add(t, 0); t = dpp_add(t, 1); t = dpp_add(t, 2); t = dpp_add(t, 3);
    const int jl = kbase + ((lane >> 4) & 1) * 2 + (lane >> 5);
    const float sdl = __shfl(sdv, jl), gwl = __shfl(gwv, jl);
    const float w = gwl * gelu_tanh(sdl * t);
    float wj[4];
    wj[0] = __int_as_float(__builtin_amdgcn_readlane(__float_as_int(w), 0)); wj[1] = __int_as_float(__builtin_amdgcn_readlane(__float_as_int(w), 32));
    wj[2] = __int_as_float(__builtin_amdgcn_readlane(__float_as_int(w), 16)); wj[3] = __int_as_float(__builtin_amdgcn_readlane(__float_as_int(w), 48));
#pragma unroll
    for (int j = 0; j < 4; ++j) { const f32x2 ws = {wj[j], wj[j]};
#pragma unroll
        for (int q = 0; q < 4; ++q) { const int w2 = (int)B.u[j][q]; const f32x2 lo = __builtin_amdgcn_cvt_pk_f32_fp8(w2, false), hi = __builtin_amdgcn_cvt_pk_f32_fp8(w2, true);
            acc[2 * q] = __builtin_elementwise_fma(lo, ws, acc[2 * q]); acc[2 * q + 1] = __builtin_elementwise_fma(hi, ws, acc[2 * q + 1]); } }
}

constexpr int QP_STR = 528, S_OFF = 128 * QP_STR, S_STR = 132, L_OFF = S_OFF + 128 * S_STR * 4;

__device__ void phase3(const Params& p, unsigned char* lds) {
    const int tid = threadIdx.x, lane = tid & 63, wid = __builtin_amdgcn_readfirstlane(tid >> 6), r32 = lane & 31, hi = lane >> 5, wm = wid >> 2, wn = wid & 3;
    unsigned char* ws = p.ws;
    bf16_t* hbuf = (bf16_t*)(ws + OFF_HBUF); const bf16_t* ybuf = (const bf16_t*)(ws + OFF_YBUF);
    int* idxb = (int*)(ws + OFF_IDX); float* gb = (float*)(ws + OFF_G);
    for (int tile = blockIdx.x; tile < 256; tile += gridDim.x) {
        const int row0 = tile * 128, b = row0 >> 11;
        const float* mod = (const float*)(ws + OFF_MODT) + (size_t)tile * 6144 - (size_t)b * 6144;
        float* ssum = (float*)(lds + CT_BYTES); float* ratio = ssum + 128; float* rsat = ratio + 128; float* ss1 = rsat + 128;
        const bf16_t* ybT = ybuf + (size_t)row0 * 16;
        for (int rp3a = 0; rp3a < ((PROBE_REP & 16) ? 2 : 1); ++rp3a) {
        for (int nc = 0; nc < 2; ++nc)
            gemm_128<2, 1, 0>(AGrp{ybT}, (const bf16_t*)(ws + OFF_WGLUT) + (size_t)nc * 256 * 512, 512, 512, lds, nullptr, [&](const float* Ct) {
#pragma unroll 2
                for (int i = 0; i < 8; ++i) { const int pidx = tid + NTHR * i, row = pidx >> 5, c8 = (pidx & 31) * 8, col = nc * 256 + c8;
                    const f32x4 a0 = *(const f32x4*)(Ct + row * CSTR + c8), a1 = *(const f32x4*)(Ct + row * CSTR + c8 + 4);
                    const u32x4 yw = *(const u32x4*)(ybT + ((size_t)(col >> 4) * T_TOK + row) * 16 + (col & 15));
                    const f32x4 b0 = *(const f32x4*)(p.b_glu + col), b1 = *(const f32x4*)(p.b_glu + col + 4);
                    float o[8];
                    o[0] = bflo(yw.x) * sigmoidf_(a0.x + b0.x); o[1] = bfhi(yw.x) * sigmoidf_(a0.y + b0.y); o[2] = bflo(yw.y) * sigmoidf_(a0.z + b0.z); o[3] = bfhi(yw.y) * sigmoidf_(a0.w + b0.w);
                    o[4] = bflo(yw.z) * sigmoidf_(a1.x + b1.x); o[5] = bfhi(yw.z) * sigmoidf_(a1.y + b1.y); o[6] = bflo(yw.w) * sigmoidf_(a1.z + b1.z); o[7] = bfhi(yw.w) * sigmoidf_(a1.w + b1.w);
                    float ss = 0.f;
#pragma unroll
                    for (int k = 0; k < 8; ++k) ss += o[k] * o[k];
                    *(u32x4*)(hbuf + (size_t)(row0 + row) * 1024 + col) = (u32x4){pk2(o[0], o[1]), pk2(o[2], o[3]), pk2(o[4], o[5]), pk2(o[6], o[7])};
#pragma unroll
                    for (int of = 1; of < 32; of <<= 1) ss += __shfl_xor(ss, of);
                    if ((lane & 31) == 0) { if (nc == 0) ssum[row] = ss; else ssum[row] += ss; } } });
        }
        for (int r = wid; r < 128; r += NWAVE) {
            const u32x4 w = *(const u32x4*)(hbuf + (size_t)(row0 + r) * 1024 + 512 + lane * 8);
            float ss = bflo(w.x) * bflo(w.x) + bfhi(w.x) * bfhi(w.x) + bflo(w.y) * bflo(w.y) + bfhi(w.y) * bfhi(w.y) + bflo(w.z) * bflo(w.z) + bfhi(w.z) * bfhi(w.z) + bflo(w.w) * bflo(w.w) + bfhi(w.w) * bfhi(w.w);
            ss = wave_sum(ss);
            if (lane == 0) { const float ra = rsqrtf(ss * (1.0f / 512.0f) + EPS), rs = rsqrtf(ssum[r] * (1.0f / 512.0f) + EPS); rsat[r] = ra; ratio[r] = rs / ra; }
        }
        __threadfence_block(); __syncthreads();
        for (int rep_c = 0; rep_c < ((PROBE_REP & 128) ? 2 : 1); ++rep_c)
        for (int nc = 0; nc < 4; ++nc)
            gemm_128<2, 1, 8>(ARow{hbuf + (size_t)row0 * 1024, 1024}, (const bf16_t*)(ws + OFF_WOUTT) + (size_t)nc * 256 * 1024, 1024, 1024, lds, ratio, [&](const float* Ct) {
#pragma unroll 4
                for (int i = 0; i < 16; ++i) { const int row = wid + NWAVE * i, col = nc * 256 + lane * 4; const size_t o = (size_t)(row0 + row) * 1024 + col;
                    const f32x4 v = *(const f32x4*)(Ct + row * CSTR + lane * 4), xv = *(const f32x4*)(p.x + o), gm = *(const f32x4*)(mod + b * 6144 + 2048 + col); const float ra = rsat[row];
                    f32x4 r; r.x = xv.x + gm.x * v.x * ra; r.y = xv.y + gm.y * v.y * ra; r.z = xv.z + gm.z * v.z * ra; r.w = xv.w + gm.w * v.w * ra;
                    *(f32x4*)(p.out + o) = r;
                    const float ss = wave_sum(r.x * r.x + r.y * r.y + r.z * r.z + r.w * r.w);
                    if (lane == 0) { if (nc == 0) ss1[row] = ss; else ss1[row] += ss; } } });
        __threadfence_block(); __syncthreads();
        for (int rp3d = 0; rp3d < ((PROBE_REP & 4096) ? 2 : 1); ++rp3d) {
        for (int r = wid; r < 128; r += NWAVE) {
            const f32x4* xr = (const f32x4*)(p.out + (size_t)(row0 + r) * 1024); const float rs = rsqrtf(ss1[r] * (1.0f / 1024.0f) + EPS);
#pragma unroll
            for (int j = 0; j < 4; ++j) { const int col = 4 * (lane + 64 * j); const f32x4 v = xr[lane + 64 * j];
                const f32x4 g = *(const f32x4*)(p.norm_ffn + col), sc = *(const f32x4*)(mod + b * 6144 + 4096 + col), sh = *(const f32x4*)(mod + b * 6144 + 3072 + col);
                u32x2 o; o.x = pk2(v.x * rs * g.x * (1.f + sc.x) + sh.x, v.y * rs * g.y * (1.f + sc.y) + sh.y); o.y = pk2(v.z * rs * g.z * (1.f + sc.z) + sh.z, v.w * rs * g.w * (1.f + sc.w) + sh.w);
                *(u32x2*)(hbuf + (size_t)(row0 + r) * 1024 + col) = o; }
        }
        __threadfence_block(); __syncthreads();
        }
        for (int rep_e = 0; rep_e < ((PROBE_REP & 32) ? 2 : 1); ++rep_e) {
        float* Sx = (float*)(lds + S_OFF); float* Ls = (float*)(lds + L_OFF);
        for (int h = 0; h < 8; ++h) {
            gemm_128<2, 0, 0>(ARow{hbuf + (size_t)row0 * 1024, 1024}, (const bf16_t*)(ws + OFF_WQT) + (size_t)h * 256 * 1024, 1024, 1024, lds, nullptr, [&](int row, int col, float v) {
                *(bf16_t*)(lds + row * QP_STR + col * 2) = (bf16_t)f2bf(v); });
            __syncthreads();
            for (int ph = 0; ph < 2; ++ph) {
                f32x16 a0, a1;
#pragma unroll
                for (int r = 0; r < 16; ++r) { a0[r] = 0.f; a1[r] = 0.f; }
                const bf16_t* sk = (const bf16_t*)(ws + OFF_SUBK) + ((size_t)ph * 128 + wn * 32 + r32) * 128 + hi * 8;
                const unsigned char* qa = lds + (wm * 64 + r32) * QP_STR + (ph * 128 + hi * 8) * 2;
#pragma unroll
                for (int ks = 0; ks < 8; ++ks) {
                    const bf16x8 bfr = *(const bf16x8*)(sk + ks * 16);
                    const bf16x8 f0 = *(const bf16x8*)(qa + ks * 32), f1 = *(const bf16x8*)(qa + 32 * QP_STR + ks * 32);
                    a0 = __builtin_amdgcn_mfma_f32_32x32x16_bf16(f0, bfr, a0, 0, 0, 0);
                    a1 = __builtin_amdgcn_mfma_f32_32x32x16_bf16(f1, bfr, a1, 0, 0, 0);
                }
#pragma unroll
                for (int r = 0; r < 16; ++r) { Sx[(wm * 64 + crow(r, hi)) * S_STR + wn * 32 + r32] = a0[r]; Sx[(wm * 64 + 32 + crow(r, hi)) * S_STR + wn * 32 + r32] = a1[r]; }
                __syncthreads();
                {
                    const int row = tid >> 2, qd = tid & 3; float top[16];
#pragma unroll
                    for (int c2 = 0; c2 < 2; ++c2) { float c[16];
#pragma unroll
                        for (int q = 0; q < 4; ++q) { const int kb = qd * 32 + c2 * 16 + 4 * q; const f32x4 t4 = *(const f32x4*)(Sx + row * S_STR + kb);
                            c[4 * q] = __uint_as_float((__float_as_uint(t4.x) & 0xFFFFFF80u) | (unsigned)(127 - kb));
                            c[4 * q + 1] = __uint_as_float((__float_as_uint(t4.y) & 0xFFFFFF80u) | (unsigned)(126 - kb));
                            c[4 * q + 2] = __uint_as_float((__float_as_uint(t4.z) & 0xFFFFFF80u) | (unsigned)(125 - kb));
                            c[4 * q + 3] = __uint_as_float((__float_as_uint(t4.w) & 0xFFFFFF80u) | (unsigned)(124 - kb)); }
                        sort16_desc(c);
                        if (c2 == 0) {
#pragma unroll
                            for (int k = 0; k < 16; ++k) top[k] = c[k];
                        } else merge16(top, c); }
                    { float o[16];
#pragma unroll
                      for (int k = 0; k < 16; ++k) o[k] = __int_as_float(__builtin_amdgcn_update_dpp(0, __float_as_int(top[k]), 0xB1, 0xF, 0xF, false));
                      merge16(top, o);
#pragma unroll
                      for (int k = 0; k < 16; ++k) o[k] = __int_as_float(__builtin_amdgcn_update_dpp(0, __float_as_int(top[k]), 0x4E, 0xF, 0xF, false));
                      merge16(top, o); }
                    if (qd == 0) {
#pragma unroll
                        for (int q = 0; q < 4; ++q) *(f32x4*)(Ls + (ph * 128 + row) * 16 + 4 * q) = (f32x4){top[4 * q], top[4 * q + 1], top[4 * q + 2], top[4 * q + 3]}; }
                }
                __syncthreads();
            }
            if (wid < 2) {
                const int row = wid * 64 + lane; float a1[16], a2[16], top[16];
#pragma unroll
                for (int k = 0; k < 16; ++k) { a1[k] = __uint_as_float(__float_as_uint(Ls[row * 16 + k]) & 0xFFFFFF80u); a2[k] = __uint_as_float(__float_as_uint(Ls[(128 + row) * 16 + k]) & 0xFFFFFF80u); }
    { float c[16];
      c[0] = mkc(a1[0], a2[0], 255u);
      c[1] = mkc(a1[0], a2[1], 254u);
      c[2] = mkc(a1[0], a2[2], 253u);
      c[3] = mkc(a1[0], a2[3], 252u);
      c[4] = mkc(a1[0], a2[4], 251u);
      c[5] = mkc(a1[0], a2[5], 250u);
      c[6] = mkc(a1[0], a2[6], 249u);
      c[7] = mkc(a1[0], a2[7], 248u);
      c[8] = mkc(a1[0], a2[8], 247u);
      c[9] = mkc(a1[0], a2[9], 246u);
      c[10] = mkc(a1[0], a2[10], 245u);
      c[11] = mkc(a1[0], a2[11], 244u);
      c[12] = mkc(a1[0], a2[12], 243u);
      c[13] = mkc(a1[0], a2[13], 242u);
      c[14] = mkc(a1[0], a2[14], 241u);
      c[15] = mkc(a1[0], a2[15], 240u);
      sort16_desc(c); _Pragma("unroll") for (int k = 0; k < 16; ++k) top[k] = c[k];
    }
    { float c[16];
      c[0] = mkc(a1[1], a2[0], 239u);
      c[1] = mkc(a1[1], a2[1], 238u);
      c[2] = mkc(a1[1], a2[2], 237u);
      c[3] = mkc(a1[1], a2[3], 236u);
      c[4] = mkc(a1[1], a2[4], 235u);
      c[5] = mkc(a1[1], a2[5], 234u);
      c[6] = mkc(a1[1], a2[6], 233u);
      c[7] = mkc(a1[1], a2[7], 232u);
      c[8] = mkc(a1[2], a2[0], 223u);
      c[9] = mkc(a1[2], a2[1], 222u);
      c[10] = mkc(a1[2], a2[2], 221u);
      c[11] = mkc(a1[2], a2[3], 220u);
      c[12] = mkc(a1[2], a2[4], 219u);
      c[13] = mkc(a1[3], a2[0], 207u);
      c[14] = mkc(a1[3], a2[1], 206u);
      c[15] = mkc(a1[3], a2[2], 205u);
      sort16_desc(c); merge16(top, c);
    }
    { float c[16];
      c[0] = mkc(a1[3], a2[3], 204u);
      c[1] = mkc(a1[4], a2[0], 191u);
      c[2] = mkc(a1[4], a2[1], 190u);
      c[3] = mkc(a1[4], a2[2], 189u);
      c[4] = mkc(a1[5], a2[0], 175u);
      c[5] = mkc(a1[5], a2[1], 174u);
      c[6] = mkc(a1[6], a2[0], 159u);
      c[7] = mkc(a1[6], a2[1], 158u);
      c[8] = mkc(a1[7], a2[0], 143u);
      c[9] = mkc(a1[7], a2[1], 142u);
      c[10] = mkc(a1[8], a2[0], 127u);
      c[11] = mkc(a1[9], a2[0], 111u);
      c[12] = mkc(a1[10], a2[0], 95u);
      c[13] = mkc(a1[11], a2[0], 79u);
      c[14] = mkc(a1[12], a2[0], 63u);
      c[15] = mkc(a1[13], a2[0], 47u);
      sort16_desc(c); merge16(top, c);
    }
    { float c[16];
      c[0] = mkc(a1[14], a2[0], 31u);
      c[1] = mkc(a1[15], a2[0], 15u);
      c[2] = -3.0e38f;
      c[3] = -3.0e38f;
      c[4] = -3.0e38f;
      c[5] = -3.0e38f;
      c[6] = -3.0e38f;
      c[7] = -3.0e38f;
      c[8] = -3.0e38f;
      c[9] = -3.0e38f;
      c[10] = -3.0e38f;
      c[11] = -3.0e38f;
      c[12] = -3.0e38f;
      c[13] = -3.0e38f;
      c[14] = -3.0e38f;
      c[15] = -3.0e38f;
      sort16_desc(c); merge16(top, c);
    }
                float e[16], es = 0.f; const float m0 = __uint_as_float(__float_as_uint(top[0]) & 0xFFFFFF00u);
#pragma unroll
                for (int k = 0; k < 16; ++k) { e[k] = __expf(__uint_as_float(__float_as_uint(top[k]) & 0xFFFFFF00u) - m0); es += e[k]; }
                const float inv = 1.0f / es; const size_t ob = (size_t)(row0 + row) * 128 + h * 16;
#pragma unroll
                for (int k = 0; k < 16; ++k) { const unsigned code = 255u - (__float_as_uint(top[k]) & 0xFFu); const int i = code >> 4, j = code & 15;
                    const int i1 = 127 - (int)(__float_as_uint(Ls[row * 16 + i]) & 0x7Fu), i2 = 127 - (int)(__float_as_uint(Ls[(128 + row) * 16 + j]) & 0x7Fu);
                    idxb[ob + k] = i1 * 128 + i2; gb[ob + k] = e[k] * inv; }
            }
            __syncthreads();
        }
        }
        __syncthreads();
    }
}

constexpr int P4_LIST = 192;
struct TokState { f32x2 acc[8]; int offv; float sh; };

struct Rows4 { u32x4 r[4]; };
__device__ __forceinline__ void rows_load(Rows4& B, const unsigned char* __restrict__ Etab, const int* sidp, int lane) {
    const u32x4 ids = *(const u32x4*)sidp;
    const int e0 = __builtin_amdgcn_readfirstlane((int)ids.x), e1 = __builtin_amdgcn_readfirstlane((int)ids.y), e2 = __builtin_amdgcn_readfirstlane((int)ids.z), e3 = __builtin_amdgcn_readfirstlane((int)ids.w);
    B.r[0] = *(const u32x4*)(Etab + (size_t)e0 * 1024 + lane * 16); B.r[1] = *(const u32x4*)(Etab + (size_t)e1 * 1024 + lane * 16);
    B.r[2] = *(const u32x4*)(Etab + (size_t)e2 * 1024 + lane * 16); B.r[3] = *(const u32x4*)(Etab + (size_t)e3 * 1024 + lane * 16);
}
__device__ __forceinline__ int dpp_addi(int t, const int ctrl_sel) {
    if (ctrl_sel == 0) return t + __builtin_amdgcn_update_dpp(0, t, 0xB1, 0xF, 0xF, false);
    if (ctrl_sel == 1) return t + __builtin_amdgcn_update_dpp(0, t, 0x4E, 0xF, 0xF, false);
    if (ctrl_sel == 2) return t + __builtin_amdgcn_update_dpp(0, t, 0x141, 0xF, 0xF, false);
    return t + __builtin_amdgcn_update_dpp(0, t, 0x140, 0xF, 0xF, false);
}
__device__ __forceinline__ void g_compute2(const Rows4& D, const Rows4& U, const u32x4 hq, TokState& T, float sdl, float gwl) {
    int s[4];
#pragma unroll
    for (int j = 0; j < 4; ++j) { int a = 0;
#pragma unroll
        for (int q = 0; q < 4; ++q) a = __builtin_amdgcn_sdot4((int)D.r[j][q], (int)hq[q], a, false);
        s[j] = a; }
    auto r0 = __builtin_amdgcn_permlane32_swap((unsigned)s[0], (unsigned)s[1], false, false);
    auto r1 = __builtin_amdgcn_permlane32_swap((unsigned)s[2], (unsigned)s[3], false, false);
    const int r01 = (int)r0[0] + (int)r0[1], r23 = (int)r1[0] + (int)r1[1];
    auto r2 = __builtin_amdgcn_permlane16_swap((unsigned)r01, (unsigned)r23, false, false);
    int ti = (int)r2[0] + (int)r2[1];
    ti = dpp_addi(ti, 0); ti = dpp_addi(ti, 1); ti = dpp_addi(ti, 2); ti = dpp_addi(ti, 3);
    const float t = (float)ti * T.sh;
    const float w = gwl * gelu_tanh(sdl * t);
    float wj[4];
    wj[0] = __int_as_float(__builtin_amdgcn_readlane(__float_as_int(w), 0)); wj[1] = __int_as_float(__builtin_amdgcn_readlane(__float_as_int(w), 32));
    wj[2] = __int_as_float(__builtin_amdgcn_readlane(__float_as_int(w), 16)); wj[3] = __int_as_float(__builtin_amdgcn_readlane(__float_as_int(w), 48));
#pragma unroll
    for (int j = 0; j < 4; ++j) { const f32x2 ws = {wj[j], wj[j]};
#pragma unroll
        for (int q = 0; q < 4; ++q) { const int w2 = (int)U.r[j][q]; const f32x2 lo = __builtin_amdgcn_cvt_pk_f32_fp8(w2, false), hi = __builtin_amdgcn_cvt_pk_f32_fp8(w2, true);
            T.acc[2 * q] = __builtin_elementwise_fma(lo, ws, T.acc[2 * q]); T.acc[2 * q + 1] = __builtin_elementwise_fma(hi, ws, T.acc[2 * q + 1]); }
        __builtin_amdgcn_sched_barrier(0); }
}

template <int FAKE> __device__ void phase4(const Params& p, unsigned char* lds) {
    const int tid = threadIdx.x, lane = tid & 63, wid = __builtin_amdgcn_readfirstlane(tid >> 6);
    unsigned char* ws = p.ws;
    const bf16_t* hbuf = (const bf16_t*)(ws + OFF_HBUF); const int* idxb = (const int*)(ws + OFF_IDX); const float* gb = (const float*)(ws + OFF_G);
    const unsigned char* Ed = ws + OFF_E8; const unsigned char* Eu = ws + OFF_E8 + (size_t)16384 * 1024; const float* esc = (const float*)(ws + OFF_ESC);
    int* sid = (int*)(lds + wid * (3 * 4 * P4_LIST * 4)); float* sgw = (float*)(sid + 4 * P4_LIST); float* ssd = sgw + 4 * P4_LIST;
    unsigned char* hql = lds + 8 * (3 * 4 * P4_LIST * 4) + wid * 4096;
    const int jl = ((lane >> 4) & 1) * 2 + (lane >> 5);
    for (int tile = blockIdx.x; tile < 256; tile += gridDim.x) {
        const int row0 = tile * 128, b = row0 >> 11;
        const float* gf = (const float*)(ws + OFF_MODT) + (size_t)tile * 6144 + 5120 + lane * 16;
#pragma unroll 1
        for (int st = 0; st < 4; ++st) {
            const int tokb = row0 + st * 32 + wid * 4;
            TokState T0, T1, T2, T3;
#define P4_PRO(T, j) { const size_t tok = tokb + (j); \
                int id0 = idxb[tok * 128 + lane], id1 = idxb[tok * 128 + 64 + lane]; if (FAKE) { id0 = (id0 & ~1023) | (id0 & 31); id1 = (id1 & ~1023) | (id1 & 31); } \
                const float sd0 = esc[id0], sd1 = esc[id1], gw0 = gb[tok * 128 + lane] * esc[16384 + id0], gw1 = gb[tok * 128 + 64 + lane] * esc[16384 + id1]; \
                _Pragma("unroll") for (int i = 0; i < 8; ++i) T.acc[i] = (f32x2){0.f, 0.f}; \
                { const u32x4 w0 = *(const u32x4*)(hbuf + tok * 1024 + lane * 16), w1 = *(const u32x4*)(hbuf + tok * 1024 + lane * 16 + 8); \
                  float hv[16] = {bflo(w0.x), bfhi(w0.x), bflo(w0.y), bfhi(w0.y), bflo(w0.z), bfhi(w0.z), bflo(w0.w), bfhi(w0.w), bflo(w1.x), bfhi(w1.x), bflo(w1.y), bfhi(w1.y), bflo(w1.z), bfhi(w1.z), bflo(w1.w), bfhi(w1.w)}; \
                  float am = 0.f; _Pragma("unroll") for (int i = 0; i < 16; ++i) am = fmaxf(am, fabsf(hv[i])); \
                  _Pragma("unroll") for (int o = 1; o < 64; o <<= 1) am = fmaxf(am, __shfl_xor(am, o)); \
                  const float sc = (am > 0.f) ? am * (1.0f / 127.0f) : 1.0f, inv = 1.0f / sc; T.sh = sc; u32x4 hq; \
                  _Pragma("unroll") for (int q = 0; q < 4; ++q) { const int b0 = (int)rintf(hv[4 * q] * inv), b1 = (int)rintf(hv[4 * q + 1] * inv), b2 = (int)rintf(hv[4 * q + 2] * inv), b3 = (int)rintf(hv[4 * q + 3] * inv); \
                      hq[q] = (unsigned)(b0 & 0xFF) | ((unsigned)(b1 & 0xFF) << 8) | ((unsigned)(b2 & 0xFF) << 16) | ((unsigned)(b3 & 0xFF) << 24); } \
                  *(u32x4*)(hql + (j) * 1024 + lane * 16) = hq; } \
                const int sl0 = id0 >> 10, sl1 = id1 >> 10; int po = 0, offv = 0, pos0 = 0, pos1 = 0; \
                _Pragma("unroll 1") for (int s = 0; s < 16; ++s) { \
                    const unsigned long long m0 = __ballot(sl0 == s), m1 = __ballot(sl1 == s); const int c0 = __popcll(m0), c = c0 + __popcll(m1); \
                    if (lane == s) offv = (po + 3) & ~3; \
                    if (sl0 == s) pos0 = po + (int)__builtin_amdgcn_mbcnt_hi((unsigned)(m0 >> 32), __builtin_amdgcn_mbcnt_lo((unsigned)m0, 0u)); \
                    if (sl1 == s) pos1 = po + c0 + (int)__builtin_amdgcn_mbcnt_hi((unsigned)(m1 >> 32), __builtin_amdgcn_mbcnt_lo((unsigned)m1, 0u)); \
                    po += c; } \
                if (lane == 16) offv = 128; T.offv = offv; \
                sid[(j) * P4_LIST + pos0] = id0; sgw[(j) * P4_LIST + pos0] = gw0; ssd[(j) * P4_LIST + pos0] = sd0; \
                sid[(j) * P4_LIST + pos1] = id1; sgw[(j) * P4_LIST + pos1] = gw1; ssd[(j) * P4_LIST + pos1] = sd1; }
            P4_PRO(T0, 0) P4_PRO(T1, 1) P4_PRO(T2, 2) P4_PRO(T3, 3)
#undef P4_PRO
            asm volatile("s_waitcnt lgkmcnt(0)" ::: "memory");
#define P4_ITEM(T, j) { const int st_ = __builtin_amdgcn_readlane(T.offv, s), en_ = __builtin_amdgcn_readlane(T.offv, s + 1); \
                if (st_ < en_) { const u32x4 hq = *(const u32x4*)(hql + (j) * 1024 + lane * 16); \
                    _Pragma("unroll 1") for (int i = st_; i < en_; i += 4) { Rows4 D, U; rows_load(D, Ed, sid + (j) * P4_LIST + i, lane); rows_load(U, Eu, sid + (j) * P4_LIST + i, lane); \
                        g_compute2(D, U, hq, T, ssd[(j) * P4_LIST + i + jl], sgw[(j) * P4_LIST + i + jl]); } } }
#pragma unroll 1
            for (int s = 0; s < 16; ++s) { P4_ITEM(T0, 0) P4_ITEM(T1, 1) P4_ITEM(T2, 2) P4_ITEM(T3, 3) }
#undef P4_ITEM
#define P4_EPI(T, j) { float* orow = p.out + (size_t)(tokb + (j)) * 1024 + lane * 16; \
                _Pragma("unroll") for (int q = 0; q < 4; ++q) { f32x4 o = *(const f32x4*)(orow + 4 * q); const f32x4 gg = *(const f32x4*)(gf + 4 * q); \
                    o.x += gg.x * T.acc[2 * q].x; o.y += gg.y * T.acc[2 * q].y; o.z += gg.z * T.acc[2 * q + 1].x; o.w += gg.w * T.acc[2 * q + 1].y; if (FAKE) asm volatile("" :: "v"(o.x), "v"(o.y), "v"(o.z), "v"(o.w)); else *(f32x4*)(orow + 4 * q) = o; } }
            P4_EPI(T0, 0) P4_EPI(T1, 1) P4_EPI(T2, 2) P4_EPI(T3, 3)
#undef P4_EPI
        }
    }
}

#define LAS __attribute__((address_space(3)))
#define XB_TMO      128
#define XB_XCNT(j)  (256  + 64 * (j))
#define XB_XSUB(j)  (1280 + 64 * (j))
#define XB_XGEN(j)  (2304 + 64 * (j))
#define XB_TOP      3328
#define XB_TOPGEN   3392
#define XCD_BAR_WORDS 3456
#define XB_SPIN_CAP (1u << 18)

__device__ __forceinline__ unsigned xb_ld(unsigned* p)              { return __hip_atomic_load(p, __ATOMIC_RELAXED, __HIP_MEMORY_SCOPE_AGENT); }
__device__ __forceinline__ unsigned xb_add(unsigned* p, unsigned v) { return __hip_atomic_fetch_add(p, v, __ATOMIC_RELAXED, __HIP_MEMORY_SCOPE_AGENT); }
__device__ __forceinline__ unsigned xb_xcc_id() { return (unsigned)__builtin_amdgcn_s_getreg((3 << 11) | 20) & 0xFu; }
#define XB_SPIN(cond, bar) do { unsigned _sp = 0; while (cond) { __builtin_amdgcn_s_sleep(1); \
    if ((++_sp & 255u) == 0u) { if (xb_ld(&(bar)[XB_TMO])) break; if (_sp > XB_SPIN_CAP) { atomicAdd(&(bar)[XB_TMO], 1u); break; } } } } while (0)

struct XcdBarrier {
    unsigned* bar; unsigned x;
    volatile LAS unsigned* st;
};

__device__ __forceinline__ XcdBarrier xcd_barrier_post(unsigned* bar, volatile LAS unsigned* st) {
    XcdBarrier b; b.bar = bar; b.x = xb_xcc_id(); b.st = st;
    if (threadIdx.x == 0) (void)xb_add(&bar[XB_XCNT(b.x)], 1u);
    return b;
}
__device__ __forceinline__ void xcd_barrier_complete(unsigned* bar, unsigned x, unsigned& nloc, unsigned& nx) {
    const unsigned G = gridDim.x * gridDim.y * gridDim.z;
    unsigned sum, cnt, mine, sp = 0u;
    for (;;) {
        sum = 0u; cnt = 0u; mine = 0u;
#pragma unroll
        for (unsigned j = 0; j < 16; ++j) { const unsigned c = xb_ld(&bar[XB_XCNT(j)]); sum += c; cnt += (c > 0u) ? 1u : 0u; mine = (j == x) ? c : mine; }
        if (sum == G) break;
        __builtin_amdgcn_s_sleep(1);
        if ((++sp & 255u) == 0u) { if (xb_ld(&bar[XB_TMO])) break; if (sp > XB_SPIN_CAP) { atomicAdd(&bar[XB_TMO], 1u); break; } }
    }
    nloc = mine > 0u ? mine : 1u; nx = cnt > 0u ? cnt : 1u;
}

__device__ __forceinline__ void xcd_barrier(const XcdBarrier& b) {
    asm volatile("s_waitcnt vmcnt(0)" ::: "memory");
    __syncthreads();
    if (threadIdx.x == 0) {
        unsigned* bar = b.bar;
        __builtin_amdgcn_s_waitcnt(0);
        unsigned nloc = b.st[0], nx = b.st[1];
        if (nloc == 0u) { xcd_barrier_complete(bar, b.x, nloc, nx); b.st[0] = nloc; b.st[1] = nx; }
        const unsigned old = xb_add(&bar[XB_XSUB(b.x)], 1u);
        const unsigned gen = old / nloc;
        if (old + 1u == (gen + 1u) * nloc) {
            __builtin_amdgcn_fence(__ATOMIC_RELEASE, "agent");
            asm volatile("s_waitcnt vmcnt(0)" ::: "memory");
            const unsigned og = xb_add(&bar[XB_TOP], 1u);
            const unsigned tg = og / nx;
            if (og + 1u == (tg + 1u) * nx) xb_add(&bar[XB_TOPGEN], 1u);
            else XB_SPIN(xb_ld(&bar[XB_TOPGEN]) == tg, bar);
            __builtin_amdgcn_fence(__ATOMIC_ACQUIRE, "agent");
            xb_add(&bar[XB_XGEN(b.x)], 1u);
            asm volatile("s_waitcnt vmcnt(0)" ::: "memory");
        } else {
            XB_SPIN(xb_ld(&bar[XB_XGEN(b.x)]) == gen, bar);
            __builtin_amdgcn_fence(__ATOMIC_ACQUIRE, "agent");
            asm volatile("s_waitcnt vmcnt(0)" ::: "memory");
        }
    }
    __syncthreads();
}

__global__ void __launch_bounds__(NTHR, 2) fwd_kernel(Params p) {
    extern __shared__ __attribute__((aligned(16))) unsigned char lds[];
#if MK_COOP
    volatile LAS unsigned* bst = (volatile LAS unsigned*)(lds + LDS_BYTES - 16);
    if (threadIdx.x < 2) bst[threadIdx.x] = 0u;
    __syncthreads();
    const XcdBarrier xbar = xcd_barrier_post((unsigned*)(p.ws + OFF_BAR), bst);
#endif
    if (p.ph_lo <= 0 && 0 < p.ph_hi) { phase0(p, lds); if (PROBE_REP & 1) { __syncthreads(); phase0(p, lds); } }
#if MK_COOP
    if (p.ph_lo <= 0 && 1 < p.ph_hi) cg::this_grid().sync();
#endif
    if (p.ph_lo <= 1 && 1 < p.ph_hi) { phase1(p, lds); if (PROBE_REP & 2) { __syncthreads(); phase1(p, lds); } }
#if MK_COOP
    if (p.ph_lo <= 1 && 2 < p.ph_hi) xcd_barrier(xbar);
#endif
    if (p.ph_lo <= 2 && 2 < p.ph_hi) { phase2(p, lds); if (PROBE_REP & 4) { __syncthreads(); phase2(p, lds); } }
#if MK_COOP
    if (p.ph_lo <= 2 && 3 < p.ph_hi) xcd_barrier(xbar);
#endif
    if (p.ph_lo <= 3 && 3 < p.ph_hi) phase3(p, lds);
#if MK_COOP
    if (p.ph_lo <= 3 && 4 < p.ph_hi) xcd_barrier(xbar);
#endif
    if (p.ph_lo <= 4 && 4 < p.ph_hi) { if (PROBE_REP & 2048) { phase4<1>(p, lds); __syncthreads(); } phase4<0>(p, lds); }
}

extern "C" void kernel_launch(void* const* d_in, const int* in_sizes, int n_in, void* d_out, int out_size, void* d_ws, size_t ws_size, hipStream_t stream) {
    static int grid = 0;
    if (grid == 0) {
        if (n_in != 31 || ws_size < WS_NEED) { fprintf(stderr, "kernel_launch: bad inputs (n_in %d, ws %zu < %zu)\n", n_in, ws_size, (size_t)WS_NEED); grid = -1; return; }
        int dev = 0, cus = 0, per_cu = 0;
        hipGetDevice(&dev); hipDeviceGetAttribute(&cus, hipDeviceAttributeMultiprocessorCount, dev);
        if (hipFuncSetAttribute((const void*)fwd_kernel, hipFuncAttributeMaxDynamicSharedMemorySize, LDS_BYTES) != hipSuccess) { fprintf(stderr, "kernel_launch: hipFuncSetAttribute failed\n"); grid = -1; return; }
        hipOccupancyMaxActiveBlocksPerMultiprocessor(&per_cu, (const void*)fwd_kernel, NTHR, LDS_BYTES);
        if (per_cu < 1) { fprintf(stderr, "kernel_launch: occupancy query says %d blocks/CU\n", per_cu); per_cu = 1; }
        grid = cus;
        (void)hipGetLastError();
    }
    if (grid < 0) return;
    (void)hipMemsetAsync((char*)d_ws + OFF_BAR, 0, 16384, stream);
    Params p{};
    const float** f = (const float**)&p;
    for (int i = 0; i < 31; ++i) f[i] = (const float*)d_in[i];
    p.out = (float*)d_out; p.ws = (unsigned char*)d_ws;
#if MK_COOP
    p.ph_lo = 0; p.ph_hi = 5;
    void* args[] = {&p};
    hipError_t e = hipLaunchCooperativeKernel((const void*)fwd_kernel, dim3(grid), dim3(NTHR), args, LDS_BYTES, stream);
    if (e != hipSuccess) fprintf(stderr, "cooperative launch failed: %s (grid %d)\n", hipGetErrorString(e), grid);
#else
    for (int ph = 0; ph < 5; ++ph) { p.ph_lo = ph; p.ph_hi = ph + 1; hipLaunchKernelGGL(fwd_kernel, dim3(grid), dim3(NTHR), LDS_BYTES, stream, p); }
#endif
}
```

```cpp
#include <hip/hip_runtime.h>
#include <hip/hip_cooperative_groups.h>
#include <cstdio>
#include <cstdint>
namespace cg = cooperative_groups;

#ifndef PROBE_REP
#define PROBE_REP 0
#endif
#ifndef MK_COOP
#define MK_COOP 1
#endif

typedef unsigned short bf16_t;
typedef short bf16x8 __attribute__((ext_vector_type(8)));
typedef short s16x4 __attribute__((ext_vector_type(4)));
typedef float f32x16 __attribute__((ext_vector_type(16)));
typedef float f32x4 __attribute__((ext_vector_type(4)));
typedef float f32x2 __attribute__((ext_vector_type(2)));
typedef unsigned u32x4 __attribute__((ext_vector_type(4)));
typedef unsigned u32x2 __attribute__((ext_vector_type(2)));

constexpr int NTHR = 512, NWAVE = 8;
constexpr int T_TOK = 32768, DM = 1024, NB = 16, SEQ = 2048;
constexpr int LDS_BYTES = 163840;
constexpr float EPS = 1e-6f;
constexpr float QSCALE = 0.10206207261596575f * 1.4426950408889634f;

constexpr size_t OFF_PART  = 0;
constexpr size_t OFF_MODT  = 8u << 20;
constexpr size_t OFF_WINT  = 16u << 20;
constexpr size_t OFF_WGLUT = OFF_WINT + (2u << 20);
constexpr size_t OFF_WUQT  = OFF_WGLUT + (512u << 10);
constexpr size_t OFF_WUKVT = OFF_WUQT + 524288;
constexpr size_t OFF_WOUTT = OFF_WUKVT + 262144;
constexpr size_t OFF_WQT   = OFF_WOUTT + (2u << 20);
constexpr size_t OFF_SUBK  = OFF_WQT + (4u << 20);
constexpr size_t OFF_KMT   = OFF_SUBK + 65536;
constexpr size_t OFF_WZT   = OFF_KMT + 20971520;
constexpr size_t OFF_AL    = OFF_WZT + 4194304;
constexpr size_t OFF_HBUF  = OFF_AL + 16384;
constexpr size_t OFF_PROJ2 = OFF_HBUF + (64u << 20);
constexpr size_t OFF_UBUF  = OFF_PROJ2 + (32u << 20);
constexpr size_t OFF_Q     = OFF_UBUF + 41943040;
constexpr size_t OFF_K     = OFF_Q + 50331648;
constexpr size_t OFF_VT    = OFF_K + 50331648;
constexpr size_t OFF_YBUF  = OFF_VT + 33554432;
constexpr size_t OFF_IDX   = OFF_YBUF + (32u << 20);
constexpr size_t OFF_G     = OFF_IDX + (16u << 20);
constexpr size_t OFF_E8    = OFF_G + (16u << 20);
constexpr size_t OFF_ESC   = OFF_E8 + (32u << 20);
constexpr size_t OFF_BAR   = OFF_ESC + (1u << 20);
constexpr size_t WS_NEED   = OFF_BAR + (1u << 20);

struct Params {
    const float* x; const float* c; const int* pos; const float* w_ada; const float* b_ada; const float* norm_mix; const float* norm_ffn; const float* w_in;
    const float* lam_re; const float* lam_im; const float* log_dt; const float* b_re; const float* b_im; const float* c_re; const float* c_im; const float* d_skip;
    const float* w_glu; const float* b_glu; const float* q_a_norm; const float* w_uq; const float* kv_a_norm; const float* w_ukv; const float* q_norm; const float* k_norm;
    const float* out_norm_ssm; const float* out_norm_attn; const float* w_out; const float* w_query; const float* sub_keys; const float* e_down; const float* e_up;
    float* out; unsigned char* ws; int ph_lo, ph_hi;
};

__device__ __forceinline__ unsigned f2bf(float f) { unsigned u = __float_as_uint(f); return (u + 0x7fffu + ((u >> 16) & 1u)) >> 16; }
__device__ __forceinline__ unsigned pk2(float lo, float hi) { return f2bf(lo) | (f2bf(hi) << 16); }
__device__ __forceinline__ float bf2f(unsigned short b) { return __uint_as_float(((unsigned)b) << 16); }
__device__ __forceinline__ float bflo(unsigned w) { return __uint_as_float(w << 16); }
__device__ __forceinline__ float bfhi(unsigned w) { return __uint_as_float(w & 0xffff0000u); }
__device__ __forceinline__ int opq_s(int x) { asm volatile("" : "+s"(x)); return x; }
__device__ __forceinline__ int opq_v(int x) { asm volatile("" : "+v"(x)); return x; }
template <class T> __device__ __forceinline__ T* opq_p(T* x) { asm volatile("" : "+s"(x)); return x; }
__device__ __forceinline__ int crow(int r, int hi) { return (r & 3) + 8 * (r >> 2) + 4 * hi; }
__device__ __forceinline__ float wave_sum(float v) {
#pragma unroll
    for (int o = 1; o < 64; o <<= 1) v += __shfl_xor(v, o);
    return v;
}
__device__ __forceinline__ float gelu_tanh(float x) {
    const float u = 0.7978845608028654f * (x + 0.044715f * x * x * x);
    const float t = 1.0f - 2.0f * __builtin_amdgcn_rcpf(1.0f + __expf(2.0f * u));
    return 0.5f * x * (1.0f + t);
}
__device__ __forceinline__ float sigmoidf_(float z) { return __builtin_amdgcn_rcpf(1.0f + __expf(-z)); }

constexpr int G_STR = 144;
constexpr int G_ABYTES = 128 * G_STR;
template <int NT> struct GemmCfg { static constexpr int BN = 128 * NT, BBYTES = BN * G_STR, STAGE = G_ABYTES + BBYTES; };

struct ARow { const bf16_t* A; int lda; __device__ __forceinline__ const bf16_t* operator()(int row, int k) const { return A + (size_t)row * lda + k; } };
struct AGrp { const bf16_t* Y; __device__ __forceinline__ const bf16_t* operator()(int row, int k) const { return Y + ((size_t)(k >> 4) * T_TOK + row) * 16 + (k & 15); } };
constexpr int CSTR = 260;

#ifndef GEMM_GLDS
#define GEMM_GLDS 1
#endif
#ifndef GEMM16
#define GEMM16 0
#endif
#if GEMM16
template <int NT, int MODE, int MID, int NST, class AL, class Epi>
__device__ __forceinline__ void gemm_128(const AL aload, const bf16_t* __restrict__ Bt, int ldb, int K, unsigned char* lds, const float* midscale, Epi epi) {
    typedef GemmCfg<NT> C;
    const int tid = opq_v((int)threadIdx.x), lane = tid & 63, wid = __builtin_amdgcn_readfirstlane(tid >> 6), wm = wid >> 2, wn = wid & 3, fr = lane & 15, fq = lane >> 4;
    f32x4 acc[4][2 * NT];
#pragma unroll
    for (int i = 0; i < 4; ++i)
#pragma unroll
        for (int j = 0; j < 2 * NT; ++j) acc[i][j] = (f32x4){0.f, 0.f, 0.f, 0.f};
    const int prow = tid >> 3, pc = tid & 7;
    const bf16_t* gb = Bt + (size_t)prow * ldb + pc * 8;
    const int ldsoff = prow * G_STR + pc * 16;
    u32x4 ra[2], rb[2 * NT];
    const int nk = K >> 6;
#pragma unroll
    for (int q = 0; q < 2; ++q) ra[q] = *(const u32x4*)aload(prow + 64 * q, pc * 8);
#pragma unroll
    for (int q = 0; q < 2 * NT; ++q) rb[q] = *(const u32x4*)(gb + (size_t)(64 * q) * ldb);
#pragma unroll
    for (int q = 0; q < 2; ++q) *(u32x4*)(lds + ldsoff + q * 64 * G_STR) = ra[q];
#pragma unroll
    for (int q = 0; q < 2 * NT; ++q) *(u32x4*)(lds + G_ABYTES + ldsoff + q * 64 * G_STR) = rb[q];
    __syncthreads();
    for (int kt = 0; kt < nk; ++kt) {
        unsigned char* st = lds + (kt & 1) * C::STAGE;
        if (kt + 1 < nk) {
#pragma unroll
            for (int q = 0; q < 2; ++q) ra[q] = *(const u32x4*)aload(prow + 64 * q, (kt + 1) * 64 + pc * 8);
#pragma unroll
            for (int q = 0; q < 2 * NT; ++q) rb[q] = *(const u32x4*)(gb + (size_t)(64 * q) * ldb + (kt + 1) * 64);
        }
        if (MID > 0 && kt == MID) {
#pragma unroll
            for (int i = 0; i < 4; ++i)
#pragma unroll
                for (int r = 0; r < 4; ++r) { const float sc = midscale[wm * 64 + i * 16 + fq * 4 + r];
#pragma unroll
                    for (int j = 0; j < 2 * NT; ++j) acc[i][j][r] *= sc; }
        }
        const unsigned char* pa = st + (wm * 64 + fr) * G_STR + fq * 16;
        const unsigned char* pb = st + G_ABYTES + (wn * 32 * NT + fr) * G_STR + fq * 16;
#pragma unroll
        for (int ks = 0; ks < 2; ++ks) {
            bf16x8 af[4], bfr[2 * NT];
#pragma unroll
            for (int i = 0; i < 4; ++i) af[i] = *(const bf16x8*)(pa + i * 16 * G_STR + ks * 64);
#pragma unroll
            for (int j = 0; j < 2 * NT; ++j) bfr[j] = *(const bf16x8*)(pb + j * 16 * G_STR + ks * 64);
#pragma unroll
            for (int i = 0; i < 4; ++i)
#pragma unroll
                for (int j = 0; j < 2 * NT; ++j) acc[i][j] = __builtin_amdgcn_mfma_f32_16x16x32_bf16(af[i], bfr[j], acc[i][j], 0, 0, 0);
        }
        if (kt + 1 < nk) {
            unsigned char* sn = lds + ((kt + 1) & 1) * C::STAGE;
#pragma unroll
            for (int q = 0; q < 2; ++q) *(u32x4*)(sn + ldsoff + q * 64 * G_STR) = ra[q];
#pragma unroll
            for (int q = 0; q < 2 * NT; ++q) *(u32x4*)(sn + G_ABYTES + ldsoff + q * 64 * G_STR) = rb[q];
        }
        __syncthreads();
    }
    if constexpr (MODE == 0) {
#pragma unroll
        for (int i = 0; i < 4; ++i)
#pragma unroll
            for (int j = 0; j < 2 * NT; ++j)
#pragma unroll
                for (int r = 0; r < 4; ++r) epi(wm * 64 + i * 16 + fq * 4 + r, wn * 32 * NT + j * 16 + fr, acc[i][j][r]);
    } else {
        float* Ct = (float*)lds;
#pragma unroll
        for (int i = 0; i < 4; ++i)
#pragma unroll
            for (int j = 0; j < 2 * NT; ++j)
#pragma unroll
                for (int r = 0; r < 4; ++r) Ct[(wm * 64 + i * 16 + fq * 4 + r) * CSTR + wn * 32 * NT + j * 16 + fr] = acc[i][j][r];
        __syncthreads();
        epi((const float*)Ct);
        __syncthreads();
    }
}

#elif GEMM_GLDS
template <int NT, int MODE, int MID, int NST, class AL, class Epi>
__device__ __forceinline__ void gemm_128(const AL aload, const bf16_t* __restrict__ Bt, int ldb, int K, unsigned char* lds, const float* midscale, Epi epi) {
    typedef GemmCfg<NT> C;
    const int tid = opq_v((int)threadIdx.x), lane = tid & 63, wid = __builtin_amdgcn_readfirstlane(tid >> 6), wm = wid >> 2, wn = wid & 3, r32 = lane & 31, hi = lane >> 5;
    f32x16 acc[2][NT];
#pragma unroll
    for (int i = 0; i < 2; ++i)
#pragma unroll
        for (int j = 0; j < NT; ++j)
#pragma unroll
            for (int r = 0; r < 16; ++r) acc[i][j][r] = 0.f;
    typedef __attribute__((address_space(3))) unsigned char lds_uc;
    lds_uc* ldsl = (lds_uc*)lds;
    const int srow = wid * 8 + (lane >> 3), schunk = ((lane & 7) ^ ((srow >> 1) & 7)) * 8;
    const bf16_t* gb = Bt + (size_t)srow * ldb + schunk;
    const int nk = K >> 6;
    constexpr int SA = 128 * 128, SB = 128 * NT * 128, SSTAGE = SA + SB;
#define GL_STAGE(stg, kk) do { \
        _Pragma("unroll") for (int q = 0; q < 2; ++q) __builtin_amdgcn_global_load_lds((const unsigned*)aload(srow + 64 * q, (kk) * 64 + schunk), (__attribute__((address_space(3))) unsigned*)(ldsl + (stg) * SSTAGE + q * 8192 + wid * 1024), 16, 0, 0); \
        _Pragma("unroll") for (int q = 0; q < 2 * NT; ++q) __builtin_amdgcn_global_load_lds((const unsigned*)(gb + (size_t)(64 * q) * ldb + (kk) * 64), (__attribute__((address_space(3))) unsigned*)(ldsl + (stg) * SSTAGE + SA + q * 8192 + wid * 1024), 16, 0, 0); } while (0)
#define GL_WAITN() do { if constexpr (NT == 2) asm volatile("s_waitcnt vmcnt(6)" ::: "memory"); else asm volatile("s_waitcnt vmcnt(4)" ::: "memory"); } while (0)
#define GL_BAR() asm volatile("s_waitcnt lgkmcnt(0)\n\ts_barrier" ::: "memory")
    GL_STAGE(0, 0);
    if (NST == 3 && nk > 1) { GL_STAGE(1, 1); GL_WAITN(); } else asm volatile("s_waitcnt vmcnt(0)" ::: "memory");
    GL_BAR();
    const int swz = (r32 >> 1) & 7;
    int cofs[4];
#pragma unroll
    for (int ks = 0; ks < 4; ++ks) cofs[ks] = ((((ks << 1) | hi) ^ swz) << 4);
    for (int kt = 0; kt < nk; ++kt) {
        const unsigned char* st = lds + (kt % NST) * SSTAGE;
        if (kt + NST - 1 < nk) GL_STAGE((kt + NST - 1) % NST, kt + NST - 1);
        if (MID > 0 && kt == MID) {
#pragma unroll
            for (int i = 0; i < 2; ++i)
#pragma unroll
                for (int r = 0; r < 16; ++r) { const float sc = midscale[wm * 64 + i * 32 + crow(r, hi)];
#pragma unroll
                    for (int j = 0; j < NT; ++j) acc[i][j][r] *= sc; }
        }
        const unsigned char* pa = st + (wm * 64 + r32) * 128;
        const unsigned char* pb = st + SA + (wn * 32 * NT + r32) * 128;
#pragma unroll
        for (int ks = 0; ks < 4; ++ks) {
            bf16x8 af[2], bfr[NT];
#pragma unroll
            for (int i = 0; i < 2; ++i) af[i] = *(const bf16x8*)(pa + i * 32 * 128 + cofs[ks]);
#pragma unroll
            for (int j = 0; j < NT; ++j) bfr[j] = *(const bf16x8*)(pb + j * 32 * 128 + cofs[ks]);
#pragma unroll
            for (int i = 0; i < 2; ++i)
#pragma unroll
                for (int j = 0; j < NT; ++j) acc[i][j] = __builtin_amdgcn_mfma_f32_32x32x16_bf16(af[i], bfr[j], acc[i][j], 0, 0, 0);
        }
        if (NST == 3 && kt + 2 < nk) GL_WAITN(); else asm volatile("s_waitcnt vmcnt(0)" ::: "memory");
        GL_BAR();
    }
#undef GL_STAGE
#undef GL_WAITN
#undef GL_BAR
    if constexpr (MODE == 0) {
#pragma unroll
        for (int i = 0; i < 2; ++i)
#pragma unroll
            for (int j = 0; j < NT; ++j)
#pragma unroll
                for (int r = 0; r < 16; ++r) epi(wm * 64 + i * 32 + crow(r, hi), wn * 32 * NT + j * 32 + r32, acc[i][j][r]);
    } else {
        float* Ct = (float*)lds;
#pragma unroll
        for (int i = 0; i < 2; ++i)
#pragma unroll
            for (int j = 0; j < NT; ++j)
#pragma unroll
                for (int r = 0; r < 16; ++r) Ct[(wm * 64 + i * 32 + crow(r, hi)) * CSTR + wn * 32 * NT + j * 32 + r32] = acc[i][j][r];
        __syncthreads();
        epi((const float*)Ct);
        __syncthreads();
    }
}

#else
template <int NT, int MODE, int MID, int NST, class AL, class Epi>
__device__ __forceinline__ void gemm_128(const AL aload, const bf16_t* __restrict__ Bt, int ldb, int K, unsigned char* lds, const float* midscale, Epi epi) {
    typedef GemmCfg<NT> C;
    const int tid = opq_v((int)threadIdx.x), lane = tid & 63, wid = __builtin_amdgcn_readfirstlane(tid >> 6), wm = wid >> 2, wn = wid & 3, r32 = lane & 31, hi = lane >> 5;
    f32x16 acc[2][NT];
#pragma unroll
    for (int i = 0; i < 2; ++i)
#pragma unroll
        for (int j = 0; j < NT; ++j)
#pragma unroll
            for (int r = 0; r < 16; ++r) acc[i][j][r] = 0.f;
    const int prow = tid >> 3, pc = tid & 7;
    const bf16_t* gb = Bt + (size_t)prow * ldb + pc * 8;
    const int ldsoff = prow * G_STR + pc * 16;
    u32x4 ra[2], rb[2 * NT];
    const int nk = K >> 6;
#pragma unroll
    for (int q = 0; q < 2; ++q) ra[q] = *(const u32x4*)aload(prow + 64 * q, pc * 8);
#pragma unroll
    for (int q = 0; q < 2 * NT; ++q) rb[q] = *(const u32x4*)(gb + (size_t)(64 * q) * ldb);
#pragma unroll
    for (int q = 0; q < 2; ++q) *(u32x4*)(lds + ldsoff + q * 64 * G_STR) = ra[q];
#pragma unroll
    for (int q = 0; q < 2 * NT; ++q) *(u32x4*)(lds + G_ABYTES + ldsoff + q * 64 * G_STR) = rb[q];
    __syncthreads();
    for (int kt = 0; kt < nk; ++kt) {
        unsigned char* st = lds + (kt & 1) * C::STAGE;
        if (kt + 1 < nk) {
#pragma unroll
            for (int q = 0; q < 2; ++q) ra[q] = *(const u32x4*)aload(prow + 64 * q, (kt + 1) * 64 + pc * 8);
#pragma unroll
            for (int q = 0; q < 2 * NT; ++q) rb[q] = *(const u32x4*)(gb + (size_t)(64 * q) * ldb + (kt + 1) * 64);
        }
        if (MID > 0 && kt == MID) {
#pragma unroll
            for (int i = 0; i < 2; ++i)
#pragma unroll
                for (int r = 0; r < 16; ++r) { const float sc = midscale[wm * 64 + i * 32 + crow(r, hi)];
#pragma unroll
                    for (int j = 0; j < NT; ++j) acc[i][j][r] *= sc; }
        }
        const unsigned char* pa = st + (wm * 64 + r32) * G_STR + hi * 16;
        const unsigned char* pb = st + G_ABYTES + (wn * 32 * NT + r32) * G_STR + hi * 16;
#pragma unroll
        for (int ks = 0; ks < 4; ++ks) {
            bf16x8 af[2], bfr[NT];
#pragma unroll
            for (int i = 0; i < 2; ++i) af[i] = *(const bf16x8*)(pa + i * 32 * G_STR + ks * 32);
#pragma unroll
            for (int j = 0; j < NT; ++j) bfr[j] = *(const bf16x8*)(pb + j * 32 * G_STR + ks * 32);
#pragma unroll
            for (int i = 0; i < 2; ++i)
#pragma unroll
                for (int j = 0; j < NT; ++j) acc[i][j] = __builtin_amdgcn_mfma_f32_32x32x16_bf16(af[i], bfr[j], acc[i][j], 0, 0, 0);
        }
        if (kt + 1 < nk) {
            unsigned char* sn = lds + ((kt + 1) & 1) * C::STAGE;
#pragma unroll
            for (int q = 0; q < 2; ++q) *(u32x4*)(sn + ldsoff + q * 64 * G_STR) = ra[q];
#pragma unroll
            for (int q = 0; q < 2 * NT; ++q) *(u32x4*)(sn + G_ABYTES + ldsoff + q * 64 * G_STR) = rb[q];
        }
        __syncthreads();
    }
    if constexpr (MODE == 0) {
#pragma unroll
        for (int i = 0; i < 2; ++i)
#pragma unroll
            for (int j = 0; j < NT; ++j)
#pragma unroll
                for (int r = 0; r < 16; ++r) epi(wm * 64 + i * 32 + crow(r, hi), wn * 32 * NT + j * 32 + r32, acc[i][j][r]);
    } else {
        float* Ct = (float*)lds;
#pragma unroll
        for (int i = 0; i < 2; ++i)
#pragma unroll
            for (int j = 0; j < NT; ++j)
#pragma unroll
                for (int r = 0; r < 16; ++r) Ct[(wm * 64 + i * 32 + crow(r, hi)) * CSTR + wn * 32 * NT + j * 32 + r32] = acc[i][j][r];
        __syncthreads();
        epi((const float*)Ct);
        __syncthreads();
    }
}

#endif
__device__ __forceinline__ void p0_transpose(const float* __restrict__ W, int K, int N, int Npad, bf16_t* __restrict__ WT,
                                             const float* g0, const float* g1, int gsplit, float* scr, int item, int cmap = 0) {
    const int tid = threadIdx.x;
    const int nkb = K / 64, kb = item % nkb, nb = item / nkb, k0 = kb * 64, n0 = nb * 64;
#pragma unroll
    for (int r = 0; r < 8; ++r) {
        const int kk = r * 8 + (tid >> 6), nn = tid & 63, k = k0 + kk; int n = n0 + nn;
        if (cmap) n = ((n & 255) < 192) ? (n >> 8) * 192 + (n & 255) : N;
        float v = (n < N) ? W[(size_t)k * N + n] : 0.f;
        if (g0) v *= (k < gsplit) ? g0[k] : g1[k - gsplit];
        scr[kk * 65 + nn] = v;
    }
    __syncthreads();
    {
        const int n = tid >> 3, kc = tid & 7; const float* s = scr + (kc * 8) * 65 + n;
        u32x4 o; o.x = pk2(s[0], s[65]); o.y = pk2(s[2 * 65], s[3 * 65]); o.z = pk2(s[4 * 65], s[5 * 65]); o.w = pk2(s[6 * 65], s[7 * 65]);
        *(u32x4*)(WT + (size_t)(n0 + n) * K + k0 + kc * 8) = o;
    }
    __syncthreads();
}


__device__ __forceinline__ void quant_row(const f32x4 (&a)[4], unsigned char* dst, float* scale_out, int lane) {
    float am = 0.f;
#pragma unroll
    for (int q = 0; q < 4; ++q) am = fmaxf(am, fmaxf(fmaxf(fabsf(a[q].x), fabsf(a[q].y)), fmaxf(fabsf(a[q].z), fabsf(a[q].w))));
#pragma unroll
    for (int o = 1; o < 64; o <<= 1) am = fmaxf(am, __shfl_xor(am, o));
    const float sc = (am > 0.f) ? am * (1.0f / 224.0f) : 1.0f, inv = 1.0f / sc;
    u32x4 o;
    { int w = __builtin_amdgcn_cvt_pk_fp8_f32(a[0].x * inv, a[0].y * inv, 0, false); w = __builtin_amdgcn_cvt_pk_fp8_f32(a[0].z * inv, a[0].w * inv, w, true); o.x = (unsigned)w; }
    { int w = __builtin_amdgcn_cvt_pk_fp8_f32(a[1].x * inv, a[1].y * inv, 0, false); w = __builtin_amdgcn_cvt_pk_fp8_f32(a[1].z * inv, a[1].w * inv, w, true); o.y = (unsigned)w; }
    { int w = __builtin_amdgcn_cvt_pk_fp8_f32(a[2].x * inv, a[2].y * inv, 0, false); w = __builtin_amdgcn_cvt_pk_fp8_f32(a[2].z * inv, a[2].w * inv, w, true); o.z = (unsigned)w; }
    { int w = __builtin_amdgcn_cvt_pk_fp8_f32(a[3].x * inv, a[3].y * inv, 0, false); w = __builtin_amdgcn_cvt_pk_fp8_f32(a[3].z * inv, a[3].w * inv, w, true); o.w = (unsigned)w; }
    *(u32x4*)dst = o;
    if (lane == 0) *scale_out = sc;
}

__device__ __forceinline__ void quant_row_i8(const f32x4 (&a)[4], unsigned char* dst, float* scale_out, int lane) {
    float am = 0.f;
#pragma unroll
    for (int q = 0; q < 4; ++q) am = fmaxf(am, fmaxf(fmaxf(fabsf(a[q].x), fabsf(a[q].y)), fmaxf(fabsf(a[q].z), fabsf(a[q].w))));
#pragma unroll
    for (int o = 1; o < 64; o <<= 1) am = fmaxf(am, __shfl_xor(am, o));
    const float sc = (am > 0.f) ? am * (1.0f / 127.0f) : 1.0f, inv = 1.0f / sc;
    u32x4 o;
#pragma unroll
    for (int q = 0; q < 4; ++q) { const int b0 = (int)rintf(a[q].x * inv), b1 = (int)rintf(a[q].y * inv), b2 = (int)rintf(a[q].z * inv), b3 = (int)rintf(a[q].w * inv);
        o[q] = (unsigned)(b0 & 0xFF) | ((unsigned)(b1 & 0xFF) << 8) | ((unsigned)(b2 & 0xFF) << 16) | ((unsigned)(b3 & 0xFF) << 24); }
    *(u32x4*)dst = o;
    if (lane == 0) *scale_out = sc;
}
__device__ void phase0(const Params& p, unsigned char* lds) {
    const int tid = threadIdx.x, G = gridDim.x, bid = blockIdx.x;
    unsigned char* ws = p.ws;
    float* scr = (float*)lds;
    {
        float* part = (float*)(ws + OFF_PART);
        for (int it = bid; it < 24 * 16; it += G) {
            const int nb = it % 24, ks = it / 24, n = nb * 256 + (tid & 255), bh = tid >> 8;
            for (int i = tid; i < 16 * 64; i += NTHR) { const int b = i >> 6, kk = i & 63; const float cv = p.c[b * 1024 + ks * 64 + kk]; scr[i] = cv / (1.0f + __expf(-cv)); }
            __syncthreads();
            float acc[8];
#pragma unroll
            for (int j = 0; j < 8; ++j) acc[j] = 0.f;
            for (int kk = 0; kk < 64; ++kk) {
                const float w = p.w_ada[(size_t)(ks * 64 + kk) * 6144 + n];
#pragma unroll
                for (int j = 0; j < 8; ++j) acc[j] += w * scr[(bh * 8 + j) * 64 + kk];
            }
#pragma unroll
            for (int j = 0; j < 8; ++j) part[((size_t)ks * 16 + bh * 8 + j) * 6144 + n] = acc[j];
            __syncthreads();
        }
    }
    {
        constexpr int I_IN = 16 * 16, I_GLU = 8 * 8, I_UQ = 4 * 16, I_UKV = 2 * 16, I_OUT = 16 * 16, I_Q = 16 * 32;
        constexpr int NIT = I_IN + I_GLU + I_UQ + I_UKV + I_OUT + I_Q;
        for (int it = bid; it < NIT; it += G) {
            int r = it;
            if (r < I_IN) { p0_transpose(p.w_in, 1024, 928, 1024, (bf16_t*)(ws + OFF_WINT), nullptr, nullptr, 0, scr, r); continue; } r -= I_IN;
            if (r < I_GLU) { p0_transpose(p.w_glu, 512, 512, 512, (bf16_t*)(ws + OFF_WGLUT), nullptr, nullptr, 0, scr, r); continue; } r -= I_GLU;
            if (r < I_UQ) { p0_transpose(p.w_uq, 256, 768, 1024, (bf16_t*)(ws + OFF_WUQT), p.q_a_norm, p.q_a_norm, 256, scr, r, 1); continue; } r -= I_UQ;
            if (r < I_UKV) { p0_transpose(p.w_ukv, 128, 1024, 1024, (bf16_t*)(ws + OFF_WUKVT), p.kv_a_norm, p.kv_a_norm, 128, scr, r); continue; } r -= I_UKV;
            if (r < I_OUT) { p0_transpose(p.w_out, 1024, 1024, 1024, (bf16_t*)(ws + OFF_WOUTT), p.out_norm_ssm, p.out_norm_attn, 512, scr, r); continue; } r -= I_OUT;
            p0_transpose(p.w_query, 1024, 2048, 2048, (bf16_t*)(ws + OFF_WQT), nullptr, nullptr, 0, scr, r);
        }
    }
    {
        const size_t gt = (size_t)bid * NTHR + tid, gs = (size_t)G * NTHR;
        for (size_t i = gt; i < 32768 / 8; i += gs) { const f32x4 a = ((const f32x4*)p.sub_keys)[2 * i], b = ((const f32x4*)p.sub_keys)[2 * i + 1];
            u32x4 o; o.x = pk2(a.x, a.y); o.y = pk2(a.z, a.w); o.z = pk2(b.x, b.y); o.w = pk2(b.z, b.w); ((u32x4*)(ws + OFF_SUBK))[i] = o; }
    }
    {
        const int lane = tid & 63, gw = bid * NWAVE + (tid >> 6), NGW = G * NWAVE;
        unsigned char* E8 = ws + OFF_E8; float* esc = (float*)(ws + OFF_ESC);
        for (int r = gw; r < 32768; r += 2 * NGW) {
            const int r2 = r + NGW; const bool has2 = r2 < 32768;
            const float* s0p = ((r < 16384) ? p.e_down : p.e_up) + (size_t)(r & 16383) * 1024 + lane * 16;
            const float* s1p = ((r2 < 16384) ? p.e_down : p.e_up) + (size_t)(r2 & 16383) * 1024 + lane * 16;
            f32x4 a[4], b[4];
#pragma unroll
            for (int q = 0; q < 4; ++q) a[q] = ((const f32x4*)s0p)[q];
            if (has2) {
#pragma unroll
                for (int q = 0; q < 4; ++q) b[q] = ((const f32x4*)s1p)[q]; }
            if (r < 16384) quant_row_i8(a, E8 + (size_t)r * 1024 + lane * 16, esc + r, lane); else quant_row(a, E8 + (size_t)r * 1024 + lane * 16, esc + r, lane);
            if (has2) { if (r2 < 16384) quant_row_i8(b, E8 + (size_t)r2 * 1024 + lane * 16, esc + r2, lane); else quant_row(b, E8 + (size_t)r2 * 1024 + lane * 16, esc + r2, lane); }
        }
    }
    {
        f32x2* apow = (f32x2*)lds;
        f32x2* Bb = (f32x2*)(lds + 16896);
        f32x2* Cc = (f32x2*)(lds + 16896 + 8192);
        float* Kt = (float*)(lds + 16896 + 16384);
        for (int it = ((bid >= G / 2) ? bid - G / 2 : bid + G / 2); it < 128; it += G) {
            const int g = it >> 2, cq = it & 3;
            const float dt = __expf(p.log_dt[g]);
            for (int i = tid; i < 33 * 64; i += NTHR) { const int j = i >> 6, pp = i & 63; const float lr = p.lam_re[g * 64 + pp], li = p.lam_im[g * 64 + pp];
                const float mag = expf((float)j * lr * dt); float sn, cs; sincosf((float)j * li * dt, &sn, &cs); apow[i] = (f32x2){mag * cs, mag * sn}; }
            for (int i = tid; i < 1024; i += NTHR) { const int pp = i >> 4; const float lr = p.lam_re[g * 64 + pp], li = p.lam_im[g * 64 + pp];
                const float mag = expf(lr * dt); float sn, cs; sincosf(li * dt, &sn, &cs); const float nr = mag * cs - 1.0f, ni = mag * sn, den = lr * lr + li * li;
                const float cr = (nr * lr + ni * li) / den, ci = (ni * lr - nr * li) / den; const float br = p.b_re[(size_t)g * 1024 + i], bi = p.b_im[(size_t)g * 1024 + i];
                Bb[i] = (f32x2){cr * br - ci * bi, cr * bi + ci * br}; }
            for (int i = tid; i < 1024; i += NTHR) Cc[i] = (f32x2){p.c_re[(size_t)g * 1024 + i], p.c_im[(size_t)g * 1024 + i]};
            __syncthreads();
            for (int i2 = tid; i2 < 2048; i2 += NTHR) { const int j = i2 >> 6, co = cq * 4 + ((i2 >> 4) & 3), ci = i2 & 15, i = (j << 8) | (co << 4) | ci; float s = 0.f;
                for (int pp = 0; pp < 64; ++pp) { const f32x2 c = Cc[co * 64 + pp], a = apow[j * 64 + pp], b = Bb[pp * 16 + ci]; const float car = c.x * a.x - c.y * a.y, cai = c.x * a.y + c.y * a.x; s += car * b.x - cai * b.y; }
                if (j == 0 && co == ci) s += p.d_skip[g * 16 + co];
                Kt[i] = s; }
            __syncthreads();
            bf16_t* KmT = (bf16_t*)(ws + OFF_KMT) + (size_t)g * 512 * 640;
            for (int q = tid; q < 128 * 80; q += NTHR) { const int nn = q / 80, kc = q % 80, k0 = kc * 8, t = nn >> 2, co = cq * 4 + (nn & 3), n = t * 16 + co; float v[8];
                if (k0 < 512) { const int s = k0 >> 4, ci0 = k0 & 15;
#pragma unroll
                    for (int i = 0; i < 8; ++i) v[i] = (t >= s) ? Kt[((t - s) * 16 + co) * 16 + ci0 + i] : 0.f;
                } else { const int kk0 = k0 - 512, ri = kk0 >> 6, p0 = kk0 & 63;
#pragma unroll
                    for (int i = 0; i < 8; ++i) { const f32x2 c = Cc[co * 64 + p0 + i], a = apow[(t + 1) * 64 + p0 + i]; v[i] = (ri == 0) ? (c.x * a.x - c.y * a.y) : -(c.x * a.y + c.y * a.x); } }
                u32x4 o; o.x = pk2(v[0], v[1]); o.y = pk2(v[2], v[3]); o.z = pk2(v[4], v[5]); o.w = pk2(v[6], v[7]); *(u32x4*)(KmT + (size_t)n * 640 + k0) = o; }
            bf16_t* WzT = (bf16_t*)(ws + OFF_WZT) + (size_t)g * 128 * 512;
            for (int q = tid; q < 32 * 64; q += NTHR) { const int n = cq * 32 + (q >> 6), kc = q & 63, k0 = kc * 8, s = k0 >> 4, ci0 = k0 & 15, ri = n >> 6, pp = n & 63; float v[8];
                const f32x2 a = apow[(31 - s) * 64 + pp];
#pragma unroll
                for (int i = 0; i < 8; ++i) { const f32x2 b = Bb[pp * 16 + ci0 + i]; v[i] = (ri == 0) ? (a.x * b.x - a.y * b.y) : (a.x * b.y + a.y * b.x); }
                u32x4 o; o.x = pk2(v[0], v[1]); o.y = pk2(v[2], v[3]); o.z = pk2(v[4], v[5]); o.w = pk2(v[6], v[7]); *(u32x4*)(WzT + (size_t)n * 512 + k0) = o; }
            if (cq == 0 && tid < 64) ((f32x2*)(ws + OFF_AL))[g * 64 + tid] = apow[32 * 64 + tid];
            __syncthreads();
        }
    }
}


__device__ __forceinline__ void finalize_row(const float* nope, const float* ra, const float* rb, float rn, float rnr, const float* __restrict__ gain, const _Float16* cs, const _Float16* sn, bf16_t* dst) {
#pragma unroll
    for (int j = 0; j < 8; ++j) { const f32x4 a = *(const f32x4*)(nope + 8 * j), c = *(const f32x4*)(nope + 8 * j + 4);
        u32x4 o; o.x = pk2(a.x * rn * gain[8 * j], a.y * rn * gain[8 * j + 1]); o.y = pk2(a.z * rn * gain[8 * j + 2], a.w * rn * gain[8 * j + 3]);
        o.z = pk2(c.x * rn * gain[8 * j + 4], c.y * rn * gain[8 * j + 5]); o.w = pk2(c.z * rn * gain[8 * j + 6], c.w * rn * gain[8 * j + 7]); *(u32x4*)(dst + 8 * j) = o; }
#pragma unroll
    for (int j = 0; j < 2; ++j) { float o1[8], o2[8];
#pragma unroll
        for (int i = 0; i < 8; ++i) { const int f = 8 * j + i; const float x1 = ra[f] * rnr * gain[64 + f], x2 = rb[f] * rnr * gain[80 + f]; const float cf = (float)cs[f], sf = (float)sn[f]; o1[i] = x1 * cf - x2 * sf; o2[i] = x2 * cf + x1 * sf; }
        u32x4 o; o.x = pk2(o1[0], o1[1]); o.y = pk2(o1[2], o1[3]); o.z = pk2(o1[4], o1[5]); o.w = pk2(o1[6], o1[7]); *(u32x4*)(dst + 64 + 8 * j) = o;
        o.x = pk2(o2[0], o2[1]); o.y = pk2(o2[2], o2[3]); o.z = pk2(o2[4], o2[5]); o.w = pk2(o2[6], o2[7]); *(u32x4*)(dst + 80 + 8 * j) = o; }
}
constexpr int CT_BYTES = 128 * CSTR * 4;
constexpr int SM_OFF = 147456;
constexpr int P1_RSQ = SM_OFF, P1_RSKV = P1_RSQ + 512, P1_CS = P1_RSKV + 512, P1_SN = P1_CS + 4096;

__device__ void phase1(const Params& p, unsigned char* lds) {
    const int tid = threadIdx.x, lane = tid & 63, wid = __builtin_amdgcn_readfirstlane(tid >> 6);
    unsigned char* ws = p.ws;
    bf16_t* hbuf = (bf16_t*)(ws + OFF_HBUF); bf16_t* proj2 = (bf16_t*)(ws + OFF_PROJ2); bf16_t* ubuf = (bf16_t*)(ws + OFF_UBUF);
    float* rsq = (float*)(lds + P1_RSQ); float* rskv = (float*)(lds + P1_RSKV); _Float16* cst = (_Float16*)(lds + P1_CS); _Float16* snt = (_Float16*)(lds + P1_SN);
    for (int tile = blockIdx.x; tile < 256; tile += gridDim.x) {
        const int row0 = tile * 128, b = row0 >> 11;
        float* mod = (float*)(ws + OFF_MODT) + (size_t)tile * 6144 - (size_t)b * 6144;
        for (int i = tid; i < 6144; i += NTHR) { float s = p.b_ada[i]; const float* pp = (const float*)(ws + OFF_PART) + (size_t)b * 6144 + i;
            for (int ks = 0; ks < 16; ++ks) s += pp[(size_t)ks * 16 * 6144]; mod[b * 6144 + i] = s; }
        for (int i = tid; i < 2048; i += NTHR) { const int r = i >> 4, f = i & 15; const float ang = (float)p.pos[row0 + r] * exp2f(-(float)f * (13.287712379549449f / 16.0f));
            float sn, cs; sincosf(ang, &sn, &cs); cst[i] = (_Float16)cs; snt[i] = (_Float16)sn; }
        __threadfence_block(); __syncthreads();
        for (int rp1a = 0; rp1a < ((PROBE_REP & 8192) ? 2 : 1); ++rp1a) {
        for (int r = wid; r < 128; r += NWAVE) {
            const f32x4* xr = (const f32x4*)(p.x + (size_t)(row0 + r) * 1024); f32x4 v[4]; float ss = 0.f;
#pragma unroll
            for (int j = 0; j < 4; ++j) { v[j] = xr[lane + 64 * j]; ss += v[j].x * v[j].x + v[j].y * v[j].y + v[j].z * v[j].z + v[j].w * v[j].w; }
            const float rs = rsqrtf(wave_sum(ss) * (1.0f / 1024.0f) + EPS);
#pragma unroll
            for (int j = 0; j < 4; ++j) { const int col = 4 * (lane + 64 * j);
                const f32x4 g = *(const f32x4*)(p.norm_mix + col), sc = *(const f32x4*)(mod + b * 6144 + 1024 + col), sh = *(const f32x4*)(mod + b * 6144 + col);
                u32x2 o; o.x = pk2(v[j].x * rs * g.x * (1.f + sc.x) + sh.x, v[j].y * rs * g.y * (1.f + sc.y) + sh.y); o.y = pk2(v[j].z * rs * g.z * (1.f + sc.z) + sh.z, v[j].w * rs * g.w * (1.f + sc.w) + sh.w);
                *(u32x2*)(hbuf + (size_t)(row0 + r) * 1024 + col) = o; }
        }
        __threadfence_block(); __syncthreads();
        }
        for (int rp1b = 0; rp1b < ((PROBE_REP & 16384) ? 2 : 1); ++rp1b) {
        const ARow ah{hbuf + (size_t)row0 * 1024, 1024};
        for (int nc = 0; nc < 4; ++nc) {
            const bf16_t* Bt = (const bf16_t*)(ws + OFF_WINT) + (size_t)nc * 256 * 1024;
            if (nc < 2) gemm_128<2, 1, 0, 3>(ah, Bt, 1024, 1024, lds, nullptr, [&](const float* Ct) {
                    const int ln = opq_v(lane), r0u = opq_s(row0), ncu = opq_s(nc); bf16_t* ub = opq_p(ubuf);
                    for (int tk = wid; tk < 32; tk += NWAVE) { const int gi = tk >> 1, r = (tk & 1) * 64 + ln, g = ncu * 16 + gi, tok = r0u + r;
                        const float* c = Ct + r * CSTR + gi * 16; const f32x4 a0 = *(const f32x4*)c, a1 = *(const f32x4*)(c + 4), a2 = *(const f32x4*)(c + 8), a3 = *(const f32x4*)(c + 12);
                        bf16_t* d = ub + ((size_t)g * 1024 + (tok >> 5)) * 640 + (tok & 31) * 16;
                        *(u32x4*)d = (u32x4){pk2(a0.x, a0.y), pk2(a0.z, a0.w), pk2(a1.x, a1.y), pk2(a1.z, a1.w)}; *(u32x4*)(d + 8) = (u32x4){pk2(a2.x, a2.y), pk2(a2.z, a2.w), pk2(a3.x, a3.y), pk2(a3.z, a3.w)}; } });
            else if (nc == 2) gemm_128<2, 1, 0, 3>(ah, Bt, 1024, 1024, lds, nullptr, [&](const float* Ct) {
                    const int ln = opq_v(lane), r0u = opq_s(row0); bf16_t* pj = opq_p(proj2);
                    for (int r = wid; r < 128; r += NWAVE) { const f32x4 v = *(const f32x4*)(Ct + r * CSTR + ln * 4);
                        const float sq = wave_sum(v.x * v.x + v.y * v.y + v.z * v.z + v.w * v.w); if (ln == 0) rsq[r] = rsqrtf(sq * (1.0f / 256.0f) + EPS);
                        *(u32x2*)(pj + (size_t)(r0u + r) * 512 + ln * 4) = (u32x2){pk2(v.x, v.y), pk2(v.z, v.w)}; } });
            else gemm_128<2, 1, 0, 3>(ah, Bt, 1024, 1024, lds, nullptr, [&](const float* Ct) {
                    const int ln = opq_v(lane), r0u = opq_s(row0); bf16_t* pj = opq_p(proj2);
                    for (int r = wid; r < 128; r += NWAVE) { const f32x4 v = (ln < 40) ? *(const f32x4*)(Ct + r * CSTR + ln * 4) : (f32x4){0.f, 0.f, 0.f, 0.f};
                        const float sq = wave_sum((ln < 32) ? (v.x * v.x + v.y * v.y + v.z * v.z + v.w * v.w) : 0.f); if (ln == 0) rskv[r] = rsqrtf(sq * (1.0f / 128.0f) + EPS);
                        const u32x2 o = (u32x2){pk2(v.x, v.y), pk2(v.z, v.w)};
                        if (ln < 32) *(u32x2*)(pj + (size_t)(r0u + r) * 512 + 256 + ln * 4) = o; else if (ln < 40) *(u32x2*)(pj + (size_t)(r0u + r) * 512 + 384 + (ln - 32) * 4) = o; } });
        }
        }
        for (int rp1d = 0; rp1d < ((PROBE_REP & 32768) ? 2 : 1); ++rp1d) {
        const ARow aq{proj2 + (size_t)row0 * 512, 512};
        for (int nc = 0; nc < 4; ++nc)
            gemm_128<2, 1, 0, 3>(aq, (const bf16_t*)(ws + OFF_WUQT) + (size_t)nc * 256 * 256, 256, 256, lds, nullptr, [&](const float* Ct) {
                const int tq = opq_v(tid); const float* gq = opq_p(p.q_norm);
                if (tq < 256) { const int row = tq & 127, hh = tq >> 7, h = opq_s(nc) * 2 + hh; const float* q = Ct + row * CSTR + hh * 96; float ss = 0.f;
#pragma unroll
                    for (int j = 0; j < 24; ++j) { const f32x4 t4 = *(const f32x4*)(q + 4 * j); ss += t4.x * t4.x + t4.y * t4.y + t4.z * t4.z + t4.w * t4.w; }
                    const float rq = rsq[row], rn = rsqrtf(ss * rq * rq * (1.0f / 96.0f) + EPS) * rq * QSCALE;
                    const int r0q = opq_s(row0); bf16_t* dst = (bf16_t*)(ws + OFF_Q) + ((size_t)((r0q >> 11) * 8 + h) * 2048 + ((r0q + row) & 2047)) * 96;
                    finalize_row(q, q + 64, q + 80, rn, rn, gq, cst + row * 16, snt + row * 16, dst); } });
        }
        for (int rp1e = 0; rp1e < ((PROBE_REP & 65536) ? 2 : 1); ++rp1e) {
        const ARow akv{proj2 + (size_t)row0 * 512 + 256, 512};
        for (int nc = 0; nc < 4; ++nc)
            gemm_128<2, 1, 0, 3>(akv, (const bf16_t*)(ws + OFF_WUKVT) + (size_t)nc * 256 * 128, 128, 128, lds, nullptr, [&](const float* Ct) {
                const int tq = opq_v(tid); const float* gk = opq_p(p.k_norm); const int r0k = opq_s(row0), nck = opq_s(nc);
                if (tq < 256) { const int row = tq & 127, hh = tq >> 7, h = nck * 2 + hh; const float* kp = Ct + row * CSTR + hh * 128; float ss = 0.f, sr = 0.f; float rp[32];
#pragma unroll
                    for (int j = 0; j < 16; ++j) { const f32x4 t4 = *(const f32x4*)(kp + 4 * j); ss += t4.x * t4.x + t4.y * t4.y + t4.z * t4.z + t4.w * t4.w; }
#pragma unroll
                    for (int j = 0; j < 4; ++j) { const u32x4 w = *(const u32x4*)(proj2 + (size_t)(r0k + row) * 512 + 384 + 8 * j);
                        rp[8 * j] = bflo(w.x); rp[8 * j + 1] = bfhi(w.x); rp[8 * j + 2] = bflo(w.y); rp[8 * j + 3] = bfhi(w.y); rp[8 * j + 4] = bflo(w.z); rp[8 * j + 5] = bfhi(w.z); rp[8 * j + 6] = bflo(w.w); rp[8 * j + 7] = bfhi(w.w); }
#pragma unroll
                    for (int d = 0; d < 32; ++d) sr += rp[d] * rp[d];
                    const float rk = rskv[row], rn = rsqrtf((ss * rk * rk + sr) * (1.0f / 96.0f) + EPS);
                    bf16_t* dst = (bf16_t*)(ws + OFF_K) + ((size_t)((r0k >> 11) * 8 + h) * 2048 + ((r0k + row) & 2047)) * 96;
                    finalize_row(kp, rp, rp + 16, rn * rk, rn, gk, cst + row * 16, snt + row * 16, dst);
                } else { const int t = tq - 256, d = t & 63, hh = (t >> 6) & 1, rh = t >> 7, h = nck * 2 + hh;
                    bf16_t* dst = (bf16_t*)(ws + OFF_VT) + ((size_t)((r0k >> 11) * 8 + h) * 64 + d) * 2048 + (r0k & 2047) + rh * 64;
                    const float* vp = Ct + (rh * 64) * CSTR + hh * 128 + 64 + d;
#pragma unroll 2
                    for (int r8 = 0; r8 < 8; ++r8) { float v[8];
#pragma unroll
                        for (int i = 0; i < 8; ++i) v[i] = vp[(r8 * 8 + i) * CSTR] * rskv[rh * 64 + r8 * 8 + i];
                        *(u32x4*)(dst + r8 * 8) = (u32x4){pk2(v[0], v[1]), pk2(v[2], v[3]), pk2(v[4], v[5]), pk2(v[6], v[7])}; } } });
        }
    }
}

__device__ void s5_item(const Params& p, unsigned char* lds, int g, int bp) {
    const int tid = threadIdx.x;
    unsigned char* ws = p.ws;
    bf16_t* A = (bf16_t*)(ws + OFF_UBUF) + ((size_t)g * 1024 + bp * 128) * 640;
    float* Z = (float*)(lds + 73728);
    const ARow au{A, 640};
    gemm_128<1, 0, 0, 2>(au, (const bf16_t*)(ws + OFF_WZT) + (size_t)g * 128 * 512, 512, 512, lds, nullptr, [&](int row, int col, float v) { Z[row * 129 + col] = v; });
    __syncthreads();
    if (tid < 128) {
        const int bs = tid >> 6, pp = tid & 63; const f32x2 aL = ((const f32x2*)(ws + OFF_AL))[g * 64 + pp]; float xr = 0.f, xi = 0.f;
        for (int k = 0; k < 64; ++k) { const int row = bs * 64 + k; bf16_t* xin = A + (size_t)row * 640 + 512;
            xin[pp] = (bf16_t)f2bf(xr); xin[64 + pp] = (bf16_t)f2bf(xi);
            const float zr = Z[row * 129 + pp], zi = Z[row * 129 + 64 + pp], nr = aL.x * xr - aL.y * xi + zr, ni = aL.x * xi + aL.y * xr + zi; xr = nr; xi = ni; }
    }
    __threadfence_block(); __syncthreads();
    bf16_t* ybT = (bf16_t*)(ws + OFF_YBUF) + (size_t)g * T_TOK * 16;
    for (int nc = 0; nc < 2; ++nc)
        gemm_128<2, 1, 0, 3>(au, (const bf16_t*)(ws + OFF_KMT) + ((size_t)g * 512 + nc * 256) * 640, 640, 640, lds, nullptr, [&](const float* Ct) {
#pragma unroll
            for (int i = 0; i < 4; ++i) { const int pidx = tid + NTHR * i, row = pidx >> 4, tt = pidx & 15; const float* c = Ct + row * CSTR + tt * 16;
                const f32x4 a0 = *(const f32x4*)c, a1 = *(const f32x4*)(c + 4), a2 = *(const f32x4*)(c + 8), a3 = *(const f32x4*)(c + 12);
                bf16_t* d = ybT + ((size_t)(bp * 128 + row) * 32 + nc * 16 + tt) * 16;
                *(u32x4*)d = (u32x4){pk2(gelu_tanh(a0.x), gelu_tanh(a0.y)), pk2(gelu_tanh(a0.z), gelu_tanh(a0.w)), pk2(gelu_tanh(a1.x), gelu_tanh(a1.y)), pk2(gelu_tanh(a1.z), gelu_tanh(a1.w))};
                *(u32x4*)(d + 8) = (u32x4){pk2(gelu_tanh(a2.x), gelu_tanh(a2.y)), pk2(gelu_tanh(a2.z), gelu_tanh(a2.w)), pk2(gelu_tanh(a3.x), gelu_tanh(a3.y)), pk2(gelu_tanh(a3.z), gelu_tanh(a3.w))}; } });
}

constexpr int AT_KSTR = 208, AT_VSTR = 136, AT_KB = 64 * AT_KSTR, AT_VB = 64 * AT_VSTR, AT_STAGE = AT_KB + AT_VB;

__device__ void attn_item(const Params& p, unsigned char* lds, int bh, int qb) {
    const int tid = threadIdx.x, lane = tid & 63, wid = __builtin_amdgcn_readfirstlane(tid >> 6), r32 = lane & 31, hi = lane >> 5;
    unsigned char* ws = p.ws;
    const int q0 = qb * 256, qw0 = q0 + wid * 32, qg = qw0 + r32;
    const bf16_t* Qp = (const bf16_t*)(ws + OFF_Q) + ((size_t)bh * 2048 + qw0) * 96;
    const bf16_t* Kp = (const bf16_t*)(ws + OFF_K) + (size_t)bh * 2048 * 96;
    const bf16_t* Vp = (const bf16_t*)(ws + OFF_VT) + (size_t)bh * 64 * 2048;
    bf16x8 qf[6];
#pragma unroll
    for (int ks = 0; ks < 6; ++ks) qf[ks] = *(const bf16x8*)(Qp + r32 * 96 + ks * 16 + hi * 8);
    f32x16 ot[2];
#pragma unroll
    for (int r = 0; r < 16; ++r) { ot[0][r] = 0.f; ot[1][r] = 0.f; }
    float m = -INFINITY, l = 0.f;
    const int nkv = (q0 + 256) / 64;
    const int kr0 = tid / 12, kc0 = tid % 12, kr1 = (tid + 512) / 12, kc1 = (tid + 512) % 12; const bool k2 = tid < 256;
    const int vd = tid >> 3, vc = tid & 7;
    u32x4 rk0, rk1, rv;
    rk0 = *(const u32x4*)(Kp + (size_t)kr0 * 96 + kc0 * 8); if (k2) rk1 = *(const u32x4*)(Kp + (size_t)kr1 * 96 + kc1 * 8);
    rv = *(const u32x4*)(Vp + (size_t)vd * 2048 + vc * 8);
    *(u32x4*)(lds + kr0 * AT_KSTR + kc0 * 16) = rk0; if (k2) *(u32x4*)(lds + kr1 * AT_KSTR + kc1 * 16) = rk1;
    { u32x2* d = (u32x2*)(lds + AT_KB + vd * AT_VSTR + vc * 16); d[0] = (u32x2){rv.x, rv.y}; d[1] = (u32x2){rv.z, rv.w}; }
    __syncthreads();
    for (int t = 0; t < nkv; ++t) {
        const unsigned char* st = lds + (t & 1) * AT_STAGE; const int kv0 = t * 64;
        if (t + 1 < nkv) {
            const int kn = kv0 + 64;
            rk0 = *(const u32x4*)(Kp + (size_t)(kn + kr0) * 96 + kc0 * 8); if (k2) rk1 = *(const u32x4*)(Kp + (size_t)(kn + kr1) * 96 + kc1 * 8);
            rv = *(const u32x4*)(Vp + (size_t)vd * 2048 + kn + vc * 8);
        }
        if (kv0 <= qw0 + 31) {
            f32x16 s0, s1;
#pragma unroll
            for (int r = 0; r < 16; ++r) { s0[r] = 0.f; s1[r] = 0.f; }
#pragma unroll
            for (int ks = 0; ks < 6; ++ks) {
                const bf16x8 k0f = *(const bf16x8*)(st + r32 * AT_KSTR + ks * 32 + hi * 16);
                const bf16x8 k1f = *(const bf16x8*)(st + (32 + r32) * AT_KSTR + ks * 32 + hi * 16);
                s0 = __builtin_amdgcn_mfma_f32_32x32x16_bf16(k0f, qf[ks], s0, 0, 0, 0);
                s1 = __builtin_amdgcn_mfma_f32_32x32x16_bf16(k1f, qf[ks], s1, 0, 0, 0);
            }
            if (kv0 + 63 > qw0) {
#pragma unroll
                for (int r = 0; r < 16; ++r) { const int key = kv0 + crow(r, hi); if (key > qg) s0[r] = -INFINITY; if (key + 32 > qg) s1[r] = -INFINITY; }
            }
            float mx = fmaxf(s0[0], s1[0]);
#pragma unroll
            for (int r = 1; r < 16; ++r) mx = fmaxf(mx, fmaxf(s0[r], s1[r]));
            mx = fmaxf(mx, __shfl_xor(mx, 32));
            const float mn = fmaxf(m, mx), alpha = __builtin_amdgcn_exp2f(m - mn);
            float ps = 0.f;
#pragma unroll
            for (int r = 0; r < 16; ++r) { s0[r] = __builtin_amdgcn_exp2f(s0[r] - mn); s1[r] = __builtin_amdgcn_exp2f(s1[r] - mn); ps += s0[r] + s1[r]; }
            l = l * alpha + ps; m = mn;
#pragma unroll
            for (int r = 0; r < 16; ++r) { ot[0][r] *= alpha; ot[1][r] *= alpha; }
            const unsigned char* vb = st + AT_KB + r32 * AT_VSTR + hi * 8;
#pragma unroll
            for (int kt2 = 0; kt2 < 2; ++kt2)
#pragma unroll
                for (int s = 0; s < 2; ++s) {
                    u32x4 pw;
                    if (kt2 == 0) { pw.x = pk2(s0[8 * s], s0[8 * s + 1]); pw.y = pk2(s0[8 * s + 2], s0[8 * s + 3]); pw.z = pk2(s0[8 * s + 4], s0[8 * s + 5]); pw.w = pk2(s0[8 * s + 6], s0[8 * s + 7]); }
                    else { pw.x = pk2(s1[8 * s], s1[8 * s + 1]); pw.y = pk2(s1[8 * s + 2], s1[8 * s + 3]); pw.z = pk2(s1[8 * s + 4], s1[8 * s + 5]); pw.w = pk2(s1[8 * s + 6], s1[8 * s + 7]); }
                    const bf16x8 pf = __builtin_bit_cast(bf16x8, pw);
#pragma unroll
                    for (int dt = 0; dt < 2; ++dt) {
                        const unsigned char* a = vb + dt * 32 * AT_VSTR + (kt2 * 32 + 16 * s) * 2;
                        const u32x2 lo = *(const u32x2*)a, hh = *(const u32x2*)(a + 16);
                        const bf16x8 vf = __builtin_bit_cast(bf16x8, (u32x4){lo.x, lo.y, hh.x, hh.y});
                        ot[dt] = __builtin_amdgcn_mfma_f32_32x32x16_bf16(vf, pf, ot[dt], 0, 0, 0);
                    }
                }
        }
        if (t + 1 < nkv) {
            unsigned char* sn = lds + ((t + 1) & 1) * AT_STAGE;
            *(u32x4*)(sn + kr0 * AT_KSTR + kc0 * 16) = rk0; if (k2) *(u32x4*)(sn + kr1 * AT_KSTR + kc1 * 16) = rk1;
            u32x2* d = (u32x2*)(sn + AT_KB + vd * AT_VSTR + vc * 16); d[0] = (u32x2){rv.x, rv.y}; d[1] = (u32x2){rv.z, rv.w};
        }
        __syncthreads();
    }
    l += __shfl_xor(l, 32);
    const float inv = 1.0f / l;
    bf16_t* dst = (bf16_t*)(ws + OFF_HBUF) + ((size_t)(bh >> 3) * 2048 + qg) * 1024 + 512 + (bh & 7) * 64;
#pragma unroll
    for (int dt = 0; dt < 2; ++dt)
#pragma unroll
        for (int g4 = 0; g4 < 4; ++g4) { u32x2 o; o.x = pk2(ot[dt][4 * g4] * inv, ot[dt][4 * g4 + 1] * inv); o.y = pk2(ot[dt][4 * g4 + 2] * inv, ot[dt][4 * g4 + 3] * inv);
            *(u32x2*)(dst + dt * 32 + 8 * g4 + 4 * hi) = o; }
}

__device__ void phase2(const Params& p, unsigned char* lds) {
    for (int rp = 0; rp < ((PROBE_REP & 131072) ? 2 : 1); ++rp)
    for (int it = blockIdx.x; it < 256; it += gridDim.x) s5_item(p, lds, it >> 3, it & 7);
    for (int rp2 = 0; rp2 < ((PROBE_REP & 262144) ? 2 : 1); ++rp2)
    for (int v = blockIdx.x; v < 256; v += gridDim.x) {
        const int bh = v >> 1;
        for (int i = 0; i < 4; ++i) { const int qb = (v & 1) ? ((i == 0) ? 6 : (i == 1) ? 1 : (i == 2) ? 5 : 2) : ((i == 0) ? 7 : (i == 1) ? 0 : (i == 2) ? 4 : 3); attn_item(p, lds, bh, qb); }
    }
}

__device__ __forceinline__ void cex_desc(float& a, float& b) { const float mx = fmaxf(a, b), mn = fminf(a, b); a = mx; b = mn; }
__device__ __forceinline__ void sort16_desc(float (&v)[16]) {
#pragma unroll
    for (int k = 2; k <= 16; k <<= 1)
#pragma unroll
        for (int j = k >> 1; j > 0; j >>= 1)
#pragma unroll
            for (int i = 0; i < 16; ++i) { const int l = i ^ j; if (l > i) { if ((i & k) == 0) cex_desc(v[i], v[l]); else cex_desc(v[l], v[i]); } }
}
__device__ __forceinline__ void merge16(float (&top)[16], const float (&c)[16]) {
#pragma unroll
    for (int i = 0; i < 16; ++i) top[i] = fmaxf(top[i], c[15 - i]);
#pragma unroll
    for (int j = 8; j > 0; j >>= 1)
#pragma unroll
        for (int i = 0; i < 16; ++i) { const int l = i ^ j; if (l > i) cex_desc(top[i], top[l]); }
}
__device__ __forceinline__ float mkc(float a, float b, unsigned code) { return __uint_as_float((__float_as_uint(a + b) & 0xFFFFFF00u) | code); }


struct RowBuf { u32x4 d[4], u[4]; };
__device__ __forceinline__ void g_load(RowBuf& B, const unsigned char* __restrict__ E8, int idv, int kbase, int lane) {
#pragma unroll
    for (int j = 0; j < 4; ++j) { const int e = __builtin_amdgcn_readlane(idv, kbase + j);
        B.d[j] = *(const u32x4*)(E8 + (size_t)e * 1024 + lane * 16); B.u[j] = *(const u32x4*)(E8 + (size_t)(16384 + e) * 1024 + lane * 16); }
}
__device__ __forceinline__ float dpp_add(float t, const int ctrl_sel) {
    if (ctrl_sel == 0) return t + __int_as_float(__builtin_amdgcn_update_dpp(0, __float_as_int(t), 0xB1, 0xF, 0xF, false));
    if (ctrl_sel == 1) return t + __int_as_float(__builtin_amdgcn_update_dpp(0, __float_as_int(t), 0x4E, 0xF, 0xF, false));
    if (ctrl_sel == 2) return t + __int_as_float(__builtin_amdgcn_update_dpp(0, __float_as_int(t), 0x141, 0xF, 0xF, false));
    return t + __int_as_float(__builtin_amdgcn_update_dpp(0, __float_as_int(t), 0x140, 0xF, 0xF, false));
}
__device__ __forceinline__ void g_compute(const RowBuf& B, const f32x2 (&hv)[8], f32x2 (&acc)[8], float sdv, float gwv, int kbase, int lane) {
    float s[4];
#pragma unroll
    for (int j = 0; j < 4; ++j) { f32x2 a = {0.f, 0.f};
#pragma unroll
        for (int q = 0; q < 4; ++q) { const int w = (int)B.d[j][q]; const f32x2 lo = __builtin_amdgcn_cvt_pk_f32_fp8(w, false), hi = __builtin_amdgcn_cvt_pk_f32_fp8(w, true);
            a = __builtin_elementwise_fma(lo, hv[2 * q], a); a = __builtin_elementwise_fma(hi, hv[2 * q + 1], a); }
        s[j] = a.x + a.y; }
    auto r0 = __builtin_amdgcn_permlane32_swap(__float_as_uint(s[0]), __float_as_uint(s[1]), false, false);
    auto r1 = __builtin_amdgcn_permlane32_swap(__float_as_uint(s[2]), __float_as_uint(s[3]), false, false);
    const float r01 = __uint_as_float(r0[0]) + __uint_as_float(r0[1]), r23 = __uint_as_float(r1[0]) + __uint_as_float(r1[1]);
    auto r2 = __builtin_amdgcn_permlane16_swap(__float_as_uint(r01), __float_as_uint(r23), false, false);
    float t = __uint_as_float(r2[0]) + __uint_as_float(r2[1]);
    t = dpp_add(t, 0); t = dpp_add(t, 1); t = dpp_add(t, 2); t = dpp_add(t, 3);
    const int jl = kbase + ((lane >> 4) & 1) * 2 + (lane >> 5);
    const float sdl = __shfl(sdv, jl), gwl = __shfl(gwv, jl);
    const float w = gwl * gelu_tanh(sdl * t);
    float wj[4];
    wj[0] = __int_as_float(__builtin_amdgcn_readlane(__float_as_int(w), 0)); wj[1] = __int_as_float(__builtin_amdgcn_readlane(__float_as_int(w), 32));
    wj[2] = __int_as_float(__builtin_amdgcn_readlane(__float_as_int(w), 16)); wj[3] = __int_as_float(__builtin_amdgcn_readlane(__float_as_int(w), 48));
#pragma unroll
    for (int j = 0; j < 4; ++j) { const f32x2 ws = {wj[j], wj[j]};
#pragma unroll
        for (int q = 0; q < 4; ++q) { const int w2 = (int)B.u[j][q]; const f32x2 lo = __builtin_amdgcn_cvt_pk_f32_fp8(w2, false), hi = __builtin_amdgcn_cvt_pk_f32_fp8(w2, true);
            acc[2 * q] = __builtin_elementwise_fma(lo, ws, acc[2 * q]); acc[2 * q + 1] = __builtin_elementwise_fma(hi, ws, acc[2 * q + 1]); } }
}

constexpr int QP_STR = 528, S_OFF = 128 * QP_STR, S_STR = 132, L_OFF = S_OFF + 128 * S_STR * 4;

__device__ void phase3(const Params& p, unsigned char* lds) {
    const int tid = threadIdx.x, lane = tid & 63, wid = __builtin_amdgcn_readfirstlane(tid >> 6), r32 = lane & 31, hi = lane >> 5, wm = wid >> 2, wn = wid & 3;
    unsigned char* ws = p.ws;
    bf16_t* hbuf = (bf16_t*)(ws + OFF_HBUF); const bf16_t* ybuf = (const bf16_t*)(ws + OFF_YBUF);
    int* idxb = (int*)(ws + OFF_IDX); float* gb = (float*)(ws + OFF_G);
    for (int tile = blockIdx.x; tile < 256; tile += gridDim.x) {
        const int row0 = tile * 128, b = row0 >> 11;
        const float* mod = (const float*)(ws + OFF_MODT) + (size_t)tile * 6144 - (size_t)b * 6144;
        float* ssum = (float*)(lds + SM_OFF); float* ratio = ssum + 128; float* rsat = ratio + 128; float* ss1 = rsat + 128;
        const bf16_t* ybT = ybuf + (size_t)row0 * 16;
        for (int rp3a = 0; rp3a < ((PROBE_REP & 16) ? 2 : 1); ++rp3a) {
        for (int nc = 0; nc < 2; ++nc)
            gemm_128<2, 1, 0, 3>(AGrp{ybT}, (const bf16_t*)(ws + OFF_WGLUT) + (size_t)nc * 256 * 512, 512, 512, lds, nullptr, [&](const float* Ct) {
#pragma unroll 2
                for (int i = 0; i < 8; ++i) { const int pidx = tid + NTHR * i, row = pidx >> 5, c8 = (pidx & 31) * 8, col = nc * 256 + c8;
                    const f32x4 a0 = *(const f32x4*)(Ct + row * CSTR + c8), a1 = *(const f32x4*)(Ct + row * CSTR + c8 + 4);
                    const u32x4 yw = *(const u32x4*)(ybT + ((size_t)(col >> 4) * T_TOK + row) * 16 + (col & 15));
                    const f32x4 b0 = *(const f32x4*)(p.b_glu + col), b1 = *(const f32x4*)(p.b_glu + col + 4);
                    float o[8];
                    o[0] = bflo(yw.x) * sigmoidf_(a0.x + b0.x); o[1] = bfhi(yw.x) * sigmoidf_(a0.y + b0.y); o[2] = bflo(yw.y) * sigmoidf_(a0.z + b0.z); o[3] = bfhi(yw.y) * sigmoidf_(a0.w + b0.w);
                    o[4] = bflo(yw.z) * sigmoidf_(a1.x + b1.x); o[5] = bfhi(yw.z) * sigmoidf_(a1.y + b1.y); o[6] = bflo(yw.w) * sigmoidf_(a1.z + b1.z); o[7] = bfhi(yw.w) * sigmoidf_(a1.w + b1.w);
                    float ss = 0.f;
#pragma unroll
                    for (int k = 0; k < 8; ++k) ss += o[k] * o[k];
                    *(u32x4*)(hbuf + (size_t)(row0 + row) * 1024 + col) = (u32x4){pk2(o[0], o[1]), pk2(o[2], o[3]), pk2(o[4], o[5]), pk2(o[6], o[7])};
#pragma unroll
                    for (int of = 1; of < 32; of <<= 1) ss += __shfl_xor(ss, of);
                    if ((lane & 31) == 0) { if (nc == 0) ssum[row] = ss; else ssum[row] += ss; } } });
        }
        for (int r = wid; r < 128; r += NWAVE) {
            const u32x4 w = *(const u32x4*)(hbuf + (size_t)(row0 + r) * 1024 + 512 + lane * 8);
            float ss = bflo(w.x) * bflo(w.x) + bfhi(w.x) * bfhi(w.x) + bflo(w.y) * bflo(w.y) + bfhi(w.y) * bfhi(w.y) + bflo(w.z) * bflo(w.z) + bfhi(w.z) * bfhi(w.z) + bflo(w.w) * bflo(w.w) + bfhi(w.w) * bfhi(w.w);
            ss = wave_sum(ss);
            if (lane == 0) { const float ra = rsqrtf(ss * (1.0f / 512.0f) + EPS), rs = rsqrtf(ssum[r] * (1.0f / 512.0f) + EPS); rsat[r] = ra; ratio[r] = rs / ra; }
        }
        __threadfence_block(); __syncthreads();
        for (int rep_c = 0; rep_c < ((PROBE_REP & 128) ? 2 : 1); ++rep_c)
        for (int nc = 0; nc < 4; ++nc)
            gemm_128<2, 1, 8, 3>(ARow{hbuf + (size_t)row0 * 1024, 1024}, (const bf16_t*)(ws + OFF_WOUTT) + (size_t)nc * 256 * 1024, 1024, 1024, lds, ratio, [&](const float* Ct) {
#pragma unroll 4
                for (int i = 0; i < 16; ++i) { const int row = wid + NWAVE * i, col = nc * 256 + lane * 4; const size_t o = (size_t)(row0 + row) * 1024 + col;
                    const f32x4 v = *(const f32x4*)(Ct + row * CSTR + lane * 4), xv = *(const f32x4*)(p.x + o), gm = *(const f32x4*)(mod + b * 6144 + 2048 + col); const float ra = rsat[row];
                    f32x4 r; r.x = xv.x + gm.x * v.x * ra; r.y = xv.y + gm.y * v.y * ra; r.z = xv.z + gm.z * v.z * ra; r.w = xv.w + gm.w * v.w * ra;
                    *(f32x4*)(p.out + o) = r;
                    const float ss = wave_sum(r.x * r.x + r.y * r.y + r.z * r.z + r.w * r.w);
                    if (lane == 0) { if (nc == 0) ss1[row] = ss; else ss1[row] += ss; } } });
        __threadfence_block(); __syncthreads();
        for (int rp3d = 0; rp3d < ((PROBE_REP & 4096) ? 2 : 1); ++rp3d) {
        for (int r = wid; r < 128; r += NWAVE) {
            const f32x4* xr = (const f32x4*)(p.out + (size_t)(row0 + r) * 1024); const float rs = rsqrtf(ss1[r] * (1.0f / 1024.0f) + EPS);
#pragma unroll
            for (int j = 0; j < 4; ++j) { const int col = 4 * (lane + 64 * j); const f32x4 v = xr[lane + 64 * j];
                const f32x4 g = *(const f32x4*)(p.norm_ffn + col), sc = *(const f32x4*)(mod + b * 6144 + 4096 + col), sh = *(const f32x4*)(mod + b * 6144 + 3072 + col);
                u32x2 o; o.x = pk2(v.x * rs * g.x * (1.f + sc.x) + sh.x, v.y * rs * g.y * (1.f + sc.y) + sh.y); o.y = pk2(v.z * rs * g.z * (1.f + sc.z) + sh.z, v.w * rs * g.w * (1.f + sc.w) + sh.w);
                *(u32x2*)(hbuf + (size_t)(row0 + r) * 1024 + col) = o; }
        }
        __threadfence_block(); __syncthreads();
        }
        for (int rep_e = 0; rep_e < ((PROBE_REP & 32) ? 2 : 1); ++rep_e) {
        float* Sx = (float*)(lds + S_OFF); float* Ls = (float*)(lds + L_OFF);
        for (int h = 0; h < 8; ++h) {
            gemm_128<2, 0, 0, 3>(ARow{hbuf + (size_t)row0 * 1024, 1024}, (const bf16_t*)(ws + OFF_WQT) + (size_t)h * 256 * 1024, 1024, 1024, lds, nullptr, [&](int row, int col, float v) {
                *(bf16_t*)(lds + row * QP_STR + col * 2) = (bf16_t)f2bf(v); });
            __syncthreads();
            for (int ph = 0; ph < 2; ++ph) {
                f32x16 a0, a1;
#pragma unroll
                for (int r = 0; r < 16; ++r) { a0[r] = 0.f; a1[r] = 0.f; }
                const bf16_t* sk = (const bf16_t*)(ws + OFF_SUBK) + ((size_t)ph * 128 + wn * 32 + r32) * 128 + hi * 8;
                const unsigned char* qa = lds + (wm * 64 + r32) * QP_STR + (ph * 128 + hi * 8) * 2;
#pragma unroll
                for (int ks = 0; ks < 8; ++ks) {
                    const bf16x8 bfr = *(const bf16x8*)(sk + ks * 16);
                    const bf16x8 f0 = *(const bf16x8*)(qa + ks * 32), f1 = *(const bf16x8*)(qa + 32 * QP_STR + ks * 32);
                    a0 = __builtin_amdgcn_mfma_f32_32x32x16_bf16(f0, bfr, a0, 0, 0, 0);
                    a1 = __builtin_amdgcn_mfma_f32_32x32x16_bf16(f1, bfr, a1, 0, 0, 0);
                }
#pragma unroll
                for (int r = 0; r < 16; ++r) { Sx[(wm * 64 + crow(r, hi)) * S_STR + wn * 32 + r32] = a0[r]; Sx[(wm * 64 + 32 + crow(r, hi)) * S_STR + wn * 32 + r32] = a1[r]; }
                __syncthreads();
                {
                    const int row = tid >> 2, qd = tid & 3; float top[16];
#pragma unroll
                    for (int c2 = 0; c2 < 2; ++c2) { float c[16];
#pragma unroll
                        for (int q = 0; q < 4; ++q) { const int kb = qd * 32 + c2 * 16 + 4 * q; const f32x4 t4 = *(const f32x4*)(Sx + row * S_STR + kb);
                            c[4 * q] = __uint_as_float((__float_as_uint(t4.x) & 0xFFFFFF80u) | (unsigned)(127 - kb));
                            c[4 * q + 1] = __uint_as_float((__float_as_uint(t4.y) & 0xFFFFFF80u) | (unsigned)(126 - kb));
                            c[4 * q + 2] = __uint_as_float((__float_as_uint(t4.z) & 0xFFFFFF80u) | (unsigned)(125 - kb));
                            c[4 * q + 3] = __uint_as_float((__float_as_uint(t4.w) & 0xFFFFFF80u) | (unsigned)(124 - kb)); }
                        sort16_desc(c);
                        if (c2 == 0) {
#pragma unroll
                            for (int k = 0; k < 16; ++k) top[k] = c[k];
                        } else merge16(top, c); }
                    { float o[16];
#pragma unroll
                      for (int k = 0; k < 16; ++k) o[k] = __int_as_float(__builtin_amdgcn_update_dpp(0, __float_as_int(top[k]), 0xB1, 0xF, 0xF, false));
                      merge16(top, o);
#pragma unroll
                      for (int k = 0; k < 16; ++k) o[k] = __int_as_float(__builtin_amdgcn_update_dpp(0, __float_as_int(top[k]), 0x4E, 0xF, 0xF, false));
                      merge16(top, o); }
                    if (qd == 0) {
#pragma unroll
                        for (int q = 0; q < 4; ++q) *(f32x4*)(Ls + (ph * 128 + row) * 16 + 4 * q) = (f32x4){top[4 * q], top[4 * q + 1], top[4 * q + 2], top[4 * q + 3]}; }
                }
                __syncthreads();
            }
            if (wid < 2) {
                const int row = wid * 64 + lane; float a1[16], a2[16], top[16];
#pragma unroll
                for (int k = 0; k < 16; ++k) { a1[k] = __uint_as_float(__float_as_uint(Ls[row * 16 + k]) & 0xFFFFFF80u); a2[k] = __uint_as_float(__float_as_uint(Ls[(128 + row) * 16 + k]) & 0xFFFFFF80u); }
    { float c[16];
      c[0] = mkc(a1[0], a2[0], 255u);
      c[1] = mkc(a1[0], a2[1], 254u);
      c[2] = mkc(a1[0], a2[2], 253u);
      c[3] = mkc(a1[0], a2[3], 252u);
      c[4] = mkc(a1[0], a2[4], 251u);
      c[5] = mkc(a1[0], a2[5], 250u);
      c[6] = mkc(a1[0], a2[6], 249u);
      c[7] = mkc(a1[0], a2[7], 248u);
      c[8] = mkc(a1[0], a2[8], 247u);
      c[9] = mkc(a1[0], a2[9], 246u);
      c[10] = mkc(a1[0], a2[10], 245u);
      c[11] = mkc(a1[0], a2[11], 244u);
      c[12] = mkc(a1[0], a2[12], 243u);
      c[13] = mkc(a1[0], a2[13], 242u);
      c[14] = mkc(a1[0], a2[14], 241u);
      c[15] = mkc(a1[0], a2[15], 240u);
      sort16_desc(c); _Pragma("unroll") for (int k = 0; k < 16; ++k) top[k] = c[k];
    }
    { float c[16];
      c[0] = mkc(a1[1], a2[0], 239u);
      c[1] = mkc(a1[1], a2[1], 238u);
      c[2] = mkc(a1[1], a2[2], 237u);
      c[3] = mkc(a1[1], a2[3], 236u);
      c[4] = mkc(a1[1], a2[4], 235u);
      c[5] = mkc(a1[1], a2[5], 234u);
      c[6] = mkc(a1[1], a2[6], 233u);
      c[7] = mkc(a1[1], a2[7], 232u);
      c[8] = mkc(a1[2], a2[0], 223u);
      c[9] = mkc(a1[2], a2[1], 222u);
      c[10] = mkc(a1[2], a2[2], 221u);
      c[11] = mkc(a1[2], a2[3], 220u);
      c[12] = mkc(a1[2], a2[4], 219u);
      c[13] = mkc(a1[3], a2[0], 207u);
      c[14] = mkc(a1[3], a2[1], 206u);
      c[15] = mkc(a1[3], a2[2], 205u);
      sort16_desc(c); merge16(top, c);
    }
    { float c[16];
      c[0] = mkc(a1[3], a2[3], 204u);
      c[1] = mkc(a1[4], a2[0], 191u);
      c[2] = mkc(a1[4], a2[1], 190u);
      c[3] = mkc(a1[4], a2[2], 189u);
      c[4] = mkc(a1[5], a2[0], 175u);
      c[5] = mkc(a1[5], a2[1], 174u);
      c[6] = mkc(a1[6], a2[0], 159u);
      c[7] = mkc(a1[6], a2[1], 158u);
      c[8] = mkc(a1[7], a2[0], 143u);
      c[9] = mkc(a1[7], a2[1], 142u);
      c[10] = mkc(a1[8], a2[0], 127u);
      c[11] = mkc(a1[9], a2[0], 111u);
      c[12] = mkc(a1[10], a2[0], 95u);
      c[13] = mkc(a1[11], a2[0], 79u);
      c[14] = mkc(a1[12], a2[0], 63u);
      c[15] = mkc(a1[13], a2[0], 47u);
      sort16_desc(c); merge16(top, c);
    }
    { float c[16];
      c[0] = mkc(a1[14], a2[0], 31u);
      c[1] = mkc(a1[15], a2[0], 15u);
      c[2] = -3.0e38f;
      c[3] = -3.0e38f;
      c[4] = -3.0e38f;
      c[5] = -3.0e38f;
      c[6] = -3.0e38f;
      c[7] = -3.0e38f;
      c[8] = -3.0e38f;
      c[9] = -3.0e38f;
      c[10] = -3.0e38f;
      c[11] = -3.0e38f;
      c[12] = -3.0e38f;
      c[13] = -3.0e38f;
      c[14] = -3.0e38f;
      c[15] = -3.0e38f;
      sort16_desc(c); merge16(top, c);
    }
                float e[16], es = 0.f; const float m0 = __uint_as_float(__float_as_uint(top[0]) & 0xFFFFFF00u);
#pragma unroll
                for (int k = 0; k < 16; ++k) { e[k] = __expf(__uint_as_float(__float_as_uint(top[k]) & 0xFFFFFF00u) - m0); es += e[k]; }
                const float inv = 1.0f / es; const size_t ob = (size_t)(row0 + row) * 128 + h * 16;
#pragma unroll
                for (int k = 0; k < 16; ++k) { const unsigned code = 255u - (__float_as_uint(top[k]) & 0xFFu); const int i = code >> 4, j = code & 15;
                    const int i1 = 127 - (int)(__float_as_uint(Ls[row * 16 + i]) & 0x7Fu), i2 = 127 - (int)(__float_as_uint(Ls[(128 + row) * 16 + j]) & 0x7Fu);
                    idxb[ob + k] = i1 * 128 + i2; gb[ob + k] = e[k] * inv; }
            }
            __syncthreads();
        }
        }
        __syncthreads();
    }
}

constexpr int P4_LIST = 192;
struct TokState { f32x2 acc[8]; int offv; float sh; };

struct Rows4 { u32x4 r[4]; };
__device__ __forceinline__ void rows_load(Rows4& B, const unsigned char* __restrict__ Etab, const int* sidp, int lane) {
    const u32x4 ids = *(const u32x4*)sidp;
    const int e0 = __builtin_amdgcn_readfirstlane((int)ids.x), e1 = __builtin_amdgcn_readfirstlane((int)ids.y), e2 = __builtin_amdgcn_readfirstlane((int)ids.z), e3 = __builtin_amdgcn_readfirstlane((int)ids.w);
    B.r[0] = *(const u32x4*)(Etab + (size_t)e0 * 1024 + lane * 16); B.r[1] = *(const u32x4*)(Etab + (size_t)e1 * 1024 + lane * 16);
    B.r[2] = *(const u32x4*)(Etab + (size_t)e2 * 1024 + lane * 16); B.r[3] = *(const u32x4*)(Etab + (size_t)e3 * 1024 + lane * 16);
}
__device__ __forceinline__ int dpp_addi(int t, const int ctrl_sel) {
    if (ctrl_sel == 0) return t + __builtin_amdgcn_update_dpp(0, t, 0xB1, 0xF, 0xF, false);
    if (ctrl_sel == 1) return t + __builtin_amdgcn_update_dpp(0, t, 0x4E, 0xF, 0xF, false);
    if (ctrl_sel == 2) return t + __builtin_amdgcn_update_dpp(0, t, 0x141, 0xF, 0xF, false);
    return t + __builtin_amdgcn_update_dpp(0, t, 0x140, 0xF, 0xF, false);
}
__device__ __forceinline__ void g_compute2(const Rows4& D, const Rows4& U, const u32x4 hq, TokState& T, float sdl, float gwl) {
    int s[4];
#pragma unroll
    for (int j = 0; j < 4; ++j) { int a = 0;
#pragma unroll
        for (int q = 0; q < 4; ++q) a = __builtin_amdgcn_sdot4((int)D.r[j][q], (int)hq[q], a, false);
        s[j] = a; }
    auto r0 = __builtin_amdgcn_permlane32_swap((unsigned)s[0], (unsigned)s[1], false, false);
    auto r1 = __builtin_amdgcn_permlane32_swap((unsigned)s[2], (unsigned)s[3], false, false);
    const int r01 = (int)r0[0] + (int)r0[1], r23 = (int)r1[0] + (int)r1[1];
    auto r2 = __builtin_amdgcn_permlane16_swap((unsigned)r01, (unsigned)r23, false, false);
    int ti = (int)r2[0] + (int)r2[1];
    ti = dpp_addi(ti, 0); ti = dpp_addi(ti, 1); ti = dpp_addi(ti, 2); ti = dpp_addi(ti, 3);
    const float t = (float)ti * T.sh;
    const float w = gwl * gelu_tanh(sdl * t);
    float wj[4];
    wj[0] = __int_as_float(__builtin_amdgcn_readlane(__float_as_int(w), 0)); wj[1] = __int_as_float(__builtin_amdgcn_readlane(__float_as_int(w), 32));
    wj[2] = __int_as_float(__builtin_amdgcn_readlane(__float_as_int(w), 16)); wj[3] = __int_as_float(__builtin_amdgcn_readlane(__float_as_int(w), 48));
#pragma unroll
    for (int j = 0; j < 4; ++j) { const f32x2 ws = {wj[j], wj[j]};
#pragma unroll
        for (int q = 0; q < 4; ++q) { const int w2 = (int)U.r[j][q]; const f32x2 lo = __builtin_amdgcn_cvt_pk_f32_fp8(w2, false), hi = __builtin_amdgcn_cvt_pk_f32_fp8(w2, true);
            T.acc[2 * q] = __builtin_elementwise_fma(lo, ws, T.acc[2 * q]); T.acc[2 * q + 1] = __builtin_elementwise_fma(hi, ws, T.acc[2 * q + 1]); }
        __builtin_amdgcn_sched_barrier(0); }
}

template <int FAKE> __device__ void phase4(const Params& p, unsigned char* lds) {
    const int tid = threadIdx.x, lane = tid & 63, wid = __builtin_amdgcn_readfirstlane(tid >> 6);
    unsigned char* ws = p.ws;
    const bf16_t* hbuf = (const bf16_t*)(ws + OFF_HBUF); const int* idxb = (const int*)(ws + OFF_IDX); const float* gb = (const float*)(ws + OFF_G);
    const unsigned char* Ed = ws + OFF_E8; const unsigned char* Eu = ws + OFF_E8 + (size_t)16384 * 1024; const float* esc = (const float*)(ws + OFF_ESC);
    int* sid = (int*)(lds + wid * (3 * 4 * P4_LIST * 4)); float* sgw = (float*)(sid + 4 * P4_LIST); float* ssd = sgw + 4 * P4_LIST;
    unsigned char* hql = lds + 8 * (3 * 4 * P4_LIST * 4) + wid * 4096;
    const int jl = ((lane >> 4) & 1) * 2 + (lane >> 5);
    for (int tile = blockIdx.x; tile < 256; tile += gridDim.x) {
        const int row0 = tile * 128, b = row0 >> 11;
        const float* gf = (const float*)(ws + OFF_MODT) + (size_t)tile * 6144 + 5120 + lane * 16;
#pragma unroll 1
        for (int st = 0; st < 4; ++st) {
            const int tokb = row0 + st * 32 + wid * 4;
            TokState T0, T1, T2, T3;
#define P4_PRO(T, j) { const size_t tok = tokb + (j); \
                int id0 = idxb[tok * 128 + lane], id1 = idxb[tok * 128 + 64 + lane]; if (FAKE) { id0 = (id0 & ~1023) | (id0 & 31); id1 = (id1 & ~1023) | (id1 & 31); } \
                const float sd0 = esc[id0], sd1 = esc[id1], gw0 = gb[tok * 128 + lane] * esc[16384 + id0], gw1 = gb[tok * 128 + 64 + lane] * esc[16384 + id1]; \
                _Pragma("unroll") for (int i = 0; i < 8; ++i) T.acc[i] = (f32x2){0.f, 0.f}; \
                { const u32x4 w0 = *(const u32x4*)(hbuf + tok * 1024 + lane * 16), w1 = *(const u32x4*)(hbuf + tok * 1024 + lane * 16 + 8); \
                  float hv[16] = {bflo(w0.x), bfhi(w0.x), bflo(w0.y), bfhi(w0.y), bflo(w0.z), bfhi(w0.z), bflo(w0.w), bfhi(w0.w), bflo(w1.x), bfhi(w1.x), bflo(w1.y), bfhi(w1.y), bflo(w1.z), bfhi(w1.z), bflo(w1.w), bfhi(w1.w)}; \
                  float am = 0.f; _Pragma("unroll") for (int i = 0; i < 16; ++i) am = fmaxf(am, fabsf(hv[i])); \
                  _Pragma("unroll") for (int o = 1; o < 64; o <<= 1) am = fmaxf(am, __shfl_xor(am, o)); \
                  const float sc = (am > 0.f) ? am * (1.0f / 127.0f) : 1.0f, inv = 1.0f / sc; T.sh = sc; u32x4 hq; \
                  _Pragma("unroll") for (int q = 0; q < 4; ++q) { const int b0 = (int)rintf(hv[4 * q] * inv), b1 = (int)rintf(hv[4 * q + 1] * inv), b2 = (int)rintf(hv[4 * q + 2] * inv), b3 = (int)rintf(hv[4 * q + 3] * inv); \
                      hq[q] = (unsigned)(b0 & 0xFF) | ((unsigned)(b1 & 0xFF) << 8) | ((unsigned)(b2 & 0xFF) << 16) | ((unsigned)(b3 & 0xFF) << 24); } \
                  *(u32x4*)(hql + (j) * 1024 + lane * 16) = hq; } \
                const int sl0 = id0 >> 10, sl1 = id1 >> 10; int po = 0, offv = 0, pos0 = 0, pos1 = 0; \
                _Pragma("unroll 1") for (int s = 0; s < 16; ++s) { \
                    const unsigned long long m0 = __ballot(sl0 == s), m1 = __ballot(sl1 == s); const int c0 = __popcll(m0), c = c0 + __popcll(m1); \
                    if (lane == s) offv = (po + 3) & ~3; \
                    if (sl0 == s) pos0 = po + (int)__builtin_amdgcn_mbcnt_hi((unsigned)(m0 >> 32), __builtin_amdgcn_mbcnt_lo((unsigned)m0, 0u)); \
                    if (sl1 == s) pos1 = po + c0 + (int)__builtin_amdgcn_mbcnt_hi((unsigned)(m1 >> 32), __builtin_amdgcn_mbcnt_lo((unsigned)m1, 0u)); \
                    po += c; } \
                if (lane == 16) offv = 128; T.offv = offv; \
                sid[(j) * P4_LIST + pos0] = id0; sgw[(j) * P4_LIST + pos0] = gw0; ssd[(j) * P4_LIST + pos0] = sd0; \
                sid[(j) * P4_LIST + pos1] = id1; sgw[(j) * P4_LIST + pos1] = gw1; ssd[(j) * P4_LIST + pos1] = sd1; }
            P4_PRO(T0, 0) P4_PRO(T1, 1) P4_PRO(T2, 2) P4_PRO(T3, 3)
#undef P4_PRO
            asm volatile("s_waitcnt lgkmcnt(0)" ::: "memory");
#define P4_ITEM(T, j) { const int st_ = __builtin_amdgcn_readlane(T.offv, s), en_ = __builtin_amdgcn_readlane(T.offv, s + 1); \
                if (st_ < en_) { const u32x4 hq = *(const u32x4*)(hql + (j) * 1024 + lane * 16); \
                    _Pragma("unroll 1") for (int i = st_; i < en_; i += 4) { Rows4 D, U; rows_load(D, Ed, sid + (j) * P4_LIST + i, lane); rows_load(U, Eu, sid + (j) * P4_LIST + i, lane); \
                        g_compute2(D, U, hq, T, ssd[(j) * P4_LIST + i + jl], sgw[(j) * P4_LIST + i + jl]); } } }
#pragma unroll 1
            for (int s = 0; s < 16; ++s) { P4_ITEM(T0, 0) P4_ITEM(T1, 1) P4_ITEM(T2, 2) P4_ITEM(T3, 3) }
#undef P4_ITEM
#define P4_EPI(T, j) { float* orow = p.out + (size_t)(tokb + (j)) * 1024 + lane * 16; \
                _Pragma("unroll") for (int q = 0; q < 4; ++q) { f32x4 o = *(const f32x4*)(orow + 4 * q); const f32x4 gg = *(const f32x4*)(gf + 4 * q); \
                    o.x += gg.x * T.acc[2 * q].x; o.y += gg.y * T.acc[2 * q].y; o.z += gg.z * T.acc[2 * q + 1].x; o.w += gg.w * T.acc[2 * q + 1].y; if (FAKE) asm volatile("" :: "v"(o.x), "v"(o.y), "v"(o.z), "v"(o.w)); else *(f32x4*)(orow + 4 * q) = o; } }
            P4_EPI(T0, 0) P4_EPI(T1, 1) P4_EPI(T2, 2) P4_EPI(T3, 3)
#undef P4_EPI
        }
    }
}

#define LAS __attribute__((address_space(3)))
#define XB_TMO      128
#define XB_XCNT(j)  (256  + 64 * (j))
#define XB_XSUB(j)  (1280 + 64 * (j))
#define XB_XGEN(j)  (2304 + 64 * (j))
#define XB_TOP      3328
#define XB_TOPGEN   3392
#define XCD_BAR_WORDS 3456
#define XB_SPIN_CAP (1u << 18)

__device__ __forceinline__ unsigned xb_ld(unsigned* p)              { return __hip_atomic_load(p, __ATOMIC_RELAXED, __HIP_MEMORY_SCOPE_AGENT); }
__device__ __forceinline__ unsigned xb_add(unsigned* p, unsigned v) { return __hip_atomic_fetch_add(p, v, __ATOMIC_RELAXED, __HIP_MEMORY_SCOPE_AGENT); }
__device__ __forceinline__ unsigned xb_xcc_id() { return (unsigned)__builtin_amdgcn_s_getreg((3 << 11) | 20) & 0xFu; }
#define XB_SPIN(cond, bar) do { unsigned _sp = 0; while (cond) { __builtin_amdgcn_s_sleep(1); \
    if ((++_sp & 255u) == 0u) { if (xb_ld(&(bar)[XB_TMO])) break; if (_sp > XB_SPIN_CAP) { atomicAdd(&(bar)[XB_TMO], 1u); break; } } } } while (0)

struct XcdBarrier {
    unsigned* bar; unsigned x;
    volatile LAS unsigned* st;
};

__device__ __forceinline__ XcdBarrier xcd_barrier_post(unsigned* bar, volatile LAS unsigned* st) {
    XcdBarrier b; b.bar = bar; b.x = xb_xcc_id(); b.st = st;
    if (threadIdx.x == 0) (void)xb_add(&bar[XB_XCNT(b.x)], 1u);
    return b;
}
__device__ __forceinline__ void xcd_barrier_complete(unsigned* bar, unsigned x, unsigned& nloc, unsigned& nx) {
    const unsigned G = gridDim.x * gridDim.y * gridDim.z;
    unsigned sum, cnt, mine, sp = 0u;
    for (;;) {
        sum = 0u; cnt = 0u; mine = 0u;
#pragma unroll
        for (unsigned j = 0; j < 16; ++j) { const unsigned c = xb_ld(&bar[XB_XCNT(j)]); sum += c; cnt += (c > 0u) ? 1u : 0u; mine = (j == x) ? c : mine; }
        if (sum == G) break;
        __builtin_amdgcn_s_sleep(1);
        if ((++sp & 255u) == 0u) { if (xb_ld(&bar[XB_TMO])) break; if (sp > XB_SPIN_CAP) { atomicAdd(&bar[XB_TMO], 1u); break; } }
    }
    nloc = mine > 0u ? mine : 1u; nx = cnt > 0u ? cnt : 1u;
}

__device__ __forceinline__ void xcd_barrier(const XcdBarrier& b) {
    asm volatile("s_waitcnt vmcnt(0)" ::: "memory");
    __syncthreads();
    if (threadIdx.x == 0) {
        unsigned* bar = b.bar;
        __builtin_amdgcn_s_waitcnt(0);
        unsigned nloc = b.st[0], nx = b.st[1];
        if (nloc == 0u) { xcd_barrier_complete(bar, b.x, nloc, nx); b.st[0] = nloc; b.st[1] = nx; }
        const unsigned old = xb_add(&bar[XB_XSUB(b.x)], 1u);
        const unsigned gen = old / nloc;
        if (old + 1u == (gen + 1u) * nloc) {
            __builtin_amdgcn_fence(__ATOMIC_RELEASE, "agent");
            asm volatile("s_waitcnt vmcnt(0)" ::: "memory");
            const unsigned og = xb_add(&bar[XB_TOP], 1u);
            const unsigned tg = og / nx;
            if (og + 1u == (tg + 1u) * nx) xb_add(&bar[XB_TOPGEN], 1u);
            else XB_SPIN(xb_ld(&bar[XB_TOPGEN]) == tg, bar);
            __builtin_amdgcn_fence(__ATOMIC_ACQUIRE, "agent");
            xb_add(&bar[XB_XGEN(b.x)], 1u);
            asm volatile("s_waitcnt vmcnt(0)" ::: "memory");
        } else {
            XB_SPIN(xb_ld(&bar[XB_XGEN(b.x)]) == gen, bar);
            __builtin_amdgcn_fence(__ATOMIC_ACQUIRE, "agent");
            asm volatile("s_waitcnt vmcnt(0)" ::: "memory");
        }
    }
    __syncthreads();
}

__global__ void __launch_bounds__(NTHR, 2) fwd_kernel(Params p) {
    extern __shared__ __attribute__((aligned(16))) unsigned char lds[];
#if MK_COOP
    volatile LAS unsigned* bst = (volatile LAS unsigned*)(lds + LDS_BYTES - 16);
    if (threadIdx.x < 2) bst[threadIdx.x] = 0u;
    __syncthreads();
    const XcdBarrier xbar = xcd_barrier_post((unsigned*)(p.ws + OFF_BAR), bst);
#endif
    if (p.ph_lo <= 0 && 0 < p.ph_hi) { phase0(p, lds); if (PROBE_REP & 1) { __syncthreads(); phase0(p, lds); } }
#if MK_COOP
    if (p.ph_lo <= 0 && 1 < p.ph_hi) cg::this_grid().sync();
#endif
    if (p.ph_lo <= 1 && 1 < p.ph_hi) { phase1(p, lds); if (PROBE_REP & 2) { __syncthreads(); phase1(p, lds); } }
#if MK_COOP
    if (p.ph_lo <= 1 && 2 < p.ph_hi) xcd_barrier(xbar);
#endif
    if (p.ph_lo <= 2 && 2 < p.ph_hi) { phase2(p, lds); if (PROBE_REP & 4) { __syncthreads(); phase2(p, lds); } }
#if MK_COOP
    if (p.ph_lo <= 2 && 3 < p.ph_hi) xcd_barrier(xbar);
#endif
    if (p.ph_lo <= 3 && 3 < p.ph_hi) phase3(p, lds);
#if MK_COOP
    if (p.ph_lo <= 3 && 4 < p.ph_hi) xcd_barrier(xbar);
#endif
    if (p.ph_lo <= 4 && 4 < p.ph_hi) { if (PROBE_REP & 2048) { phase4<1>(p, lds); __syncthreads(); } phase4<0>(p, lds); }
}

extern "C" void kernel_launch(void* const* d_in, const int* in_sizes, int n_in, void* d_out, int out_size, void* d_ws, size_t ws_size, hipStream_t stream) {
    static int grid = 0;
    if (grid == 0) {
        if (n_in != 31 || ws_size < WS_NEED) { fprintf(stderr, "kernel_launch: bad inputs (n_in %d, ws %zu < %zu)\n", n_in, ws_size, (size_t)WS_NEED); grid = -1; return; }
        int dev = 0, cus = 0, per_cu = 0;
        hipGetDevice(&dev); hipDeviceGetAttribute(&cus, hipDeviceAttributeMultiprocessorCount, dev);
        if (hipFuncSetAttribute((const void*)fwd_kernel, hipFuncAttributeMaxDynamicSharedMemorySize, LDS_BYTES) != hipSuccess) { fprintf(stderr, "kernel_launch: hipFuncSetAttribute failed\n"); grid = -1; return; }
        hipOccupancyMaxActiveBlocksPerMultiprocessor(&per_cu, (const void*)fwd_kernel, NTHR, LDS_BYTES);
        if (per_cu < 1) { fprintf(stderr, "kernel_launch: occupancy query says %d blocks/CU\n", per_cu); per_cu = 1; }
        grid = cus;
        (void)hipGetLastError();
    }
    if (grid < 0) return;
    (void)hipMemsetAsync((char*)d_ws + OFF_BAR, 0, 16384, stream);
    Params p{};
    const float** f = (const float**)&p;
    for (int i = 0; i < 31; ++i) f[i] = (const float*)d_in[i];
    p.out = (float*)d_out; p.ws = (unsigned char*)d_ws;
#if MK_COOP
    p.ph_lo = 0; p.ph_hi = 5;
    void* args[] = {&p};
    hipError_t e = hipLaunchCooperativeKernel((const void*)fwd_kernel, dim3(grid), dim3(NTHR), args, LDS_BYTES, stream);
    if (e != hipSuccess) fprintf(stderr, "cooperative launch failed: %s (grid %d)\n", hipGetErrorString(e), grid);
#else
    for (int ph = 0; ph < 5; ++ph) { p.ph_lo = ph; p.ph_hi = ph + 1; hipLaunchKernelGGL(fwd_kernel, dim3(grid), dim3(NTHR), LDS_BYTES, stream, p); }
#endif
}
```

```cpp
#include <hip/hip_runtime.h>
#include <hip/hip_cooperative_groups.h>
#include <cstdio>
#include <cstdint>
namespace cg = cooperative_groups;

#ifndef PROBE_REP
#define PROBE_REP 0
#endif
#ifndef MK_COOP
#define MK_COOP 1
#endif

typedef unsigned short bf16_t;
typedef short bf16x8 __attribute__((ext_vector_type(8)));
typedef short s16x4 __attribute__((ext_vector_type(4)));
typedef float f32x16 __attribute__((ext_vector_type(16)));
typedef float f32x4 __attribute__((ext_vector_type(4)));
typedef float f32x2 __attribute__((ext_vector_type(2)));
typedef unsigned u32x4 __attribute__((ext_vector_type(4)));
typedef unsigned u32x2 __attribute__((ext_vector_type(2)));

constexpr int NTHR = 512, NWAVE = 8;
constexpr int T_TOK = 32768, DM = 1024, NB = 16, SEQ = 2048;
constexpr int LDS_BYTES = 163840;
constexpr float EPS = 1e-6f;
constexpr float QSCALE = 0.10206207261596575f * 1.4426950408889634f;

constexpr size_t OFF_PART  = 0;
constexpr size_t OFF_MODT  = 8u << 20;
constexpr size_t OFF_WINT  = 16u << 20;
constexpr size_t OFF_WGLUT = OFF_WINT + (2u << 20);
constexpr size_t OFF_WUQT  = OFF_WGLUT + (512u << 10);
constexpr size_t OFF_WUKVT = OFF_WUQT + 524288;
constexpr size_t OFF_WOUTT = OFF_WUKVT + 262144;
constexpr size_t OFF_WQT   = OFF_WOUTT + (2u << 20);
constexpr size_t OFF_SUBK  = OFF_WQT + (4u << 20);
constexpr size_t OFF_KMT   = OFF_SUBK + 65536;
constexpr size_t OFF_WZT   = OFF_KMT + 20971520;
constexpr size_t OFF_AL    = OFF_WZT + 4194304;
constexpr size_t OFF_HBUF  = OFF_AL + 16384;
constexpr size_t OFF_PROJ2 = OFF_HBUF + (64u << 20);
constexpr size_t OFF_UBUF  = OFF_PROJ2 + (32u << 20);
constexpr size_t OFF_Q     = OFF_UBUF + 41943040;
constexpr size_t OFF_K     = OFF_Q + 50331648;
constexpr size_t OFF_VT    = OFF_K + 50331648;
constexpr size_t OFF_YBUF  = OFF_VT + 33554432;
constexpr size_t OFF_IDX   = OFF_YBUF + (32u << 20);
constexpr size_t OFF_G     = OFF_IDX + (16u << 20);
constexpr size_t OFF_E8    = OFF_G + (16u << 20);
constexpr size_t OFF_ESC   = OFF_E8 + (32u << 20);
constexpr size_t OFF_BAR   = OFF_ESC + (1u << 20);
constexpr size_t WS_NEED   = OFF_BAR + (1u << 20);

struct Params {
    const float* x; const float* c; const int* pos; const float* w_ada; const float* b_ada; const float* norm_mix; const float* norm_ffn; const float* w_in;
    const float* lam_re; const float* lam_im; const float* log_dt; const float* b_re; const float* b_im; const float* c_re; const float* c_im; const float* d_skip;
    const float* w_glu; const float* b_glu; const float* q_a_norm; const float* w_uq; const float* kv_a_norm; const float* w_ukv; const float* q_norm; const float* k_norm;
    const float* out_norm_ssm; const float* out_norm_attn; const float* w_out; const float* w_query; const float* sub_keys; const float* e_down; const float* e_up;
    float* out; unsigned char* ws; int ph_lo, ph_hi;
};

__device__ __forceinline__ unsigned f2bf(float f) { unsigned u = __float_as_uint(f); return (u + 0x7fffu + ((u >> 16) & 1u)) >> 16; }
typedef __bf16 hwbf16x2 __attribute__((ext_vector_type(2)));
__device__ __forceinline__ unsigned pk2(float lo, float hi) { const f32x2 v = {lo, hi}; return __builtin_bit_cast(unsigned, __builtin_convertvector(v, hwbf16x2)); }
__device__ __forceinline__ float bf2f(unsigned short b) { return __uint_as_float(((unsigned)b) << 16); }
__device__ __forceinline__ float bflo(unsigned w) { return __uint_as_float(w << 16); }
__device__ __forceinline__ float bfhi(unsigned w) { return __uint_as_float(w & 0xffff0000u); }
__device__ __forceinline__ int opq_s(int x) { asm volatile("" : "+s"(x)); return x; }
__device__ __forceinline__ int opq_v(int x) { asm volatile("" : "+v"(x)); return x; }
template <class T> __device__ __forceinline__ T* opq_p(T* x) { asm volatile("" : "+s"(x)); return x; }
__device__ __forceinline__ int crow(int r, int hi) { return (r & 3) + 8 * (r >> 2) + 4 * hi; }
__device__ __forceinline__ float wave_sum(float v) {
#pragma unroll
    for (int o = 1; o < 64; o <<= 1) v += __shfl_xor(v, o);
    return v;
}
__device__ __forceinline__ float gelu_tanh(float x) {
    const float u = 0.7978845608028654f * (x + 0.044715f * x * x * x);
    const float t = 1.0f - 2.0f * __builtin_amdgcn_rcpf(1.0f + __expf(2.0f * u));
    return 0.5f * x * (1.0f + t);
}
__device__ __forceinline__ float sigmoidf_(float z) { return __builtin_amdgcn_rcpf(1.0f + __expf(-z)); }

constexpr int G_STR = 144;
constexpr int G_ABYTES = 128 * G_STR;
template <int NT> struct GemmCfg { static constexpr int BN = 128 * NT, BBYTES = BN * G_STR, STAGE = G_ABYTES + BBYTES; };

struct ARow { const bf16_t* A; int lda; __device__ __forceinline__ const bf16_t* operator()(int row, int k) const { return A + (size_t)row * lda + k; }
              __device__ __forceinline__ size_t kstep32() const { return 32; } };
struct AGrp { const bf16_t* Y; __device__ __forceinline__ const bf16_t* operator()(int row, int k) const { return Y + ((size_t)(k >> 4) * T_TOK + row) * 16 + (k & 15); }
              __device__ __forceinline__ size_t kstep32() const { return (size_t)2 * T_TOK * 16; } };
constexpr int CSTR = 260;

#ifndef GEMM_GLDS
#define GEMM_GLDS 1
#endif
#ifndef GEMM16
#define GEMM16 0
#endif
#if GEMM16
template <int NT, int MODE, int MID, int NST, class AL, class Epi>
__device__ __forceinline__ void gemm_128(const AL aload, const bf16_t* __restrict__ Bt, int ldb, int K, unsigned char* lds, const float* midscale, Epi epi) {
    typedef GemmCfg<NT> C;
    const int tid = opq_v((int)threadIdx.x), lane = tid & 63, wid = __builtin_amdgcn_readfirstlane(tid >> 6), wm = wid >> 2, wn = wid & 3, fr = lane & 15, fq = lane >> 4;
    f32x4 acc[4][2 * NT];
#pragma unroll
    for (int i = 0; i < 4; ++i)
#pragma unroll
        for (int j = 0; j < 2 * NT; ++j) acc[i][j] = (f32x4){0.f, 0.f, 0.f, 0.f};
    const int prow = tid >> 3, pc = tid & 7;
    const bf16_t* gb = Bt + (size_t)prow * ldb + pc * 8;
    const int ldsoff = prow * G_STR + pc * 16;
    u32x4 ra[2], rb[2 * NT];
    const int nk = K >> 6;
#pragma unroll
    for (int q = 0; q < 2; ++q) ra[q] = *(const u32x4*)aload(prow + 64 * q, pc * 8);
#pragma unroll
    for (int q = 0; q < 2 * NT; ++q) rb[q] = *(const u32x4*)(gb + (size_t)(64 * q) * ldb);
#pragma unroll
    for (int q = 0; q < 2; ++q) *(u32x4*)(lds + ldsoff + q * 64 * G_STR) = ra[q];
#pragma unroll
    for (int q = 0; q < 2 * NT; ++q) *(u32x4*)(lds + G_ABYTES + ldsoff + q * 64 * G_STR) = rb[q];
    __syncthreads();
    for (int kt = 0; kt < nk; ++kt) {
        unsigned char* st = lds + (kt & 1) * C::STAGE;
        if (kt + 1 < nk) {
#pragma unroll
            for (int q = 0; q < 2; ++q) ra[q] = *(const u32x4*)aload(prow + 64 * q, (kt + 1) * 64 + pc * 8);
#pragma unroll
            for (int q = 0; q < 2 * NT; ++q) rb[q] = *(const u32x4*)(gb + (size_t)(64 * q) * ldb + (kt + 1) * 64);
        }
        if (MID > 0 && kt == MID) {
#pragma unroll
            for (int i = 0; i < 4; ++i)
#pragma unroll
                for (int r = 0; r < 4; ++r) { const float sc = midscale[wm * 64 + i * 16 + fq * 4 + r];
#pragma unroll
                    for (int j = 0; j < 2 * NT; ++j) acc[i][j][r] *= sc; }
        }
        const unsigned char* pa = st + (wm * 64 + fr) * G_STR + fq * 16;
        const unsigned char* pb = st + G_ABYTES + (wn * 32 * NT + fr) * G_STR + fq * 16;
#pragma unroll
        for (int ks = 0; ks < 2; ++ks) {
            bf16x8 af[4], bfr[2 * NT];
#pragma unroll
            for (int i = 0; i < 4; ++i) af[i] = *(const bf16x8*)(pa + i * 16 * G_STR + ks * 64);
#pragma unroll
            for (int j = 0; j < 2 * NT; ++j) bfr[j] = *(const bf16x8*)(pb + j * 16 * G_STR + ks * 64);
#pragma unroll
            for (int i = 0; i < 4; ++i)
#pragma unroll
                for (int j = 0; j < 2 * NT; ++j) acc[i][j] = __builtin_amdgcn_mfma_f32_16x16x32_bf16(af[i], bfr[j], acc[i][j], 0, 0, 0);
        }
        if (kt + 1 < nk) {
            unsigned char* sn = lds + ((kt + 1) & 1) * C::STAGE;
#pragma unroll
            for (int q = 0; q < 2; ++q) *(u32x4*)(sn + ldsoff + q * 64 * G_STR) = ra[q];
#pragma unroll
            for (int q = 0; q < 2 * NT; ++q) *(u32x4*)(sn + G_ABYTES + ldsoff + q * 64 * G_STR) = rb[q];
        }
        __syncthreads();
    }
    if constexpr (MODE == 0) {
#pragma unroll
        for (int i = 0; i < 4; ++i)
#pragma unroll
            for (int j = 0; j < 2 * NT; ++j)
#pragma unroll
                for (int r = 0; r < 4; ++r) epi(wm * 64 + i * 16 + fq * 4 + r, wn * 32 * NT + j * 16 + fr, acc[i][j][r]);
    } else {
        float* Ct = (float*)lds;
#pragma unroll
        for (int i = 0; i < 4; ++i)
#pragma unroll
            for (int j = 0; j < 2 * NT; ++j)
#pragma unroll
                for (int r = 0; r < 4; ++r) Ct[(wm * 64 + i * 16 + fq * 4 + r) * CSTR + wn * 32 * NT + j * 16 + fr] = acc[i][j][r];
        __syncthreads();
        epi((const float*)Ct);
        __syncthreads();
    }
}

#elif GEMM_GLDS
template <int NT, int MODE, int MID, int NST, class AL, class Epi>
__device__ __forceinline__ void gemm_128(const AL aload, const bf16_t* __restrict__ Bt, int ldb, int K, unsigned char* lds, const float* midscale, Epi epi) {
    typedef GemmCfg<NT> C;
    const int tid = opq_v((int)threadIdx.x), lane = tid & 63, wid = __builtin_amdgcn_readfirstlane(tid >> 6), wm = wid >> 2, wn = wid & 3, r32 = lane & 31, hi = lane >> 5;
    f32x16 acc[2][NT];
#pragma unroll
    for (int i = 0; i < 2; ++i)
#pragma unroll
        for (int j = 0; j < NT; ++j)
#pragma unroll
            for (int r = 0; r < 16; ++r) acc[i][j][r] = 0.f;
    typedef __attribute__((address_space(3))) unsigned char lds_uc;
    lds_uc* ldsl = (lds_uc*)lds;
    const int srow = wid * 8 + (lane >> 3), schunk = ((lane & 7) ^ ((srow >> 1) & 7)) * 8;
    const bf16_t* gb = Bt + (size_t)srow * ldb + schunk;
    const int nk = K >> 6;
    constexpr int SA = 128 * 128, SB = 128 * NT * 128, SSTAGE = SA + SB;
#define GL_STAGE(stg, kk) do { \
        _Pragma("unroll") for (int q = 0; q < 2; ++q) __builtin_amdgcn_global_load_lds((const unsigned*)aload(srow + 64 * q, (kk) * 64 + schunk), (__attribute__((address_space(3))) unsigned*)(ldsl + (stg) * SSTAGE + q * 8192 + wid * 1024), 16, 0, 0); \
        _Pragma("unroll") for (int q = 0; q < 2 * NT; ++q) __builtin_amdgcn_global_load_lds((const unsigned*)(gb + (size_t)(64 * q) * ldb + (kk) * 64), (__attribute__((address_space(3))) unsigned*)(ldsl + (stg) * SSTAGE + SA + q * 8192 + wid * 1024), 16, 0, 0); } while (0)
#define GL_WAITN() do { if constexpr (NT == 2) asm volatile("s_waitcnt vmcnt(6)" ::: "memory"); else asm volatile("s_waitcnt vmcnt(4)" ::: "memory"); } while (0)
#define GL_BAR() asm volatile("s_waitcnt lgkmcnt(0)\n\ts_barrier" ::: "memory")
    GL_STAGE(0, 0);
    if (NST == 3 && nk > 1) { GL_STAGE(1, 1); GL_WAITN(); } else asm volatile("s_waitcnt vmcnt(0)" ::: "memory");
    GL_BAR();
    const int swz = (r32 >> 1) & 7;
    int cofs[4];
#pragma unroll
    for (int ks = 0; ks < 4; ++ks) cofs[ks] = ((((ks << 1) | hi) ^ swz) << 4);
    for (int kt = 0; kt < nk; ++kt) {
        const unsigned char* st = lds + (kt % NST) * SSTAGE;
        if (kt + NST - 1 < nk) GL_STAGE((kt + NST - 1) % NST, kt + NST - 1);
        if (MID > 0 && kt == MID) {
#pragma unroll
            for (int i = 0; i < 2; ++i)
#pragma unroll
                for (int r = 0; r < 16; ++r) { const float sc = midscale[wm * 64 + i * 32 + crow(r, hi)];
#pragma unroll
                    for (int j = 0; j < NT; ++j) acc[i][j][r] *= sc; }
        }
        const unsigned char* pa = st + (wm * 64 + r32) * 128;
        const unsigned char* pb = st + SA + (wn * 32 * NT + r32) * 128;
#pragma unroll
        for (int ks = 0; ks < 4; ++ks) {
            bf16x8 af[2], bfr[NT];
#pragma unroll
            for (int i = 0; i < 2; ++i) af[i] = *(const bf16x8*)(pa + i * 32 * 128 + cofs[ks]);
#pragma unroll
            for (int j = 0; j < NT; ++j) bfr[j] = *(const bf16x8*)(pb + j * 32 * 128 + cofs[ks]);
#pragma unroll
            for (int i = 0; i < 2; ++i)
#pragma unroll
                for (int j = 0; j < NT; ++j) acc[i][j] = __builtin_amdgcn_mfma_f32_32x32x16_bf16(af[i], bfr[j], acc[i][j], 0, 0, 0);
        }
        if (NST == 3 && kt + 2 < nk) GL_WAITN(); else asm volatile("s_waitcnt vmcnt(0)" ::: "memory");
        GL_BAR();
    }
#undef GL_STAGE
#undef GL_WAITN
#undef GL_BAR
    if constexpr (MODE == 0) {
#pragma unroll
        for (int i = 0; i < 2; ++i)
#pragma unroll
            for (int j = 0; j < NT; ++j)
#pragma unroll
                for (int r = 0; r < 16; ++r) epi(wm * 64 + i * 32 + crow(r, hi), wn * 32 * NT + j * 32 + r32, acc[i][j][r]);
    } else {
        float* Ct = (float*)lds;
#pragma unroll
        for (int i = 0; i < 2; ++i)
#pragma unroll
            for (int j = 0; j < NT; ++j)
#pragma unroll
                for (int r = 0; r < 16; ++r) Ct[(wm * 64 + i * 32 + crow(r, hi)) * CSTR + wn * 32 * NT + j * 32 + r32] = acc[i][j][r];
        __syncthreads();
        epi((const float*)Ct);
        __syncthreads();
    }
}

#else
template <int NT, int MODE, int MID, int NST, class AL, class Epi>
__device__ __forceinline__ void gemm_128(const AL aload, const bf16_t* __restrict__ Bt, int ldb, int K, unsigned char* lds, const float* midscale, Epi epi) {
    typedef GemmCfg<NT> C;
    const int tid = opq_v((int)threadIdx.x), lane = tid & 63, wid = __builtin_amdgcn_readfirstlane(tid >> 6), wm = wid >> 2, wn = wid & 3, r32 = lane & 31, hi = lane >> 5;
    f32x16 acc[2][NT];
#pragma unroll
    for (int i = 0; i < 2; ++i)
#pragma unroll
        for (int j = 0; j < NT; ++j)
#pragma unroll
            for (int r = 0; r < 16; ++r) acc[i][j][r] = 0.f;
    const int prow = tid >> 3, pc = tid & 7;
    const bf16_t* gb = Bt + (size_t)prow * ldb + pc * 8;
    const int ldsoff = prow * G_STR + pc * 16;
    u32x4 ra[2], rb[2 * NT];
    const int nk = K >> 6;
#pragma unroll
    for (int q = 0; q < 2; ++q) ra[q] = *(const u32x4*)aload(prow + 64 * q, pc * 8);
#pragma unroll
    for (int q = 0; q < 2 * NT; ++q) rb[q] = *(const u32x4*)(gb + (size_t)(64 * q) * ldb);
#pragma unroll
    for (int q = 0; q < 2; ++q) *(u32x4*)(lds + ldsoff + q * 64 * G_STR) = ra[q];
#pragma unroll
    for (int q = 0; q < 2 * NT; ++q) *(u32x4*)(lds + G_ABYTES + ldsoff + q * 64 * G_STR) = rb[q];
    __syncthreads();
    for (int kt = 0; kt < nk; ++kt) {
        unsigned char* st = lds + (kt & 1) * C::STAGE;
        if (kt + 1 < nk) {
#pragma unroll
            for (int q = 0; q < 2; ++q) ra[q] = *(const u32x4*)aload(prow + 64 * q, (kt + 1) * 64 + pc * 8);
#pragma unroll
            for (int q = 0; q < 2 * NT; ++q) rb[q] = *(const u32x4*)(gb + (size_t)(64 * q) * ldb + (kt + 1) * 64);
        }
        if (MID > 0 && kt == MID) {
#pragma unroll
            for (int i = 0; i < 2; ++i)
#pragma unroll
                for (int r = 0; r < 16; ++r) { const float sc = midscale[wm * 64 + i * 32 + crow(r, hi)];
#pragma unroll
                    for (int j = 0; j < NT; ++j) acc[i][j][r] *= sc; }
        }
        const unsigned char* pa = st + (wm * 64 + r32) * G_STR + hi * 16;
        const unsigned char* pb = st + G_ABYTES + (wn * 32 * NT + r32) * G_STR + hi * 16;
#pragma unroll
        for (int ks = 0; ks < 4; ++ks) {
            bf16x8 af[2], bfr[NT];
#pragma unroll
            for (int i = 0; i < 2; ++i) af[i] = *(const bf16x8*)(pa + i * 32 * G_STR + ks * 32);
#pragma unroll
            for (int j = 0; j < NT; ++j) bfr[j] = *(const bf16x8*)(pb + j * 32 * G_STR + ks * 32);
#pragma unroll
            for (int i = 0; i < 2; ++i)
#pragma unroll
                for (int j = 0; j < NT; ++j) acc[i][j] = __builtin_amdgcn_mfma_f32_32x32x16_bf16(af[i], bfr[j], acc[i][j], 0, 0, 0);
        }
        if (kt + 1 < nk) {
            unsigned char* sn = lds + ((kt + 1) & 1) * C::STAGE;
#pragma unroll
            for (int q = 0; q < 2; ++q) *(u32x4*)(sn + ldsoff + q * 64 * G_STR) = ra[q];
#pragma unroll
            for (int q = 0; q < 2 * NT; ++q) *(u32x4*)(sn + G_ABYTES + ldsoff + q * 64 * G_STR) = rb[q];
        }
        __syncthreads();
    }
    if constexpr (MODE == 0) {
#pragma unroll
        for (int i = 0; i < 2; ++i)
#pragma unroll
            for (int j = 0; j < NT; ++j)
#pragma unroll
                for (int r = 0; r < 16; ++r) epi(wm * 64 + i * 32 + crow(r, hi), wn * 32 * NT + j * 32 + r32, acc[i][j][r]);
    } else {
        float* Ct = (float*)lds;
#pragma unroll
        for (int i = 0; i < 2; ++i)
#pragma unroll
            for (int j = 0; j < NT; ++j)
#pragma unroll
                for (int r = 0; r < 16; ++r) Ct[(wm * 64 + i * 32 + crow(r, hi)) * CSTR + wn * 32 * NT + j * 32 + r32] = acc[i][j][r];
        __syncthreads();
        epi((const float*)Ct);
        __syncthreads();
    }
}

#endif

template <int MID32, class AL, class Epi>
__device__ __forceinline__ void gemm_128w(const AL aload, const bf16_t* __restrict__ Bt, int ldb, int K, unsigned char* lds, const float* midscale, Epi epi) {
    const int tid = opq_v((int)threadIdx.x), lane = tid & 63, wid = __builtin_amdgcn_readfirstlane(tid >> 6), wm = wid >> 2, wn = wid & 3, r32 = lane & 31, hi = lane >> 5;
    f32x16 acc[2][4];
#pragma unroll
    for (int i = 0; i < 2; ++i)
#pragma unroll
        for (int j = 0; j < 4; ++j)
#pragma unroll
            for (int r = 0; r < 16; ++r) acc[i][j][r] = 0.f;
    typedef __attribute__((address_space(3))) unsigned char lds_uc;
    lds_uc* ldsl = (lds_uc*)lds;
    const int srow = wid * 16 + (lane >> 2), schunk = ((lane & 3) ^ ((srow >> 2) & 3)) * 8;
    const bf16_t* gb = Bt + (size_t)srow * ldb + schunk;
    const int nk = K >> 5;
    constexpr int SA = 128 * 64, SB = 512 * 64, SSTAGE = SA + SB;
#define GW_STAGE(stg, pa_, pb_) do { \
        __builtin_amdgcn_global_load_lds((const unsigned*)(pa_), (__attribute__((address_space(3))) unsigned*)(ldsl + (stg) * SSTAGE + wid * 1024), 16, 0, 0); \
        _Pragma("unroll") for (int q = 0; q < 4; ++q) __builtin_amdgcn_global_load_lds((const unsigned*)((pb_) + (size_t)(128 * q) * ldb), (__attribute__((address_space(3))) unsigned*)(ldsl + (stg) * SSTAGE + SA + q * 8192 + wid * 1024), 16, 0, 0); } while (0)
#define GW_BAR() asm volatile("s_waitcnt lgkmcnt(0)\n\ts_barrier" ::: "memory")
    const bf16_t* pga = aload(srow, schunk); const size_t astep = aload.kstep32();
    const bf16_t* pgb = gb;
    GW_STAGE(0, pga, pgb); pga += astep; pgb += 32;
    if (nk > 1) { GW_STAGE(1, pga, pgb); pga += astep; pgb += 32; asm volatile("s_waitcnt vmcnt(5)" ::: "memory"); } else asm volatile("s_waitcnt vmcnt(0)" ::: "memory");
    GW_BAR();
    const int swz = (r32 >> 2) & 3;
    const int cof0 = ((hi ^ swz) << 4), cof1 = (((2 | hi) ^ swz) << 4);
    const int arow = (wm * 64 + r32) * 64, brow = SA + (wn * 64 + r32) * 64;
    int cur = 0, nxt = 2;
#pragma unroll 1
    for (int kt = 0; kt < nk; ++kt) {
        const unsigned char* st = lds + cur * SSTAGE;
        if (kt + 2 < nk) { GW_STAGE(nxt, pga, pgb); pga += astep; pgb += 32; }
        if (MID32 > 0 && kt == MID32) {
#pragma unroll
            for (int i = 0; i < 2; ++i)
#pragma unroll
                for (int r = 0; r < 16; ++r) { const float sc = midscale[wm * 64 + i * 32 + crow(r, hi)];
#pragma unroll
                    for (int j = 0; j < 4; ++j) acc[i][j][r] *= sc; }
        }
#pragma unroll
        for (int ks = 0; ks < 2; ++ks) {
            const int cof = ks ? cof1 : cof0;
            bf16x8 af[2], bfr[4];
#pragma unroll
            for (int i = 0; i < 2; ++i) af[i] = *(const bf16x8*)(st + arow + i * 32 * 64 + cof);
#pragma unroll
            for (int j = 0; j < 4; ++j) bfr[j] = *(const bf16x8*)(st + brow + ((j >> 1) * 256 + (j & 1) * 32) * 64 + cof);
#pragma unroll
            for (int i = 0; i < 2; ++i)
#pragma unroll
                for (int j = 0; j < 4; ++j) acc[i][j] = __builtin_amdgcn_mfma_f32_32x32x16_bf16(af[i], bfr[j], acc[i][j], 0, 0, 0);
        }
        if (kt + 2 < nk) asm volatile("s_waitcnt vmcnt(5)" ::: "memory"); else asm volatile("s_waitcnt vmcnt(0)" ::: "memory");
        GW_BAR();
        cur = (cur == 2) ? 0 : cur + 1; nxt = (nxt == 2) ? 0 : nxt + 1;
    }
#undef GW_STAGE
#undef GW_BAR
    float* Ct = (float*)lds;
#pragma unroll
    for (int c = 0; c < 2; ++c) {
#pragma unroll
        for (int i = 0; i < 2; ++i)
#pragma unroll
            for (int jj = 0; jj < 2; ++jj)
#pragma unroll
                for (int r = 0; r < 16; ++r) Ct[(wm * 64 + i * 32 + crow(r, hi)) * CSTR + wn * 64 + jj * 32 + r32] = acc[i][2 * c + jj][r];
        __syncthreads();
        epi((const float*)Ct, c);
        __syncthreads();
    }
}

__device__ __forceinline__ void p0_transpose(const float* __restrict__ W, int K, int N, int Npad, bf16_t* __restrict__ WT,
                                             const float* g0, const float* g1, int gsplit, float* scr, int item, int cmap = 0) {
    const int tid = threadIdx.x;
    const int nkb = K / 64, kb = item % nkb, nb = item / nkb, k0 = kb * 64, n0 = nb * 64;
#pragma unroll
    for (int r = 0; r < 8; ++r) {
        const int kk = r * 8 + (tid >> 6), nn = tid & 63, k = k0 + kk; int n = n0 + nn;
        if (cmap) n = ((n & 255) < 192) ? (n >> 8) * 192 + (n & 255) : N;
        float v = (n < N) ? W[(size_t)k * N + n] : 0.f;
        if (g0) v *= (k < gsplit) ? g0[k] : g1[k - gsplit];
        scr[kk * 65 + nn] = v;
    }
    __syncthreads();
    {
        const int n = tid >> 3, kc = tid & 7; const float* s = scr + (kc * 8) * 65 + n;
        u32x4 o; o.x = pk2(s[0], s[65]); o.y = pk2(s[2 * 65], s[3 * 65]); o.z = pk2(s[4 * 65], s[5 * 65]); o.w = pk2(s[6 * 65], s[7 * 65]);
        *(u32x4*)(WT + (size_t)(n0 + n) * K + k0 + kc * 8) = o;
    }
    __syncthreads();
}


__device__ __forceinline__ void quant_row(const f32x4 (&a)[4], unsigned char* dst, float* scale_out, int lane) {
    float am = 0.f;
#pragma unroll
    for (int q = 0; q < 4; ++q) am = fmaxf(am, fmaxf(fmaxf(fabsf(a[q].x), fabsf(a[q].y)), fmaxf(fabsf(a[q].z), fabsf(a[q].w))));
#pragma unroll
    for (int o = 1; o < 64; o <<= 1) am = fmaxf(am, __shfl_xor(am, o));
    const float sc = (am > 0.f) ? am * (1.0f / 224.0f) : 1.0f, inv = 1.0f / sc;
    u32x4 o;
    { int w = __builtin_amdgcn_cvt_pk_fp8_f32(a[0].x * inv, a[0].y * inv, 0, false); w = __builtin_amdgcn_cvt_pk_fp8_f32(a[0].z * inv, a[0].w * inv, w, true); o.x = (unsigned)w; }
    { int w = __builtin_amdgcn_cvt_pk_fp8_f32(a[1].x * inv, a[1].y * inv, 0, false); w = __builtin_amdgcn_cvt_pk_fp8_f32(a[1].z * inv, a[1].w * inv, w, true); o.y = (unsigned)w; }
    { int w = __builtin_amdgcn_cvt_pk_fp8_f32(a[2].x * inv, a[2].y * inv, 0, false); w = __builtin_amdgcn_cvt_pk_fp8_f32(a[2].z * inv, a[2].w * inv, w, true); o.z = (unsigned)w; }
    { int w = __builtin_amdgcn_cvt_pk_fp8_f32(a[3].x * inv, a[3].y * inv, 0, false); w = __builtin_amdgcn_cvt_pk_fp8_f32(a[3].z * inv, a[3].w * inv, w, true); o.w = (unsigned)w; }
    *(u32x4*)dst = o;
    if (lane == 0) *scale_out = sc;
}

__device__ __forceinline__ void quant_row_i8(const f32x4 (&a)[4], unsigned char* dst, float* scale_out, int lane) {
    float am = 0.f;
#pragma unroll
    for (int q = 0; q < 4; ++q) am = fmaxf(am, fmaxf(fmaxf(fabsf(a[q].x), fabsf(a[q].y)), fmaxf(fabsf(a[q].z), fabsf(a[q].w))));
#pragma unroll
    for (int o = 1; o < 64; o <<= 1) am = fmaxf(am, __shfl_xor(am, o));
    const float sc = (am > 0.f) ? am * (1.0f / 127.0f) : 1.0f, inv = 1.0f / sc;
    u32x4 o;
#pragma unroll
    for (int q = 0; q < 4; ++q) { const int b0 = (int)rintf(a[q].x * inv), b1 = (int)rintf(a[q].y * inv), b2 = (int)rintf(a[q].z * inv), b3 = (int)rintf(a[q].w * inv);
        o[q] = (unsigned)(b0 & 0xFF) | ((unsigned)(b1 & 0xFF) << 8) | ((unsigned)(b2 & 0xFF) << 16) | ((unsigned)(b3 & 0xFF) << 24); }
    *(u32x4*)dst = o;
    if (lane == 0) *scale_out = sc;
}
__device__ void phase0(const Params& p, unsigned char* lds) {
    const int tid = threadIdx.x, G = gridDim.x, bid = blockIdx.x;
    unsigned char* ws = p.ws;
    float* scr = (float*)lds;
    {
        float* part = (float*)(ws + OFF_PART);
        for (int it = bid; it < 24 * 16; it += G) {
            const int nb = it % 24, ks = it / 24, n = nb * 256 + (tid & 255), bh = tid >> 8;
            for (int i = tid; i < 16 * 64; i += NTHR) { const int b = i >> 6, kk = i & 63; const float cv = p.c[b * 1024 + ks * 64 + kk]; scr[i] = cv / (1.0f + __expf(-cv)); }
            __syncthreads();
            float acc[8];
#pragma unroll
            for (int j = 0; j < 8; ++j) acc[j] = 0.f;
            for (int kk = 0; kk < 64; ++kk) {
                const float w = p.w_ada[(size_t)(ks * 64 + kk) * 6144 + n];
#pragma unroll
                for (int j = 0; j < 8; ++j) acc[j] += w * scr[(bh * 8 + j) * 64 + kk];
            }
#pragma unroll
            for (int j = 0; j < 8; ++j) part[((size_t)ks * 16 + bh * 8 + j) * 6144 + n] = acc[j];
            __syncthreads();
        }
    }
    {
        constexpr int I_IN = 16 * 16, I_GLU = 8 * 8, I_UQ = 4 * 16, I_UKV = 2 * 16, I_OUT = 16 * 16, I_Q = 16 * 32;
        constexpr int NIT = I_IN + I_GLU + I_UQ + I_UKV + I_OUT + I_Q;
        for (int it = bid; it < NIT; it += G) {
            int r = it;
            if (r < I_IN) { p0_transpose(p.w_in, 1024, 928, 1024, (bf16_t*)(ws + OFF_WINT), nullptr, nullptr, 0, scr, r); continue; } r -= I_IN;
            if (r < I_GLU) { p0_transpose(p.w_glu, 512, 512, 512, (bf16_t*)(ws + OFF_WGLUT), nullptr, nullptr, 0, scr, r); continue; } r -= I_GLU;
            if (r < I_UQ) { p0_transpose(p.w_uq, 256, 768, 1024, (bf16_t*)(ws + OFF_WUQT), p.q_a_norm, p.q_a_norm, 256, scr, r, 1); continue; } r -= I_UQ;
            if (r < I_UKV) { p0_transpose(p.w_ukv, 128, 1024, 1024, (bf16_t*)(ws + OFF_WUKVT), p.kv_a_norm, p.kv_a_norm, 128, scr, r); continue; } r -= I_UKV;
            if (r < I_OUT) { p0_transpose(p.w_out, 1024, 1024, 1024, (bf16_t*)(ws + OFF_WOUTT), p.out_norm_ssm, p.out_norm_attn, 512, scr, r); continue; } r -= I_OUT;
            {
                const int kb = r & 15, nb = r >> 4, k0 = kb * 64, n0 = nb * 64, hp = n0 >> 7, key0 = n0 & 127, ph = hp & 1;
                float* SK = scr; float* WQ = scr + 64 * 129;
                for (int i = tid; i < 64 * 32; i += NTHR) { const int rr = i >> 5, c4 = (i & 31) * 4;
                    const f32x4 a = *(const f32x4*)(p.sub_keys + ((size_t)ph * 128 + key0 + rr) * 128 + c4), b = *(const f32x4*)(p.w_query + (size_t)(k0 + rr) * 2048 + hp * 128 + c4);
                    SK[rr * 129 + c4] = a.x; SK[rr * 129 + c4 + 1] = a.y; SK[rr * 129 + c4 + 2] = a.z; SK[rr * 129 + c4 + 3] = a.w;
                    WQ[rr * 129 + c4] = b.x; WQ[rr * 129 + c4 + 1] = b.y; WQ[rr * 129 + c4 + 2] = b.z; WQ[rr * 129 + c4 + 3] = b.w; }
                __syncthreads();
                const int kk = tid & 63, nn0 = (tid >> 6) * 8; float acc[8];
#pragma unroll
                for (int j = 0; j < 8; ++j) acc[j] = 0.f;
                for (int d = 0; d < 128; ++d) { const float wq = WQ[kk * 129 + d];
#pragma unroll
                    for (int j = 0; j < 8; ++j) acc[j] += wq * SK[(nn0 + j) * 129 + d]; }
                bf16_t* WT = (bf16_t*)(ws + OFF_WQT);
#pragma unroll
                for (int j = 0; j < 8; ++j) WT[(size_t)(n0 + nn0 + j) * 1024 + k0 + kk] = (bf16_t)f2bf(acc[j]);
                __syncthreads();
            }
        }
    }
    {
        const size_t gt = (size_t)bid * NTHR + tid, gs = (size_t)G * NTHR;
        for (size_t i = gt; i < 32768 / 8; i += gs) { const f32x4 a = ((const f32x4*)p.sub_keys)[2 * i], b = ((const f32x4*)p.sub_keys)[2 * i + 1];
            u32x4 o; o.x = pk2(a.x, a.y); o.y = pk2(a.z, a.w); o.z = pk2(b.x, b.y); o.w = pk2(b.z, b.w); ((u32x4*)(ws + OFF_SUBK))[i] = o; }
    }
    {
        const int lane = tid & 63, gw = bid * NWAVE + (tid >> 6), NGW = G * NWAVE;
        unsigned char* E8 = ws + OFF_E8; float* esc = (float*)(ws + OFF_ESC);
        for (int r = gw; r < 32768; r += 4 * NGW) {
            f32x4 a[4][4];
#pragma unroll
            for (int u = 0; u < 4; ++u) { const int ru = r + u * NGW; if (ru < 32768) { const float* sp = ((ru < 16384) ? p.e_down : p.e_up) + (size_t)(ru & 16383) * 1024 + lane * 16;
#pragma unroll
                for (int q = 0; q < 4; ++q) a[u][q] = ((const f32x4*)sp)[q]; } }
#pragma unroll
            for (int u = 0; u < 4; ++u) { const int ru = r + u * NGW; if (ru < 32768) { if (ru < 16384) quant_row_i8(a[u], E8 + (size_t)ru * 1024 + lane * 16, esc + ru, lane); else quant_row(a[u], E8 + (size_t)ru * 1024 + lane * 16, esc + ru, lane); } }
        }
    }
    {
        f32x2* apow = (f32x2*)lds;
        f32x2* Bb = (f32x2*)(lds + 16896);
        f32x2* Cc = (f32x2*)(lds + 16896 + 8192);
        float* Kt = (float*)(lds + 16896 + 16384);
        for (int it = ((bid >= G / 2) ? bid - G / 2 : bid + G / 2); it < 128; it += G) {
            const int g = it >> 2, cq = it & 3;
            const float dt = __expf(p.log_dt[g]);
            for (int i = tid; i < 33 * 64; i += NTHR) { const int j = i >> 6, pp = i & 63; const float lr = p.lam_re[g * 64 + pp], li = p.lam_im[g * 64 + pp];
                const float mag = expf((float)j * lr * dt); float sn, cs; sincosf((float)j * li * dt, &sn, &cs); apow[i] = (f32x2){mag * cs, mag * sn}; }
            for (int i = tid; i < 1024; i += NTHR) { const int pp = i >> 4; const float lr = p.lam_re[g * 64 + pp], li = p.lam_im[g * 64 + pp];
                const float mag = expf(lr * dt); float sn, cs; sincosf(li * dt, &sn, &cs); const float nr = mag * cs - 1.0f, ni = mag * sn, den = lr * lr + li * li;
                const float cr = (nr * lr + ni * li) / den, ci = (ni * lr - nr * li) / den; const float br = p.b_re[(size_t)g * 1024 + i], bi = p.b_im[(size_t)g * 1024 + i];
                Bb[i] = (f32x2){cr * br - ci * bi, cr * bi + ci * br}; }
            for (int i = tid; i < 1024; i += NTHR) Cc[i] = (f32x2){p.c_re[(size_t)g * 1024 + i], p.c_im[(size_t)g * 1024 + i]};
            __syncthreads();
            for (int i2 = tid; i2 < 2048; i2 += NTHR) { const int j = i2 >> 6, co = cq * 4 + ((i2 >> 4) & 3), ci = i2 & 15, i = (j << 8) | (co << 4) | ci; float s = 0.f;
                for (int pp = 0; pp < 64; ++pp) { const f32x2 c = Cc[co * 64 + pp], a = apow[j * 64 + pp], b = Bb[pp * 16 + ci]; const float car = c.x * a.x - c.y * a.y, cai = c.x * a.y + c.y * a.x; s += car * b.x - cai * b.y; }
                if (j == 0 && co == ci) s += p.d_skip[g * 16 + co];
                Kt[i] = s; }
            __syncthreads();
            bf16_t* KmT = (bf16_t*)(ws + OFF_KMT) + (size_t)g * 512 * 640;
            for (int q = tid; q < 128 * 80; q += NTHR) { const int nn = q / 80, kc = q % 80, k0 = kc * 8, t = nn >> 2, co = cq * 4 + (nn & 3), n = t * 16 + co; float v[8];
                if (k0 < 512) { const int s = k0 >> 4, ci0 = k0 & 15;
#pragma unroll
                    for (int i = 0; i < 8; ++i) v[i] = (t >= s) ? Kt[((t - s) * 16 + co) * 16 + ci0 + i] : 0.f;
                } else { const int kk0 = k0 - 512, ri = kk0 >> 6, p0 = kk0 & 63;
#pragma unroll
                    for (int i = 0; i < 8; ++i) { const f32x2 c = Cc[co * 64 + p0 + i], a = apow[(t + 1) * 64 + p0 + i]; v[i] = (ri == 0) ? (c.x * a.x - c.y * a.y) : -(c.x * a.y + c.y * a.x); } }
                u32x4 o; o.x = pk2(v[0], v[1]); o.y = pk2(v[2], v[3]); o.z = pk2(v[4], v[5]); o.w = pk2(v[6], v[7]); *(u32x4*)(KmT + (size_t)n * 640 + k0) = o; }
            bf16_t* WzT = (bf16_t*)(ws + OFF_WZT) + (size_t)g * 128 * 512;
            for (int q = tid; q < 32 * 64; q += NTHR) { const int n = cq * 32 + (q >> 6), kc = q & 63, k0 = kc * 8, s = k0 >> 4, ci0 = k0 & 15, ri = n >> 6, pp = n & 63; float v[8];
                const f32x2 a = apow[(31 - s) * 64 + pp];
#pragma unroll
                for (int i = 0; i < 8; ++i) { const f32x2 b = Bb[pp * 16 + ci0 + i]; v[i] = (ri == 0) ? (a.x * b.x - a.y * b.y) : (a.x * b.y + a.y * b.x); }
                u32x4 o; o.x = pk2(v[0], v[1]); o.y = pk2(v[2], v[3]); o.z = pk2(v[4], v[5]); o.w = pk2(v[6], v[7]); *(u32x4*)(WzT + (size_t)n * 512 + k0) = o; }
            if (cq == 0 && tid < 64) ((f32x2*)(ws + OFF_AL))[g * 64 + tid] = apow[32 * 64 + tid];
            __syncthreads();
        }
    }
}


__device__ __forceinline__ void finalize_row(const float* nope, const float* ra, const float* rb, float rn, float rnr, const float* __restrict__ gain, const _Float16* cs, const _Float16* sn, bf16_t* dst) {
#pragma unroll
    for (int j = 0; j < 8; ++j) { const f32x4 a = *(const f32x4*)(nope + 8 * j), c = *(const f32x4*)(nope + 8 * j + 4);
        u32x4 o; o.x = pk2(a.x * rn * gain[8 * j], a.y * rn * gain[8 * j + 1]); o.y = pk2(a.z * rn * gain[8 * j + 2], a.w * rn * gain[8 * j + 3]);
        o.z = pk2(c.x * rn * gain[8 * j + 4], c.y * rn * gain[8 * j + 5]); o.w = pk2(c.z * rn * gain[8 * j + 6], c.w * rn * gain[8 * j + 7]); *(u32x4*)(dst + 8 * j) = o; }
#pragma unroll
    for (int j = 0; j < 2; ++j) { float o1[8], o2[8];
#pragma unroll
        for (int i = 0; i < 8; ++i) { const int f = 8 * j + i; const float x1 = ra[f] * rnr * gain[64 + f], x2 = rb[f] * rnr * gain[80 + f]; const float cf = (float)cs[f], sf = (float)sn[f]; o1[i] = x1 * cf - x2 * sf; o2[i] = x2 * cf + x1 * sf; }
        u32x4 o; o.x = pk2(o1[0], o1[1]); o.y = pk2(o1[2], o1[3]); o.z = pk2(o1[4], o1[5]); o.w = pk2(o1[6], o1[7]); *(u32x4*)(dst + 64 + 8 * j) = o;
        o.x = pk2(o2[0], o2[1]); o.y = pk2(o2[2], o2[3]); o.z = pk2(o2[4], o2[5]); o.w = pk2(o2[6], o2[7]); *(u32x4*)(dst + 80 + 8 * j) = o; }
}
constexpr int CT_BYTES = 128 * CSTR * 4;
constexpr int SM_OFF = 147456;
constexpr int P1_RSQ = SM_OFF, P1_RSKV = P1_RSQ + 512, P1_CS = P1_RSKV + 512, P1_SN = P1_CS + 4096;

__device__ void phase1(const Params& p, unsigned char* lds) {
    const int tid = threadIdx.x, lane = tid & 63, wid = __builtin_amdgcn_readfirstlane(tid >> 6);
    unsigned char* ws = p.ws;
    bf16_t* hbuf = (bf16_t*)(ws + OFF_HBUF); bf16_t* proj2 = (bf16_t*)(ws + OFF_PROJ2); bf16_t* ubuf = (bf16_t*)(ws + OFF_UBUF);
    float* rsq = (float*)(lds + P1_RSQ); float* rskv = (float*)(lds + P1_RSKV); _Float16* cst = (_Float16*)(lds + P1_CS); _Float16* snt = (_Float16*)(lds + P1_SN);
    for (int tile = blockIdx.x; tile < 256; tile += gridDim.x) {
        const int row0 = tile * 128, b = row0 >> 11;
        float* mod = (float*)(ws + OFF_MODT) + (size_t)tile * 6144 - (size_t)b * 6144;
        for (int i = tid; i < 6144; i += NTHR) { float s = p.b_ada[i]; const float* pp = (const float*)(ws + OFF_PART) + (size_t)b * 6144 + i;
            for (int ks = 0; ks < 16; ++ks) s += pp[(size_t)ks * 16 * 6144]; mod[b * 6144 + i] = s; }
        for (int i = tid; i < 2048; i += NTHR) { const int r = i >> 4, f = i & 15; const float ang = (float)p.pos[row0 + r] * exp2f(-(float)f * (13.287712379549449f / 16.0f));
            float sn, cs; sincosf(ang, &sn, &cs); cst[i] = (_Float16)cs; snt[i] = (_Float16)sn; }
        __threadfence_block(); __syncthreads();
        for (int rp1a = 0; rp1a < ((PROBE_REP & 8192) ? 2 : 1); ++rp1a) {
        {   f32x4 mg[4], msh[4];
#pragma unroll
            for (int j = 0; j < 4; ++j) { const int col = 4 * (lane + 64 * j); const f32x4 g = *(const f32x4*)(p.norm_mix + col), sc = *(const f32x4*)(mod + b * 6144 + 1024 + col);
                mg[j] = (f32x4){g.x * (1.f + sc.x), g.y * (1.f + sc.y), g.z * (1.f + sc.z), g.w * (1.f + sc.w)}; msh[j] = *(const f32x4*)(mod + b * 6144 + col); }
#pragma unroll 1
            for (int r4 = 0; r4 < 4; ++r4) {
                f32x4 v[4][4];
#pragma unroll
                for (int u = 0; u < 4; ++u)
#pragma unroll
                    for (int j = 0; j < 4; ++j) v[u][j] = ((const f32x4*)(p.x + (size_t)(row0 + r4 * 32 + u * 8 + wid) * 1024))[lane + 64 * j];
#pragma unroll
                for (int u = 0; u < 4; ++u) { float ss = 0.f;
#pragma unroll
                    for (int j = 0; j < 4; ++j) ss += v[u][j].x * v[u][j].x + v[u][j].y * v[u][j].y + v[u][j].z * v[u][j].z + v[u][j].w * v[u][j].w;
                    const float rs = rsqrtf(wave_sum(ss) * (1.0f / 1024.0f) + EPS);
#pragma unroll
                    for (int j = 0; j < 4; ++j) { const int col = 4 * (lane + 64 * j);
                        u32x2 o; o.x = pk2(v[u][j].x * rs * mg[j].x + msh[j].x, v[u][j].y * rs * mg[j].y + msh[j].y); o.y = pk2(v[u][j].z * rs * mg[j].z + msh[j].z, v[u][j].w * rs * mg[j].w + msh[j].w);
                        *(u32x2*)(hbuf + (size_t)(row0 + r4 * 32 + u * 8 + wid) * 1024 + col) = o; } }
            }
        }
        __threadfence_block(); __syncthreads();
        }
        for (int rp1b = 0; rp1b < ((PROBE_REP & 16384) ? 2 : 1); ++rp1b) {
        const ARow ah{hbuf + (size_t)row0 * 1024, 1024};
        for (int nc = 0; nc < 4; ++nc) {
            const bf16_t* Bt = (const bf16_t*)(ws + OFF_WINT) + (size_t)nc * 256 * 1024;
            if (nc < 2) gemm_128<2, 1, 0, 3>(ah, Bt, 1024, 1024, lds, nullptr, [&](const float* Ct) {
                    const int ln = opq_v(lane), r0u = opq_s(row0), ncu = opq_s(nc); bf16_t* ub = opq_p(ubuf);
                    for (int tk = wid; tk < 32; tk += NWAVE) { const int gi = tk >> 1, r = (tk & 1) * 64 + ln, g = ncu * 16 + gi, tok = r0u + r;
                        const float* c = Ct + r * CSTR + gi * 16; const f32x4 a0 = *(const f32x4*)c, a1 = *(const f32x4*)(c + 4), a2 = *(const f32x4*)(c + 8), a3 = *(const f32x4*)(c + 12);
                        bf16_t* d = ub + ((size_t)g * 1024 + (tok >> 5)) * 640 + (tok & 31) * 16;
                        *(u32x4*)d = (u32x4){pk2(a0.x, a0.y), pk2(a0.z, a0.w), pk2(a1.x, a1.y), pk2(a1.z, a1.w)}; *(u32x4*)(d + 8) = (u32x4){pk2(a2.x, a2.y), pk2(a2.z, a2.w), pk2(a3.x, a3.y), pk2(a3.z, a3.w)}; } });
            else if (nc == 2) gemm_128<2, 1, 0, 3>(ah, Bt, 1024, 1024, lds, nullptr, [&](const float* Ct) {
                    const int ln = opq_v(lane), r0u = opq_s(row0); bf16_t* pj = opq_p(proj2);
                    for (int r = wid; r < 128; r += NWAVE) { const f32x4 v = *(const f32x4*)(Ct + r * CSTR + ln * 4);
                        const float sq = wave_sum(v.x * v.x + v.y * v.y + v.z * v.z + v.w * v.w); if (ln == 0) rsq[r] = rsqrtf(sq * (1.0f / 256.0f) + EPS);
                        *(u32x2*)(pj + (size_t)(r0u + r) * 512 + ln * 4) = (u32x2){pk2(v.x, v.y), pk2(v.z, v.w)}; } });
            else gemm_128<2, 1, 0, 3>(ah, Bt, 1024, 1024, lds, nullptr, [&](const float* Ct) {
                    const int ln = opq_v(lane), r0u = opq_s(row0); bf16_t* pj = opq_p(proj2);
                    for (int r = wid; r < 128; r += NWAVE) { const f32x4 v = (ln < 40) ? *(const f32x4*)(Ct + r * CSTR + ln * 4) : (f32x4){0.f, 0.f, 0.f, 0.f};
                        const float sq = wave_sum((ln < 32) ? (v.x * v.x + v.y * v.y + v.z * v.z + v.w * v.w) : 0.f); if (ln == 0) rskv[r] = rsqrtf(sq * (1.0f / 128.0f) + EPS);
                        const u32x2 o = (u32x2){pk2(v.x, v.y), pk2(v.z, v.w)};
                        if (ln < 32) *(u32x2*)(pj + (size_t)(r0u + r) * 512 + 256 + ln * 4) = o; else if (ln < 40) *(u32x2*)(pj + (size_t)(r0u + r) * 512 + 384 + (ln - 32) * 4) = o; } });
        }
        }
        for (int rp1d = 0; rp1d < ((PROBE_REP & 32768) ? 2 : 1); ++rp1d) {
        const ARow aq{proj2 + (size_t)row0 * 512, 512};
        for (int nc = 0; nc < 4; ++nc)
            gemm_128<2, 1, 0, 3>(aq, (const bf16_t*)(ws + OFF_WUQT) + (size_t)nc * 256 * 256, 256, 256, lds, nullptr, [&](const float* Ct) {
                const int tq = opq_v(tid); const float* gq = opq_p(p.q_norm);
                if (tq < 256) { const int row = tq & 127, hh = tq >> 7, h = opq_s(nc) * 2 + hh; const float* q = Ct + row * CSTR + hh * 96; float ss = 0.f;
#pragma unroll
                    for (int j = 0; j < 24; ++j) { const f32x4 t4 = *(const f32x4*)(q + 4 * j); ss += t4.x * t4.x + t4.y * t4.y + t4.z * t4.z + t4.w * t4.w; }
                    const float rq = rsq[row], rn = rsqrtf(ss * rq * rq * (1.0f / 96.0f) + EPS) * rq * QSCALE;
                    const int r0q = opq_s(row0); bf16_t* dst = (bf16_t*)(ws + OFF_Q) + ((size_t)((r0q >> 11) * 8 + h) * 2048 + ((r0q + row) & 2047)) * 96;
                    finalize_row(q, q + 64, q + 80, rn, rn, gq, cst + row * 16, snt + row * 16, dst); } });
        }
        for (int rp1e = 0; rp1e < ((PROBE_REP & 65536) ? 2 : 1); ++rp1e) {
        const ARow akv{proj2 + (size_t)row0 * 512 + 256, 512};
        for (int nc = 0; nc < 4; ++nc)
            gemm_128<2, 1, 0, 3>(akv, (const bf16_t*)(ws + OFF_WUKVT) + (size_t)nc * 256 * 128, 128, 128, lds, nullptr, [&](const float* Ct) {
                const int tq = opq_v(tid); const float* gk = opq_p(p.k_norm); const int r0k = opq_s(row0), nck = opq_s(nc);
                if (tq < 256) { const int row = tq & 127, hh = tq >> 7, h = nck * 2 + hh; const float* kp = Ct + row * CSTR + hh * 128; float ss = 0.f, sr = 0.f; float rp[32];
#pragma unroll
                    for (int j = 0; j < 16; ++j) { const f32x4 t4 = *(const f32x4*)(kp + 4 * j); ss += t4.x * t4.x + t4.y * t4.y + t4.z * t4.z + t4.w * t4.w; }
#pragma unroll
                    for (int j = 0; j < 4; ++j) { const u32x4 w = *(const u32x4*)(proj2 + (size_t)(r0k + row) * 512 + 384 + 8 * j);
                        rp[8 * j] = bflo(w.x); rp[8 * j + 1] = bfhi(w.x); rp[8 * j + 2] = bflo(w.y); rp[8 * j + 3] = bfhi(w.y); rp[8 * j + 4] = bflo(w.z); rp[8 * j + 5] = bfhi(w.z); rp[8 * j + 6] = bflo(w.w); rp[8 * j + 7] = bfhi(w.w); }
#pragma unroll
                    for (int d = 0; d < 32; ++d) sr += rp[d] * rp[d];
                    const float rk = rskv[row], rn = rsqrtf((ss * rk * rk + sr) * (1.0f / 96.0f) + EPS);
                    bf16_t* dst = (bf16_t*)(ws + OFF_K) + ((size_t)((r0k >> 11) * 8 + h) * 2048 + ((r0k + row) & 2047)) * 96;
                    finalize_row(kp, rp, rp + 16, rn * rk, rn, gk, cst + row * 16, snt + row * 16, dst);
                } else { const int t = tq - 256, d = t & 63, hh = (t >> 6) & 1, rh = t >> 7, h = nck * 2 + hh;
                    bf16_t* dst = (bf16_t*)(ws + OFF_VT) + ((size_t)((r0k >> 11) * 8 + h) * 64 + d) * 2048 + (r0k & 2047) + rh * 64;
                    const float* vp = Ct + (rh * 64) * CSTR + hh * 128 + 64 + d;
#pragma unroll 2
                    for (int r8 = 0; r8 < 8; ++r8) { float v[8];
#pragma unroll
                        for (int i = 0; i < 8; ++i) v[i] = vp[(r8 * 8 + i) * CSTR] * rskv[rh * 64 + r8 * 8 + i];
                        *(u32x4*)(dst + r8 * 8) = (u32x4){pk2(v[0], v[1]), pk2(v[2], v[3]), pk2(v[4], v[5]), pk2(v[6], v[7])}; } } });
        }
    }
}

__device__ void s5_item(const Params& p, unsigned char* lds, int g, int bp) {
    const int tid = threadIdx.x;
    unsigned char* ws = p.ws;
    bf16_t* A = (bf16_t*)(ws + OFF_UBUF) + ((size_t)g * 1024 + bp * 128) * 640;
    float* Z = (float*)(lds + 73728);
    const ARow au{A, 640};
    gemm_128<1, 0, 0, 2>(au, (const bf16_t*)(ws + OFF_WZT) + (size_t)g * 128 * 512, 512, 512, lds, nullptr, [&](int row, int col, float v) { Z[row * 129 + col] = v; });
    __syncthreads();
    if (tid < 128) {
        const int bs = tid >> 6, pp = tid & 63; const f32x2 aL = ((const f32x2*)(ws + OFF_AL))[g * 64 + pp]; float xr = 0.f, xi = 0.f;
        for (int k = 0; k < 64; ++k) { const int row = bs * 64 + k; bf16_t* xin = A + (size_t)row * 640 + 512;
            xin[pp] = (bf16_t)f2bf(xr); xin[64 + pp] = (bf16_t)f2bf(xi);
            const float zr = Z[row * 129 + pp], zi = Z[row * 129 + 64 + pp], nr = aL.x * xr - aL.y * xi + zr, ni = aL.x * xi + aL.y * xr + zi; xr = nr; xi = ni; }
    }
    __threadfence_block(); __syncthreads();
    bf16_t* ybT = (bf16_t*)(ws + OFF_YBUF) + (size_t)g * T_TOK * 16;
        gemm_128w<0>(au, (const bf16_t*)(ws + OFF_KMT) + (size_t)g * 512 * 640, 640, 640, lds, nullptr, [&](const float* Ct, int nc) {
#pragma unroll
            for (int i = 0; i < 4; ++i) { const int pidx = tid + NTHR * i, row = pidx >> 4, tt = pidx & 15; const float* c = Ct + row * CSTR + tt * 16;
                const f32x4 a0 = *(const f32x4*)c, a1 = *(const f32x4*)(c + 4), a2 = *(const f32x4*)(c + 8), a3 = *(const f32x4*)(c + 12);
                bf16_t* d = ybT + ((size_t)(bp * 128 + row) * 32 + nc * 16 + tt) * 16;
                *(u32x4*)d = (u32x4){pk2(gelu_tanh(a0.x), gelu_tanh(a0.y)), pk2(gelu_tanh(a0.z), gelu_tanh(a0.w)), pk2(gelu_tanh(a1.x), gelu_tanh(a1.y)), pk2(gelu_tanh(a1.z), gelu_tanh(a1.w))};
                *(u32x4*)(d + 8) = (u32x4){pk2(gelu_tanh(a2.x), gelu_tanh(a2.y)), pk2(gelu_tanh(a2.z), gelu_tanh(a2.w)), pk2(gelu_tanh(a3.x), gelu_tanh(a3.y)), pk2(gelu_tanh(a3.z), gelu_tanh(a3.w))}; } });
}

constexpr int AT_KSTR = 208, AT_VSTR = 264, AT_KB = 128 * AT_KSTR, AT_VB = 64 * AT_VSTR, AT_STAGE = AT_KB + AT_VB;

__device__ void attn_item(const Params& p, unsigned char* lds, int bh, int qb) {
    const int tid = threadIdx.x, lane = tid & 63, wid = __builtin_amdgcn_readfirstlane(tid >> 6), r32 = lane & 31, hi = lane >> 5;
    unsigned char* ws = p.ws;
    const int q0 = qb * 256, qw0 = q0 + wid * 32, qg = qw0 + r32;
    const bf16_t* Qp = (const bf16_t*)(ws + OFF_Q) + ((size_t)bh * 2048 + qw0) * 96;
    const bf16_t* Kp = (const bf16_t*)(ws + OFF_K) + (size_t)bh * 2048 * 96;
    const bf16_t* Vp = (const bf16_t*)(ws + OFF_VT) + (size_t)bh * 64 * 2048;
    bf16x8 qf[6];
#pragma unroll
    for (int ks = 0; ks < 6; ++ks) qf[ks] = *(const bf16x8*)(Qp + r32 * 96 + ks * 16 + hi * 8);
    f32x16 ot[2];
#pragma unroll
    for (int r = 0; r < 16; ++r) { ot[0][r] = 0.f; ot[1][r] = 0.f; }
    float m = -INFINITY, l = 0.f;
    const int nst = (q0 + 256) / 128;
    int kro[3], kco[3];
#pragma unroll
    for (int i = 0; i < 3; ++i) { const int pc = tid + NTHR * i; kro[i] = pc / 12; kco[i] = pc % 12; }
    const int vd0 = tid >> 4, vc = tid & 15;
    u32x4 rk[3], rv[2];
#pragma unroll
    for (int i = 0; i < 3; ++i) rk[i] = *(const u32x4*)(Kp + (size_t)kro[i] * 96 + kco[i] * 8);
#pragma unroll
    for (int i = 0; i < 2; ++i) rv[i] = *(const u32x4*)(Vp + (size_t)(vd0 + 32 * i) * 2048 + vc * 8);
#pragma unroll
    for (int i = 0; i < 3; ++i) *(u32x4*)(lds + kro[i] * AT_KSTR + kco[i] * 16) = rk[i];
#pragma unroll
    for (int i = 0; i < 2; ++i) { u32x2* d = (u32x2*)(lds + AT_KB + (vd0 + 32 * i) * AT_VSTR + vc * 16); d[0] = (u32x2){rv[i].x, rv[i].y}; d[1] = (u32x2){rv[i].z, rv[i].w}; }
    __syncthreads();
    for (int t = 0; t < nst; ++t) {
        const unsigned char* st = lds + (t & 1) * AT_STAGE;
        if (t + 1 < nst) {
            const int kn = (t + 1) * 128;
#pragma unroll
            for (int i = 0; i < 3; ++i) rk[i] = *(const u32x4*)(Kp + (size_t)(kn + kro[i]) * 96 + kco[i] * 8);
#pragma unroll
            for (int i = 0; i < 2; ++i) rv[i] = *(const u32x4*)(Vp + (size_t)(vd0 + 32 * i) * 2048 + kn + vc * 8);
        }
#pragma unroll
        for (int sub = 0; sub < 2; ++sub) {
            const int kv0 = t * 128 + sub * 64;
            if (kv0 <= qw0 + 31) {
                f32x16 s0, s1;
#pragma unroll
                for (int r = 0; r < 16; ++r) { s0[r] = 0.f; s1[r] = 0.f; }
                const unsigned char* kb = st + (sub * 64 + r32) * AT_KSTR + hi * 16;
#pragma unroll
                for (int ks = 0; ks < 6; ++ks) {
                    const bf16x8 k0f = *(const bf16x8*)(kb + ks * 32);
                    const bf16x8 k1f = *(const bf16x8*)(kb + 32 * AT_KSTR + ks * 32);
                    s0 = __builtin_amdgcn_mfma_f32_32x32x16_bf16(k0f, qf[ks], s0, 0, 0, 0);
                    s1 = __builtin_amdgcn_mfma_f32_32x32x16_bf16(k1f, qf[ks], s1, 0, 0, 0);
                }
                if (kv0 + 63 > qw0) {
#pragma unroll
                    for (int r = 0; r < 16; ++r) { const int key = kv0 + crow(r, hi); if (key > qg) s0[r] = -INFINITY; if (key + 32 > qg) s1[r] = -INFINITY; }
                }
                float mx = fmaxf(s0[0], s1[0]);
#pragma unroll
                for (int r = 1; r < 16; ++r) mx = fmaxf(mx, fmaxf(s0[r], s1[r]));
                mx = fmaxf(mx, __shfl_xor(mx, 32));
                const float mn = fmaxf(m, mx), alpha = __builtin_amdgcn_exp2f(m - mn);
                float ps = 0.f;
#pragma unroll
                for (int r = 0; r < 16; ++r) { s0[r] = __builtin_amdgcn_exp2f(s0[r] - mn); s1[r] = __builtin_amdgcn_exp2f(s1[r] - mn); ps += s0[r] + s1[r]; }
                l = l * alpha + ps; m = mn;
#pragma unroll
                for (int r = 0; r < 16; ++r) { ot[0][r] *= alpha; ot[1][r] *= alpha; }
                const unsigned char* vb = st + AT_KB + r32 * AT_VSTR + sub * 128 + hi * 8;
#pragma unroll
                for (int kt2 = 0; kt2 < 2; ++kt2)
#pragma unroll
                    for (int s = 0; s < 2; ++s) {
                        u32x4 pw;
                        if (kt2 == 0) { pw.x = pk2(s0[8 * s], s0[8 * s + 1]); pw.y = pk2(s0[8 * s + 2], s0[8 * s + 3]); pw.z = pk2(s0[8 * s + 4], s0[8 * s + 5]); pw.w = pk2(s0[8 * s + 6], s0[8 * s + 7]); }
                        else { pw.x = pk2(s1[8 * s], s1[8 * s + 1]); pw.y = pk2(s1[8 * s + 2], s1[8 * s + 3]); pw.z = pk2(s1[8 * s + 4], s1[8 * s + 5]); pw.w = pk2(s1[8 * s + 6], s1[8 * s + 7]); }
                        const bf16x8 pf = __builtin_bit_cast(bf16x8, pw);
#pragma unroll
                        for (int dt = 0; dt < 2; ++dt) {
                            const unsigned char* a = vb + dt * 32 * AT_VSTR + (kt2 * 32 + 16 * s) * 2;
                            const u32x2 lo = *(const u32x2*)a, hh = *(const u32x2*)(a + 16);
                            const bf16x8 vf = __builtin_bit_cast(bf16x8, (u32x4){lo.x, lo.y, hh.x, hh.y});
                            ot[dt] = __builtin_amdgcn_mfma_f32_32x32x16_bf16(vf, pf, ot[dt], 0, 0, 0);
                        }
                    }
            }
        }
        if (t + 1 < nst) {
            unsigned char* sn = lds + ((t + 1) & 1) * AT_STAGE;
#pragma unroll
            for (int i = 0; i < 3; ++i) *(u32x4*)(sn + kro[i] * AT_KSTR + kco[i] * 16) = rk[i];
#pragma unroll
            for (int i = 0; i < 2; ++i) { u32x2* d = (u32x2*)(sn + AT_KB + (vd0 + 32 * i) * AT_VSTR + vc * 16); d[0] = (u32x2){rv[i].x, rv[i].y}; d[1] = (u32x2){rv[i].z, rv[i].w}; }
        }
        __syncthreads();
    }
    l += __shfl_xor(l, 32);
    const float inv = 1.0f / l;
    bf16_t* dst = (bf16_t*)(ws + OFF_HBUF) + ((size_t)(bh >> 3) * 2048 + qg) * 1024 + 512 + (bh & 7) * 64;
#pragma unroll
    for (int dt = 0; dt < 2; ++dt)
#pragma unroll
        for (int g4 = 0; g4 < 4; ++g4) { u32x2 o; o.x = pk2(ot[dt][4 * g4] * inv, ot[dt][4 * g4 + 1] * inv); o.y = pk2(ot[dt][4 * g4 + 2] * inv, ot[dt][4 * g4 + 3] * inv);
            *(u32x2*)(dst + dt * 32 + 8 * g4 + 4 * hi) = o; }
}

__device__ void phase2(const Params& p, unsigned char* lds) {
    for (int rp = 0; rp < ((PROBE_REP & 131072) ? 2 : 1); ++rp)
    for (int it = blockIdx.x; it < 256; it += gridDim.x) s5_item(p, lds, it >> 3, it & 7);
    for (int rp2 = 0; rp2 < ((PROBE_REP & 262144) ? 2 : 1); ++rp2)
    for (int v = blockIdx.x; v < 256; v += gridDim.x) {
        const int bh = v >> 1;
        for (int i = 0; i < 4; ++i) { const int qb = (v & 1) ? ((i == 0) ? 6 : (i == 1) ? 1 : (i == 2) ? 5 : 2) : ((i == 0) ? 7 : (i == 1) ? 0 : (i == 2) ? 4 : 3); attn_item(p, lds, bh, qb); }
    }
}

__device__ __forceinline__ void cex_desc(float& a, float& b) { const float mx = fmaxf(a, b), mn = fminf(a, b); a = mx; b = mn; }
__device__ __forceinline__ void sort16_desc(float (&v)[16]) {
#pragma unroll
    for (int k = 2; k <= 16; k <<= 1)
#pragma unroll
        for (int j = k >> 1; j > 0; j >>= 1)
#pragma unroll
            for (int i = 0; i < 16; ++i) { const int l = i ^ j; if (l > i) { if ((i & k) == 0) cex_desc(v[i], v[l]); else cex_desc(v[l], v[i]); } }
}
__device__ __forceinline__ void merge16(float (&top)[16], const float (&c)[16]) {
#pragma unroll
    for (int i = 0; i < 16; ++i) top[i] = fmaxf(top[i], c[15 - i]);
#pragma unroll
    for (int j = 8; j > 0; j >>= 1)
#pragma unroll
        for (int i = 0; i < 16; ++i) { const int l = i ^ j; if (l > i) cex_desc(top[i], top[l]); }
}
__device__ __forceinline__ float mkc(float a, float b, unsigned code) { return __uint_as_float((__float_as_uint(a + b) & 0xFFFFFF00u) | code); }


struct RowBuf { u32x4 d[4], u[4]; };
__device__ __forceinline__ void g_load(RowBuf& B, const unsigned char* __restrict__ E8, int idv, int kbase, int lane) {
#pragma unroll
    for (int j = 0; j < 4; ++j) { const int e = __builtin_amdgcn_readlane(idv, kbase + j);
        B.d[j] = *(const u32x4*)(E8 + (size_t)e * 1024 + lane * 16); B.u[j] = *(const u32x4*)(E8 + (size_t)(16384 + e) * 1024 + lane * 16); }
}
__device__ __forceinline__ float dpp_add(float t, const int ctrl_sel) {
    if (ctrl_sel == 0) return t + __int_as_float(__builtin_amdgcn_update_dpp(0, __float_as_int(t), 0xB1, 0xF, 0xF, false));
    if (ctrl_sel == 1) return t + __int_as_float(__builtin_amdgcn_update_dpp(0, __float_as_int(t), 0x4E, 0xF, 0xF, false));
    if (ctrl_sel == 2) return t + __int_as_float(__builtin_amdgcn_update_dpp(0, __float_as_int(t), 0x141, 0xF, 0xF, false));
    return t + __int_as_float(__builtin_amdgcn_update_dpp(0, __float_as_int(t), 0x140, 0xF, 0xF, false));
}
__device__ __forceinline__ void g_compute(const RowBuf& B, const f32x2 (&hv)[8], f32x2 (&acc)[8], float sdv, float gwv, int kbase, int lane) {
    float s[4];
#pragma unroll
    for (int j = 0; j < 4; ++j) { f32x2 a = {0.f, 0.f};
#pragma unroll
        for (int q = 0; q < 4; ++q) { const int w = (int)B.d[j][q]; const f32x2 lo = __builtin_amdgcn_cvt_pk_f32_fp8(w, false), hi = __builtin_amdgcn_cvt_pk_f32_fp8(w, true);
            a = __builtin_elementwise_fma(lo, hv[2 * q], a); a = __builtin_elementwise_fma(hi, hv[2 * q + 1], a); }
        s[j] = a.x + a.y; }
    auto r0 = __builtin_amdgcn_permlane32_swap(__float_as_uint(s[0]), __float_as_uint(s[1]), false, false);
    auto r1 = __builtin_amdgcn_permlane32_swap(__float_as_uint(s[2]), __float_as_uint(s[3]), false, false);
    const float r01 = __uint_as_float(r0[0]) + __uint_as_float(r0[1]), r23 = __uint_as_float(r1[0]) + __uint_as_float(r1[1]);
    auto r2 = __builtin_amdgcn_permlane16_swap(__float_as_uint(r01), __float_as_uint(r23), false, false);
    float t = __uint_as_float(r2[0]) + __uint_as_float(r2[1]);
    t = dpp_add(t, 0); t = dpp_add(t, 1); t = dpp_add(t, 2); t = dpp_add(t, 3);
    const int jl = kbase + ((lane >> 4) & 1) * 2 + (lane >> 5);
    const float sdl = __shfl(sdv, jl), gwl = __shfl(gwv, jl);
    const float w = gwl * gelu_tanh(sdl * t);
    float wj[4];
    wj[0] = __int_as_float(__builtin_amdgcn_readlane(__float_as_int(w), 0)); wj[1] = __int_as_float(__builtin_amdgcn_readlane(__float_as_int(w), 32));
    wj[2] = __int_as_float(__builtin_amdgcn_readlane(__float_as_int(w), 16)); wj[3] = __int_as_float(__builtin_amdgcn_readlane(__float_as_int(w), 48));
#pragma unroll
    for (int j = 0; j < 4; ++j) { const f32x2 ws = {wj[j], wj[j]};
#pragma unroll
        for (int q = 0; q < 4; ++q) { const int w2 = (int)B.u[j][q]; const f32x2 lo = __builtin_amdgcn_cvt_pk_f32_fp8(w2, false), hi = __builtin_amdgcn_cvt_pk_f32_fp8(w2, true);
            acc[2 * q] = __builtin_elementwise_fma(lo, ws, acc[2 * q]); acc[2 * q + 1] = __builtin_elementwise_fma(hi, ws, acc[2 * q + 1]); } }
}

constexpr int QP_STR = 528, S_OFF = 128 * QP_STR, S_STR = 132, L_OFF = S_OFF + 128 * S_STR * 4;

__device__ void phase3(const Params& p, unsigned char* lds) {
    const int tid = threadIdx.x, lane = tid & 63, wid = __builtin_amdgcn_readfirstlane(tid >> 6), r32 = lane & 31, hi = lane >> 5, wm = wid >> 2, wn = wid & 3;
    unsigned char* ws = p.ws;
    bf16_t* hbuf = (bf16_t*)(ws + OFF_HBUF); const bf16_t* ybuf = (const bf16_t*)(ws + OFF_YBUF);
    int* idxb = (int*)(ws + OFF_IDX); float* gb = (float*)(ws + OFF_G);
    for (int tile = blockIdx.x; tile < 256; tile += gridDim.x) {
        const int row0 = tile * 128, b = row0 >> 11;
        const float* mod = (const float*)(ws + OFF_MODT) + (size_t)tile * 6144 - (size_t)b * 6144;
        float* ssum = (float*)(lds + SM_OFF); float* ratio = ssum + 128; float* rsat = ratio + 128; float* ss1 = rsat + 128;
        const bf16_t* ybT = ybuf + (size_t)row0 * 16;
        for (int rp3a = 0; rp3a < ((PROBE_REP & 16) ? 2 : 1); ++rp3a) {
            gemm_128w<0>(AGrp{ybT}, (const bf16_t*)(ws + OFF_WGLUT), 512, 512, lds, nullptr, [&](const float* Ct, int nc) {
#pragma unroll 2
                for (int i = 0; i < 8; ++i) { const int pidx = tid + NTHR * i, row = pidx >> 5, c8 = (pidx & 31) * 8, col = nc * 256 + c8;
                    const f32x4 a0 = *(const f32x4*)(Ct + row * CSTR + c8), a1 = *(const f32x4*)(Ct + row * CSTR + c8 + 4);
                    const u32x4 yw = *(const u32x4*)(ybT + ((size_t)(col >> 4) * T_TOK + row) * 16 + (col & 15));
                    const f32x4 b0 = *(const f32x4*)(p.b_glu + col), b1 = *(const f32x4*)(p.b_glu + col + 4);
                    float o[8];
                    o[0] = bflo(yw.x) * sigmoidf_(a0.x + b0.x); o[1] = bfhi(yw.x) * sigmoidf_(a0.y + b0.y); o[2] = bflo(yw.y) * sigmoidf_(a0.z + b0.z); o[3] = bfhi(yw.y) * sigmoidf_(a0.w + b0.w);
                    o[4] = bflo(yw.z) * sigmoidf_(a1.x + b1.x); o[5] = bfhi(yw.z) * sigmoidf_(a1.y + b1.y); o[6] = bflo(yw.w) * sigmoidf_(a1.z + b1.z); o[7] = bfhi(yw.w) * sigmoidf_(a1.w + b1.w);
                    float ss = 0.f;
#pragma unroll
                    for (int k = 0; k < 8; ++k) ss += o[k] * o[k];
                    *(u32x4*)(hbuf + (size_t)(row0 + row) * 1024 + col) = (u32x4){pk2(o[0], o[1]), pk2(o[2], o[3]), pk2(o[4], o[5]), pk2(o[6], o[7])};
#pragma unroll
                    for (int of = 1; of < 32; of <<= 1) ss += __shfl_xor(ss, of);
                    if ((lane & 31) == 0) { if (nc == 0) ssum[row] = ss; else ssum[row] += ss; } } });
        }
#pragma unroll 1
        for (int r4 = 0; r4 < 4; ++r4) { u32x4 w[4];
#pragma unroll
            for (int u = 0; u < 4; ++u) w[u] = *(const u32x4*)(hbuf + (size_t)(row0 + r4 * 32 + u * 8 + wid) * 1024 + 512 + lane * 8);
#pragma unroll
            for (int u = 0; u < 4; ++u) { const int r = r4 * 32 + u * 8 + wid;
                float ss = bflo(w[u].x) * bflo(w[u].x) + bfhi(w[u].x) * bfhi(w[u].x) + bflo(w[u].y) * bflo(w[u].y) + bfhi(w[u].y) * bfhi(w[u].y) + bflo(w[u].z) * bflo(w[u].z) + bfhi(w[u].z) * bfhi(w[u].z) + bflo(w[u].w) * bflo(w[u].w) + bfhi(w[u].w) * bfhi(w[u].w);
                ss = wave_sum(ss);
                if (lane == 0) { const float ra = rsqrtf(ss * (1.0f / 512.0f) + EPS), rs = rsqrtf(ssum[r] * (1.0f / 512.0f) + EPS); rsat[r] = ra; ratio[r] = rs / ra; } }
        }
        __threadfence_block(); __syncthreads();
        for (int rep_c = 0; rep_c < ((PROBE_REP & 128) ? 2 : 1); ++rep_c)
        for (int nc = 0; nc < 4; ++nc) {
            f32x4 xpre[16];
#pragma unroll
            for (int i = 0; i < 16; ++i) xpre[i] = *(const f32x4*)(p.x + (size_t)(row0 + wid + NWAVE * i) * 1024 + nc * 256 + lane * 4);
            gemm_128<2, 1, 8, 3>(ARow{hbuf + (size_t)row0 * 1024, 1024}, (const bf16_t*)(ws + OFF_WOUTT) + (size_t)nc * 256 * 1024, 1024, 1024, lds, ratio, [&](const float* Ct) {
                const f32x4 gm = *(const f32x4*)(mod + b * 6144 + 2048 + nc * 256 + lane * 4);
#pragma unroll
                for (int i = 0; i < 16; ++i) { const int row = wid + NWAVE * i, col = nc * 256 + lane * 4; const size_t o = (size_t)(row0 + row) * 1024 + col;
                    const f32x4 v = *(const f32x4*)(Ct + row * CSTR + lane * 4), xv = xpre[i]; const float ra = rsat[row];
                    f32x4 r; r.x = xv.x + gm.x * v.x * ra; r.y = xv.y + gm.y * v.y * ra; r.z = xv.z + gm.z * v.z * ra; r.w = xv.w + gm.w * v.w * ra;
                    *(f32x4*)(p.out + o) = r;
                    const float ss = wave_sum(r.x * r.x + r.y * r.y + r.z * r.z + r.w * r.w);
                    if (lane == 0) { if (nc == 0) ss1[row] = ss; else ss1[row] += ss; } } });
        }
        __threadfence_block(); __syncthreads();
        for (int rp3d = 0; rp3d < ((PROBE_REP & 4096) ? 2 : 1); ++rp3d) {
        {   f32x4 mg[4], msh[4];
#pragma unroll
            for (int j = 0; j < 4; ++j) { const int col = 4 * (lane + 64 * j); const f32x4 g = *(const f32x4*)(p.norm_ffn + col), sc = *(const f32x4*)(mod + b * 6144 + 4096 + col);
                mg[j] = (f32x4){g.x * (1.f + sc.x), g.y * (1.f + sc.y), g.z * (1.f + sc.z), g.w * (1.f + sc.w)}; msh[j] = *(const f32x4*)(mod + b * 6144 + 3072 + col); }
#pragma unroll 1
            for (int r4 = 0; r4 < 4; ++r4) {
                f32x4 v[4][4];
#pragma unroll
                for (int u = 0; u < 4; ++u)
#pragma unroll
                    for (int j = 0; j < 4; ++j) v[u][j] = ((const f32x4*)(p.out + (size_t)(row0 + r4 * 32 + u * 8 + wid) * 1024))[lane + 64 * j];
#pragma unroll
                for (int u = 0; u < 4; ++u) { const int r = r4 * 32 + u * 8 + wid; const float rs = rsqrtf(ss1[r] * (1.0f / 1024.0f) + EPS);
#pragma unroll
                    for (int j = 0; j < 4; ++j) { const int col = 4 * (lane + 64 * j);
                        u32x2 o; o.x = pk2(v[u][j].x * rs * mg[j].x + msh[j].x, v[u][j].y * rs * mg[j].y + msh[j].y); o.y = pk2(v[u][j].z * rs * mg[j].z + msh[j].z, v[u][j].w * rs * mg[j].w + msh[j].w);
                        *(u32x2*)(hbuf + (size_t)(row0 + r) * 1024 + col) = o; } }
            }
        }
        __threadfence_block(); __syncthreads();
        }
        if (PROBE_REP & (524288 | 1048576)) { struct ARowM { const bf16_t* A; int lda; int mask; __device__ __forceinline__ const bf16_t* operator()(int row, int k) const { return A + (size_t)row * lda + (k & mask); } };
            for (int h = 0; h < 8; ++h) gemm_128<2, 0, 0, 3>(ARowM{hbuf + (size_t)row0 * 1024, 1024, (PROBE_REP & 524288) ? 63 : 1023}, (const bf16_t*)(ws + OFF_WQT) + (size_t)h * 256 * 1024, 1024, 1024, lds, nullptr, [&](int row, int col, float v) { asm volatile("" :: "v"(v), "v"(row), "v"(col)); });
            __syncthreads(); }
        for (int rep_e = 0; rep_e < ((PROBE_REP & 32) ? 2 : 1); ++rep_e) {
        float* Ls = (float*)(lds + CT_BYTES);
        for (int h = 0; h < 8; ++h) {
            gemm_128<2, 1, 0, 3>(ARow{hbuf + (size_t)row0 * 1024, 1024}, (const bf16_t*)(ws + OFF_WQT) + (size_t)h * 256 * 1024, 1024, 1024, lds, nullptr, [&](const float* Ct) {
#pragma unroll 1
                for (int ph = 0; ph < 2; ++ph) {
                    const int row = tid >> 2, qd = tid & 3; float top[16];
#pragma unroll
                    for (int c2 = 0; c2 < 2; ++c2) { float c[16];
#pragma unroll
                        for (int q = 0; q < 4; ++q) { const int kb = qd * 32 + c2 * 16 + 4 * q; const f32x4 t4 = *(const f32x4*)(Ct + row * CSTR + ph * 128 + kb);
                            c[4 * q] = __uint_as_float((__float_as_uint(t4.x) & 0xFFFFFF80u) | (unsigned)(127 - kb));
                            c[4 * q + 1] = __uint_as_float((__float_as_uint(t4.y) & 0xFFFFFF80u) | (unsigned)(126 - kb));
                            c[4 * q + 2] = __uint_as_float((__float_as_uint(t4.z) & 0xFFFFFF80u) | (unsigned)(125 - kb));
                            c[4 * q + 3] = __uint_as_float((__float_as_uint(t4.w) & 0xFFFFFF80u) | (unsigned)(124 - kb)); }
                        sort16_desc(c);
                        if (c2 == 0) {
#pragma unroll
                            for (int k = 0; k < 16; ++k) top[k] = c[k];
                        } else merge16(top, c); }
                    { float o[16];
#pragma unroll
                      for (int k = 0; k < 16; ++k) o[k] = __int_as_float(__builtin_amdgcn_update_dpp(0, __float_as_int(top[k]), 0xB1, 0xF, 0xF, false));
                      merge16(top, o);
#pragma unroll
                      for (int k = 0; k < 16; ++k) o[k] = __int_as_float(__builtin_amdgcn_update_dpp(0, __float_as_int(top[k]), 0x4E, 0xF, 0xF, false));
                      merge16(top, o); }
                    if (qd == 0) {
#pragma unroll
                        for (int q = 0; q < 4; ++q) *(f32x4*)(Ls + (ph * 128 + row) * 16 + 4 * q) = (f32x4){top[4 * q], top[4 * q + 1], top[4 * q + 2], top[4 * q + 3]}; }
                }
                __syncthreads();
            if (wid < 2) {
                const int row = wid * 64 + lane; float a1[16], a2[16], top[16];
#pragma unroll
                for (int k = 0; k < 16; ++k) { a1[k] = __uint_as_float(__float_as_uint(Ls[row * 16 + k]) & 0xFFFFFF80u); a2[k] = __uint_as_float(__float_as_uint(Ls[(128 + row) * 16 + k]) & 0xFFFFFF80u); }
    { float c[16];
      c[0] = mkc(a1[0], a2[0], 255u);
      c[1] = mkc(a1[0], a2[1], 254u);
      c[2] = mkc(a1[0], a2[2], 253u);
      c[3] = mkc(a1[0], a2[3], 252u);
      c[4] = mkc(a1[0], a2[4], 251u);
      c[5] = mkc(a1[0], a2[5], 250u);
      c[6] = mkc(a1[0], a2[6], 249u);
      c[7] = mkc(a1[0], a2[7], 248u);
      c[8] = mkc(a1[0], a2[8], 247u);
      c[9] = mkc(a1[0], a2[9], 246u);
      c[10] = mkc(a1[0], a2[10], 245u);
      c[11] = mkc(a1[0], a2[11], 244u);
      c[12] = mkc(a1[0], a2[12], 243u);
      c[13] = mkc(a1[0], a2[13], 242u);
      c[14] = mkc(a1[0], a2[14], 241u);
      c[15] = mkc(a1[0], a2[15], 240u);
      sort16_desc(c); _Pragma("unroll") for (int k = 0; k < 16; ++k) top[k] = c[k];
    }
    { float c[16];
      c[0] = mkc(a1[1], a2[0], 239u);
      c[1] = mkc(a1[1], a2[1], 238u);
      c[2] = mkc(a1[1], a2[2], 237u);
      c[3] = mkc(a1[1], a2[3], 236u);
      c[4] = mkc(a1[1], a2[4], 235u);
      c[5] = mkc(a1[1], a2[5], 234u);
      c[6] = mkc(a1[1], a2[6], 233u);
      c[7] = mkc(a1[1], a2[7], 232u);
      c[8] = mkc(a1[2], a2[0], 223u);
      c[9] = mkc(a1[2], a2[1], 222u);
      c[10] = mkc(a1[2], a2[2], 221u);
      c[11] = mkc(a1[2], a2[3], 220u);
      c[12] = mkc(a1[2], a2[4], 219u);
      c[13] = mkc(a1[3], a2[0], 207u);
      c[14] = mkc(a1[3], a2[1], 206u);
      c[15] = mkc(a1[3], a2[2], 205u);
      sort16_desc(c); merge16(top, c);
    }
    { float c[16];
      c[0] = mkc(a1[3], a2[3], 204u);
      c[1] = mkc(a1[4], a2[0], 191u);
      c[2] = mkc(a1[4], a2[1], 190u);
      c[3] = mkc(a1[4], a2[2], 189u);
      c[4] = mkc(a1[5], a2[0], 175u);
      c[5] = mkc(a1[5], a2[1], 174u);
      c[6] = mkc(a1[6], a2[0], 159u);
      c[7] = mkc(a1[6], a2[1], 158u);
      c[8] = mkc(a1[7], a2[0], 143u);
      c[9] = mkc(a1[7], a2[1], 142u);
      c[10] = mkc(a1[8], a2[0], 127u);
      c[11] = mkc(a1[9], a2[0], 111u);
      c[12] = mkc(a1[10], a2[0], 95u);
      c[13] = mkc(a1[11], a2[0], 79u);
      c[14] = mkc(a1[12], a2[0], 63u);
      c[15] = mkc(a1[13], a2[0], 47u);
      sort16_desc(c); merge16(top, c);
    }
    { float c[16];
      c[0] = mkc(a1[14], a2[0], 31u);
      c[1] = mkc(a1[15], a2[0], 15u);
      c[2] = -3.0e38f;
      c[3] = -3.0e38f;
      c[4] = -3.0e38f;
      c[5] = -3.0e38f;
      c[6] = -3.0e38f;
      c[7] = -3.0e38f;
      c[8] = -3.0e38f;
      c[9] = -3.0e38f;
      c[10] = -3.0e38f;
      c[11] = -3.0e38f;
      c[12] = -3.0e38f;
      c[13] = -3.0e38f;
      c[14] = -3.0e38f;
      c[15] = -3.0e38f;
      sort16_desc(c); merge16(top, c);
    }
                float e[16], es = 0.f; const float m0 = __uint_as_float(__float_as_uint(top[0]) & 0xFFFFFF00u);
#pragma unroll
                for (int k = 0; k < 16; ++k) { e[k] = __expf(__uint_as_float(__float_as_uint(top[k]) & 0xFFFFFF00u) - m0); es += e[k]; }
                const float inv = 1.0f / es; const size_t ob = (size_t)(row0 + row) * 128 + h * 16;
#pragma unroll
                for (int k = 0; k < 16; ++k) { const unsigned code = 255u - (__float_as_uint(top[k]) & 0xFFu); const int i = code >> 4, j = code & 15;
                    const int i1 = 127 - (int)(__float_as_uint(Ls[row * 16 + i]) & 0x7Fu), i2 = 127 - (int)(__float_as_uint(Ls[(128 + row) * 16 + j]) & 0x7Fu);
                    idxb[ob + k] = i1 * 128 + i2; gb[ob + k] = e[k] * inv; }
            } });
        }
        }
        __syncthreads();
    }
}

constexpr int P4_LIST = 192;
struct TokState { f32x2 acc[8]; int offv; float sh; };

struct Rows4 { u32x4 r[4]; };
__device__ __forceinline__ void rows_load(Rows4& B, __amdgpu_buffer_rsrc_t rs, int rowbase, const int* sidp, int lane16) {
    const u32x4 ids = *(const u32x4*)sidp;
    const int e0 = __builtin_amdgcn_readfirstlane((int)ids.x), e1 = __builtin_amdgcn_readfirstlane((int)ids.y), e2 = __builtin_amdgcn_readfirstlane((int)ids.z), e3 = __builtin_amdgcn_readfirstlane((int)ids.w);
    B.r[0] = __builtin_amdgcn_raw_buffer_load_b128(rs, lane16, (rowbase + e0) << 10, 0); B.r[1] = __builtin_amdgcn_raw_buffer_load_b128(rs, lane16, (rowbase + e1) << 10, 0);
    B.r[2] = __builtin_amdgcn_raw_buffer_load_b128(rs, lane16, (rowbase + e2) << 10, 0); B.r[3] = __builtin_amdgcn_raw_buffer_load_b128(rs, lane16, (rowbase + e3) << 10, 0);
}
__device__ __forceinline__ int dpp_addi(int t, const int ctrl_sel) {
    if (ctrl_sel == 0) return t + __builtin_amdgcn_update_dpp(0, t, 0xB1, 0xF, 0xF, false);
    if (ctrl_sel == 1) return t + __builtin_amdgcn_update_dpp(0, t, 0x4E, 0xF, 0xF, false);
    if (ctrl_sel == 2) return t + __builtin_amdgcn_update_dpp(0, t, 0x141, 0xF, 0xF, false);
    return t + __builtin_amdgcn_update_dpp(0, t, 0x140, 0xF, 0xF, false);
}
__device__ __forceinline__ void g_compute2(const Rows4& D, const Rows4& U, const u32x4 hq, TokState& T, float sdl, float gwl) {
    int s[4];
#pragma unroll
    for (int j = 0; j < 4; ++j) { int a = 0;
#pragma unroll
        for (int q = 0; q < 4; ++q) a = __builtin_amdgcn_sdot4((int)D.r[j][q], (int)hq[q], a, false);
        s[j] = a; }
    auto r0 = __builtin_amdgcn_permlane32_swap((unsigned)s[0], (unsigned)s[1], false, false);
    auto r1 = __builtin_amdgcn_permlane32_swap((unsigned)s[2], (unsigned)s[3], false, false);
    const int r01 = (int)r0[0] + (int)r0[1], r23 = (int)r1[0] + (int)r1[1];
    auto r2 = __builtin_amdgcn_permlane16_swap((unsigned)r01, (unsigned)r23, false, false);
    int ti = (int)r2[0] + (int)r2[1];
    ti = dpp_addi(ti, 0); ti = dpp_addi(ti, 1); ti = dpp_addi(ti, 2); ti = dpp_addi(ti, 3);
    const float t = (float)ti * T.sh;
    const float w = gwl * gelu_tanh(sdl * t);
    float wj[4];
    wj[0] = __int_as_float(__builtin_amdgcn_readlane(__float_as_int(w), 0)); wj[1] = __int_as_float(__builtin_amdgcn_readlane(__float_as_int(w), 32));
    wj[2] = __int_as_float(__builtin_amdgcn_readlane(__float_as_int(w), 16)); wj[3] = __int_as_float(__builtin_amdgcn_readlane(__float_as_int(w), 48));
#pragma unroll
    for (int j = 0; j < 4; ++j) { const f32x2 ws = {wj[j], wj[j]};
#pragma unroll
        for (int q = 0; q < 4; ++q) { const int w2 = (int)U.r[j][q]; const f32x2 lo = __builtin_amdgcn_cvt_pk_f32_fp8(w2, false), hi = __builtin_amdgcn_cvt_pk_f32_fp8(w2, true);
            T.acc[2 * q] = __builtin_elementwise_fma(lo, ws, T.acc[2 * q]); T.acc[2 * q + 1] = __builtin_elementwise_fma(hi, ws, T.acc[2 * q + 1]); }
        __builtin_amdgcn_sched_barrier(0); }
}

template <int FAKE> __device__ void phase4(const Params& p, unsigned char* lds) {
    const int tid = threadIdx.x, lane = tid & 63, wid = __builtin_amdgcn_readfirstlane(tid >> 6);
    unsigned char* ws = p.ws;
    const bf16_t* hbuf = (const bf16_t*)(ws + OFF_HBUF); const int* idxb = (const int*)(ws + OFF_IDX); const float* gb = (const float*)(ws + OFF_G);
    const float* esc = (const float*)(ws + OFF_ESC);
    const __amdgpu_buffer_rsrc_t ers = __builtin_amdgcn_make_buffer_rsrc((void*)(ws + OFF_E8), 0, 32 << 20, 0x00020000); const int lane16 = lane * 16;
    int* sid = (int*)(lds + wid * (3 * 4 * P4_LIST * 4)); float* sgw = (float*)(sid + 4 * P4_LIST); float* ssd = sgw + 4 * P4_LIST;
    unsigned char* hql = lds + 8 * (3 * 4 * P4_LIST * 4) + wid * 4096;
    const int jl = ((lane >> 4) & 1) * 2 + (lane >> 5);
    for (int tile = blockIdx.x; tile < 256; tile += gridDim.x) {
        const int row0 = tile * 128, b = row0 >> 11;
        const float* gf = (const float*)(ws + OFF_MODT) + (size_t)tile * 6144 + 5120 + lane * 16;
#pragma unroll 1
        for (int st = 0; st < 4; ++st) {
            const int tokb = row0 + st * 32 + wid * 4;
            TokState T0, T1, T2, T3;
#define P4_PRO(T, j) { const size_t tok = tokb + (j); \
                int id0 = idxb[tok * 128 + lane], id1 = idxb[tok * 128 + 64 + lane]; if (FAKE) { id0 = (id0 & ~1023) | (id0 & 31); id1 = (id1 & ~1023) | (id1 & 31); } \
                const float sd0 = esc[id0], sd1 = esc[id1], gw0 = gb[tok * 128 + lane] * esc[16384 + id0], gw1 = gb[tok * 128 + 64 + lane] * esc[16384 + id1]; \
                _Pragma("unroll") for (int i = 0; i < 8; ++i) T.acc[i] = (f32x2){0.f, 0.f}; \
                { const u32x4 w0 = *(const u32x4*)(hbuf + tok * 1024 + lane * 16), w1 = *(const u32x4*)(hbuf + tok * 1024 + lane * 16 + 8); \
                  float hv[16] = {bflo(w0.x), bfhi(w0.x), bflo(w0.y), bfhi(w0.y), bflo(w0.z), bfhi(w0.z), bflo(w0.w), bfhi(w0.w), bflo(w1.x), bfhi(w1.x), bflo(w1.y), bfhi(w1.y), bflo(w1.z), bfhi(w1.z), bflo(w1.w), bfhi(w1.w)}; \
                  float am = 0.f; _Pragma("unroll") for (int i = 0; i < 16; ++i) am = fmaxf(am, fabsf(hv[i])); \
                  _Pragma("unroll") for (int o = 1; o < 64; o <<= 1) am = fmaxf(am, __shfl_xor(am, o)); \
                  const float sc = (am > 0.f) ? am * (1.0f / 127.0f) : 1.0f, inv = 1.0f / sc; T.sh = sc; u32x4 hq; \
                  _Pragma("unroll") for (int q = 0; q < 4; ++q) { const int b0 = (int)rintf(hv[4 * q] * inv), b1 = (int)rintf(hv[4 * q + 1] * inv), b2 = (int)rintf(hv[4 * q + 2] * inv), b3 = (int)rintf(hv[4 * q + 3] * inv); \
                      hq[q] = (unsigned)(b0 & 0xFF) | ((unsigned)(b1 & 0xFF) << 8) | ((unsigned)(b2 & 0xFF) << 16) | ((unsigned)(b3 & 0xFF) << 24); } \
                  *(u32x4*)(hql + (j) * 1024 + lane * 16) = hq; } \
                const int sl0 = id0 >> 10, sl1 = id1 >> 10; int po = 0, offv = 0, pos0 = 0, pos1 = 0; \
                _Pragma("unroll 1") for (int s = 0; s < 16; ++s) { \
                    const unsigned long long m0 = __ballot(sl0 == s), m1 = __ballot(sl1 == s); const int c0 = __popcll(m0), c = c0 + __popcll(m1); \
                    if (lane == s) offv = (po + 3) & ~3; \
                    if (sl0 == s) pos0 = po + (int)__builtin_amdgcn_mbcnt_hi((unsigned)(m0 >> 32), __builtin_amdgcn_mbcnt_lo((unsigned)m0, 0u)); \
                    if (sl1 == s) pos1 = po + c0 + (int)__builtin_amdgcn_mbcnt_hi((unsigned)(m1 >> 32), __builtin_amdgcn_mbcnt_lo((unsigned)m1, 0u)); \
                    po += c; } \
                if (lane == 16) offv = 128; T.offv = offv; \
                sid[(j) * P4_LIST + pos0] = id0; sgw[(j) * P4_LIST + pos0] = gw0; ssd[(j) * P4_LIST + pos0] = sd0; \
                sid[(j) * P4_LIST + pos1] = id1; sgw[(j) * P4_LIST + pos1] = gw1; ssd[(j) * P4_LIST + pos1] = sd1; }
            P4_PRO(T0, 0) P4_PRO(T1, 1) P4_PRO(T2, 2) P4_PRO(T3, 3)
#undef P4_PRO
            asm volatile("s_waitcnt lgkmcnt(0)" ::: "memory");
#define P4_ITEM(T, j) { const int st_ = __builtin_amdgcn_readlane(T.offv, s), en_ = __builtin_amdgcn_readlane(T.offv, s + 1); \
                if (st_ < en_) { const u32x4 hq = *(const u32x4*)(hql + (j) * 1024 + lane * 16); \
                    _Pragma("unroll 1") for (int i = st_; i < en_; i += 4) { Rows4 D, U; rows_load(D, ers, 0, sid + (j) * P4_LIST + i, lane16); rows_load(U, ers, 16384, sid + (j) * P4_LIST + i, lane16); \
                        g_compute2(D, U, hq, T, ssd[(j) * P4_LIST + i + jl], sgw[(j) * P4_LIST + i + jl]); } } }
#pragma unroll 1
            for (int s = 0; s < 16; ++s) { P4_ITEM(T0, 0) P4_ITEM(T1, 1) P4_ITEM(T2, 2) P4_ITEM(T3, 3) }
#undef P4_ITEM
#define P4_EPI(T, j) { float* orow = p.out + (size_t)(tokb + (j)) * 1024 + lane * 16; \
                _Pragma("unroll") for (int q = 0; q < 4; ++q) { f32x4 o = *(const f32x4*)(orow + 4 * q); const f32x4 gg = *(const f32x4*)(gf + 4 * q); \
                    o.x += gg.x * T.acc[2 * q].x; o.y += gg.y * T.acc[2 * q].y; o.z += gg.z * T.acc[2 * q + 1].x; o.w += gg.w * T.acc[2 * q + 1].y; if (FAKE) asm volatile("" :: "v"(o.x), "v"(o.y), "v"(o.z), "v"(o.w)); else *(f32x4*)(orow + 4 * q) = o; } }
            P4_EPI(T0, 0) P4_EPI(T1, 1) P4_EPI(T2, 2) P4_EPI(T3, 3)
#undef P4_EPI
        }
    }
}

#define LAS __attribute__((address_space(3)))
#define XB_TMO      128
#define XB_XCNT(j)  (256  + 64 * (j))
#define XB_XSUB(j)  (1280 + 64 * (j))
#define XB_XGEN(j)  (2304 + 64 * (j))
#define XB_TOP      3328
#define XB_TOPGEN   3392
#define XCD_BAR_WORDS 3456
#define XB_SPIN_CAP (1u << 18)

__device__ __forceinline__ unsigned xb_ld(unsigned* p)              { return __hip_atomic_load(p, __ATOMIC_RELAXED, __HIP_MEMORY_SCOPE_AGENT); }
__device__ __forceinline__ unsigned xb_add(unsigned* p, unsigned v) { return __hip_atomic_fetch_add(p, v, __ATOMIC_RELAXED, __HIP_MEMORY_SCOPE_AGENT); }
__device__ __forceinline__ unsigned xb_xcc_id() { return (unsigned)__builtin_amdgcn_s_getreg((3 << 11) | 20) & 0xFu; }
#define XB_SPIN(cond, bar) do { unsigned _sp = 0; while (cond) { __builtin_amdgcn_s_sleep(1); \
    if ((++_sp & 255u) == 0u) { if (xb_ld(&(bar)[XB_TMO])) break; if (_sp > XB_SPIN_CAP) { atomicAdd(&(bar)[XB_TMO], 1u); break; } } } } while (0)

struct XcdBarrier {
    unsigned* bar; unsigned x;
    volatile LAS unsigned* st;
};

__device__ __forceinline__ XcdBarrier xcd_barrier_post(unsigned* bar, volatile LAS unsigned* st) {
    XcdBarrier b; b.bar = bar; b.x = xb_xcc_id(); b.st = st;
    if (threadIdx.x == 0) (void)xb_add(&bar[XB_XCNT(b.x)], 1u);
    return b;
}
__device__ __forceinline__ void xcd_barrier_complete(unsigned* bar, unsigned x, unsigned& nloc, unsigned& nx) {
    const unsigned G = gridDim.x * gridDim.y * gridDim.z;
    unsigned sum, cnt, mine, sp = 0u;
    for (;;) {
        sum = 0u; cnt = 0u; mine = 0u;
#pragma unroll
        for (unsigned j = 0; j < 16; ++j) { const unsigned c = xb_ld(&bar[XB_XCNT(j)]); sum += c; cnt += (c > 0u) ? 1u : 0u; mine = (j == x) ? c : mine; }
        if (sum == G) break;
        __builtin_amdgcn_s_sleep(1);
        if ((++sp & 255u) == 0u) { if (xb_ld(&bar[XB_TMO])) break; if (sp > XB_SPIN_CAP) { atomicAdd(&bar[XB_TMO], 1u); break; } }
    }
    nloc = mine > 0u ? mine : 1u; nx = cnt > 0u ? cnt : 1u;
}

__device__ __forceinline__ void xcd_barrier(const XcdBarrier& b) {
    asm volatile("s_waitcnt vmcnt(0)" ::: "memory");
    __syncthreads();
    if (threadIdx.x == 0) {
        unsigned* bar = b.bar;
        __builtin_amdgcn_s_waitcnt(0);
        unsigned nloc = b.st[0], nx = b.st[1];
        if (nloc == 0u) { xcd_barrier_complete(bar, b.x, nloc, nx); b.st[0] = nloc; b.st[1] = nx; }
        const unsigned old = xb_add(&bar[XB_XSUB(b.x)], 1u);
        const unsigned gen = old / nloc;
        if (old + 1u == (gen + 1u) * nloc) {
            __builtin_amdgcn_fence(__ATOMIC_RELEASE, "agent");
            asm volatile("s_waitcnt vmcnt(0)" ::: "memory");
            const unsigned og = xb_add(&bar[XB_TOP], 1u);
            const unsigned tg = og / nx;
            if (og + 1u == (tg + 1u) * nx) xb_add(&bar[XB_TOPGEN], 1u);
            else XB_SPIN(xb_ld(&bar[XB_TOPGEN]) == tg, bar);
            __builtin_amdgcn_fence(__ATOMIC_ACQUIRE, "agent");
            xb_add(&bar[XB_XGEN(b.x)], 1u);
            asm volatile("s_waitcnt vmcnt(0)" ::: "memory");
        } else {
            XB_SPIN(xb_ld(&bar[XB_XGEN(b.x)]) == gen, bar);
            __builtin_amdgcn_fence(__ATOMIC_ACQUIRE, "agent");
            asm volatile("s_waitcnt vmcnt(0)" ::: "memory");
        }
    }
    __syncthreads();
}

__global__ void __launch_bounds__(NTHR, 2) fwd_kernel(Params p) {
    extern __shared__ __attribute__((aligned(16))) unsigned char lds[];
#if MK_COOP
    volatile LAS unsigned* bst = (volatile LAS unsigned*)(lds + LDS_BYTES - 16);
    if (threadIdx.x < 2) bst[threadIdx.x] = 0u;
    __syncthreads();
    const XcdBarrier xbar = xcd_barrier_post((unsigned*)(p.ws + OFF_BAR), bst);
#endif
    if (p.ph_lo <= 0 && 0 < p.ph_hi) { phase0(p, lds); if (PROBE_REP & 1) { __syncthreads(); phase0(p, lds); } }
#if MK_COOP
    if (p.ph_lo <= 0 && 1 < p.ph_hi) { if (p.ph_hi > 64) cg::this_grid().sync(); else xcd_barrier(xbar); }
#endif
    if (p.ph_lo <= 1 && 1 < p.ph_hi) { phase1(p, lds); if (PROBE_REP & 2) { __syncthreads(); phase1(p, lds); } }
#if MK_COOP
    if (p.ph_lo <= 1 && 2 < p.ph_hi) { xcd_barrier(xbar); if (PROBE_REP & 2097152) { for (int q = 0; q < 8; ++q) xcd_barrier(xbar); } if (PROBE_REP & 4194304) { for (int q = 0; q < 4; ++q) cg::this_grid().sync(); } }
#endif
    if (p.ph_lo <= 2 && 2 < p.ph_hi) { phase2(p, lds); if (PROBE_REP & 4) { __syncthreads(); phase2(p, lds); } }
#if MK_COOP
    if (p.ph_lo <= 2 && 3 < p.ph_hi) xcd_barrier(xbar);
#endif
    if (p.ph_lo <= 3 && 3 < p.ph_hi) phase3(p, lds);
#if MK_COOP
    if (p.ph_lo <= 3 && 4 < p.ph_hi) xcd_barrier(xbar);
#endif
    if (p.ph_lo <= 4 && 4 < p.ph_hi) { if (PROBE_REP & 2048) { phase4<1>(p, lds); __syncthreads(); } phase4<0>(p, lds); }
}

extern "C" void kernel_launch(void* const* d_in, const int* in_sizes, int n_in, void* d_out, int out_size, void* d_ws, size_t ws_size, hipStream_t stream) {
    static int grid = 0;
    if (grid == 0) {
        if (n_in != 31 || ws_size < WS_NEED) { fprintf(stderr, "kernel_launch: bad inputs (n_in %d, ws %zu < %zu)\n", n_in, ws_size, (size_t)WS_NEED); grid = -1; return; }
        int dev = 0, cus = 0, per_cu = 0;
        hipGetDevice(&dev); hipDeviceGetAttribute(&cus, hipDeviceAttributeMultiprocessorCount, dev);
        if (hipFuncSetAttribute((const void*)fwd_kernel, hipFuncAttributeMaxDynamicSharedMemorySize, LDS_BYTES) != hipSuccess) { fprintf(stderr, "kernel_launch: hipFuncSetAttribute failed\n"); grid = -1; return; }
        hipOccupancyMaxActiveBlocksPerMultiprocessor(&per_cu, (const void*)fwd_kernel, NTHR, LDS_BYTES);
        if (per_cu < 1) { fprintf(stderr, "kernel_launch: occupancy query says %d blocks/CU\n", per_cu); per_cu = 1; }
        grid = cus;
        (void)hipGetLastError();
    }
    if (grid < 0) return;
    (void)hipMemsetAsync((char*)d_ws + OFF_BAR, 0, 16384, stream);
    Params p{};
    const float** f = (const float**)&p;
    for (int i = 0; i < 31; ++i) f[i] = (const float*)d_in[i];
    p.out = (float*)d_out; p.ws = (unsigned char*)d_ws;
#if MK_COOP
    p.ph_lo = 0; p.ph_hi = 5;
    void* args[] = {&p};
    hipError_t e = hipLaunchCooperativeKernel((const void*)fwd_kernel, dim3(grid), dim3(NTHR), args, LDS_BYTES, stream);
    if (e != hipSuccess) fprintf(stderr, "cooperative launch failed: %s (grid %d)\n", hipGetErrorString(e), grid);
#else
    for (int ph = 0; ph < 5; ++ph) { p.ph_lo = ph; p.ph_hi = ph + 1; hipLaunchKernelGGL(fwd_kernel, dim3(grid), dim3(NTHR), LDS_BYTES, stream, p); }
#endif
}
```

```cpp
#include <hip/hip_runtime.h>
#include <hip/hip_cooperative_groups.h>
#include <cstdio>
#include <cstdint>
namespace cg = cooperative_groups;

#ifndef PROBE_REP
#define PROBE_REP 0
#endif
#ifndef PROBE_P0
#define PROBE_P0 0
#endif
#ifndef PROBE_TS
#define PROBE_TS 0
#endif
#ifndef MK_COOP
#define MK_COOP 1
#endif

typedef unsigned short bf16_t;
typedef short bf16x8 __attribute__((ext_vector_type(8)));
typedef short s16x4 __attribute__((ext_vector_type(4)));
typedef float f32x16 __attribute__((ext_vector_type(16)));
typedef float f32x4 __attribute__((ext_vector_type(4)));
typedef float f32x2 __attribute__((ext_vector_type(2)));
typedef unsigned u32x4 __attribute__((ext_vector_type(4)));
typedef unsigned u32x2 __attribute__((ext_vector_type(2)));

constexpr int NTHR = 512, NWAVE = 8;
constexpr int T_TOK = 32768, DM = 1024, NB = 16, SEQ = 2048;
constexpr int LDS_BYTES = 163840;
constexpr float EPS = 1e-6f;
constexpr float QSCALE = 0.10206207261596575f * 1.4426950408889634f;

constexpr size_t OFF_PART  = 0;
constexpr size_t OFF_MODT  = 8u << 20;
constexpr size_t OFF_WINT  = 16u << 20;
constexpr size_t OFF_WGLUT = OFF_WINT + (2u << 20);
constexpr size_t OFF_WUQT  = OFF_WGLUT + (512u << 10);
constexpr size_t OFF_WUKVT = OFF_WUQT + 524288;
constexpr size_t OFF_WOUTT = OFF_WUKVT + 262144;
constexpr size_t OFF_WQT   = OFF_WOUTT + (2u << 20);
constexpr size_t OFF_SUBK  = OFF_WQT + (4u << 20);
constexpr size_t OFF_KMT   = OFF_SUBK + 65536;
constexpr size_t OFF_WZT   = OFF_KMT + 20971520;
constexpr size_t OFF_AL    = OFF_WZT + 4194304;
constexpr size_t OFF_HBUF  = OFF_AL + 16384;
constexpr size_t OFF_PROJ2 = OFF_HBUF + (64u << 20);
constexpr size_t OFF_UBUF  = OFF_PROJ2 + (32u << 20);
constexpr size_t OFF_Q     = OFF_UBUF + 41943040;
constexpr size_t OFF_K     = OFF_Q + 50331648;
constexpr size_t OFF_VT    = OFF_K + 50331648;
constexpr size_t OFF_YBUF  = OFF_VT + 33554432;
constexpr size_t OFF_IDX   = OFF_YBUF + (32u << 20);
constexpr size_t OFF_G     = OFF_IDX + (16u << 20);
constexpr size_t OFF_E8    = OFF_G + (16u << 20);
constexpr size_t OFF_ESC   = OFF_E8 + (32u << 20);
constexpr size_t OFF_BAR   = OFF_ESC + (1u << 20);
constexpr size_t WS_NEED   = OFF_BAR + (1u << 20);

struct Params {
    const float* x; const float* c; const int* pos; const float* w_ada; const float* b_ada; const float* norm_mix; const float* norm_ffn; const float* w_in;
    const float* lam_re; const float* lam_im; const float* log_dt; const float* b_re; const float* b_im; const float* c_re; const float* c_im; const float* d_skip;
    const float* w_glu; const float* b_glu; const float* q_a_norm; const float* w_uq; const float* kv_a_norm; const float* w_ukv; const float* q_norm; const float* k_norm;
    const float* out_norm_ssm; const float* out_norm_attn; const float* w_out; const float* w_query; const float* sub_keys; const float* e_down; const float* e_up;
    float* out; unsigned char* ws; int ph_lo, ph_hi;
};

__device__ __forceinline__ unsigned f2bf(float f) { unsigned u = __float_as_uint(f); return (u + 0x7fffu + ((u >> 16) & 1u)) >> 16; }
typedef __bf16 hwbf16x2 __attribute__((ext_vector_type(2)));
__device__ __forceinline__ unsigned pk2(float lo, float hi) { const f32x2 v = {lo, hi}; return __builtin_bit_cast(unsigned, __builtin_convertvector(v, hwbf16x2)); }
__device__ __forceinline__ float bf2f(unsigned short b) { return __uint_as_float(((unsigned)b) << 16); }
__device__ __forceinline__ float bflo(unsigned w) { return __uint_as_float(w << 16); }
__device__ __forceinline__ float bfhi(unsigned w) { return __uint_as_float(w & 0xffff0000u); }
__device__ __forceinline__ int opq_s(int x) { asm volatile("" : "+s"(x)); return x; }
__device__ __forceinline__ int opq_v(int x) { asm volatile("" : "+v"(x)); return x; }
template <class T> __device__ __forceinline__ T* opq_p(T* x) { asm volatile("" : "+s"(x)); return x; }
__device__ __forceinline__ int crow(int r, int hi) { return (r & 3) + 8 * (r >> 2) + 4 * hi; }
__device__ __forceinline__ float wave_sum(float v) {
#pragma unroll
    for (int o = 1; o < 64; o <<= 1) v += __shfl_xor(v, o);
    return v;
}
__device__ __forceinline__ float gelu_tanh(float x) {
    const float u = 0.7978845608028654f * (x + 0.044715f * x * x * x);
    const float t = 1.0f - 2.0f * __builtin_amdgcn_rcpf(1.0f + __expf(2.0f * u));
    return 0.5f * x * (1.0f + t);
}
__device__ __forceinline__ float sigmoidf_(float z) { return __builtin_amdgcn_rcpf(1.0f + __expf(-z)); }

constexpr int G_STR = 144;
constexpr int G_ABYTES = 128 * G_STR;
template <int NT> struct GemmCfg { static constexpr int BN = 128 * NT, BBYTES = BN * G_STR, STAGE = G_ABYTES + BBYTES; };

struct ARow { const bf16_t* A; int lda; __device__ __forceinline__ const bf16_t* operator()(int row, int k) const { return A + (size_t)row * lda + k; }
              __device__ __forceinline__ size_t kstep32() const { return 32; } };
struct AGrp { const bf16_t* Y; __device__ __forceinline__ const bf16_t* operator()(int row, int k) const { return Y + ((size_t)(k >> 4) * T_TOK + row) * 16 + (k & 15); }
              __device__ __forceinline__ size_t kstep32() const { return (size_t)2 * T_TOK * 16; } };
constexpr int CSTR = 260;

#ifndef GEMM_GLDS
#define GEMM_GLDS 1
#endif
#ifndef GEMM16
#define GEMM16 0
#endif
#if GEMM16
template <int NT, int MODE, int MID, int NST, class AL, class Epi>
__device__ __forceinline__ void gemm_128(const AL aload, const bf16_t* __restrict__ Bt, int ldb, int K, unsigned char* lds, const float* midscale, Epi epi) {
    typedef GemmCfg<NT> C;
    const int tid = opq_v((int)threadIdx.x), lane = tid & 63, wid = __builtin_amdgcn_readfirstlane(tid >> 6), wm = wid >> 2, wn = wid & 3, fr = lane & 15, fq = lane >> 4;
    f32x4 acc[4][2 * NT];
#pragma unroll
    for (int i = 0; i < 4; ++i)
#pragma unroll
        for (int j = 0; j < 2 * NT; ++j) acc[i][j] = (f32x4){0.f, 0.f, 0.f, 0.f};
    const int prow = tid >> 3, pc = tid & 7;
    const bf16_t* gb = Bt + (size_t)prow * ldb + pc * 8;
    const int ldsoff = prow * G_STR + pc * 16;
    u32x4 ra[2], rb[2 * NT];
    const int nk = K >> 6;
#pragma unroll
    for (int q = 0; q < 2; ++q) ra[q] = *(const u32x4*)aload(prow + 64 * q, pc * 8);
#pragma unroll
    for (int q = 0; q < 2 * NT; ++q) rb[q] = *(const u32x4*)(gb + (size_t)(64 * q) * ldb);
#pragma unroll
    for (int q = 0; q < 2; ++q) *(u32x4*)(lds + ldsoff + q * 64 * G_STR) = ra[q];
#pragma unroll
    for (int q = 0; q < 2 * NT; ++q) *(u32x4*)(lds + G_ABYTES + ldsoff + q * 64 * G_STR) = rb[q];
    __syncthreads();
    for (int kt = 0; kt < nk; ++kt) {
        unsigned char* st = lds + (kt & 1) * C::STAGE;
        if (kt + 1 < nk) {
#pragma unroll
            for (int q = 0; q < 2; ++q) ra[q] = *(const u32x4*)aload(prow + 64 * q, (kt + 1) * 64 + pc * 8);
#pragma unroll
            for (int q = 0; q < 2 * NT; ++q) rb[q] = *(const u32x4*)(gb + (size_t)(64 * q) * ldb + (kt + 1) * 64);
        }
        if (MID > 0 && kt == MID) {
#pragma unroll
            for (int i = 0; i < 4; ++i)
#pragma unroll
                for (int r = 0; r < 4; ++r) { const float sc = midscale[wm * 64 + i * 16 + fq * 4 + r];
#pragma unroll
                    for (int j = 0; j < 2 * NT; ++j) acc[i][j][r] *= sc; }
        }
        const unsigned char* pa = st + (wm * 64 + fr) * G_STR + fq * 16;
        const unsigned char* pb = st + G_ABYTES + (wn * 32 * NT + fr) * G_STR + fq * 16;
#pragma unroll
        for (int ks = 0; ks < 2; ++ks) {
            bf16x8 af[4], bfr[2 * NT];
#pragma unroll
            for (int i = 0; i < 4; ++i) af[i] = *(const bf16x8*)(pa + i * 16 * G_STR + ks * 64);
#pragma unroll
            for (int j = 0; j < 2 * NT; ++j) bfr[j] = *(const bf16x8*)(pb + j * 16 * G_STR + ks * 64);
#pragma unroll
            for (int i = 0; i < 4; ++i)
#pragma unroll
                for (int j = 0; j < 2 * NT; ++j) acc[i][j] = __builtin_amdgcn_mfma_f32_16x16x32_bf16(af[i], bfr[j], acc[i][j], 0, 0, 0);
        }
        if (kt + 1 < nk) {
            unsigned char* sn = lds + ((kt + 1) & 1) * C::STAGE;
#pragma unroll
            for (int q = 0; q < 2; ++q) *(u32x4*)(sn + ldsoff + q * 64 * G_STR) = ra[q];
#pragma unroll
            for (int q = 0; q < 2 * NT; ++q) *(u32x4*)(sn + G_ABYTES + ldsoff + q * 64 * G_STR) = rb[q];
        }
        __syncthreads();
    }
    if constexpr (MODE == 0) {
#pragma unroll
        for (int i = 0; i < 4; ++i)
#pragma unroll
            for (int j = 0; j < 2 * NT; ++j)
#pragma unroll
                for (int r = 0; r < 4; ++r) epi(wm * 64 + i * 16 + fq * 4 + r, wn * 32 * NT + j * 16 + fr, acc[i][j][r]);
    } else {
        float* Ct = (float*)lds;
#pragma unroll
        for (int i = 0; i < 4; ++i)
#pragma unroll
            for (int j = 0; j < 2 * NT; ++j)
#pragma unroll
                for (int r = 0; r < 4; ++r) Ct[(wm * 64 + i * 16 + fq * 4 + r) * CSTR + wn * 32 * NT + j * 16 + fr] = acc[i][j][r];
        __syncthreads();
        epi((const float*)Ct);
        __syncthreads();
    }
}

#elif GEMM_GLDS
template <int NT, int MODE, int MID, int NST, class AL, class Epi>
__device__ __forceinline__ void gemm_128(const AL aload, const bf16_t* __restrict__ Bt, int ldb, int K, unsigned char* lds, const float* midscale, Epi epi) {
    typedef GemmCfg<NT> C;
    const int tid = opq_v((int)threadIdx.x), lane = tid & 63, wid = __builtin_amdgcn_readfirstlane(tid >> 6), wm = wid >> 2, wn = wid & 3, r32 = lane & 31, hi = lane >> 5;
    f32x16 acc[2][NT];
#pragma unroll
    for (int i = 0; i < 2; ++i)
#pragma unroll
        for (int j = 0; j < NT; ++j)
#pragma unroll
            for (int r = 0; r < 16; ++r) acc[i][j][r] = 0.f;
    typedef __attribute__((address_space(3))) unsigned char lds_uc;
    lds_uc* ldsl = (lds_uc*)lds;
    const int srow = wid * 8 + (lane >> 3), schunk = ((lane & 7) ^ ((srow >> 1) & 7)) * 8;
    const bf16_t* gb = Bt + (size_t)srow * ldb + schunk;
    const int nk = K >> 6;
    constexpr int SA = 128 * 128, SB = 128 * NT * 128, SSTAGE = SA + SB;
#define GL_STAGE(stg, kk) do { \
        _Pragma("unroll") for (int q = 0; q < 2; ++q) __builtin_amdgcn_global_load_lds((const unsigned*)aload(srow + 64 * q, (kk) * 64 + schunk), (__attribute__((address_space(3))) unsigned*)(ldsl + (stg) * SSTAGE + q * 8192 + wid * 1024), 16, 0, 0); \
        _Pragma("unroll") for (int q = 0; q < 2 * NT; ++q) __builtin_amdgcn_global_load_lds((const unsigned*)(gb + (size_t)(64 * q) * ldb + (kk) * 64), (__attribute__((address_space(3))) unsigned*)(ldsl + (stg) * SSTAGE + SA + q * 8192 + wid * 1024), 16, 0, 0); } while (0)
#define GL_WAITN() do { if constexpr (NT == 2) asm volatile("s_waitcnt vmcnt(6)" ::: "memory"); else asm volatile("s_waitcnt vmcnt(4)" ::: "memory"); } while (0)
#define GL_BAR() asm volatile("s_waitcnt lgkmcnt(0)\n\ts_barrier" ::: "memory")
    GL_STAGE(0, 0);
    if (NST == 3 && nk > 1) { GL_STAGE(1, 1); GL_WAITN(); } else asm volatile("s_waitcnt vmcnt(0)" ::: "memory");
    GL_BAR();
    const int swz = (r32 >> 1) & 7;
    int cofs[4];
#pragma unroll
    for (int ks = 0; ks < 4; ++ks) cofs[ks] = ((((ks << 1) | hi) ^ swz) << 4);
    for (int kt = 0; kt < nk; ++kt) {
        const unsigned char* st = lds + (kt % NST) * SSTAGE;
        if (kt + NST - 1 < nk) GL_STAGE((kt + NST - 1) % NST, kt + NST - 1);
        if (MID > 0 && kt == MID) {
#pragma unroll
            for (int i = 0; i < 2; ++i)
#pragma unroll
                for (int r = 0; r < 16; ++r) { const float sc = midscale[wm * 64 + i * 32 + crow(r, hi)];
#pragma unroll
                    for (int j = 0; j < NT; ++j) acc[i][j][r] *= sc; }
        }
        const unsigned char* pa = st + (wm * 64 + r32) * 128;
        const unsigned char* pb = st + SA + (wn * 32 * NT + r32) * 128;
#pragma unroll
        for (int ks = 0; ks < 4; ++ks) {
            bf16x8 af[2], bfr[NT];
#pragma unroll
            for (int i = 0; i < 2; ++i) af[i] = *(const bf16x8*)(pa + i * 32 * 128 + cofs[ks]);
#pragma unroll
            for (int j = 0; j < NT; ++j) bfr[j] = *(const bf16x8*)(pb + j * 32 * 128 + cofs[ks]);
#pragma unroll
            for (int i = 0; i < 2; ++i)
#pragma unroll
                for (int j = 0; j < NT; ++j) acc[i][j] = __builtin_amdgcn_mfma_f32_32x32x16_bf16(af[i], bfr[j], acc[i][j], 0, 0, 0);
        }
        if (NST == 3 && kt + 2 < nk) GL_WAITN(); else asm volatile("s_waitcnt vmcnt(0)" ::: "memory");
        GL_BAR();
    }
#undef GL_STAGE
#undef GL_WAITN
#undef GL_BAR
    if constexpr (MODE == 0) {
#pragma unroll
        for (int i = 0; i < 2; ++i)
#pragma unroll
            for (int j = 0; j < NT; ++j)
#pragma unroll
                for (int r = 0; r < 16; ++r) epi(wm * 64 + i * 32 + crow(r, hi), wn * 32 * NT + j * 32 + r32, acc[i][j][r]);
    } else {
        float* Ct = (float*)lds;
#pragma unroll
        for (int i = 0; i < 2; ++i)
#pragma unroll
            for (int j = 0; j < NT; ++j)
#pragma unroll
                for (int r = 0; r < 16; ++r) Ct[(wm * 64 + i * 32 + crow(r, hi)) * CSTR + wn * 32 * NT + j * 32 + r32] = acc[i][j][r];
        __syncthreads();
        epi((const float*)Ct);
        __syncthreads();
    }
}

#else
template <int NT, int MODE, int MID, int NST, class AL, class Epi>
__device__ __forceinline__ void gemm_128(const AL aload, const bf16_t* __restrict__ Bt, int ldb, int K, unsigned char* lds, const float* midscale, Epi epi) {
    typedef GemmCfg<NT> C;
    const int tid = opq_v((int)threadIdx.x), lane = tid & 63, wid = __builtin_amdgcn_readfirstlane(tid >> 6), wm = wid >> 2, wn = wid & 3, r32 = lane & 31, hi = lane >> 5;
    f32x16 acc[2][NT];
#pragma unroll
    for (int i = 0; i < 2; ++i)
#pragma unroll
        for (int j = 0; j < NT; ++j)
#pragma unroll
            for (int r = 0; r < 16; ++r) acc[i][j][r] = 0.f;
    const int prow = tid >> 3, pc = tid & 7;
    const bf16_t* gb = Bt + (size_t)prow * ldb + pc * 8;
    const int ldsoff = prow * G_STR + pc * 16;
    u32x4 ra[2], rb[2 * NT];
    const int nk = K >> 6;
#pragma unroll
    for (int q = 0; q < 2; ++q) ra[q] = *(const u32x4*)aload(prow + 64 * q, pc * 8);
#pragma unroll
    for (int q = 0; q < 2 * NT; ++q) rb[q] = *(const u32x4*)(gb + (size_t)(64 * q) * ldb);
#pragma unroll
    for (int q = 0; q < 2; ++q) *(u32x4*)(lds + ldsoff + q * 64 * G_STR) = ra[q];
#pragma unroll
    for (int q = 0; q < 2 * NT; ++q) *(u32x4*)(lds + G_ABYTES + ldsoff + q * 64 * G_STR) = rb[q];
    __syncthreads();
    for (int kt = 0; kt < nk; ++kt) {
        unsigned char* st = lds + (kt & 1) * C::STAGE;
        if (kt + 1 < nk) {
#pragma unroll
            for (int q = 0; q < 2; ++q) ra[q] = *(const u32x4*)aload(prow + 64 * q, (kt + 1) * 64 + pc * 8);
#pragma unroll
            for (int q = 0; q < 2 * NT; ++q) rb[q] = *(const u32x4*)(gb + (size_t)(64 * q) * ldb + (kt + 1) * 64);
        }
        if (MID > 0 && kt == MID) {
#pragma unroll
            for (int i = 0; i < 2; ++i)
#pragma unroll
                for (int r = 0; r < 16; ++r) { const float sc = midscale[wm * 64 + i * 32 + crow(r, hi)];
#pragma unroll
                    for (int j = 0; j < NT; ++j) acc[i][j][r] *= sc; }
        }
        const unsigned char* pa = st + (wm * 64 + r32) * G_STR + hi * 16;
        const unsigned char* pb = st + G_ABYTES + (wn * 32 * NT + r32) * G_STR + hi * 16;
#pragma unroll
        for (int ks = 0; ks < 4; ++ks) {
            bf16x8 af[2], bfr[NT];
#pragma unroll
            for (int i = 0; i < 2; ++i) af[i] = *(const bf16x8*)(pa + i * 32 * G_STR + ks * 32);
#pragma unroll
            for (int j = 0; j < NT; ++j) bfr[j] = *(const bf16x8*)(pb + j * 32 * G_STR + ks * 32);
#pragma unroll
            for (int i = 0; i < 2; ++i)
#pragma unroll
                for (int j = 0; j < NT; ++j) acc[i][j] = __builtin_amdgcn_mfma_f32_32x32x16_bf16(af[i], bfr[j], acc[i][j], 0, 0, 0);
        }
        if (kt + 1 < nk) {
            unsigned char* sn = lds + ((kt + 1) & 1) * C::STAGE;
#pragma unroll
            for (int q = 0; q < 2; ++q) *(u32x4*)(sn + ldsoff + q * 64 * G_STR) = ra[q];
#pragma unroll
            for (int q = 0; q < 2 * NT; ++q) *(u32x4*)(sn + G_ABYTES + ldsoff + q * 64 * G_STR) = rb[q];
        }
        __syncthreads();
    }
    if constexpr (MODE == 0) {
#pragma unroll
        for (int i = 0; i < 2; ++i)
#pragma unroll
            for (int j = 0; j < NT; ++j)
#pragma unroll
                for (int r = 0; r < 16; ++r) epi(wm * 64 + i * 32 + crow(r, hi), wn * 32 * NT + j * 32 + r32, acc[i][j][r]);
    } else {
        float* Ct = (float*)lds;
#pragma unroll
        for (int i = 0; i < 2; ++i)
#pragma unroll
            for (int j = 0; j < NT; ++j)
#pragma unroll
                for (int r = 0; r < 16; ++r) Ct[(wm * 64 + i * 32 + crow(r, hi)) * CSTR + wn * 32 * NT + j * 32 + r32] = acc[i][j][r];
        __syncthreads();
        epi((const float*)Ct);
        __syncthreads();
    }
}

#endif

template <int MID32, class AL, class Epi>
__device__ __forceinline__ void gemm_128w(const AL aload, const bf16_t* __restrict__ Bt, int ldb, int K, unsigned char* lds, const float* midscale, Epi epi) {
    const int tid = opq_v((int)threadIdx.x), lane = tid & 63, wid = __builtin_amdgcn_readfirstlane(tid >> 6), wm = wid >> 2, wn = wid & 3, r32 = lane & 31, hi = lane >> 5;
    f32x16 acc[2][4];
#pragma unroll
    for (int i = 0; i < 2; ++i)
#pragma unroll
        for (int j = 0; j < 4; ++j)
#pragma unroll
            for (int r = 0; r < 16; ++r) acc[i][j][r] = 0.f;
    typedef __attribute__((address_space(3))) unsigned char lds_uc;
    lds_uc* ldsl = (lds_uc*)lds;
    const int srow = wid * 16 + (lane >> 2), schunk = ((lane & 3) ^ ((srow >> 2) & 3)) * 8;
    const bf16_t* gb = Bt + (size_t)srow * ldb + schunk;
    const int nk = K >> 5;
    constexpr int SA = 128 * 64, SB = 512 * 64, SSTAGE = SA + SB;
#define GW_STAGE(stg, pa_, pb_) do { \
        __builtin_amdgcn_global_load_lds((const unsigned*)(pa_), (__attribute__((address_space(3))) unsigned*)(ldsl + (stg) * SSTAGE + wid * 1024), 16, 0, 0); \
        _Pragma("unroll") for (int q = 0; q < 4; ++q) __builtin_amdgcn_global_load_lds((const unsigned*)((pb_) + (size_t)(128 * q) * ldb), (__attribute__((address_space(3))) unsigned*)(ldsl + (stg) * SSTAGE + SA + q * 8192 + wid * 1024), 16, 0, 0); } while (0)
#define GW_BAR() asm volatile("s_waitcnt lgkmcnt(0)\n\ts_barrier" ::: "memory")
    const bf16_t* pga = aload(srow, schunk); const size_t astep = aload.kstep32();
    const bf16_t* pgb = gb;
    GW_STAGE(0, pga, pgb); pga += astep; pgb += 32;
    if (nk > 1) { GW_STAGE(1, pga, pgb); pga += astep; pgb += 32; asm volatile("s_waitcnt vmcnt(5)" ::: "memory"); } else asm volatile("s_waitcnt vmcnt(0)" ::: "memory");
    GW_BAR();
    const int swz = (r32 >> 2) & 3;
    const int cof0 = ((hi ^ swz) << 4), cof1 = (((2 | hi) ^ swz) << 4);
    const int arow = (wm * 64 + r32) * 64, brow = SA + (wn * 64 + r32) * 64;
    int cur = 0, nxt = 2;
#pragma unroll 1
    for (int kt = 0; kt < nk; ++kt) {
        const unsigned char* st = lds + cur * SSTAGE;
        if (kt + 2 < nk) { GW_STAGE(nxt, pga, pgb); pga += astep; pgb += 32; }
        if (MID32 > 0 && kt == MID32) {
#pragma unroll
            for (int i = 0; i < 2; ++i)
#pragma unroll
                for (int r = 0; r < 16; ++r) { const float sc = midscale[wm * 64 + i * 32 + crow(r, hi)];
#pragma unroll
                    for (int j = 0; j < 4; ++j) acc[i][j][r] *= sc; }
        }
#pragma unroll
        for (int ks = 0; ks < 2; ++ks) {
            const int cof = ks ? cof1 : cof0;
            bf16x8 af[2], bfr[4];
#pragma unroll
            for (int i = 0; i < 2; ++i) af[i] = *(const bf16x8*)(st + arow + i * 32 * 64 + cof);
#pragma unroll
            for (int j = 0; j < 4; ++j) bfr[j] = *(const bf16x8*)(st + brow + ((j >> 1) * 256 + (j & 1) * 32) * 64 + cof);
#pragma unroll
            for (int i = 0; i < 2; ++i)
#pragma unroll
                for (int j = 0; j < 4; ++j) acc[i][j] = __builtin_amdgcn_mfma_f32_32x32x16_bf16(af[i], bfr[j], acc[i][j], 0, 0, 0);
        }
        if (kt + 2 < nk) asm volatile("s_waitcnt vmcnt(5)" ::: "memory"); else asm volatile("s_waitcnt vmcnt(0)" ::: "memory");
        GW_BAR();
        cur = (cur == 2) ? 0 : cur + 1; nxt = (nxt == 2) ? 0 : nxt + 1;
    }
#undef GW_STAGE
#undef GW_BAR
    float* Ct = (float*)lds;
#pragma unroll
    for (int c = 0; c < 2; ++c) {
#pragma unroll
        for (int i = 0; i < 2; ++i)
#pragma unroll
            for (int jj = 0; jj < 2; ++jj)
#pragma unroll
                for (int r = 0; r < 16; ++r) Ct[(wm * 64 + i * 32 + crow(r, hi)) * CSTR + wn * 64 + jj * 32 + r32] = acc[i][2 * c + jj][r];
        __syncthreads();
        epi((const float*)Ct, c);
        __syncthreads();
    }
}

struct TrD { const float* W; bf16_t* WT; const float* g0; const float* g1; int K, N, gsplit, cmap, item; };
__device__ __forceinline__ void p0_tr_load(const TrD& d, float (&v)[8]) {
    const int tid = threadIdx.x, nkb = d.K / 64, kb = d.item % nkb, nb = d.item / nkb, k0 = kb * 64, n0 = nb * 64;
#pragma unroll
    for (int r = 0; r < 8; ++r) {
        const int kk = r * 8 + (tid >> 6), nn = tid & 63, k = k0 + kk; int n = n0 + nn;
        if (d.cmap) n = ((n & 255) < 192) ? (n >> 8) * 192 + (n & 255) : d.N;
        float x = (n < d.N) ? d.W[(size_t)k * d.N + n] : 0.f;
        if (d.g0) x *= (k < d.gsplit) ? d.g0[k] : d.g1[k - d.gsplit];
        v[r] = x;
    }
}
__device__ __forceinline__ void p0_tr_store(const TrD& d, const float* scr) {
    const int tid = threadIdx.x, nkb = d.K / 64, kb = d.item % nkb, nb = d.item / nkb, k0 = kb * 64, n0 = nb * 64;
    const int n = tid >> 3, kc = tid & 7; const float* s = scr + (kc * 8) * 65 + n;
    u32x4 o; o.x = pk2(s[0], s[65]); o.y = pk2(s[2 * 65], s[3 * 65]); o.z = pk2(s[4 * 65], s[5 * 65]); o.w = pk2(s[6 * 65], s[7 * 65]);
    *(u32x4*)(d.WT + (size_t)(n0 + n) * d.K + k0 + kc * 8) = o;
}
__device__ __forceinline__ void split_hl(const f32x4 a, const f32x4 b, bf16x8& h, bf16x8& l) {
    u32x4 hh, ll; const float x[8] = {a.x, a.y, a.z, a.w, b.x, b.y, b.z, b.w};
#pragma unroll
    for (int q = 0; q < 4; ++q) { const unsigned hw = pk2(x[2 * q], x[2 * q + 1]); hh[q] = hw; ll[q] = pk2(x[2 * q] - __uint_as_float(hw << 16), x[2 * q + 1] - __uint_as_float(hw & 0xffff0000u)); }
    h = __builtin_bit_cast(bf16x8, hh); l = __builtin_bit_cast(bf16x8, ll);
}


__device__ __forceinline__ void quant_row(const f32x4 (&a)[4], unsigned char* dst, float* scale_out, int lane) {
    float am = 0.f;
#pragma unroll
    for (int q = 0; q < 4; ++q) am = fmaxf(am, fmaxf(fmaxf(fabsf(a[q].x), fabsf(a[q].y)), fmaxf(fabsf(a[q].z), fabsf(a[q].w))));
#pragma unroll
    for (int o = 1; o < 64; o <<= 1) am = fmaxf(am, __shfl_xor(am, o));
    const float sc = (am > 0.f) ? am * (1.0f / 224.0f) : 1.0f, inv = 1.0f / sc;
    u32x4 o;
    { int w = __builtin_amdgcn_cvt_pk_fp8_f32(a[0].x * inv, a[0].y * inv, 0, false); w = __builtin_amdgcn_cvt_pk_fp8_f32(a[0].z * inv, a[0].w * inv, w, true); o.x = (unsigned)w; }
    { int w = __builtin_amdgcn_cvt_pk_fp8_f32(a[1].x * inv, a[1].y * inv, 0, false); w = __builtin_amdgcn_cvt_pk_fp8_f32(a[1].z * inv, a[1].w * inv, w, true); o.y = (unsigned)w; }
    { int w = __builtin_amdgcn_cvt_pk_fp8_f32(a[2].x * inv, a[2].y * inv, 0, false); w = __builtin_amdgcn_cvt_pk_fp8_f32(a[2].z * inv, a[2].w * inv, w, true); o.z = (unsigned)w; }
    { int w = __builtin_amdgcn_cvt_pk_fp8_f32(a[3].x * inv, a[3].y * inv, 0, false); w = __builtin_amdgcn_cvt_pk_fp8_f32(a[3].z * inv, a[3].w * inv, w, true); o.w = (unsigned)w; }
    *(u32x4*)dst = o;
    if (lane == 0) *scale_out = sc;
}

typedef unsigned u32x6 __attribute__((ext_vector_type(6)));
typedef unsigned u32x3 __attribute__((ext_vector_type(3)));
__device__ __forceinline__ void quant_row_fp6(const f32x4 (&a)[4], unsigned char* dst, float* scale_out, int lane) {
    float am = 0.f;
#pragma unroll
    for (int q = 0; q < 4; ++q) am = fmaxf(am, fmaxf(fmaxf(fabsf(a[q].x), fabsf(a[q].y)), fmaxf(fabsf(a[q].z), fabsf(a[q].w))));
#pragma unroll
    for (int o = 1; o < 64; o <<= 1) am = fmaxf(am, __shfl_xor(am, o));
    const float sc = (am > 0.f) ? am * (1.0f / 7.5f) : 1.0f, inv = 1.0f / sc;
    f32x16 s0, s1;
#pragma unroll
    for (int q = 0; q < 4; ++q) { s0[2 * q] = a[q].x * inv; s1[2 * q] = a[q].y * inv; s0[2 * q + 1] = a[q].z * inv; s1[2 * q + 1] = a[q].w * inv; }
#pragma unroll
    for (int i = 8; i < 16; ++i) { s0[i] = 0.f; s1[i] = 0.f; }
    const u32x6 c = __builtin_amdgcn_cvt_scalef32_2xpk16_fp6_f32(s0, s1, 1.0f);
    unsigned* d = (unsigned*)dst; d[0] = c[0]; d[1] = c[1]; d[2] = c[2];
    if (lane == 0) *scale_out = sc;
}

__device__ __forceinline__ void quant_row_i8(const f32x4 (&a)[4], unsigned char* dst, float* scale_out, int lane) {
    float am = 0.f;
#pragma unroll
    for (int q = 0; q < 4; ++q) am = fmaxf(am, fmaxf(fmaxf(fabsf(a[q].x), fabsf(a[q].y)), fmaxf(fabsf(a[q].z), fabsf(a[q].w))));
#pragma unroll
    for (int o = 1; o < 64; o <<= 1) am = fmaxf(am, __shfl_xor(am, o));
    const float sc = (am > 0.f) ? am * (1.0f / 127.0f) : 1.0f, inv = 1.0f / sc;
    u32x4 o;
#pragma unroll
    for (int q = 0; q < 4; ++q) { const int b0 = (int)rintf(a[q].x * inv), b1 = (int)rintf(a[q].y * inv), b2 = (int)rintf(a[q].z * inv), b3 = (int)rintf(a[q].w * inv);
        o[q] = (unsigned)(b0 & 0xFF) | ((unsigned)(b1 & 0xFF) << 8) | ((unsigned)(b2 & 0xFF) << 16) | ((unsigned)(b3 & 0xFF) << 24); }
    *(u32x4*)dst = o;
    if (lane == 0) *scale_out = sc;
}
__device__ void phase0(const Params& p, unsigned char* lds) {
    const int tid = threadIdx.x, G = gridDim.x, bid = blockIdx.x;
    unsigned char* ws = p.ws;
    float* scr = (float*)lds;
    unsigned long long p0t0 = 0; if (PROBE_P0) p0t0 = __builtin_amdgcn_s_memrealtime();
#define P0_MARK(k) if (PROBE_P0 == (k)) { __syncthreads(); if (tid == 0) { asm volatile("s_waitcnt vmcnt(0)" ::: "memory"); atomicMax((unsigned*)(ws + OFF_BAR + 16000), (unsigned)(__builtin_amdgcn_s_memrealtime() - p0t0)); } }
    const auto jobA = [&]() __attribute__((always_inline)) {
    {
        float* part = (float*)(ws + OFF_PART);
        for (int it = bid; it < 24 * 16; it += G) {
            const int nb = it % 24, ks = it / 24, n = nb * 256 + (tid & 255), bh = tid >> 8;
            float w[64];
#pragma unroll
            for (int kk = 0; kk < 64; ++kk) w[kk] = p.w_ada[(size_t)(ks * 64 + kk) * 6144 + n];
            for (int i = tid; i < 16 * 64; i += NTHR) { const int b = i >> 6, kk = i & 63; const float cv = p.c[b * 1024 + ks * 64 + kk]; scr[i] = cv / (1.0f + __expf(-cv)); }
            __syncthreads();
            float acc[8];
#pragma unroll
            for (int j = 0; j < 8; ++j) acc[j] = 0.f;
#pragma unroll
            for (int k4 = 0; k4 < 16; ++k4) {
#pragma unroll
                for (int j = 0; j < 8; ++j) { const f32x4 s = *(const f32x4*)(scr + (bh * 8 + j) * 64 + k4 * 4);
                    acc[j] = fmaf(w[4 * k4], s.x, acc[j]); acc[j] = fmaf(w[4 * k4 + 1], s.y, acc[j]); acc[j] = fmaf(w[4 * k4 + 2], s.z, acc[j]); acc[j] = fmaf(w[4 * k4 + 3], s.w, acc[j]); }
            }
#pragma unroll
            for (int j = 0; j < 8; ++j) part[((size_t)ks * 16 + bh * 8 + j) * 6144 + n] = acc[j];
            __syncthreads();
        }
    }
    };
    const auto jobB = [&]() __attribute__((always_inline)) {
    {
        constexpr int I_IN = 16 * 16, I_GLU = 8 * 8, I_UQ = 4 * 16, I_UKV = 2 * 16, I_OUT = 16 * 16, I_Q = 16 * 32;
        constexpr int NTR = I_IN + I_GLU + I_UQ + I_UKV + I_OUT;
        for (int it0 = bid; it0 < NTR; it0 += 3 * G) {
            TrD d[3]; float v[3][8];
#pragma unroll
            for (int u = 0; u < 3; ++u) { const int it = it0 + u * G; if (it < NTR) {
                int r = it;
                if (r < I_IN) d[u] = TrD{p.w_in, (bf16_t*)(ws + OFF_WINT), nullptr, nullptr, 1024, 928, 0, 0, r};
                else if ((r -= I_IN) < I_GLU) d[u] = TrD{p.w_glu, (bf16_t*)(ws + OFF_WGLUT), nullptr, nullptr, 512, 512, 0, 0, r};
                else if ((r -= I_GLU) < I_UQ) d[u] = TrD{p.w_uq, (bf16_t*)(ws + OFF_WUQT), p.q_a_norm, p.q_a_norm, 256, 768, 256, 1, r};
                else if ((r -= I_UQ) < I_UKV) d[u] = TrD{p.w_ukv, (bf16_t*)(ws + OFF_WUKVT), p.kv_a_norm, p.kv_a_norm, 128, 1024, 128, 0, r};
                else { r -= I_UKV; d[u] = TrD{p.w_out, (bf16_t*)(ws + OFF_WOUTT), p.out_norm_ssm, p.out_norm_attn, 1024, 1024, 512, 0, r}; }
                p0_tr_load(d[u], v[u]); } }
#pragma unroll
            for (int u = 0; u < 3; ++u) if (it0 + u * G < NTR) {
#pragma unroll
                for (int r = 0; r < 8; ++r) scr[u * (64 * 65) + (r * 8 + (tid >> 6)) * 65 + (tid & 63)] = v[u][r]; }
            __syncthreads();
#pragma unroll
            for (int u = 0; u < 3; ++u) if (it0 + u * G < NTR) p0_tr_store(d[u], scr + u * (64 * 65));
            __syncthreads();
        }
        for (int it0 = bid; it0 < I_Q; it0 += 2 * G) {
#pragma unroll
            for (int u = 0; u < 2; ++u) { const int r = it0 + u * G; if (r < I_Q) {
                const int kb = r & 15, nb = r >> 4, k0 = kb * 64, n0 = nb * 64, hp = n0 >> 7, key0 = n0 & 127, ph = hp & 1;
                float* SK = scr + u * (2 * 64 * 132); float* WQ = SK + 64 * 132;
#pragma unroll
                for (int q = 0; q < 4; ++q) { const int i = tid + q * NTHR, rr = i >> 5, c4 = (i & 31) * 4;
                    const f32x4 a = *(const f32x4*)(p.sub_keys + ((size_t)ph * 128 + key0 + rr) * 128 + c4), b = *(const f32x4*)(p.w_query + (size_t)(k0 + rr) * 2048 + hp * 128 + c4);
                    *(f32x4*)(SK + rr * 132 + c4) = a; *(f32x4*)(WQ + rr * 132 + c4) = b; } } }
            __syncthreads();
            {
                const int wv = __builtin_amdgcn_readfirstlane(tid >> 6), u = wv >> 2, r = it0 + u * G;
                if (r < I_Q) {
                    const int kb = r & 15, nb = r >> 4, k0 = kb * 64, n0 = nb * 64, mt = wv & 1, nt = (wv >> 1) & 1, l31 = tid & 31, hi = (tid >> 5) & 1;
                    const float* SK = scr + u * (2 * 64 * 132); const float* WQ = SK + 64 * 132;
                    f32x16 acc;
#pragma unroll
                    for (int i = 0; i < 16; ++i) acc[i] = 0.f;
#pragma unroll
                    for (int ks = 0; ks < 8; ++ks) {
                        const float* ap = SK + (mt * 32 + l31) * 132 + ks * 16 + hi * 8;
                        const float* bp = WQ + (nt * 32 + l31) * 132 + ks * 16 + hi * 8;
                        bf16x8 ah, al, bhh, bl;
                        split_hl(*(const f32x4*)ap, *(const f32x4*)(ap + 4), ah, al); split_hl(*(const f32x4*)bp, *(const f32x4*)(bp + 4), bhh, bl);
                        acc = __builtin_amdgcn_mfma_f32_32x32x16_bf16(ah, bhh, acc, 0, 0, 0);
                        acc = __builtin_amdgcn_mfma_f32_32x32x16_bf16(ah, bl, acc, 0, 0, 0);
                        acc = __builtin_amdgcn_mfma_f32_32x32x16_bf16(al, bhh, acc, 0, 0, 0);
                    }
                    bf16_t* WT = (bf16_t*)(ws + OFF_WQT);
#pragma unroll
                    for (int i = 0; i < 16; ++i) WT[(size_t)(n0 + mt * 32 + (i & 3) + 8 * (i >> 2) + 4 * hi) * 1024 + k0 + nt * 32 + l31] = (bf16_t)f2bf(acc[i]);
                }
            }
            __syncthreads();
        }
    }
    };
    const auto jobD = [&]() __attribute__((always_inline)) {
    {
        const int lane = tid & 63, gw = bid * NWAVE + (tid >> 6), NGW = G * NWAVE;
        unsigned char* E8 = ws + OFF_E8; float* esc = (float*)(ws + OFF_ESC);
        for (int r = gw; r < 32768; r += 4 * NGW) {
            f32x4 a[4][4];
#pragma unroll
            for (int u = 0; u < 4; ++u) { const int ru = r + u * NGW; if (ru < 32768) { const float* sp = ((ru < 16384) ? p.e_down : p.e_up) + (size_t)(ru & 16383) * 1024 + lane * 16;
#pragma unroll
                for (int q = 0; q < 4; ++q) a[u][q] = ((const f32x4*)sp)[q]; } }
#pragma unroll
            for (int u = 0; u < 4; ++u) { const int ru = r + u * NGW; if (ru < 32768) { if (ru < 16384) quant_row_i8(a[u], E8 + (size_t)ru * 1024 + lane * 16, esc + ru, lane); else quant_row_fp6(a[u], E8 + (size_t)ru * 1024 + lane * 12, esc + ru, lane); } }
        }
    }
    };
    if (bid & 1) { jobA(); jobB(); jobD(); } else { jobD(); jobA(); jobB(); }
    P0_MARK(2)
    {
        const size_t gt = (size_t)bid * NTHR + tid, gs = (size_t)G * NTHR;
        for (size_t i = gt; i < 32768 / 8; i += gs) { const f32x4 a = ((const f32x4*)p.sub_keys)[2 * i], b = ((const f32x4*)p.sub_keys)[2 * i + 1];
            u32x4 o; o.x = pk2(a.x, a.y); o.y = pk2(a.z, a.w); o.z = pk2(b.x, b.y); o.w = pk2(b.z, b.w); ((u32x4*)(ws + OFF_SUBK))[i] = o; }
    }
    P0_MARK(3)
    {
        f32x2* apow = (f32x2*)lds;
        f32x2* Bb = (f32x2*)(lds + 16896);
        f32x2* Cc = (f32x2*)(lds + 16896 + 8192);
        float* Kt = (float*)(lds + 16896 + 16384);
        for (int it = bid; it < 256; it += G) {
            const int g = it >> 3, cq = it & 7;
            const float dt = __expf(p.log_dt[g]);
            for (int i = tid; i < 33 * 64; i += NTHR) { const int j = i >> 6, pp = i & 63; const float lr = p.lam_re[g * 64 + pp], li = p.lam_im[g * 64 + pp];
                const float mag = expf((float)j * lr * dt); float sn, cs; sincosf((float)j * li * dt, &sn, &cs); apow[i] = (f32x2){mag * cs, mag * sn}; }
            for (int i = tid; i < 1024; i += NTHR) { const int pp = i >> 4; const float lr = p.lam_re[g * 64 + pp], li = p.lam_im[g * 64 + pp];
                const float mag = expf(lr * dt); float sn, cs; sincosf(li * dt, &sn, &cs); const float nr = mag * cs - 1.0f, ni = mag * sn, den = lr * lr + li * li;
                const float cr = (nr * lr + ni * li) / den, ci = (ni * lr - nr * li) / den; const float br = p.b_re[(size_t)g * 1024 + i], bi = p.b_im[(size_t)g * 1024 + i];
                Bb[i] = (f32x2){cr * br - ci * bi, cr * bi + ci * br}; }
            for (int i = tid; i < 1024; i += NTHR) Cc[i] = (f32x2){p.c_re[(size_t)g * 1024 + i], p.c_im[(size_t)g * 1024 + i]};
            __syncthreads();
            {
                const int j = tid >> 4, co = cq * 2 + ((tid >> 2) & 1), ci0 = (tid & 3) * 4, ph = (tid >> 3) & 1; float s0 = 0.f, s1 = 0.f, s2 = 0.f, s3 = 0.f;
                for (int pp = ph * 32; pp < ph * 32 + 32; ++pp) { const f32x2 c = Cc[co * 64 + pp], a = apow[j * 64 + pp]; const f32x4 b01 = *(const f32x4*)(Bb + pp * 16 + ci0), b23 = *(const f32x4*)(Bb + pp * 16 + ci0 + 2);
                    const float car = c.x * a.x - c.y * a.y, cai = c.x * a.y + c.y * a.x;
                    s0 += car * b01.x - cai * b01.y; s1 += car * b01.z - cai * b01.w; s2 += car * b23.x - cai * b23.y; s3 += car * b23.z - cai * b23.w; }
                s0 += __shfl_xor(s0, 8); s1 += __shfl_xor(s1, 8); s2 += __shfl_xor(s2, 8); s3 += __shfl_xor(s3, 8);
                const float dk = (j == 0) ? p.d_skip[g * 16 + co] : 0.f;
                if (co == ci0) s0 += dk; if (co == ci0 + 1) s1 += dk; if (co == ci0 + 2) s2 += dk; if (co == ci0 + 3) s3 += dk;
                if (ph == 0) *(f32x4*)(Kt + ((j << 8) | (co << 4) | ci0)) = (f32x4){s0, s1, s2, s3}; }
            __syncthreads();
            bf16_t* KmT = (bf16_t*)(ws + OFF_KMT) + (size_t)g * 512 * 640;
            for (int q = tid; q < 64 * 80; q += NTHR) { const int nn = q / 80, kc = q % 80, k0 = kc * 8, t = nn >> 1, co = cq * 2 + (nn & 1), n = t * 16 + co; float v[8];
                if (k0 < 512) { const int s = k0 >> 4, ci0 = k0 & 15;
#pragma unroll
                    for (int i = 0; i < 8; ++i) v[i] = (t >= s) ? Kt[((t - s) * 16 + co) * 16 + ci0 + i] : 0.f;
                } else { const int kk0 = k0 - 512, ri = kk0 >> 6, p0 = kk0 & 63;
#pragma unroll
                    for (int i = 0; i < 8; ++i) { const f32x2 c = Cc[co * 64 + p0 + i], a = apow[(t + 1) * 64 + p0 + i]; v[i] = (ri == 0) ? (c.x * a.x - c.y * a.y) : -(c.x * a.y + c.y * a.x); } }
                u32x4 o; o.x = pk2(v[0], v[1]); o.y = pk2(v[2], v[3]); o.z = pk2(v[4], v[5]); o.w = pk2(v[6], v[7]); *(u32x4*)(KmT + (size_t)n * 640 + k0) = o; }
            bf16_t* WzT = (bf16_t*)(ws + OFF_WZT) + (size_t)g * 128 * 512;
            for (int q = tid; q < 16 * 64; q += NTHR) { const int n = cq * 16 + (q >> 6), kc = q & 63, k0 = kc * 8, s = k0 >> 4, ci0 = k0 & 15, ri = n >> 6, pp = n & 63; float v[8];
                const f32x2 a = apow[(31 - s) * 64 + pp];
#pragma unroll
                for (int i = 0; i < 8; ++i) { const f32x2 b = Bb[pp * 16 + ci0 + i]; v[i] = (ri == 0) ? (a.x * b.x - a.y * b.y) : (a.x * b.y + a.y * b.x); }
                u32x4 o; o.x = pk2(v[0], v[1]); o.y = pk2(v[2], v[3]); o.z = pk2(v[4], v[5]); o.w = pk2(v[6], v[7]); *(u32x4*)(WzT + (size_t)n * 512 + k0) = o; }
            if (cq == 0 && tid < 64) ((f32x2*)(ws + OFF_AL))[g * 64 + tid] = apow[32 * 64 + tid];
            __syncthreads();
        }
    }
    P0_MARK(4)
}


__device__ __forceinline__ void finalize_row(const float* nope, const float* ra, const float* rb, float rn, float rnr, const float* __restrict__ gain, const _Float16* cs, const _Float16* sn, bf16_t* dst) {
#pragma unroll
    for (int j = 0; j < 8; ++j) { const f32x4 a = *(const f32x4*)(nope + 8 * j), c = *(const f32x4*)(nope + 8 * j + 4);
        u32x4 o; o.x = pk2(a.x * rn * gain[8 * j], a.y * rn * gain[8 * j + 1]); o.y = pk2(a.z * rn * gain[8 * j + 2], a.w * rn * gain[8 * j + 3]);
        o.z = pk2(c.x * rn * gain[8 * j + 4], c.y * rn * gain[8 * j + 5]); o.w = pk2(c.z * rn * gain[8 * j + 6], c.w * rn * gain[8 * j + 7]); *(u32x4*)(dst + 8 * j) = o; }
#pragma unroll
    for (int j = 0; j < 2; ++j) { float o1[8], o2[8];
#pragma unroll
        for (int i = 0; i < 8; ++i) { const int f = 8 * j + i; const float x1 = ra[f] * rnr * gain[64 + f], x2 = rb[f] * rnr * gain[80 + f]; const float cf = (float)cs[f], sf = (float)sn[f]; o1[i] = x1 * cf - x2 * sf; o2[i] = x2 * cf + x1 * sf; }
        u32x4 o; o.x = pk2(o1[0], o1[1]); o.y = pk2(o1[2], o1[3]); o.z = pk2(o1[4], o1[5]); o.w = pk2(o1[6], o1[7]); *(u32x4*)(dst + 64 + 8 * j) = o;
        o.x = pk2(o2[0], o2[1]); o.y = pk2(o2[2], o2[3]); o.z = pk2(o2[4], o2[5]); o.w = pk2(o2[6], o2[7]); *(u32x4*)(dst + 80 + 8 * j) = o; }
}
constexpr int CT_BYTES = 128 * CSTR * 4;
constexpr int SM_OFF = 147456;
constexpr int P1_RSQ = SM_OFF, P1_RSKV = P1_RSQ + 512, P1_CS = P1_RSKV + 512, P1_SN = P1_CS + 4096;

__device__ void phase1(const Params& p, unsigned char* lds) {
    const int tid = threadIdx.x, lane = tid & 63, wid = __builtin_amdgcn_readfirstlane(tid >> 6);
    unsigned char* ws = p.ws;
    bf16_t* hbuf = (bf16_t*)(ws + OFF_HBUF); bf16_t* proj2 = (bf16_t*)(ws + OFF_PROJ2); bf16_t* ubuf = (bf16_t*)(ws + OFF_UBUF);
    float* rsq = (float*)(lds + P1_RSQ); float* rskv = (float*)(lds + P1_RSKV); _Float16* cst = (_Float16*)(lds + P1_CS); _Float16* snt = (_Float16*)(lds + P1_SN);
    for (int tile = blockIdx.x; tile < 256; tile += gridDim.x) {
        const int row0 = tile * 128, b = row0 >> 11;
        float* mod = (float*)(ws + OFF_MODT) + (size_t)tile * 6144 - (size_t)b * 6144;
        for (int i = tid; i < 6144; i += NTHR) { float s = p.b_ada[i]; const float* pp = (const float*)(ws + OFF_PART) + (size_t)b * 6144 + i;
            for (int ks = 0; ks < 16; ++ks) s += pp[(size_t)ks * 16 * 6144]; mod[b * 6144 + i] = s; }
        for (int i = tid; i < 2048; i += NTHR) { const int r = i >> 4, f = i & 15; const float ang = (float)p.pos[row0 + r] * exp2f(-(float)f * (13.287712379549449f / 16.0f));
            float sn, cs; sincosf(ang, &sn, &cs); cst[i] = (_Float16)cs; snt[i] = (_Float16)sn; }
        __threadfence_block(); __syncthreads();
        for (int rp1a = 0; rp1a < ((PROBE_REP & 8192) ? 2 : 1); ++rp1a) {
        {   f32x4 mg[4], msh[4];
#pragma unroll
            for (int j = 0; j < 4; ++j) { const int col = 4 * (lane + 64 * j); const f32x4 g = *(const f32x4*)(p.norm_mix + col), sc = *(const f32x4*)(mod + b * 6144 + 1024 + col);
                mg[j] = (f32x4){g.x * (1.f + sc.x), g.y * (1.f + sc.y), g.z * (1.f + sc.z), g.w * (1.f + sc.w)}; msh[j] = *(const f32x4*)(mod + b * 6144 + col); }
#pragma unroll 1
            for (int r4 = 0; r4 < 4; ++r4) {
                f32x4 v[4][4];
#pragma unroll
                for (int u = 0; u < 4; ++u)
#pragma unroll
                    for (int j = 0; j < 4; ++j) v[u][j] = ((const f32x4*)(p.x + (size_t)(row0 + r4 * 32 + u * 8 + wid) * 1024))[lane + 64 * j];
#pragma unroll
                for (int u = 0; u < 4; ++u) { float ss = 0.f;
#pragma unroll
                    for (int j = 0; j < 4; ++j) ss += v[u][j].x * v[u][j].x + v[u][j].y * v[u][j].y + v[u][j].z * v[u][j].z + v[u][j].w * v[u][j].w;
                    const float rs = rsqrtf(wave_sum(ss) * (1.0f / 1024.0f) + EPS);
#pragma unroll
                    for (int j = 0; j < 4; ++j) { const int col = 4 * (lane + 64 * j);
                        u32x2 o; o.x = pk2(v[u][j].x * rs * mg[j].x + msh[j].x, v[u][j].y * rs * mg[j].y + msh[j].y); o.y = pk2(v[u][j].z * rs * mg[j].z + msh[j].z, v[u][j].w * rs * mg[j].w + msh[j].w);
                        *(u32x2*)(hbuf + (size_t)(row0 + r4 * 32 + u * 8 + wid) * 1024 + col) = o; } }
            }
        }
        __threadfence_block(); __syncthreads();
        }
        for (int rp1b = 0; rp1b < ((PROBE_REP & 16384) ? 2 : 1); ++rp1b) {
        const ARow ah{hbuf + (size_t)row0 * 1024, 1024};
        for (int nc = 0; nc < 4; ++nc) {
            const bf16_t* Bt = (const bf16_t*)(ws + OFF_WINT) + (size_t)nc * 256 * 1024;
            if (nc < 2) gemm_128<2, 1, 0, 3>(ah, Bt, 1024, 1024, lds, nullptr, [&](const float* Ct) {
                    const int ln = opq_v(lane), r0u = opq_s(row0), ncu = opq_s(nc); bf16_t* ub = opq_p(ubuf);
                    for (int tk = wid; tk < 32; tk += NWAVE) { const int gi = tk >> 1, r = (tk & 1) * 64 + ln, g = ncu * 16 + gi, tok = r0u + r;
                        const float* c = Ct + r * CSTR + gi * 16; const f32x4 a0 = *(const f32x4*)c, a1 = *(const f32x4*)(c + 4), a2 = *(const f32x4*)(c + 8), a3 = *(const f32x4*)(c + 12);
                        bf16_t* d = ub + ((size_t)g * 1024 + (tok >> 5)) * 640 + (tok & 31) * 16;
                        *(u32x4*)d = (u32x4){pk2(a0.x, a0.y), pk2(a0.z, a0.w), pk2(a1.x, a1.y), pk2(a1.z, a1.w)}; *(u32x4*)(d + 8) = (u32x4){pk2(a2.x, a2.y), pk2(a2.z, a2.w), pk2(a3.x, a3.y), pk2(a3.z, a3.w)}; } });
            else if (nc == 2) gemm_128<2, 1, 0, 3>(ah, Bt, 1024, 1024, lds, nullptr, [&](const float* Ct) {
                    const int ln = opq_v(lane), r0u = opq_s(row0); bf16_t* pj = opq_p(proj2);
                    for (int r = wid; r < 128; r += NWAVE) { const f32x4 v = *(const f32x4*)(Ct + r * CSTR + ln * 4);
                        const float sq = wave_sum(v.x * v.x + v.y * v.y + v.z * v.z + v.w * v.w); if (ln == 0) rsq[r] = rsqrtf(sq * (1.0f / 256.0f) + EPS);
                        *(u32x2*)(pj + (size_t)(r0u + r) * 512 + ln * 4) = (u32x2){pk2(v.x, v.y), pk2(v.z, v.w)}; } });
            else gemm_128<2, 1, 0, 3>(ah, Bt, 1024, 1024, lds, nullptr, [&](const float* Ct) {
                    const int ln = opq_v(lane), r0u = opq_s(row0); bf16_t* pj = opq_p(proj2);
                    for (int r = wid; r < 128; r += NWAVE) { const f32x4 v = (ln < 40) ? *(const f32x4*)(Ct + r * CSTR + ln * 4) : (f32x4){0.f, 0.f, 0.f, 0.f};
                        const float sq = wave_sum((ln < 32) ? (v.x * v.x + v.y * v.y + v.z * v.z + v.w * v.w) : 0.f); if (ln == 0) rskv[r] = rsqrtf(sq * (1.0f / 128.0f) + EPS);
                        const u32x2 o = (u32x2){pk2(v.x, v.y), pk2(v.z, v.w)};
                        if (ln < 32) *(u32x2*)(pj + (size_t)(r0u + r) * 512 + 256 + ln * 4) = o; else if (ln < 40) *(u32x2*)(pj + (size_t)(r0u + r) * 512 + 384 + (ln - 32) * 4) = o; } });
        }
        }
        for (int rp1d = 0; rp1d < ((PROBE_REP & 32768) ? 2 : 1); ++rp1d) {
        const ARow aq{proj2 + (size_t)row0 * 512, 512};
        for (int nc = 0; nc < 4; ++nc)
            gemm_128<2, 1, 0, 3>(aq, (const bf16_t*)(ws + OFF_WUQT) + (size_t)nc * 256 * 256, 256, 256, lds, nullptr, [&](const float* Ct) {
                const int tq = opq_v(tid); const float* gq = opq_p(p.q_norm);
                if (tq < 256) { const int row = tq & 127, hh = tq >> 7, h = opq_s(nc) * 2 + hh; const float* q = Ct + row * CSTR + hh * 96; float ss = 0.f;
#pragma unroll
                    for (int j = 0; j < 24; ++j) { const f32x4 t4 = *(const f32x4*)(q + 4 * j); ss += t4.x * t4.x + t4.y * t4.y + t4.z * t4.z + t4.w * t4.w; }
                    const float rq = rsq[row], rn = rsqrtf(ss * rq * rq * (1.0f / 96.0f) + EPS) * rq * QSCALE;
                    const int r0q = opq_s(row0); bf16_t* dst = (bf16_t*)(ws + OFF_Q) + ((size_t)((r0q >> 11) * 8 + h) * 2048 + ((r0q + row) & 2047)) * 96;
                    finalize_row(q, q + 64, q + 80, rn, rn, gq, cst + row * 16, snt + row * 16, dst); } });
        }
        for (int rp1e = 0; rp1e < ((PROBE_REP & 65536) ? 2 : 1); ++rp1e) {
        const ARow akv{proj2 + (size_t)row0 * 512 + 256, 512};
        for (int nc = 0; nc < 4; ++nc)
            gemm_128<2, 1, 0, 3>(akv, (const bf16_t*)(ws + OFF_WUKVT) + (size_t)nc * 256 * 128, 128, 128, lds, nullptr, [&](const float* Ct) {
                const int tq = opq_v(tid); const float* gk = opq_p(p.k_norm); const int r0k = opq_s(row0), nck = opq_s(nc);
                if (tq < 256) { const int row = tq & 127, hh = tq >> 7, h = nck * 2 + hh; const float* kp = Ct + row * CSTR + hh * 128; float ss = 0.f, sr = 0.f; float rp[32];
#pragma unroll
                    for (int j = 0; j < 16; ++j) { const f32x4 t4 = *(const f32x4*)(kp + 4 * j); ss += t4.x * t4.x + t4.y * t4.y + t4.z * t4.z + t4.w * t4.w; }
#pragma unroll
                    for (int j = 0; j < 4; ++j) { const u32x4 w = *(const u32x4*)(proj2 + (size_t)(r0k + row) * 512 + 384 + 8 * j);
                        rp[8 * j] = bflo(w.x); rp[8 * j + 1] = bfhi(w.x); rp[8 * j + 2] = bflo(w.y); rp[8 * j + 3] = bfhi(w.y); rp[8 * j + 4] = bflo(w.z); rp[8 * j + 5] = bfhi(w.z); rp[8 * j + 6] = bflo(w.w); rp[8 * j + 7] = bfhi(w.w); }
#pragma unroll
                    for (int d = 0; d < 32; ++d) sr += rp[d] * rp[d];
                    const float rk = rskv[row], rn = rsqrtf((ss * rk * rk + sr) * (1.0f / 96.0f) + EPS);
                    bf16_t* dst = (bf16_t*)(ws + OFF_K) + ((size_t)((r0k >> 11) * 8 + h) * 2048 + ((r0k + row) & 2047)) * 96;
                    finalize_row(kp, rp, rp + 16, rn * rk, rn, gk, cst + row * 16, snt + row * 16, dst);
                } else { const int t = tq - 256, d = t & 63, hh = (t >> 6) & 1, rh = t >> 7, h = nck * 2 + hh;
                    bf16_t* dst = (bf16_t*)(ws + OFF_VT) + ((size_t)((r0k >> 11) * 8 + h) * 64 + d) * 2048 + (r0k & 2047) + rh * 64;
                    const float* vp = Ct + (rh * 64) * CSTR + hh * 128 + 64 + d;
#pragma unroll 2
                    for (int r8 = 0; r8 < 8; ++r8) { float v[8];
#pragma unroll
                        for (int i = 0; i < 8; ++i) v[i] = vp[(r8 * 8 + i) * CSTR] * rskv[rh * 64 + r8 * 8 + i];
                        *(u32x4*)(dst + r8 * 8) = (u32x4){pk2(v[0], v[1]), pk2(v[2], v[3]), pk2(v[4], v[5]), pk2(v[6], v[7])}; } } });
        }
    }
}

__device__ void s5_item(const Params& p, unsigned char* lds, int g, int bp) {
    const int tid = threadIdx.x;
    unsigned char* ws = p.ws;
    bf16_t* A = (bf16_t*)(ws + OFF_UBUF) + ((size_t)g * 1024 + bp * 128) * 640;
    float* Z = (float*)(lds + 73728);
    const ARow au{A, 640};
    gemm_128<1, 0, 0, 2>(au, (const bf16_t*)(ws + OFF_WZT) + (size_t)g * 128 * 512, 512, 512, lds, nullptr, [&](int row, int col, float v) { Z[row * 129 + col] = v; });
    __syncthreads();
    if (tid < 128) {
        const int bs = tid >> 6, pp = tid & 63; const f32x2 aL = ((const f32x2*)(ws + OFF_AL))[g * 64 + pp]; float xr = 0.f, xi = 0.f;
        for (int k = 0; k < 64; ++k) { const int row = bs * 64 + k; bf16_t* xin = A + (size_t)row * 640 + 512;
            xin[pp] = (bf16_t)f2bf(xr); xin[64 + pp] = (bf16_t)f2bf(xi);
            const float zr = Z[row * 129 + pp], zi = Z[row * 129 + 64 + pp], nr = aL.x * xr - aL.y * xi + zr, ni = aL.x * xi + aL.y * xr + zi; xr = nr; xi = ni; }
    }
    __threadfence_block(); __syncthreads();
    bf16_t* ybT = (bf16_t*)(ws + OFF_YBUF) + (size_t)g * T_TOK * 16;
        gemm_128w<0>(au, (const bf16_t*)(ws + OFF_KMT) + (size_t)g * 512 * 640, 640, 640, lds, nullptr, [&](const float* Ct, int nc) {
#pragma unroll
            for (int i = 0; i < 4; ++i) { const int pidx = tid + NTHR * i, row = pidx >> 4, tt = pidx & 15; const float* c = Ct + row * CSTR + tt * 16;
                const f32x4 a0 = *(const f32x4*)c, a1 = *(const f32x4*)(c + 4), a2 = *(const f32x4*)(c + 8), a3 = *(const f32x4*)(c + 12);
                bf16_t* d = ybT + ((size_t)(bp * 128 + row) * 32 + nc * 16 + tt) * 16;
                *(u32x4*)d = (u32x4){pk2(gelu_tanh(a0.x), gelu_tanh(a0.y)), pk2(gelu_tanh(a0.z), gelu_tanh(a0.w)), pk2(gelu_tanh(a1.x), gelu_tanh(a1.y)), pk2(gelu_tanh(a1.z), gelu_tanh(a1.w))};
                *(u32x4*)(d + 8) = (u32x4){pk2(gelu_tanh(a2.x), gelu_tanh(a2.y)), pk2(gelu_tanh(a2.z), gelu_tanh(a2.w)), pk2(gelu_tanh(a3.x), gelu_tanh(a3.y)), pk2(gelu_tanh(a3.z), gelu_tanh(a3.w))}; } });
}

constexpr int AT_KSTR = 208, AT_VSTR = 264, AT_KB = 128 * AT_KSTR, AT_VB = 64 * AT_VSTR, AT_STAGE = AT_KB + AT_VB;

__device__ void attn_item(const Params& p, unsigned char* lds, int bh, int qb) {
    const int tid = threadIdx.x, lane = tid & 63, wid = __builtin_amdgcn_readfirstlane(tid >> 6), r32 = lane & 31, hi = lane >> 5;
    unsigned char* ws = p.ws;
    const int q0 = qb * 256, qw0 = q0 + wid * 32, qg = qw0 + r32;
    const bf16_t* Qp = (const bf16_t*)(ws + OFF_Q) + ((size_t)bh * 2048 + qw0) * 96;
    const bf16_t* Kp = (const bf16_t*)(ws + OFF_K) + (size_t)bh * 2048 * 96;
    const bf16_t* Vp = (const bf16_t*)(ws + OFF_VT) + (size_t)bh * 64 * 2048;
    bf16x8 qf[6];
#pragma unroll
    for (int ks = 0; ks < 6; ++ks) qf[ks] = *(const bf16x8*)(Qp + r32 * 96 + ks * 16 + hi * 8);
    f32x16 ot[2];
#pragma unroll
    for (int r = 0; r < 16; ++r) { ot[0][r] = 0.f; ot[1][r] = 0.f; }
    float m = -INFINITY, l = 0.f;
    const int nst = (q0 + 256) / 128;
    int kro[3], kco[3];
#pragma unroll
    for (int i = 0; i < 3; ++i) { const int pc = tid + NTHR * i; kro[i] = pc / 12; kco[i] = pc % 12; }
    const int vd0 = tid >> 4, vc = tid & 15;
    u32x4 rk[3], rv[2];
#pragma unroll
    for (int i = 0; i < 3; ++i) rk[i] = *(const u32x4*)(Kp + (size_t)kro[i] * 96 + kco[i] * 8);
#pragma unroll
    for (int i = 0; i < 2; ++i) rv[i] = *(const u32x4*)(Vp + (size_t)(vd0 + 32 * i) * 2048 + vc * 8);
#pragma unroll
    for (int i = 0; i < 3; ++i) *(u32x4*)(lds + kro[i] * AT_KSTR + kco[i] * 16) = rk[i];
#pragma unroll
    for (int i = 0; i < 2; ++i) { u32x2* d = (u32x2*)(lds + AT_KB + (vd0 + 32 * i) * AT_VSTR + vc * 16); d[0] = (u32x2){rv[i].x, rv[i].y}; d[1] = (u32x2){rv[i].z, rv[i].w}; }
    __syncthreads();
    for (int t = 0; t < nst; ++t) {
        const unsigned char* st = lds + (t & 1) * AT_STAGE;
        if (t + 1 < nst) {
            const int kn = (t + 1) * 128;
#pragma unroll
            for (int i = 0; i < 3; ++i) rk[i] = *(const u32x4*)(Kp + (size_t)(kn + kro[i]) * 96 + kco[i] * 8);
#pragma unroll
            for (int i = 0; i < 2; ++i) rv[i] = *(const u32x4*)(Vp + (size_t)(vd0 + 32 * i) * 2048 + kn + vc * 8);
        }
#pragma unroll
        for (int sub = 0; sub < 2; ++sub) {
            const int kv0 = t * 128 + sub * 64;
            if (kv0 <= qw0 + 31) {
                f32x16 s0, s1;
#pragma unroll
                for (int r = 0; r < 16; ++r) { s0[r] = 0.f; s1[r] = 0.f; }
                const unsigned char* kb = st + (sub * 64 + r32) * AT_KSTR + hi * 16;
#pragma unroll
                for (int ks = 0; ks < 6; ++ks) {
                    const bf16x8 k0f = *(const bf16x8*)(kb + ks * 32);
                    const bf16x8 k1f = *(const bf16x8*)(kb + 32 * AT_KSTR + ks * 32);
                    s0 = __builtin_amdgcn_mfma_f32_32x32x16_bf16(k0f, qf[ks], s0, 0, 0, 0);
                    s1 = __builtin_amdgcn_mfma_f32_32x32x16_bf16(k1f, qf[ks], s1, 0, 0, 0);
                }
                if (kv0 + 63 > qw0) {
#pragma unroll
                    for (int r = 0; r < 16; ++r) { const int key = kv0 + crow(r, hi); if (key > qg) s0[r] = -INFINITY; if (key + 32 > qg) s1[r] = -INFINITY; }
                }
                float mx = fmaxf(s0[0], s1[0]);
#pragma unroll
                for (int r = 1; r < 16; ++r) mx = fmaxf(mx, fmaxf(s0[r], s1[r]));
                mx = fmaxf(mx, __shfl_xor(mx, 32));
                const float mn = fmaxf(m, mx), alpha = __builtin_amdgcn_exp2f(m - mn);
                float ps = 0.f;
#pragma unroll
                for (int r = 0; r < 16; ++r) { s0[r] = __builtin_amdgcn_exp2f(s0[r] - mn); s1[r] = __builtin_amdgcn_exp2f(s1[r] - mn); ps += s0[r] + s1[r]; }
                l = l * alpha + ps; m = mn;
#pragma unroll
                for (int r = 0; r < 16; ++r) { ot[0][r] *= alpha; ot[1][r] *= alpha; }
                const unsigned char* vb = st + AT_KB + r32 * AT_VSTR + sub * 128 + hi * 8;
#pragma unroll
                for (int kt2 = 0; kt2 < 2; ++kt2)
#pragma unroll
                    for (int s = 0; s < 2; ++s) {
                        u32x4 pw;
                        if (kt2 == 0) { pw.x = pk2(s0[8 * s], s0[8 * s + 1]); pw.y = pk2(s0[8 * s + 2], s0[8 * s + 3]); pw.z = pk2(s0[8 * s + 4], s0[8 * s + 5]); pw.w = pk2(s0[8 * s + 6], s0[8 * s + 7]); }
                        else { pw.x = pk2(s1[8 * s], s1[8 * s + 1]); pw.y = pk2(s1[8 * s + 2], s1[8 * s + 3]); pw.z = pk2(s1[8 * s + 4], s1[8 * s + 5]); pw.w = pk2(s1[8 * s + 6], s1[8 * s + 7]); }
                        const bf16x8 pf = __builtin_bit_cast(bf16x8, pw);
#pragma unroll
                        for (int dt = 0; dt < 2; ++dt) {
                            const unsigned char* a = vb + dt * 32 * AT_VSTR + (kt2 * 32 + 16 * s) * 2;
                            const u32x2 lo = *(const u32x2*)a, hh = *(const u32x2*)(a + 16);
                            const bf16x8 vf = __builtin_bit_cast(bf16x8, (u32x4){lo.x, lo.y, hh.x, hh.y});
                            ot[dt] = __builtin_amdgcn_mfma_f32_32x32x16_bf16(vf, pf, ot[dt], 0, 0, 0);
                        }
                    }
            }
        }
        if (t + 1 < nst) {
            unsigned char* sn = lds + ((t + 1) & 1) * AT_STAGE;
#pragma unroll
            for (int i = 0; i < 3; ++i) *(u32x4*)(sn + kro[i] * AT_KSTR + kco[i] * 16) = rk[i];
#pragma unroll
            for (int i = 0; i < 2; ++i) { u32x2* d = (u32x2*)(sn + AT_KB + (vd0 + 32 * i) * AT_VSTR + vc * 16); d[0] = (u32x2){rv[i].x, rv[i].y}; d[1] = (u32x2){rv[i].z, rv[i].w}; }
        }
        __syncthreads();
    }
    l += __shfl_xor(l, 32);
    const float inv = 1.0f / l;
    bf16_t* dst = (bf16_t*)(ws + OFF_HBUF) + ((size_t)(bh >> 3) * 2048 + qg) * 1024 + 512 + (bh & 7) * 64;
#pragma unroll
    for (int dt = 0; dt < 2; ++dt)
#pragma unroll
        for (int g4 = 0; g4 < 4; ++g4) { u32x2 o; o.x = pk2(ot[dt][4 * g4] * inv, ot[dt][4 * g4 + 1] * inv); o.y = pk2(ot[dt][4 * g4 + 2] * inv, ot[dt][4 * g4 + 3] * inv);
            *(u32x2*)(dst + dt * 32 + 8 * g4 + 4 * hi) = o; }
}

__device__ void phase2(const Params& p, unsigned char* lds) {
    const int G8 = (gridDim.x % 8 == 0) ? (int)gridDim.x / 8 : 0, vb0 = G8 ? ((int)blockIdx.x & 7) * G8 + ((int)blockIdx.x >> 3) : (int)blockIdx.x;
    for (int rp = 0; rp < ((PROBE_REP & 131072) ? 2 : 1); ++rp)
    for (int it = vb0; it < 256; it += gridDim.x) s5_item(p, lds, it >> 3, it & 7);
    for (int rp2 = 0; rp2 < ((PROBE_REP & 262144) ? 2 : 1); ++rp2)
    for (int v = vb0; v < 256; v += gridDim.x) {
        const int bh = v >> 1;
        for (int i = 0; i < 4; ++i) { const int qb = (v & 1) ? ((i == 0) ? 6 : (i == 1) ? 1 : (i == 2) ? 5 : 2) : ((i == 0) ? 7 : (i == 1) ? 0 : (i == 2) ? 4 : 3); attn_item(p, lds, bh, qb); }
    }
}

__device__ __forceinline__ void cex_desc(float& a, float& b) { const float mx = fmaxf(a, b), mn = fminf(a, b); a = mx; b = mn; }
__device__ __forceinline__ void sort16_desc(float (&v)[16]) {
#pragma unroll
    for (int k = 2; k <= 16; k <<= 1)
#pragma unroll
        for (int j = k >> 1; j > 0; j >>= 1)
#pragma unroll
            for (int i = 0; i < 16; ++i) { const int l = i ^ j; if (l > i) { if ((i & k) == 0) cex_desc(v[i], v[l]); else cex_desc(v[l], v[i]); } }
}
__device__ __forceinline__ void merge16(float (&top)[16], const float (&c)[16]) {
#pragma unroll
    for (int i = 0; i < 16; ++i) top[i] = fmaxf(top[i], c[15 - i]);
#pragma unroll
    for (int j = 8; j > 0; j >>= 1)
#pragma unroll
        for (int i = 0; i < 16; ++i) { const int l = i ^ j; if (l > i) cex_desc(top[i], top[l]); }
}
__device__ __forceinline__ float mkc(float a, float b, unsigned code) { return __uint_as_float((__float_as_uint(a + b) & 0xFFFFFF00u) | code); }


struct RowBuf { u32x4 d[4], u[4]; };
__device__ __forceinline__ void g_load(RowBuf& B, const unsigned char* __restrict__ E8, int idv, int kbase, int lane) {
#pragma unroll
    for (int j = 0; j < 4; ++j) { const int e = __builtin_amdgcn_readlane(idv, kbase + j);
        B.d[j] = *(const u32x4*)(E8 + (size_t)e * 1024 + lane * 16); B.u[j] = *(const u32x4*)(E8 + (size_t)(16384 + e) * 1024 + lane * 16); }
}
__device__ __forceinline__ float dpp_add(float t, const int ctrl_sel) {
    if (ctrl_sel == 0) return t + __int_as_float(__builtin_amdgcn_update_dpp(0, __float_as_int(t), 0xB1, 0xF, 0xF, false));
    if (ctrl_sel == 1) return t + __int_as_float(__builtin_amdgcn_update_dpp(0, __float_as_int(t), 0x4E, 0xF, 0xF, false));
    if (ctrl_sel == 2) return t + __int_as_float(__builtin_amdgcn_update_dpp(0, __float_as_int(t), 0x141, 0xF, 0xF, false));
    return t + __int_as_float(__builtin_amdgcn_update_dpp(0, __float_as_int(t), 0x140, 0xF, 0xF, false));
}
__device__ __forceinline__ void g_compute(const RowBuf& B, const f32x2 (&hv)[8], f32x2 (&acc)[8], float sdv, float gwv, int kbase, int lane) {
    float s[4];
#pragma unroll
    for (int j = 0; j < 4; ++j) { f32x2 a = {0.f, 0.f};
#pragma unroll
        for (int q = 0; q < 4; ++q) { const int w = (int)B.d[j][q]; const f32x2 lo = __builtin_amdgcn_cvt_pk_f32_fp8(w, false), hi = __builtin_amdgcn_cvt_pk_f32_fp8(w, true);
            a = __builtin_elementwise_fma(lo, hv[2 * q], a); a = __builtin_elementwise_fma(hi, hv[2 * q + 1], a); }
        s[j] = a.x + a.y; }
    auto r0 = __builtin_amdgcn_permlane32_swap(__float_as_uint(s[0]), __float_as_uint(s[1]), false, false);
    auto r1 = __builtin_amdgcn_permlane32_swap(__float_as_uint(s[2]), __float_as_uint(s[3]), false, false);
    const float r01 = __uint_as_float(r0[0]) + __uint_as_float(r0[1]), r23 = __uint_as_float(r1[0]) + __uint_as_float(r1[1]);
    auto r2 = __builtin_amdgcn_permlane16_swap(__float_as_uint(r01), __float_as_uint(r23), false, false);
    float t = __uint_as_float(r2[0]) + __uint_as_float(r2[1]);
    t = dpp_add(t, 0); t = dpp_add(t, 1); t = dpp_add(t, 2); t = dpp_add(t, 3);
    const int jl = kbase + ((lane >> 4) & 1) * 2 + (lane >> 5);
    const float sdl = __shfl(sdv, jl), gwl = __shfl(gwv, jl);
    const float w = gwl * gelu_tanh(sdl * t);
    float wj[4];
    wj[0] = __int_as_float(__builtin_amdgcn_readlane(__float_as_int(w), 0)); wj[1] = __int_as_float(__builtin_amdgcn_readlane(__float_as_int(w), 32));
    wj[2] = __int_as_float(__builtin_amdgcn_readlane(__float_as_int(w), 16)); wj[3] = __int_as_float(__builtin_amdgcn_readlane(__float_as_int(w), 48));
#pragma unroll
    for (int j = 0; j < 4; ++j) { const f32x2 ws = {wj[j], wj[j]};
#pragma unroll
        for (int q = 0; q < 4; ++q) { const int w2 = (int)B.u[j][q]; const f32x2 lo = __builtin_amdgcn_cvt_pk_f32_fp8(w2, false), hi = __builtin_amdgcn_cvt_pk_f32_fp8(w2, true);
            acc[2 * q] = __builtin_elementwise_fma(lo, ws, acc[2 * q]); acc[2 * q + 1] = __builtin_elementwise_fma(hi, ws, acc[2 * q + 1]); } }
}

constexpr int QP_STR = 528, S_OFF = 128 * QP_STR, S_STR = 132, L_OFF = S_OFF + 128 * S_STR * 4;

__device__ void phase3(const Params& p, unsigned char* lds) {
    const int tid = threadIdx.x, lane = tid & 63, wid = __builtin_amdgcn_readfirstlane(tid >> 6), r32 = lane & 31, hi = lane >> 5, wm = wid >> 2, wn = wid & 3;
    unsigned char* ws = p.ws;
    bf16_t* hbuf = (bf16_t*)(ws + OFF_HBUF); const bf16_t* ybuf = (const bf16_t*)(ws + OFF_YBUF);
    int* idxb = (int*)(ws + OFF_IDX); float* gb = (float*)(ws + OFF_G);
    for (int tile = blockIdx.x; tile < 256; tile += gridDim.x) {
        const int row0 = tile * 128, b = row0 >> 11;
        const float* mod = (const float*)(ws + OFF_MODT) + (size_t)tile * 6144 - (size_t)b * 6144;
        float* ssum = (float*)(lds + SM_OFF); float* ratio = ssum + 128; float* rsat = ratio + 128; float* ss1 = rsat + 128;
        const bf16_t* ybT = ybuf + (size_t)row0 * 16;
        for (int rp3a = 0; rp3a < ((PROBE_REP & 16) ? 2 : 1); ++rp3a) {
            gemm_128w<0>(AGrp{ybT}, (const bf16_t*)(ws + OFF_WGLUT), 512, 512, lds, nullptr, [&](const float* Ct, int nc) {
#pragma unroll 2
                for (int i = 0; i < 8; ++i) { const int pidx = tid + NTHR * i, row = pidx >> 5, c8 = (pidx & 31) * 8, col = nc * 256 + c8;
                    const f32x4 a0 = *(const f32x4*)(Ct + row * CSTR + c8), a1 = *(const f32x4*)(Ct + row * CSTR + c8 + 4);
                    const u32x4 yw = *(const u32x4*)(ybT + ((size_t)(col >> 4) * T_TOK + row) * 16 + (col & 15));
                    const f32x4 b0 = *(const f32x4*)(p.b_glu + col), b1 = *(const f32x4*)(p.b_glu + col + 4);
                    float o[8];
                    o[0] = bflo(yw.x) * sigmoidf_(a0.x + b0.x); o[1] = bfhi(yw.x) * sigmoidf_(a0.y + b0.y); o[2] = bflo(yw.y) * sigmoidf_(a0.z + b0.z); o[3] = bfhi(yw.y) * sigmoidf_(a0.w + b0.w);
                    o[4] = bflo(yw.z) * sigmoidf_(a1.x + b1.x); o[5] = bfhi(yw.z) * sigmoidf_(a1.y + b1.y); o[6] = bflo(yw.w) * sigmoidf_(a1.z + b1.z); o[7] = bfhi(yw.w) * sigmoidf_(a1.w + b1.w);
                    float ss = 0.f;
#pragma unroll
                    for (int k = 0; k < 8; ++k) ss += o[k] * o[k];
                    *(u32x4*)(hbuf + (size_t)(row0 + row) * 1024 + col) = (u32x4){pk2(o[0], o[1]), pk2(o[2], o[3]), pk2(o[4], o[5]), pk2(o[6], o[7])};
#pragma unroll
                    for (int of = 1; of < 32; of <<= 1) ss += __shfl_xor(ss, of);
                    if ((lane & 31) == 0) { if (nc == 0) ssum[row] = ss; else ssum[row] += ss; } } });
        }
#pragma unroll 1
        for (int r4 = 0; r4 < 4; ++r4) { u32x4 w[4];
#pragma unroll
            for (int u = 0; u < 4; ++u) w[u] = *(const u32x4*)(hbuf + (size_t)(row0 + r4 * 32 + u * 8 + wid) * 1024 + 512 + lane * 8);
#pragma unroll
            for (int u = 0; u < 4; ++u) { const int r = r4 * 32 + u * 8 + wid;
                float ss = bflo(w[u].x) * bflo(w[u].x) + bfhi(w[u].x) * bfhi(w[u].x) + bflo(w[u].y) * bflo(w[u].y) + bfhi(w[u].y) * bfhi(w[u].y) + bflo(w[u].z) * bflo(w[u].z) + bfhi(w[u].z) * bfhi(w[u].z) + bflo(w[u].w) * bflo(w[u].w) + bfhi(w[u].w) * bfhi(w[u].w);
                ss = wave_sum(ss);
                if (lane == 0) { const float ra = rsqrtf(ss * (1.0f / 512.0f) + EPS), rs = rsqrtf(ssum[r] * (1.0f / 512.0f) + EPS); rsat[r] = ra; ratio[r] = rs / ra; } }
        }
        __threadfence_block(); __syncthreads();
        for (int rep_c = 0; rep_c < ((PROBE_REP & 128) ? 2 : 1); ++rep_c)
        for (int nc2 = 0; nc2 < 2; ++nc2)
            gemm_128w<16>(ARow{hbuf + (size_t)row0 * 1024, 1024}, (const bf16_t*)(ws + OFF_WOUTT) + (size_t)nc2 * 512 * 1024, 1024, 1024, lds, ratio, [&](const float* Ct, int half) {
                const int nc = nc2 * 2 + half; const f32x4 gm = *(const f32x4*)(mod + b * 6144 + 2048 + nc * 256 + lane * 4);
#pragma unroll 4
                for (int i = 0; i < 16; ++i) { const int row = wid + NWAVE * i, col = nc * 256 + lane * 4; const size_t o = (size_t)(row0 + row) * 1024 + col;
                    const f32x4 v = *(const f32x4*)(Ct + row * CSTR + lane * 4), xv = *(const f32x4*)(p.x + o); const float ra = rsat[row];
                    f32x4 r; r.x = xv.x + gm.x * v.x * ra; r.y = xv.y + gm.y * v.y * ra; r.z = xv.z + gm.z * v.z * ra; r.w = xv.w + gm.w * v.w * ra;
                    *(f32x4*)(p.out + o) = r;
                    const float ss = wave_sum(r.x * r.x + r.y * r.y + r.z * r.z + r.w * r.w);
                    if (lane == 0) { if (nc == 0) ss1[row] = ss; else ss1[row] += ss; } } });
        __threadfence_block(); __syncthreads();
        for (int rp3d = 0; rp3d < ((PROBE_REP & 4096) ? 2 : 1); ++rp3d) {
        {   f32x4 mg[4], msh[4];
#pragma unroll
            for (int j = 0; j < 4; ++j) { const int col = 4 * (lane + 64 * j); const f32x4 g = *(const f32x4*)(p.norm_ffn + col), sc = *(const f32x4*)(mod + b * 6144 + 4096 + col);
                mg[j] = (f32x4){g.x * (1.f + sc.x), g.y * (1.f + sc.y), g.z * (1.f + sc.z), g.w * (1.f + sc.w)}; msh[j] = *(const f32x4*)(mod + b * 6144 + 3072 + col); }
#pragma unroll 1
            for (int r4 = 0; r4 < 4; ++r4) {
                f32x4 v[4][4];
#pragma unroll
                for (int u = 0; u < 4; ++u)
#pragma unroll
                    for (int j = 0; j < 4; ++j) v[u][j] = ((const f32x4*)(p.out + (size_t)(row0 + r4 * 32 + u * 8 + wid) * 1024))[lane + 64 * j];
#pragma unroll
                for (int u = 0; u < 4; ++u) { const int r = r4 * 32 + u * 8 + wid; const float rs = rsqrtf(ss1[r] * (1.0f / 1024.0f) + EPS);
#pragma unroll
                    for (int j = 0; j < 4; ++j) { const int col = 4 * (lane + 64 * j);
                        u32x2 o; o.x = pk2(v[u][j].x * rs * mg[j].x + msh[j].x, v[u][j].y * rs * mg[j].y + msh[j].y); o.y = pk2(v[u][j].z * rs * mg[j].z + msh[j].z, v[u][j].w * rs * mg[j].w + msh[j].w);
                        *(u32x2*)(hbuf + (size_t)(row0 + r) * 1024 + col) = o; } }
            }
        }
        __threadfence_block(); __syncthreads();
        }
        if (PROBE_REP & (524288 | 1048576)) { struct ARowM { const bf16_t* A; int lda; int mask; __device__ __forceinline__ const bf16_t* operator()(int row, int k) const { return A + (size_t)row * lda + (k & mask); } };
            for (int h = 0; h < 8; ++h) gemm_128<2, 0, 0, 3>(ARowM{hbuf + (size_t)row0 * 1024, 1024, (PROBE_REP & 524288) ? 63 : 1023}, (const bf16_t*)(ws + OFF_WQT) + (size_t)h * 256 * 1024, 1024, 1024, lds, nullptr, [&](int row, int col, float v) { asm volatile("" :: "v"(v), "v"(row), "v"(col)); });
            __syncthreads(); }
        for (int rep_e = 0; rep_e < ((PROBE_REP & 32) ? 2 : 1); ++rep_e) {
        float* Ls = (float*)(lds + CT_BYTES);
        for (int h = 0; h < 8; ++h) {
            gemm_128<2, 1, 0, 3>(ARow{hbuf + (size_t)row0 * 1024, 1024}, (const bf16_t*)(ws + OFF_WQT) + (size_t)h * 256 * 1024, 1024, 1024, lds, nullptr, [&](const float* Ct) {
#pragma unroll 1
                for (int ph = 0; ph < 2; ++ph) {
                    const int row = tid >> 2, qd = tid & 3; float top[16];
#pragma unroll
                    for (int c2 = 0; c2 < 2; ++c2) { float c[16];
#pragma unroll
                        for (int q = 0; q < 4; ++q) { const int kb = qd * 32 + c2 * 16 + 4 * q; const f32x4 t4 = *(const f32x4*)(Ct + row * CSTR + ph * 128 + kb);
                            c[4 * q] = __uint_as_float((__float_as_uint(t4.x) & 0xFFFFFF80u) | (unsigned)(127 - kb));
                            c[4 * q + 1] = __uint_as_float((__float_as_uint(t4.y) & 0xFFFFFF80u) | (unsigned)(126 - kb));
                            c[4 * q + 2] = __uint_as_float((__float_as_uint(t4.z) & 0xFFFFFF80u) | (unsigned)(125 - kb));
                            c[4 * q + 3] = __uint_as_float((__float_as_uint(t4.w) & 0xFFFFFF80u) | (unsigned)(124 - kb)); }
                        sort16_desc(c);
                        if (c2 == 0) {
#pragma unroll
                            for (int k = 0; k < 16; ++k) top[k] = c[k];
                        } else merge16(top, c); }
                    { float o[16];
#pragma unroll
                      for (int k = 0; k < 16; ++k) o[k] = __int_as_float(__builtin_amdgcn_update_dpp(0, __float_as_int(top[k]), 0xB1, 0xF, 0xF, false));
                      merge16(top, o);
#pragma unroll
                      for (int k = 0; k < 16; ++k) o[k] = __int_as_float(__builtin_amdgcn_update_dpp(0, __float_as_int(top[k]), 0x4E, 0xF, 0xF, false));
                      merge16(top, o); }
                    if (qd == 0) {
#pragma unroll
                        for (int q = 0; q < 4; ++q) *(f32x4*)(Ls + (ph * 128 + row) * 16 + 4 * q) = (f32x4){top[4 * q], top[4 * q + 1], top[4 * q + 2], top[4 * q + 3]}; }
                }
                __syncthreads();
            if (wid < 2) {
                const int row = wid * 64 + lane; float a1[16], a2[16], top[16];
#pragma unroll
                for (int k = 0; k < 16; ++k) { a1[k] = __uint_as_float(__float_as_uint(Ls[row * 16 + k]) & 0xFFFFFF80u); a2[k] = __uint_as_float(__float_as_uint(Ls[(128 + row) * 16 + k]) & 0xFFFFFF80u); }
    { float c[16];
      c[0] = mkc(a1[0], a2[0], 255u);
      c[1] = mkc(a1[0], a2[1], 254u);
      c[2] = mkc(a1[0], a2[2], 253u);
      c[3] = mkc(a1[0], a2[3], 252u);
      c[4] = mkc(a1[0], a2[4], 251u);
      c[5] = mkc(a1[0], a2[5], 250u);
      c[6] = mkc(a1[0], a2[6], 249u);
      c[7] = mkc(a1[0], a2[7], 248u);
      c[8] = mkc(a1[0], a2[8], 247u);
      c[9] = mkc(a1[0], a2[9], 246u);
      c[10] = mkc(a1[0], a2[10], 245u);
      c[11] = mkc(a1[0], a2[11], 244u);
      c[12] = mkc(a1[0], a2[12], 243u);
      c[13] = mkc(a1[0], a2[13], 242u);
      c[14] = mkc(a1[0], a2[14], 241u);
      c[15] = mkc(a1[0], a2[15], 240u);
      sort16_desc(c); _Pragma("unroll") for (int k = 0; k < 16; ++k) top[k] = c[k];
    }
    { float c[16];
      c[0] = mkc(a1[1], a2[0], 239u);
      c[1] = mkc(a1[1], a2[1], 238u);
      c[2] = mkc(a1[1], a2[2], 237u);
      c[3] = mkc(a1[1], a2[3], 236u);
      c[4] = mkc(a1[1], a2[4], 235u);
      c[5] = mkc(a1[1], a2[5], 234u);
      c[6] = mkc(a1[1], a2[6], 233u);
      c[7] = mkc(a1[1], a2[7], 232u);
      c[8] = mkc(a1[2], a2[0], 223u);
      c[9] = mkc(a1[2], a2[1], 222u);
      c[10] = mkc(a1[2], a2[2], 221u);
      c[11] = mkc(a1[2], a2[3], 220u);
      c[12] = mkc(a1[2], a2[4], 219u);
      c[13] = mkc(a1[3], a2[0], 207u);
      c[14] = mkc(a1[3], a2[1], 206u);
      c[15] = mkc(a1[3], a2[2], 205u);
      sort16_desc(c); merge16(top, c);
    }
    { float c[16];
      c[0] = mkc(a1[3], a2[3], 204u);
      c[1] = mkc(a1[4], a2[0], 191u);
      c[2] = mkc(a1[4], a2[1], 190u);
      c[3] = mkc(a1[4], a2[2], 189u);
      c[4] = mkc(a1[5], a2[0], 175u);
      c[5] = mkc(a1[5], a2[1], 174u);
      c[6] = mkc(a1[6], a2[0], 159u);
      c[7] = mkc(a1[6], a2[1], 158u);
      c[8] = mkc(a1[7], a2[0], 143u);
      c[9] = mkc(a1[7], a2[1], 142u);
      c[10] = mkc(a1[8], a2[0], 127u);
      c[11] = mkc(a1[9], a2[0], 111u);
      c[12] = mkc(a1[10], a2[0], 95u);
      c[13] = mkc(a1[11], a2[0], 79u);
      c[14] = mkc(a1[12], a2[0], 63u);
      c[15] = mkc(a1[13], a2[0], 47u);
      sort16_desc(c); merge16(top, c);
    }
    { float c[16];
      c[0] = mkc(a1[14], a2[0], 31u);
      c[1] = mkc(a1[15], a2[0], 15u);
      c[2] = -3.0e38f;
      c[3] = -3.0e38f;
      c[4] = -3.0e38f;
      c[5] = -3.0e38f;
      c[6] = -3.0e38f;
      c[7] = -3.0e38f;
      c[8] = -3.0e38f;
      c[9] = -3.0e38f;
      c[10] = -3.0e38f;
      c[11] = -3.0e38f;
      c[12] = -3.0e38f;
      c[13] = -3.0e38f;
      c[14] = -3.0e38f;
      c[15] = -3.0e38f;
      sort16_desc(c); merge16(top, c);
    }
                float e[16], es = 0.f; const float m0 = __uint_as_float(__float_as_uint(top[0]) & 0xFFFFFF00u);
#pragma unroll
                for (int k = 0; k < 16; ++k) { e[k] = __expf(__uint_as_float(__float_as_uint(top[k]) & 0xFFFFFF00u) - m0); es += e[k]; }
                const float inv = 1.0f / es; const size_t ob = (size_t)(row0 + row) * 128 + h * 16;
#pragma unroll
                for (int k = 0; k < 16; ++k) { const unsigned code = 255u - (__float_as_uint(top[k]) & 0xFFu); const int i = code >> 4, j = code & 15;
                    const int i1 = 127 - (int)(__float_as_uint(Ls[row * 16 + i]) & 0x7Fu), i2 = 127 - (int)(__float_as_uint(Ls[(128 + row) * 16 + j]) & 0x7Fu);
                    idxb[ob + k] = i1 * 128 + i2; gb[ob + k] = e[k] * inv; }
            } });
        }
        }
        __syncthreads();
    }
}

#ifndef P4_NSL
#define P4_NSL 16
#endif
constexpr int P4_SHIFT = (P4_NSL == 8) ? 11 : (P4_NSL == 16) ? 10 : (P4_NSL == 32) ? 9 : 8;
constexpr int P4_LIST = 128;
constexpr int P4_WLDS = 8 * (P4_LIST * 4 + P4_LIST * 4 + P4_LIST * 4);
typedef _Float16 f16x2 __attribute__((ext_vector_type(2)));
typedef _Float16 f16x32 __attribute__((ext_vector_type(32)));
struct TokState { f16x2 acc[8]; u32x4 hq; int offv; };

struct Rows4 { u32x4 r[4]; };
struct Rows4u { u32x3 r[4]; };
__device__ __forceinline__ void rows_load(Rows4& D, Rows4u& U, __amdgpu_buffer_rsrc_t rd, __amdgpu_buffer_rsrc_t ru, const unsigned* offp, int lane16, int lane12) {
    const u32x4 o = *(const u32x4*)offp;
    const int o0 = __builtin_amdgcn_readfirstlane((int)o.x), o1 = __builtin_amdgcn_readfirstlane((int)o.y), o2 = __builtin_amdgcn_readfirstlane((int)o.z), o3 = __builtin_amdgcn_readfirstlane((int)o.w);
    D.r[0] = __builtin_amdgcn_raw_buffer_load_b128(rd, lane16, o0, 0); D.r[1] = __builtin_amdgcn_raw_buffer_load_b128(rd, lane16, o1, 0);
    D.r[2] = __builtin_amdgcn_raw_buffer_load_b128(rd, lane16, o2, 0); D.r[3] = __builtin_amdgcn_raw_buffer_load_b128(rd, lane16, o3, 0);
    U.r[0] = __builtin_amdgcn_raw_buffer_load_b96(ru, lane12, o0, 0); U.r[1] = __builtin_amdgcn_raw_buffer_load_b96(ru, lane12, o1, 0);
    U.r[2] = __builtin_amdgcn_raw_buffer_load_b96(ru, lane12, o2, 0); U.r[3] = __builtin_amdgcn_raw_buffer_load_b96(ru, lane12, o3, 0);
}
__device__ __forceinline__ int dpp_addi(int t, const int ctrl_sel) {
    if (ctrl_sel == 0) return t + __builtin_amdgcn_update_dpp(0, t, 0xB1, 0xF, 0xF, false);
    if (ctrl_sel == 1) return t + __builtin_amdgcn_update_dpp(0, t, 0x4E, 0xF, 0xF, false);
    if (ctrl_sel == 2) return t + __builtin_amdgcn_update_dpp(0, t, 0x141, 0xF, 0xF, false);
    return t + __builtin_amdgcn_update_dpp(0, t, 0x140, 0xF, 0xF, false);
}
__device__ __forceinline__ int dot4_first(unsigned a, unsigned b) { int r; asm("v_dot4_i32_i8 %0, %1, %2, 0" : "=v"(r) : "v"(a), "v"(b)); return r; }
__device__ __forceinline__ void g_compute2(const Rows4& D, const Rows4u& U, TokState& T, float sdl, float gwl) {
    int s[4];
#pragma unroll
    for (int j = 0; j < 4; ++j) { int a = dot4_first(D.r[j][0], T.hq[0]);
#pragma unroll
        for (int q = 1; q < 4; ++q) a = __builtin_amdgcn_sdot4((int)D.r[j][q], (int)T.hq[q], a, false);
        s[j] = a; }
    auto r0 = __builtin_amdgcn_permlane32_swap((unsigned)s[0], (unsigned)s[1], false, false);
    auto r1 = __builtin_amdgcn_permlane32_swap((unsigned)s[2], (unsigned)s[3], false, false);
    const int r01 = (int)r0[0] + (int)r0[1], r23 = (int)r1[0] + (int)r1[1];
    auto r2 = __builtin_amdgcn_permlane16_swap((unsigned)r01, (unsigned)r23, false, false);
    int ti = (int)r2[0] + (int)r2[1];
    ti = dpp_addi(ti, 0); ti = dpp_addi(ti, 1); ti = dpp_addi(ti, 2); ti = dpp_addi(ti, 3);
    const float t = sdl * (float)ti, u = t * t, pz = __builtin_fmaf(u, 0.044715f * 2.3022082f, 2.3022082f), e = __builtin_amdgcn_exp2f(-(t * pz));
    const float w = (gwl * t) * __builtin_amdgcn_rcpf(1.0f + e);
    const unsigned wp = __builtin_bit_cast(unsigned, __builtin_amdgcn_cvt_pkrtz(w, w));
    const unsigned w0 = (unsigned)__builtin_amdgcn_readlane((int)wp, 0), w1 = (unsigned)__builtin_amdgcn_readlane((int)wp, 32), w2 = (unsigned)__builtin_amdgcn_readlane((int)wp, 16), w3 = (unsigned)__builtin_amdgcn_readlane((int)wp, 48);
    const f16x2 wsa = __builtin_bit_cast(f16x2, w0), wsb = __builtin_bit_cast(f16x2, w1), wsc = __builtin_bit_cast(f16x2, w2), wsd = __builtin_bit_cast(f16x2, w3);
    {
        const u32x6 c = {U.r[0].x, U.r[0].y, U.r[0].z, U.r[1].x, U.r[1].y, U.r[1].z};
        const f16x32 v = __builtin_amdgcn_cvt_scalef32_pk32_f16_fp6(c, 1.0f);
#pragma unroll
        for (int i = 0; i < 8; ++i) { const f16x2 va = {v[2 * i], v[2 * i + 1]}; T.acc[i] = __builtin_elementwise_fma(va, wsa, T.acc[i]); }
#pragma unroll
        for (int i = 0; i < 8; ++i) { const f16x2 vb = {v[16 + 2 * i], v[16 + 2 * i + 1]}; T.acc[i] = __builtin_elementwise_fma(vb, wsb, T.acc[i]); }
    }
    __builtin_amdgcn_sched_barrier(0);
    {
        const u32x6 c = {U.r[2].x, U.r[2].y, U.r[2].z, U.r[3].x, U.r[3].y, U.r[3].z};
        const f16x32 v = __builtin_amdgcn_cvt_scalef32_pk32_f16_fp6(c, 1.0f);
#pragma unroll
        for (int i = 0; i < 8; ++i) { const f16x2 va = {v[2 * i], v[2 * i + 1]}; T.acc[i] = __builtin_elementwise_fma(va, wsc, T.acc[i]); }
#pragma unroll
        for (int i = 0; i < 8; ++i) { const f16x2 vb = {v[16 + 2 * i], v[16 + 2 * i + 1]}; T.acc[i] = __builtin_elementwise_fma(vb, wsd, T.acc[i]); }
    }
    __builtin_amdgcn_sched_barrier(0);
}

template <int FAKE> __device__ void phase4(const Params& p, unsigned char* lds) {
    const int tid = threadIdx.x, lane = tid & 63, wid = __builtin_amdgcn_readfirstlane(tid >> 6);
    unsigned char* ws = p.ws;
    const bf16_t* hbuf = (const bf16_t*)(ws + OFF_HBUF); const int* idxb = (const int*)(ws + OFF_IDX); const float* gb = (const float*)(ws + OFF_G);
    const float* esc = (const float*)(ws + OFF_ESC);
    const __amdgpu_buffer_rsrc_t erd = __builtin_amdgcn_make_buffer_rsrc((void*)(ws + OFF_E8), 0, 16 << 20, 0x00020000), eru = __builtin_amdgcn_make_buffer_rsrc((void*)(ws + OFF_E8 + (16u << 20)), 0, 16 << 20, 0x00020000);
    const int lane16 = lane * 16, lane12 = lane * 12;
    unsigned char* wl = lds + wid * P4_WLDS;
    unsigned* sid = (unsigned*)wl; float* sgw = (float*)(wl + 8 * P4_LIST * 4); float* ssd = sgw + 8 * P4_LIST;
    const int jl = ((lane >> 4) & 1) * 2 + (lane >> 5);
    for (int tile = blockIdx.x; tile < 256; tile += gridDim.x) {
        const int row0 = tile * 128;
        const float* gf = (const float*)(ws + OFF_MODT) + (size_t)tile * 6144 + 5120 + lane * 16;
#pragma unroll 1
        for (int st = 0; st < 2; ++st) {
            const int tokb = row0 + st * 64 + wid * 8;
            TokState T0, T1, T2, T3, T4, T5, T6, T7;
#define P4_PRO(T, j) { const size_t tok = tokb + (j); float shj; \
                int id0 = idxb[tok * 128 + lane], id1 = idxb[tok * 128 + 64 + lane]; if (FAKE) { id0 = (id0 & ~1023) | (id0 & 31); id1 = (id1 & ~1023) | (id1 & 31); } \
                const float sd0 = esc[id0], sd1 = esc[id1], gw0 = gb[tok * 128 + lane] * esc[16384 + id0] * 64.0f, gw1 = gb[tok * 128 + 64 + lane] * esc[16384 + id1] * 64.0f;     \
                _Pragma("unroll") for (int i = 0; i < 8; ++i) T.acc[i] = (f16x2){(_Float16)0.f, (_Float16)0.f}; \
                { const u32x4 w0 = *(const u32x4*)(hbuf + tok * 1024 + lane * 16), w1 = *(const u32x4*)(hbuf + tok * 1024 + lane * 16 + 8); \
                  float hv[16] = {bflo(w0.x), bfhi(w0.x), bflo(w0.y), bfhi(w0.y), bflo(w0.z), bfhi(w0.z), bflo(w0.w), bfhi(w0.w), bflo(w1.x), bfhi(w1.x), bflo(w1.y), bfhi(w1.y), bflo(w1.z), bfhi(w1.z), bflo(w1.w), bfhi(w1.w)}; \
                  float am = 0.f; _Pragma("unroll") for (int i = 0; i < 16; ++i) am = fmaxf(am, fabsf(hv[i])); \
                  _Pragma("unroll") for (int o = 1; o < 64; o <<= 1) am = fmaxf(am, __shfl_xor(am, o)); \
                  const float sc = (am > 0.f) ? am * (1.0f / 127.0f) : 1.0f, inv = 1.0f / sc; shj = sc; \
                  _Pragma("unroll") for (int q = 0; q < 4; ++q) { const int b0 = (int)rintf(hv[4 * q] * inv), b1 = (int)rintf(hv[4 * q + 1] * inv), b2 = (int)rintf(hv[4 * q + 2] * inv), b3 = (int)rintf(hv[4 * q + 3] * inv); \
                      T.hq[q] = (unsigned)(b0 & 0xFF) | ((unsigned)(b1 & 0xFF) << 8) | ((unsigned)(b2 & 0xFF) << 16) | ((unsigned)(b3 & 0xFF) << 24); } } \
                const int sl0 = id0 >> P4_SHIFT, sl1 = id1 >> P4_SHIFT; int po = 0, offv = 0, pos0 = 0, pos1 = 0; \
                _Pragma("unroll 1") for (int s = 0; s < P4_NSL; ++s) { \
                    const unsigned long long m0 = __ballot(sl0 == s), m1 = __ballot(sl1 == s); const int c0 = __popcll(m0), c = c0 + __popcll(m1); \
                    if (lane == s) offv = (po + 3) & ~3; \
                    if (sl0 == s) pos0 = po + (int)__builtin_amdgcn_mbcnt_hi((unsigned)(m0 >> 32), __builtin_amdgcn_mbcnt_lo((unsigned)m0, 0u)); \
                    if (sl1 == s) pos1 = po + c0 + (int)__builtin_amdgcn_mbcnt_hi((unsigned)(m1 >> 32), __builtin_amdgcn_mbcnt_lo((unsigned)m1, 0u)); \
                    po += c; } \
                if (lane == P4_NSL) offv = 128; T.offv = offv; \
                sid[(j) * P4_LIST + pos0] = (unsigned)id0 << 10; sgw[(j) * P4_LIST + pos0] = gw0; ssd[(j) * P4_LIST + pos0] = sd0 * shj; \
                sid[(j) * P4_LIST + pos1] = (unsigned)id1 << 10; sgw[(j) * P4_LIST + pos1] = gw1; ssd[(j) * P4_LIST + pos1] = sd1 * shj; }
            P4_PRO(T0, 0) P4_PRO(T1, 1) P4_PRO(T2, 2) P4_PRO(T3, 3) P4_PRO(T4, 4) P4_PRO(T5, 5) P4_PRO(T6, 6) P4_PRO(T7, 7)
#undef P4_PRO
            asm volatile("s_waitcnt lgkmcnt(0)" ::: "memory");
#define P4_ITEM(T, j) { const int st_ = __builtin_amdgcn_readlane(T.offv, s), en_ = __builtin_amdgcn_readlane(T.offv, s + 1); \
                _Pragma("unroll 1") for (int i = st_; i < en_; i += 4) { Rows4 D; Rows4u U; rows_load(D, U, erd, eru, sid + (j) * P4_LIST + i, lane16, lane12); \
                    g_compute2(D, U, T, ssd[(j) * P4_LIST + i + jl], sgw[(j) * P4_LIST + i + jl]); } }
#pragma unroll 1
            for (int s_ = 0; s_ < P4_NSL; ++s_) { const int s = (st & 1) ? (P4_NSL - 1 - s_) : s_;
                P4_ITEM(T0, 0) P4_ITEM(T1, 1) P4_ITEM(T2, 2) P4_ITEM(T3, 3) P4_ITEM(T4, 4) P4_ITEM(T5, 5) P4_ITEM(T6, 6) P4_ITEM(T7, 7) }
#undef P4_ITEM
#define P4_EPI(T, j) { float* orow = p.out + (size_t)(tokb + (j)) * 1024 + lane * 16; \
                _Pragma("unroll") for (int q = 0; q < 4; ++q) { f32x4 o = *(const f32x4*)(orow + 4 * q); const f32x4 gg = *(const f32x4*)(gf + 4 * q); const float sc_ = 1.0f / 64.0f; \
                    o.x += gg.x * sc_ * (float)T.acc[2 * q].x; o.y += gg.y * sc_ * (float)T.acc[2 * q].y; o.z += gg.z * sc_ * (float)T.acc[2 * q + 1].x; o.w += gg.w * sc_ * (float)T.acc[2 * q + 1].y; \
                    if (FAKE) asm volatile("" :: "v"(o.x), "v"(o.y), "v"(o.z), "v"(o.w)); else *(f32x4*)(orow + 4 * q) = o; } }
            P4_EPI(T0, 0) P4_EPI(T1, 1) P4_EPI(T2, 2) P4_EPI(T3, 3) P4_EPI(T4, 4) P4_EPI(T5, 5) P4_EPI(T6, 6) P4_EPI(T7, 7)
#undef P4_EPI
        }
    }
}

#define LAS __attribute__((address_space(3)))
#define XB_TMO      128
#define XB_XCNT(j)  (256  + 64 * (j))
#define XB_XSUB(j)  (1280 + 64 * (j))
#define XB_XGEN(j)  (2304 + 64 * (j))
#define XB_TOP      3328
#define XB_TOPGEN   3392
#define XCD_BAR_WORDS 3456
#define XB_SPIN_CAP (1u << 18)

__device__ __forceinline__ unsigned xb_ld(unsigned* p)              { return __hip_atomic_load(p, __ATOMIC_RELAXED, __HIP_MEMORY_SCOPE_AGENT); }
__device__ __forceinline__ unsigned xb_add(unsigned* p, unsigned v) { return __hip_atomic_fetch_add(p, v, __ATOMIC_RELAXED, __HIP_MEMORY_SCOPE_AGENT); }
__device__ __forceinline__ unsigned xb_xcc_id() { return (unsigned)__builtin_amdgcn_s_getreg((3 << 11) | 20) & 0xFu; }
#define XB_SPIN(cond, bar) do { unsigned _sp = 0; while (cond) { __builtin_amdgcn_s_sleep(1); \
    if ((++_sp & 255u) == 0u) { if (xb_ld(&(bar)[XB_TMO])) break; if (_sp > XB_SPIN_CAP) { atomicAdd(&(bar)[XB_TMO], 1u); break; } } } } while (0)

struct XcdBarrier {
    unsigned* bar; unsigned x;
    volatile LAS unsigned* st;
};

__device__ __forceinline__ XcdBarrier xcd_barrier_post(unsigned* bar, volatile LAS unsigned* st) {
    XcdBarrier b; b.bar = bar; b.x = xb_xcc_id(); b.st = st;
    if (threadIdx.x == 0) (void)xb_add(&bar[XB_XCNT(b.x)], 1u);
    return b;
}
__device__ __forceinline__ void xcd_barrier_complete(unsigned* bar, unsigned x, unsigned& nloc, unsigned& nx) {
    const unsigned G = gridDim.x * gridDim.y * gridDim.z;
    unsigned sum, cnt, mine, sp = 0u;
    for (;;) {
        sum = 0u; cnt = 0u; mine = 0u;
#pragma unroll
        for (unsigned j = 0; j < 16; ++j) { const unsigned c = xb_ld(&bar[XB_XCNT(j)]); sum += c; cnt += (c > 0u) ? 1u : 0u; mine = (j == x) ? c : mine; }
        if (sum == G) break;
        __builtin_amdgcn_s_sleep(1);
        if ((++sp & 255u) == 0u) { if (xb_ld(&bar[XB_TMO])) break; if (sp > XB_SPIN_CAP) { atomicAdd(&bar[XB_TMO], 1u); break; } }
    }
    nloc = mine > 0u ? mine : 1u; nx = cnt > 0u ? cnt : 1u;
}

__device__ __forceinline__ void xcd_barrier(const XcdBarrier& b) {
    asm volatile("s_waitcnt vmcnt(0)" ::: "memory");
    __syncthreads();
    if (threadIdx.x == 0) {
        unsigned* bar = b.bar;
        __builtin_amdgcn_s_waitcnt(0);
        unsigned nloc = b.st[0], nx = b.st[1];
        if (nloc == 0u) { xcd_barrier_complete(bar, b.x, nloc, nx); b.st[0] = nloc; b.st[1] = nx; }
        const unsigned old = xb_add(&bar[XB_XSUB(b.x)], 1u);
        const unsigned gen = old / nloc;
        if (old + 1u == (gen + 1u) * nloc) {
            __builtin_amdgcn_fence(__ATOMIC_RELEASE, "agent");
            asm volatile("s_waitcnt vmcnt(0)" ::: "memory");
            const unsigned og = xb_add(&bar[XB_TOP], 1u);
            const unsigned tg = og / nx;
            if (og + 1u == (tg + 1u) * nx) xb_add(&bar[XB_TOPGEN], 1u);
            else XB_SPIN(xb_ld(&bar[XB_TOPGEN]) == tg, bar);
            __builtin_amdgcn_fence(__ATOMIC_ACQUIRE, "agent");
            xb_add(&bar[XB_XGEN(b.x)], 1u);
            asm volatile("s_waitcnt vmcnt(0)" ::: "memory");
        } else {
            XB_SPIN(xb_ld(&bar[XB_XGEN(b.x)]) == gen, bar);
            __builtin_amdgcn_fence(__ATOMIC_ACQUIRE, "agent");
            asm volatile("s_waitcnt vmcnt(0)" ::: "memory");
        }
    }
    __syncthreads();
}

__global__ void __launch_bounds__(NTHR, 2) fwd_kernel(Params p) {
    extern __shared__ __attribute__((aligned(16))) unsigned char lds[];
#if MK_COOP
    volatile LAS unsigned* bst = (volatile LAS unsigned*)(lds + LDS_BYTES - 16);
    if (threadIdx.x < 2) bst[threadIdx.x] = 0u;
    __syncthreads();
    const XcdBarrier xbar = xcd_barrier_post((unsigned*)(p.ws + OFF_BAR), bst);
#endif
    unsigned long long tsv[6]; if (PROBE_TS) tsv[0] = __builtin_amdgcn_s_memrealtime();
    if (p.ph_lo <= 0 && 0 < p.ph_hi) { phase0(p, lds); if (PROBE_REP & 1) { __syncthreads(); phase0(p, lds); } }
#if MK_COOP
    if (p.ph_lo <= 0 && 1 < p.ph_hi) { if (p.ph_hi > 64) cg::this_grid().sync(); else xcd_barrier(xbar); }
#endif
    if (PROBE_TS) tsv[1] = __builtin_amdgcn_s_memrealtime();
    if (p.ph_lo <= 1 && 1 < p.ph_hi) { phase1(p, lds); if (PROBE_REP & 2) { __syncthreads(); phase1(p, lds); } }
#if MK_COOP
    if (p.ph_lo <= 1 && 2 < p.ph_hi) { xcd_barrier(xbar); if (PROBE_REP & 2097152) { for (int q = 0; q < 8; ++q) xcd_barrier(xbar); } if (PROBE_REP & 4194304) { for (int q = 0; q < 4; ++q) cg::this_grid().sync(); } }
#endif
    if (PROBE_TS) tsv[2] = __builtin_amdgcn_s_memrealtime();
    if (p.ph_lo <= 2 && 2 < p.ph_hi) { phase2(p, lds); if (PROBE_REP & 4) { __syncthreads(); phase2(p, lds); } }
#if MK_COOP
    if (p.ph_lo <= 2 && 3 < p.ph_hi) xcd_barrier(xbar);
#endif
    if (PROBE_TS) tsv[3] = __builtin_amdgcn_s_memrealtime();
    if (p.ph_lo <= 3 && 3 < p.ph_hi) phase3(p, lds);
#if MK_COOP
    if (p.ph_lo <= 3 && 4 < p.ph_hi) xcd_barrier(xbar);
#endif
    if (PROBE_TS) tsv[4] = __builtin_amdgcn_s_memrealtime();
    if (p.ph_lo <= 4 && 4 < p.ph_hi) { if (PROBE_REP & 2048) { phase4<1>(p, lds); __syncthreads(); } phase4<0>(p, lds); }
    if (PROBE_TS) { __syncthreads(); tsv[5] = __builtin_amdgcn_s_memrealtime(); if (blockIdx.x == 0 && threadIdx.x == 0) { asm volatile("s_waitcnt vmcnt(0)" ::: "memory");
        const unsigned long long d = (PROBE_TS == 6) ? (tsv[5] - tsv[0]) : (tsv[PROBE_TS] - tsv[PROBE_TS - 1]); p.out[0] += (float)d * 1e-3f; } }
    if (PROBE_P0) { __syncthreads(); if (blockIdx.x == 0 && threadIdx.x == 0) { asm volatile("s_waitcnt vmcnt(0)" ::: "memory"); p.out[0] += (float)__hip_atomic_load((unsigned*)(p.ws + OFF_BAR + 16000), __ATOMIC_RELAXED, __HIP_MEMORY_SCOPE_AGENT) * 1e-3f; } }
}

extern "C" void kernel_launch(void* const* d_in, const int* in_sizes, int n_in, void* d_out, int out_size, void* d_ws, size_t ws_size, hipStream_t stream) {
    static int grid = 0;
    if (grid == 0) {
        if (n_in != 31 || ws_size < WS_NEED) { fprintf(stderr, "kernel_launch: bad inputs (n_in %d, ws %zu < %zu)\n", n_in, ws_size, (size_t)WS_NEED); grid = -1; return; }
        int dev = 0, cus = 0, per_cu = 0;
        hipGetDevice(&dev); hipDeviceGetAttribute(&cus, hipDeviceAttributeMultiprocessorCount, dev);
        if (hipFuncSetAttribute((const void*)fwd_kernel, hipFuncAttributeMaxDynamicSharedMemorySize, LDS_BYTES) != hipSuccess) { fprintf(stderr, "kernel_launch: hipFuncSetAttribute failed\n"); grid = -1; return; }
        hipOccupancyMaxActiveBlocksPerMultiprocessor(&per_cu, (const void*)fwd_kernel, NTHR, LDS_BYTES);
        if (per_cu < 1) { fprintf(stderr, "kernel_launch: occupancy query says %d blocks/CU\n", per_cu); per_cu = 1; }
        grid = cus;
        (void)hipGetLastError();
    }
    if (grid < 0) return;
    (void)hipMemsetAsync((char*)d_ws + OFF_BAR, 0, 16384, stream);
    Params p{};
    const float** f = (const float**)&p;
    for (int i = 0; i < 31; ++i) f[i] = (const float*)d_in[i];
    p.out = (float*)d_out; p.ws = (unsigned char*)d_ws;
#if MK_COOP
    p.ph_lo = 0; p.ph_hi = 5;
    void* args[] = {&p};
    hipError_t e = hipLaunchCooperativeKernel((const void*)fwd_kernel, dim3(grid), dim3(NTHR), args, LDS_BYTES, stream);
    if (e != hipSuccess) fprintf(stderr, "cooperative launch failed: %s (grid %d)\n", hipGetErrorString(e), grid);
#else
    for (int ph = 0; ph < 5; ++ph) { p.ph_lo = ph; p.ph_hi = ph + 1; hipLaunchKernelGGL(fwd_kernel, dim3(grid), dim3(NTHR), LDS_BYTES, stream, p); }
#endif
}
```

```cpp
#include <hip/hip_runtime.h>
#include <hip/hip_cooperative_groups.h>
#include <cstdio>
#include <cstdint>
namespace cg = cooperative_groups;

#ifndef PROBE_REP
#define PROBE_REP 0
#endif
#ifndef PROBE_P0
#define PROBE_P0 0
#endif
#ifndef PROBE_TS
#define PROBE_TS 0
#endif
#ifndef MK_COOP
#define MK_COOP 1
#endif

typedef unsigned short bf16_t;
typedef short bf16x8 __attribute__((ext_vector_type(8)));
typedef short s16x4 __attribute__((ext_vector_type(4)));
typedef float f32x16 __attribute__((ext_vector_type(16)));
typedef float f32x4 __attribute__((ext_vector_type(4)));
typedef float f32x2 __attribute__((ext_vector_type(2)));
typedef unsigned u32x4 __attribute__((ext_vector_type(4)));
typedef unsigned u32x2 __attribute__((ext_vector_type(2)));

constexpr int NTHR = 512, NWAVE = 8;
constexpr int T_TOK = 32768, DM = 1024, NB = 16, SEQ = 2048;
constexpr int LDS_BYTES = 163840;
constexpr float EPS = 1e-6f;
constexpr float QSCALE = 0.10206207261596575f * 1.4426950408889634f;

constexpr size_t OFF_PART  = 0;
constexpr size_t OFF_MODT  = 8u << 20;
constexpr size_t OFF_WINT  = 16u << 20;
constexpr size_t OFF_WGLUT = OFF_WINT + (2u << 20);
constexpr size_t OFF_WUQT  = OFF_WGLUT + (512u << 10);
constexpr size_t OFF_WUKVT = OFF_WUQT + 524288;
constexpr size_t OFF_WOUTT = OFF_WUKVT + 262144;
constexpr size_t OFF_WQT   = OFF_WOUTT + (2u << 20);
constexpr size_t OFF_SUBK  = OFF_WQT + (4u << 20);
constexpr size_t OFF_KMT   = OFF_SUBK + 65536;
constexpr size_t OFF_WZT   = OFF_KMT + 20971520;
constexpr size_t OFF_AL    = OFF_WZT + 4194304;
constexpr size_t OFF_HBUF  = OFF_AL + 16384;
constexpr size_t OFF_PROJ2 = OFF_HBUF + (64u << 20);
constexpr size_t OFF_UBUF  = OFF_PROJ2 + (32u << 20);
constexpr size_t OFF_Q     = OFF_UBUF + 41943040;
constexpr size_t OFF_K     = OFF_Q + 50331648;
constexpr size_t OFF_X1    = OFF_Q;
constexpr size_t OFF_VT    = OFF_K + 50331648;
constexpr size_t OFF_YBUF  = OFF_VT + 33554432;
constexpr size_t OFF_IDX   = OFF_YBUF + (32u << 20);
constexpr size_t OFF_G     = OFF_IDX + (16u << 20);
constexpr size_t OFF_E8    = OFF_G + (16u << 20);
constexpr size_t OFF_ESC   = OFF_E8 + (32u << 20);
constexpr size_t OFF_BAR   = OFF_ESC + (1u << 20);
constexpr size_t WS_NEED   = OFF_BAR + (1u << 20);

struct Params {
    const float* x; const float* c; const int* pos; const float* w_ada; const float* b_ada; const float* norm_mix; const float* norm_ffn; const float* w_in;
    const float* lam_re; const float* lam_im; const float* log_dt; const float* b_re; const float* b_im; const float* c_re; const float* c_im; const float* d_skip;
    const float* w_glu; const float* b_glu; const float* q_a_norm; const float* w_uq; const float* kv_a_norm; const float* w_ukv; const float* q_norm; const float* k_norm;
    const float* out_norm_ssm; const float* out_norm_attn; const float* w_out; const float* w_query; const float* sub_keys; const float* e_down; const float* e_up;
    float* out; unsigned char* ws; int ph_lo, ph_hi;
};

__device__ __forceinline__ unsigned f2bf(float f) { unsigned u = __float_as_uint(f); return (u + 0x7fffu + ((u >> 16) & 1u)) >> 16; }
typedef __bf16 hwbf16x2 __attribute__((ext_vector_type(2)));
__device__ __forceinline__ unsigned pk2(float lo, float hi) { const f32x2 v = {lo, hi}; return __builtin_bit_cast(unsigned, __builtin_convertvector(v, hwbf16x2)); }
__device__ __forceinline__ float bf2f(unsigned short b) { return __uint_as_float(((unsigned)b) << 16); }
__device__ __forceinline__ float bflo(unsigned w) { return __uint_as_float(w << 16); }
__device__ __forceinline__ float bfhi(unsigned w) { return __uint_as_float(w & 0xffff0000u); }
__device__ __forceinline__ int opq_s(int x) { asm volatile("" : "+s"(x)); return x; }
__device__ __forceinline__ int opq_v(int x) { asm volatile("" : "+v"(x)); return x; }
template <class T> __device__ __forceinline__ T* opq_p(T* x) { asm volatile("" : "+s"(x)); return x; }
__device__ __forceinline__ int crow(int r, int hi) { return (r & 3) + 8 * (r >> 2) + 4 * hi; }
__device__ __forceinline__ float wave_sum(float v) {
#pragma unroll
    for (int o = 1; o < 64; o <<= 1) v += __shfl_xor(v, o);
    return v;
}
__device__ __forceinline__ float gelu_tanh(float x) {
    const float u = 0.7978845608028654f * (x + 0.044715f * x * x * x);
    const float t = 1.0f - 2.0f * __builtin_amdgcn_rcpf(1.0f + __expf(2.0f * u));
    return 0.5f * x * (1.0f + t);
}
__device__ __forceinline__ float sigmoidf_(float z) { return __builtin_amdgcn_rcpf(1.0f + __expf(-z)); }

constexpr int G_STR = 144;
constexpr int G_ABYTES = 128 * G_STR;
template <int NT> struct GemmCfg { static constexpr int BN = 128 * NT, BBYTES = BN * G_STR, STAGE = G_ABYTES + BBYTES; };

struct ARow { const bf16_t* A; int lda; __device__ __forceinline__ const bf16_t* operator()(int row, int k) const { return A + (size_t)row * lda + k; }
              __device__ __forceinline__ size_t kstep32() const { return 32; } };
struct AGrp { const bf16_t* Y; __device__ __forceinline__ const bf16_t* operator()(int row, int k) const { return Y + ((size_t)(k >> 4) * T_TOK + row) * 16 + (k & 15); }
              __device__ __forceinline__ size_t kstep32() const { return (size_t)2 * T_TOK * 16; } };
constexpr int CSTR = 260;

#ifndef GEMM_GLDS
#define GEMM_GLDS 1
#endif
#ifndef GEMM16
#define GEMM16 0
#endif
#if GEMM16
template <int NT, int MODE, int MID, int NST, class AL, class Epi>
__device__ __forceinline__ void gemm_128(const AL aload, const bf16_t* __restrict__ Bt, int ldb, int K, unsigned char* lds, const float* midscale, Epi epi) {
    typedef GemmCfg<NT> C;
    const int tid = opq_v((int)threadIdx.x), lane = tid & 63, wid = __builtin_amdgcn_readfirstlane(tid >> 6), wm = wid >> 2, wn = wid & 3, fr = lane & 15, fq = lane >> 4;
    f32x4 acc[4][2 * NT];
#pragma unroll
    for (int i = 0; i < 4; ++i)
#pragma unroll
        for (int j = 0; j < 2 * NT; ++j) acc[i][j] = (f32x4){0.f, 0.f, 0.f, 0.f};
    const int prow = tid >> 3, pc = tid & 7;
    const bf16_t* gb = Bt + (size_t)prow * ldb + pc * 8;
    const int ldsoff = prow * G_STR + pc * 16;
    u32x4 ra[2], rb[2 * NT];
    const int nk = K >> 6;
#pragma unroll
    for (int q = 0; q < 2; ++q) ra[q] = *(const u32x4*)aload(prow + 64 * q, pc * 8);
#pragma unroll
    for (int q = 0; q < 2 * NT; ++q) rb[q] = *(const u32x4*)(gb + (size_t)(64 * q) * ldb);
#pragma unroll
    for (int q = 0; q < 2; ++q) *(u32x4*)(lds + ldsoff + q * 64 * G_STR) = ra[q];
#pragma unroll
    for (int q = 0; q < 2 * NT; ++q) *(u32x4*)(lds + G_ABYTES + ldsoff + q * 64 * G_STR) = rb[q];
    __syncthreads();
    for (int kt = 0; kt < nk; ++kt) {
        unsigned char* st = lds + (kt & 1) * C::STAGE;
        if (kt + 1 < nk) {
#pragma unroll
            for (int q = 0; q < 2; ++q) ra[q] = *(const u32x4*)aload(prow + 64 * q, (kt + 1) * 64 + pc * 8);
#pragma unroll
            for (int q = 0; q < 2 * NT; ++q) rb[q] = *(const u32x4*)(gb + (size_t)(64 * q) * ldb + (kt + 1) * 64);
        }
        if (MID > 0 && kt == MID) {
#pragma unroll
            for (int i = 0; i < 4; ++i)
#pragma unroll
                for (int r = 0; r < 4; ++r) { const float sc = midscale[wm * 64 + i * 16 + fq * 4 + r];
#pragma unroll
                    for (int j = 0; j < 2 * NT; ++j) acc[i][j][r] *= sc; }
        }
        const unsigned char* pa = st + (wm * 64 + fr) * G_STR + fq * 16;
        const unsigned char* pb = st + G_ABYTES + (wn * 32 * NT + fr) * G_STR + fq * 16;
#pragma unroll
        for (int ks = 0; ks < 2; ++ks) {
            bf16x8 af[4], bfr[2 * NT];
#pragma unroll
            for (int i = 0; i < 4; ++i) af[i] = *(const bf16x8*)(pa + i * 16 * G_STR + ks * 64);
#pragma unroll
            for (int j = 0; j < 2 * NT; ++j) bfr[j] = *(const bf16x8*)(pb + j * 16 * G_STR + ks * 64);
#pragma unroll
            for (int i = 0; i < 4; ++i)
#pragma unroll
                for (int j = 0; j < 2 * NT; ++j) acc[i][j] = __builtin_amdgcn_mfma_f32_16x16x32_bf16(af[i], bfr[j], acc[i][j], 0, 0, 0);
        }
        if (kt + 1 < nk) {
            unsigned char* sn = lds + ((kt + 1) & 1) * C::STAGE;
#pragma unroll
            for (int q = 0; q < 2; ++q) *(u32x4*)(sn + ldsoff + q * 64 * G_STR) = ra[q];
#pragma unroll
            for (int q = 0; q < 2 * NT; ++q) *(u32x4*)(sn + G_ABYTES + ldsoff + q * 64 * G_STR) = rb[q];
        }
        __syncthreads();
    }
    if constexpr (MODE == 0) {
#pragma unroll
        for (int i = 0; i < 4; ++i)
#pragma unroll
            for (int j = 0; j < 2 * NT; ++j)
#pragma unroll
                for (int r = 0; r < 4; ++r) epi(wm * 64 + i * 16 + fq * 4 + r, wn * 32 * NT + j * 16 + fr, acc[i][j][r]);
    } else {
        float* Ct = (float*)lds;
#pragma unroll
        for (int i = 0; i < 4; ++i)
#pragma unroll
            for (int j = 0; j < 2 * NT; ++j)
#pragma unroll
                for (int r = 0; r < 4; ++r) Ct[(wm * 64 + i * 16 + fq * 4 + r) * CSTR + wn * 32 * NT + j * 16 + fr] = acc[i][j][r];
        __syncthreads();
        epi((const float*)Ct);
        __syncthreads();
    }
}

#elif GEMM_GLDS
template <int NT, int MODE, int MID, int NST, class AL, class Epi>
__device__ __forceinline__ void gemm_128(const AL aload, const bf16_t* __restrict__ Bt, int ldb, int K, unsigned char* lds, const float* midscale, Epi epi) {
    typedef GemmCfg<NT> C;
    const int tid = opq_v((int)threadIdx.x), lane = tid & 63, wid = __builtin_amdgcn_readfirstlane(tid >> 6), wm = wid >> 2, wn = wid & 3, r32 = lane & 31, hi = lane >> 5;
    f32x16 acc[2][NT];
#pragma unroll
    for (int i = 0; i < 2; ++i)
#pragma unroll
        for (int j = 0; j < NT; ++j)
#pragma unroll
            for (int r = 0; r < 16; ++r) acc[i][j][r] = 0.f;
    typedef __attribute__((address_space(3))) unsigned char lds_uc;
    lds_uc* ldsl = (lds_uc*)lds;
    const int srow = wid * 8 + (lane >> 3), schunk = ((lane & 7) ^ ((srow >> 1) & 7)) * 8;
    const bf16_t* gb = Bt + (size_t)srow * ldb + schunk;
    const int nk = K >> 6;
    const int krot = (MID == 0) ? (int)(((unsigned)blockIdx.x >> 3) % (unsigned)nk) : 0;
#define GL_RK(kk) (((kk) + krot >= nk) ? (kk) + krot - nk : (kk) + krot)
    constexpr int SA = 128 * 128, SB = 128 * NT * 128, SSTAGE = SA + SB;
#define GL_STAGE(stg, kk) do { \
        _Pragma("unroll") for (int q = 0; q < 2; ++q) __builtin_amdgcn_global_load_lds((const unsigned*)aload(srow + 64 * q, (kk) * 64 + schunk), (__attribute__((address_space(3))) unsigned*)(ldsl + (stg) * SSTAGE + q * 8192 + wid * 1024), 16, 0, 0); \
        _Pragma("unroll") for (int q = 0; q < 2 * NT; ++q) __builtin_amdgcn_global_load_lds((const unsigned*)(gb + (size_t)(64 * q) * ldb + (kk) * 64), (__attribute__((address_space(3))) unsigned*)(ldsl + (stg) * SSTAGE + SA + q * 8192 + wid * 1024), 16, 0, 0); } while (0)
#define GL_WAITN() do { if constexpr (NT == 2) asm volatile("s_waitcnt vmcnt(6)" ::: "memory"); else asm volatile("s_waitcnt vmcnt(4)" ::: "memory"); } while (0)
#define GL_BAR() asm volatile("s_waitcnt lgkmcnt(0)\n\ts_barrier" ::: "memory")
    GL_STAGE(0, GL_RK(0));
    if (NST == 3 && nk > 1) { GL_STAGE(1, GL_RK(1)); GL_WAITN(); } else asm volatile("s_waitcnt vmcnt(0)" ::: "memory");
    GL_BAR();
    const int swz = (r32 >> 1) & 7;
    int cofs[4];
#pragma unroll
    for (int ks = 0; ks < 4; ++ks) cofs[ks] = ((((ks << 1) | hi) ^ swz) << 4);
    for (int kt = 0; kt < nk; ++kt) {
        const unsigned char* st = lds + (kt % NST) * SSTAGE;
        if (kt + NST - 1 < nk) GL_STAGE((kt + NST - 1) % NST, GL_RK(kt + NST - 1));
        if (MID > 0 && kt == MID) {
#pragma unroll
            for (int i = 0; i < 2; ++i)
#pragma unroll
                for (int r = 0; r < 16; ++r) { const float sc = midscale[wm * 64 + i * 32 + crow(r, hi)];
#pragma unroll
                    for (int j = 0; j < NT; ++j) acc[i][j][r] *= sc; }
        }
        const unsigned char* pa = st + (wm * 64 + r32) * 128;
        const unsigned char* pb = st + SA + (wn * 32 * NT + r32) * 128;
#pragma unroll
        for (int ks = 0; ks < 4; ++ks) {
            bf16x8 af[2], bfr[NT];
#pragma unroll
            for (int i = 0; i < 2; ++i) af[i] = *(const bf16x8*)(pa + i * 32 * 128 + cofs[ks]);
#pragma unroll
            for (int j = 0; j < NT; ++j) bfr[j] = *(const bf16x8*)(pb + j * 32 * 128 + cofs[ks]);
#pragma unroll
            for (int i = 0; i < 2; ++i)
#pragma unroll
                for (int j = 0; j < NT; ++j) acc[i][j] = __builtin_amdgcn_mfma_f32_32x32x16_bf16(af[i], bfr[j], acc[i][j], 0, 0, 0);
        }
        if (NST == 3 && kt + 2 < nk) GL_WAITN(); else asm volatile("s_waitcnt vmcnt(0)" ::: "memory");
        GL_BAR();
    }
#undef GL_STAGE
#undef GL_RK
#undef GL_WAITN
#undef GL_BAR
    if constexpr (MODE == 0) {
#pragma unroll
        for (int i = 0; i < 2; ++i)
#pragma unroll
            for (int j = 0; j < NT; ++j)
#pragma unroll
                for (int r = 0; r < 16; ++r) epi(wm * 64 + i * 32 + crow(r, hi), wn * 32 * NT + j * 32 + r32, acc[i][j][r]);
    } else {
        float* Ct = (float*)lds;
#pragma unroll
        for (int i = 0; i < 2; ++i)
#pragma unroll
            for (int j = 0; j < NT; ++j)
#pragma unroll
                for (int r = 0; r < 16; ++r) Ct[(wm * 64 + i * 32 + crow(r, hi)) * CSTR + wn * 32 * NT + j * 32 + r32] = acc[i][j][r];
        __syncthreads();
        epi((const float*)Ct);
        __syncthreads();
    }
}

#else
template <int NT, int MODE, int MID, int NST, class AL, class Epi>
__device__ __forceinline__ void gemm_128(const AL aload, const bf16_t* __restrict__ Bt, int ldb, int K, unsigned char* lds, const float* midscale, Epi epi) {
    typedef GemmCfg<NT> C;
    const int tid = opq_v((int)threadIdx.x), lane = tid & 63, wid = __builtin_amdgcn_readfirstlane(tid >> 6), wm = wid >> 2, wn = wid & 3, r32 = lane & 31, hi = lane >> 5;
    f32x16 acc[2][NT];
#pragma unroll
    for (int i = 0; i < 2; ++i)
#pragma unroll
        for (int j = 0; j < NT; ++j)
#pragma unroll
            for (int r = 0; r < 16; ++r) acc[i][j][r] = 0.f;
    const int prow = tid >> 3, pc = tid & 7;
    const bf16_t* gb = Bt + (size_t)prow * ldb + pc * 8;
    const int ldsoff = prow * G_STR + pc * 16;
    u32x4 ra[2], rb[2 * NT];
    const int nk = K >> 6;
#pragma unroll
    for (int q = 0; q < 2; ++q) ra[q] = *(const u32x4*)aload(prow + 64 * q, pc * 8);
#pragma unroll
    for (int q = 0; q < 2 * NT; ++q) rb[q] = *(const u32x4*)(gb + (size_t)(64 * q) * ldb);
#pragma unroll
    for (int q = 0; q < 2; ++q) *(u32x4*)(lds + ldsoff + q * 64 * G_STR) = ra[q];
#pragma unroll
    for (int q = 0; q < 2 * NT; ++q) *(u32x4*)(lds + G_ABYTES + ldsoff + q * 64 * G_STR) = rb[q];
    __syncthreads();
    for (int kt = 0; kt < nk; ++kt) {
        unsigned char* st = lds + (kt & 1) * C::STAGE;
        if (kt + 1 < nk) {
#pragma unroll
            for (int q = 0; q < 2; ++q) ra[q] = *(const u32x4*)aload(prow + 64 * q, (kt + 1) * 64 + pc * 8);
#pragma unroll
            for (int q = 0; q < 2 * NT; ++q) rb[q] = *(const u32x4*)(gb + (size_t)(64 * q) * ldb + (kt + 1) * 64);
        }
        if (MID > 0 && kt == MID) {
#pragma unroll
            for (int i = 0; i < 2; ++i)
#pragma unroll
                for (int r = 0; r < 16; ++r) { const float sc = midscale[wm * 64 + i * 32 + crow(r, hi)];
#pragma unroll
                    for (int j = 0; j < NT; ++j) acc[i][j][r] *= sc; }
        }
        const unsigned char* pa = st + (wm * 64 + r32) * G_STR + hi * 16;
        const unsigned char* pb = st + G_ABYTES + (wn * 32 * NT + r32) * G_STR + hi * 16;
#pragma unroll
        for (int ks = 0; ks < 4; ++ks) {
            bf16x8 af[2], bfr[NT];
#pragma unroll
            for (int i = 0; i < 2; ++i) af[i] = *(const bf16x8*)(pa + i * 32 * G_STR + ks * 32);
#pragma unroll
            for (int j = 0; j < NT; ++j) bfr[j] = *(const bf16x8*)(pb + j * 32 * G_STR + ks * 32);
#pragma unroll
            for (int i = 0; i < 2; ++i)
#pragma unroll
                for (int j = 0; j < NT; ++j) acc[i][j] = __builtin_amdgcn_mfma_f32_32x32x16_bf16(af[i], bfr[j], acc[i][j], 0, 0, 0);
        }
        if (kt + 1 < nk) {
            unsigned char* sn = lds + ((kt + 1) & 1) * C::STAGE;
#pragma unroll
            for (int q = 0; q < 2; ++q) *(u32x4*)(sn + ldsoff + q * 64 * G_STR) = ra[q];
#pragma unroll
            for (int q = 0; q < 2 * NT; ++q) *(u32x4*)(sn + G_ABYTES + ldsoff + q * 64 * G_STR) = rb[q];
        }
        __syncthreads();
    }
    if constexpr (MODE == 0) {
#pragma unroll
        for (int i = 0; i < 2; ++i)
#pragma unroll
            for (int j = 0; j < NT; ++j)
#pragma unroll
                for (int r = 0; r < 16; ++r) epi(wm * 64 + i * 32 + crow(r, hi), wn * 32 * NT + j * 32 + r32, acc[i][j][r]);
    } else {
        float* Ct = (float*)lds;
#pragma unroll
        for (int i = 0; i < 2; ++i)
#pragma unroll
            for (int j = 0; j < NT; ++j)
#pragma unroll
                for (int r = 0; r < 16; ++r) Ct[(wm * 64 + i * 32 + crow(r, hi)) * CSTR + wn * 32 * NT + j * 32 + r32] = acc[i][j][r];
        __syncthreads();
        epi((const float*)Ct);
        __syncthreads();
    }
}

#endif

template <int MID32, class AL, class Epi>
__device__ __forceinline__ void gemm_128w(const AL aload, const bf16_t* __restrict__ Bt, int ldb, int K, unsigned char* lds, const float* midscale, Epi epi) {
    const int tid = opq_v((int)threadIdx.x), lane = tid & 63, wid = __builtin_amdgcn_readfirstlane(tid >> 6), wm = wid >> 2, wn = wid & 3, r32 = lane & 31, hi = lane >> 5;
    f32x16 acc[2][4];
#pragma unroll
    for (int i = 0; i < 2; ++i)
#pragma unroll
        for (int j = 0; j < 4; ++j)
#pragma unroll
            for (int r = 0; r < 16; ++r) acc[i][j][r] = 0.f;
    typedef __attribute__((address_space(3))) unsigned char lds_uc;
    lds_uc* ldsl = (lds_uc*)lds;
    const int srow = wid * 16 + (lane >> 2), schunk = ((lane & 3) ^ ((srow >> 2) & 3)) * 8;
    const bf16_t* gb = Bt + (size_t)srow * ldb + schunk;
    const int nk = K >> 5;
    constexpr int SA = 128 * 64, SB = 512 * 64, SSTAGE = SA + SB;
#define GW_STAGE(stg, pa_, pb_) do { \
        __builtin_amdgcn_global_load_lds((const unsigned*)(pa_), (__attribute__((address_space(3))) unsigned*)(ldsl + (stg) * SSTAGE + wid * 1024), 16, 0, 0); \
        _Pragma("unroll") for (int q = 0; q < 4; ++q) __builtin_amdgcn_global_load_lds((const unsigned*)((pb_) + (size_t)(128 * q) * ldb), (__attribute__((address_space(3))) unsigned*)(ldsl + (stg) * SSTAGE + SA + q * 8192 + wid * 1024), 16, 0, 0); } while (0)
#define GW_BAR() asm volatile("s_waitcnt lgkmcnt(0)\n\ts_barrier" ::: "memory")
    const bf16_t* pga = aload(srow, schunk); const size_t astep = aload.kstep32();
    const bf16_t* pgb = gb;
    const int kseg = (MID32 > 0) ? MID32 : nk, krot = (int)(((unsigned)blockIdx.x >> 3) % (unsigned)kseg);
#define GW_RK(kk) ((((kk) >= kseg) ? kseg : 0) + (((((kk) >= kseg) ? (kk) - kseg : (kk)) + krot >= kseg) ? (((kk) >= kseg) ? (kk) - kseg : (kk)) + krot - kseg : (((kk) >= kseg) ? (kk) - kseg : (kk)) + krot))
#define GW_STAGEK(stg, kk) do { const int rk_ = GW_RK(kk); GW_STAGE(stg, pga + (size_t)rk_ * astep, pgb + rk_ * 32); } while (0)
    GW_STAGEK(0, 0);
    if (nk > 1) { GW_STAGEK(1, 1); asm volatile("s_waitcnt vmcnt(5)" ::: "memory"); } else asm volatile("s_waitcnt vmcnt(0)" ::: "memory");
    GW_BAR();
    const int swz = (r32 >> 2) & 3;
    const int cof0 = ((hi ^ swz) << 4), cof1 = (((2 | hi) ^ swz) << 4);
    const int arow = (wm * 64 + r32) * 64, brow = SA + (wn * 64 + r32) * 64;
    int cur = 0, nxt = 2;
#pragma unroll 1
    for (int kt = 0; kt < nk; ++kt) {
        const unsigned char* st = lds + cur * SSTAGE;
        if (kt + 2 < nk) GW_STAGEK(nxt, kt + 2);
        if (MID32 > 0 && kt == MID32) {
#pragma unroll
            for (int i = 0; i < 2; ++i)
#pragma unroll
                for (int r = 0; r < 16; ++r) { const float sc = midscale[wm * 64 + i * 32 + crow(r, hi)];
#pragma unroll
                    for (int j = 0; j < 4; ++j) acc[i][j][r] *= sc; }
        }
#pragma unroll
        for (int ks = 0; ks < 2; ++ks) {
            const int cof = ks ? cof1 : cof0;
            bf16x8 af[2], bfr[4];
#pragma unroll
            for (int i = 0; i < 2; ++i) af[i] = *(const bf16x8*)(st + arow + i * 32 * 64 + cof);
#pragma unroll
            for (int j = 0; j < 4; ++j) bfr[j] = *(const bf16x8*)(st + brow + ((j >> 1) * 256 + (j & 1) * 32) * 64 + cof);
#pragma unroll
            for (int i = 0; i < 2; ++i)
#pragma unroll
                for (int j = 0; j < 4; ++j) acc[i][j] = __builtin_amdgcn_mfma_f32_32x32x16_bf16(af[i], bfr[j], acc[i][j], 0, 0, 0);
        }
        if (kt + 2 < nk) asm volatile("s_waitcnt vmcnt(5)" ::: "memory"); else asm volatile("s_waitcnt vmcnt(0)" ::: "memory");
        GW_BAR();
        cur = (cur == 2) ? 0 : cur + 1; nxt = (nxt == 2) ? 0 : nxt + 1;
    }
#undef GW_STAGE
#undef GW_STAGEK
#undef GW_RK
#undef GW_BAR
    float* Ct = (float*)lds;
#pragma unroll
    for (int c = 0; c < 2; ++c) {
#pragma unroll
        for (int i = 0; i < 2; ++i)
#pragma unroll
            for (int jj = 0; jj < 2; ++jj)
#pragma unroll
                for (int r = 0; r < 16; ++r) Ct[(wm * 64 + i * 32 + crow(r, hi)) * CSTR + wn * 64 + jj * 32 + r32] = acc[i][2 * c + jj][r];
        __syncthreads();
        epi((const float*)Ct, c);
        __syncthreads();
    }
}

struct TrD { const float* W; bf16_t* WT; const float* g0; const float* g1; int K, N, gsplit, cmap, item; };
__device__ __forceinline__ void p0_tr_load(const TrD& d, float (&v)[8]) {
    const int tid = threadIdx.x, nkb = d.K / 64, kb = d.item % nkb, nb = d.item / nkb, k0 = kb * 64, n0 = nb * 64;
#pragma unroll
    for (int r = 0; r < 8; ++r) {
        const int kk = r * 8 + (tid >> 6), nn = tid & 63, k = k0 + kk; int n = n0 + nn;
        if (d.cmap) n = ((n & 255) < 192) ? (n >> 8) * 192 + (n & 255) : d.N;
        float x = (n < d.N) ? d.W[(size_t)k * d.N + n] : 0.f;
        if (d.g0) x *= (k < d.gsplit) ? d.g0[k] : d.g1[k - d.gsplit];
        v[r] = x;
    }
}
__device__ __forceinline__ void p0_tr_store(const TrD& d, const float* scr) {
    const int tid = threadIdx.x, nkb = d.K / 64, kb = d.item % nkb, nb = d.item / nkb, k0 = kb * 64, n0 = nb * 64;
    const int n = tid >> 3, kc = tid & 7; const float* s = scr + (kc * 8) * 65 + n;
    u32x4 o; o.x = pk2(s[0], s[65]); o.y = pk2(s[2 * 65], s[3 * 65]); o.z = pk2(s[4 * 65], s[5 * 65]); o.w = pk2(s[6 * 65], s[7 * 65]);
    *(u32x4*)(d.WT + (size_t)(n0 + n) * d.K + k0 + kc * 8) = o;
}
__device__ __forceinline__ void split_hl(const f32x4 a, const f32x4 b, bf16x8& h, bf16x8& l) {
    u32x4 hh, ll; const float x[8] = {a.x, a.y, a.z, a.w, b.x, b.y, b.z, b.w};
#pragma unroll
    for (int q = 0; q < 4; ++q) { const unsigned hw = pk2(x[2 * q], x[2 * q + 1]); hh[q] = hw; ll[q] = pk2(x[2 * q] - __uint_as_float(hw << 16), x[2 * q + 1] - __uint_as_float(hw & 0xffff0000u)); }
    h = __builtin_bit_cast(bf16x8, hh); l = __builtin_bit_cast(bf16x8, ll);
}


__device__ __forceinline__ void quant_row(const f32x4 (&a)[4], unsigned char* dst, float* scale_out, int lane) {
    float am = 0.f;
#pragma unroll
    for (int q = 0; q < 4; ++q) am = fmaxf(am, fmaxf(fmaxf(fabsf(a[q].x), fabsf(a[q].y)), fmaxf(fabsf(a[q].z), fabsf(a[q].w))));
#pragma unroll
    for (int o = 1; o < 64; o <<= 1) am = fmaxf(am, __shfl_xor(am, o));
    const float sc = (am > 0.f) ? am * (1.0f / 224.0f) : 1.0f, inv = 1.0f / sc;
    u32x4 o;
    { int w = __builtin_amdgcn_cvt_pk_fp8_f32(a[0].x * inv, a[0].y * inv, 0, false); w = __builtin_amdgcn_cvt_pk_fp8_f32(a[0].z * inv, a[0].w * inv, w, true); o.x = (unsigned)w; }
    { int w = __builtin_amdgcn_cvt_pk_fp8_f32(a[1].x * inv, a[1].y * inv, 0, false); w = __builtin_amdgcn_cvt_pk_fp8_f32(a[1].z * inv, a[1].w * inv, w, true); o.y = (unsigned)w; }
    { int w = __builtin_amdgcn_cvt_pk_fp8_f32(a[2].x * inv, a[2].y * inv, 0, false); w = __builtin_amdgcn_cvt_pk_fp8_f32(a[2].z * inv, a[2].w * inv, w, true); o.z = (unsigned)w; }
    { int w = __builtin_amdgcn_cvt_pk_fp8_f32(a[3].x * inv, a[3].y * inv, 0, false); w = __builtin_amdgcn_cvt_pk_fp8_f32(a[3].z * inv, a[3].w * inv, w, true); o.w = (unsigned)w; }
    *(u32x4*)dst = o;
    if (lane == 0) *scale_out = sc;
}

typedef unsigned u32x6 __attribute__((ext_vector_type(6)));
typedef unsigned u32x3 __attribute__((ext_vector_type(3)));
__device__ __forceinline__ void quant_row_fp6(const f32x4 (&a)[4], unsigned char* dst, float* scale_out, int lane) {
    float am = 0.f;
#pragma unroll
    for (int q = 0; q < 4; ++q) am = fmaxf(am, fmaxf(fmaxf(fabsf(a[q].x), fabsf(a[q].y)), fmaxf(fabsf(a[q].z), fabsf(a[q].w))));
#pragma unroll
    for (int o = 1; o < 64; o <<= 1) am = fmaxf(am, __shfl_xor(am, o));
    const float sc = (am > 0.f) ? am * (1.0f / 7.5f) : 1.0f, inv = 1.0f / sc;
    f32x16 s0, s1;
#pragma unroll
    for (int q = 0; q < 4; ++q) { s0[2 * q] = a[q].x * inv; s1[2 * q] = a[q].y * inv; s0[2 * q + 1] = a[q].z * inv; s1[2 * q + 1] = a[q].w * inv; }
#pragma unroll
    for (int i = 8; i < 16; ++i) { s0[i] = 0.f; s1[i] = 0.f; }
    const u32x6 c = __builtin_amdgcn_cvt_scalef32_2xpk16_fp6_f32(s0, s1, 1.0f);
    unsigned* d = (unsigned*)dst; d[0] = c[0]; d[1] = c[1]; d[2] = c[2];
    if (lane == 0) *scale_out = sc;
}

__device__ __forceinline__ void quant_row_i8(const f32x4 (&a)[4], unsigned char* dst, float* scale_out, int lane) {
    float am = 0.f;
#pragma unroll
    for (int q = 0; q < 4; ++q) am = fmaxf(am, fmaxf(fmaxf(fabsf(a[q].x), fabsf(a[q].y)), fmaxf(fabsf(a[q].z), fabsf(a[q].w))));
#pragma unroll
    for (int o = 1; o < 64; o <<= 1) am = fmaxf(am, __shfl_xor(am, o));
    const float sc = (am > 0.f) ? am * (1.0f / 127.0f) : 1.0f, inv = 1.0f / sc;
    u32x4 o;
#pragma unroll
    for (int q = 0; q < 4; ++q) { const int b0 = (int)rintf(a[q].x * inv), b1 = (int)rintf(a[q].y * inv), b2 = (int)rintf(a[q].z * inv), b3 = (int)rintf(a[q].w * inv);
        o[q] = (unsigned)(b0 & 0xFF) | ((unsigned)(b1 & 0xFF) << 8) | ((unsigned)(b2 & 0xFF) << 16) | ((unsigned)(b3 & 0xFF) << 24); }
    *(u32x4*)dst = o;
    if (lane == 0) *scale_out = sc;
}
__device__ void phase0(const Params& p, unsigned char* lds) {
    const int tid = threadIdx.x, G = gridDim.x, bid = blockIdx.x;
    unsigned char* ws = p.ws;
    float* scr = (float*)lds;
    unsigned long long p0t0 = 0; if (PROBE_P0) p0t0 = __builtin_amdgcn_s_memrealtime();
#define P0_MARK(k) if (PROBE_P0 == (k)) { __syncthreads(); if (tid == 0) { asm volatile("s_waitcnt vmcnt(0)" ::: "memory"); atomicMax((unsigned*)(ws + OFF_BAR + 16000), (unsigned)(__builtin_amdgcn_s_memrealtime() - p0t0)); } }
    const auto jobA = [&]() __attribute__((always_inline)) {
    {
        float* part = (float*)(ws + OFF_PART);
        for (int it = bid; it < 24 * 16; it += G) {
            const int nb = it % 24, ks = it / 24, n = nb * 256 + (tid & 255), bh = tid >> 8;
            float w[64];
#pragma unroll
            for (int kk = 0; kk < 64; ++kk) w[kk] = p.w_ada[(size_t)(ks * 64 + kk) * 6144 + n];
            for (int i = tid; i < 16 * 64; i += NTHR) { const int b = i >> 6, kk = i & 63; const float cv = p.c[b * 1024 + ks * 64 + kk]; scr[i] = cv / (1.0f + __expf(-cv)); }
            __syncthreads();
            float acc[8];
#pragma unroll
            for (int j = 0; j < 8; ++j) acc[j] = 0.f;
#pragma unroll
            for (int k4 = 0; k4 < 16; ++k4) {
#pragma unroll
                for (int j = 0; j < 8; ++j) { const f32x4 s = *(const f32x4*)(scr + (bh * 8 + j) * 64 + k4 * 4);
                    acc[j] = fmaf(w[4 * k4], s.x, acc[j]); acc[j] = fmaf(w[4 * k4 + 1], s.y, acc[j]); acc[j] = fmaf(w[4 * k4 + 2], s.z, acc[j]); acc[j] = fmaf(w[4 * k4 + 3], s.w, acc[j]); }
            }
#pragma unroll
            for (int j = 0; j < 8; ++j) part[((size_t)ks * 16 + bh * 8 + j) * 6144 + n] = acc[j];
            __syncthreads();
        }
    }
    };
    const auto jobB = [&]() __attribute__((always_inline)) {
    {
        constexpr int I_IN = 16 * 16, I_GLU = 8 * 8, I_UQ = 4 * 16, I_UKV = 2 * 16, I_OUT = 16 * 16, I_Q = 16 * 32;
        constexpr int NTR = I_IN + I_GLU + I_UQ + I_UKV + I_OUT;
        for (int it0 = bid; it0 < NTR; it0 += 3 * G) {
            TrD d[3]; float v[3][8];
#pragma unroll
            for (int u = 0; u < 3; ++u) { const int it = it0 + u * G; if (it < NTR) {
                int r = it;
                if (r < I_IN) d[u] = TrD{p.w_in, (bf16_t*)(ws + OFF_WINT), nullptr, nullptr, 1024, 928, 0, 0, r};
                else if ((r -= I_IN) < I_GLU) d[u] = TrD{p.w_glu, (bf16_t*)(ws + OFF_WGLUT), nullptr, nullptr, 512, 512, 0, 0, r};
                else if ((r -= I_GLU) < I_UQ) d[u] = TrD{p.w_uq, (bf16_t*)(ws + OFF_WUQT), p.q_a_norm, p.q_a_norm, 256, 768, 256, 1, r};
                else if ((r -= I_UQ) < I_UKV) d[u] = TrD{p.w_ukv, (bf16_t*)(ws + OFF_WUKVT), p.kv_a_norm, p.kv_a_norm, 128, 1024, 128, 0, r};
                else { r -= I_UKV; d[u] = TrD{p.w_out, (bf16_t*)(ws + OFF_WOUTT), p.out_norm_ssm, p.out_norm_attn, 1024, 1024, 512, 0, r}; }
                p0_tr_load(d[u], v[u]); } }
#pragma unroll
            for (int u = 0; u < 3; ++u) if (it0 + u * G < NTR) {
#pragma unroll
                for (int r = 0; r < 8; ++r) scr[u * (64 * 65) + (r * 8 + (tid >> 6)) * 65 + (tid & 63)] = v[u][r]; }
            __syncthreads();
#pragma unroll
            for (int u = 0; u < 3; ++u) if (it0 + u * G < NTR) p0_tr_store(d[u], scr + u * (64 * 65));
            __syncthreads();
        }
        for (int it0 = bid; it0 < I_Q; it0 += 2 * G) {
#pragma unroll
            for (int u = 0; u < 2; ++u) { const int r = it0 + u * G; if (r < I_Q) {
                const int kb = r & 15, nb = r >> 4, k0 = kb * 64, n0 = nb * 64, hp = n0 >> 7, key0 = n0 & 127, ph = hp & 1;
                float* SK = scr + u * (2 * 64 * 132); float* WQ = SK + 64 * 132;
#pragma unroll
                for (int q = 0; q < 4; ++q) { const int i = tid + q * NTHR, rr = i >> 5, c4 = (i & 31) * 4;
                    const f32x4 a = *(const f32x4*)(p.sub_keys + ((size_t)ph * 128 + key0 + rr) * 128 + c4), b = *(const f32x4*)(p.w_query + (size_t)(k0 + rr) * 2048 + hp * 128 + c4);
                    *(f32x4*)(SK + rr * 132 + c4) = a; *(f32x4*)(WQ + rr * 132 + c4) = b; } } }
            __syncthreads();
            {
                const int wv = __builtin_amdgcn_readfirstlane(tid >> 6), u = wv >> 2, r = it0 + u * G;
                if (r < I_Q) {
                    const int kb = r & 15, nb = r >> 4, k0 = kb * 64, n0 = nb * 64, mt = wv & 1, nt = (wv >> 1) & 1, l31 = tid & 31, hi = (tid >> 5) & 1;
                    const float* SK = scr + u * (2 * 64 * 132); const float* WQ = SK + 64 * 132;
                    f32x16 acc;
#pragma unroll
                    for (int i = 0; i < 16; ++i) acc[i] = 0.f;
#pragma unroll
                    for (int ks = 0; ks < 8; ++ks) {
                        const float* ap = SK + (mt * 32 + l31) * 132 + ks * 16 + hi * 8;
                        const float* bp = WQ + (nt * 32 + l31) * 132 + ks * 16 + hi * 8;
                        bf16x8 ah, al, bhh, bl;
                        split_hl(*(const f32x4*)ap, *(const f32x4*)(ap + 4), ah, al); split_hl(*(const f32x4*)bp, *(const f32x4*)(bp + 4), bhh, bl);
                        acc = __builtin_amdgcn_mfma_f32_32x32x16_bf16(ah, bhh, acc, 0, 0, 0);
                        acc = __builtin_amdgcn_mfma_f32_32x32x16_bf16(ah, bl, acc, 0, 0, 0);
                        acc = __builtin_amdgcn_mfma_f32_32x32x16_bf16(al, bhh, acc, 0, 0, 0);
                    }
                    bf16_t* WT = (bf16_t*)(ws + OFF_WQT);
#pragma unroll
                    for (int i = 0; i < 16; ++i) WT[(size_t)(n0 + mt * 32 + (i & 3) + 8 * (i >> 2) + 4 * hi) * 1024 + k0 + nt * 32 + l31] = (bf16_t)f2bf(acc[i]);
                }
            }
            __syncthreads();
        }
    }
    };
    const auto jobD = [&]() __attribute__((always_inline)) {
    {
        const int lane = tid & 63, gw = bid * NWAVE + (tid >> 6), NGW = G * NWAVE;
        unsigned char* E8 = ws + OFF_E8; float* esc = (float*)(ws + OFF_ESC);
        for (int r = gw; r < 32768; r += 4 * NGW) {
            f32x4 a[4][4];
#pragma unroll
            for (int u = 0; u < 4; ++u) { const int ru = r + u * NGW; if (ru < 32768) { const float* sp = ((ru < 16384) ? p.e_down : p.e_up) + (size_t)(ru & 16383) * 1024 + lane * 16;
#pragma unroll
                for (int q = 0; q < 4; ++q) a[u][q] = ((const f32x4*)sp)[q]; } }
#pragma unroll
            for (int u = 0; u < 4; ++u) { const int ru = r + u * NGW; if (ru < 32768) { if (ru < 16384) quant_row_i8(a[u], E8 + (size_t)ru * 1024 + lane * 16, esc + 2 * ru, lane); else quant_row_fp6(a[u], E8 + (size_t)ru * 1024 + lane * 12, esc + 2 * (ru - 16384) + 1, lane); } }
        }
    }
    };
    if ((bid >> 3) & 1) { jobA(); jobB(); jobD(); } else { jobD(); jobA(); jobB(); }
    P0_MARK(2)
    {
        const size_t gt = (size_t)bid * NTHR + tid, gs = (size_t)G * NTHR;
        for (size_t i = gt; i < 32768 / 8; i += gs) { const f32x4 a = ((const f32x4*)p.sub_keys)[2 * i], b = ((const f32x4*)p.sub_keys)[2 * i + 1];
            u32x4 o; o.x = pk2(a.x, a.y); o.y = pk2(a.z, a.w); o.z = pk2(b.x, b.y); o.w = pk2(b.z, b.w); ((u32x4*)(ws + OFF_SUBK))[i] = o; }
    }
    P0_MARK(3)
    {
        f32x2* apow = (f32x2*)lds;
        f32x2* Bb = (f32x2*)(lds + 16896);
        f32x2* Cc = (f32x2*)(lds + 16896 + 8192);
        float* Kt = (float*)(lds + 16896 + 16384);
        for (int it = ((bid >= G / 2) ? bid - G / 2 : bid + G / 2); it < 128; it += G) {
            const int g = it >> 2, cq = it & 3;
            const float dt = __expf(p.log_dt[g]);
            for (int i = tid; i < 33 * 64; i += NTHR) { const int j = i >> 6, pp = i & 63; const float lr = p.lam_re[g * 64 + pp], li = p.lam_im[g * 64 + pp];
                const float mag = expf((float)j * lr * dt); float sn, cs; sincosf((float)j * li * dt, &sn, &cs); apow[i] = (f32x2){mag * cs, mag * sn}; }
            for (int i = tid; i < 1024; i += NTHR) { const int pp = i >> 4; const float lr = p.lam_re[g * 64 + pp], li = p.lam_im[g * 64 + pp];
                const float mag = expf(lr * dt); float sn, cs; sincosf(li * dt, &sn, &cs); const float nr = mag * cs - 1.0f, ni = mag * sn, den = lr * lr + li * li;
                const float cr = (nr * lr + ni * li) / den, ci = (ni * lr - nr * li) / den; const float br = p.b_re[(size_t)g * 1024 + i], bi = p.b_im[(size_t)g * 1024 + i];
                Bb[i] = (f32x2){cr * br - ci * bi, cr * bi + ci * br}; }
            for (int i = tid; i < 1024; i += NTHR) Cc[i] = (f32x2){p.c_re[(size_t)g * 1024 + i], p.c_im[(size_t)g * 1024 + i]};
            __syncthreads();
            {
                const int j = tid >> 4, co = cq * 4 + ((tid >> 2) & 3), ci0 = (tid & 3) * 4; float s0 = 0.f, s1 = 0.f, s2 = 0.f, s3 = 0.f;
                for (int pp = 0; pp < 64; ++pp) { const f32x2 c = Cc[co * 64 + pp], a = apow[j * 64 + pp]; const f32x4 b01 = *(const f32x4*)(Bb + pp * 16 + ci0), b23 = *(const f32x4*)(Bb + pp * 16 + ci0 + 2);
                    const float car = c.x * a.x - c.y * a.y, cai = c.x * a.y + c.y * a.x;
                    s0 += car * b01.x - cai * b01.y; s1 += car * b01.z - cai * b01.w; s2 += car * b23.x - cai * b23.y; s3 += car * b23.z - cai * b23.w; }
                const float dk = (j == 0) ? p.d_skip[g * 16 + co] : 0.f;
                if (co == ci0) s0 += dk; if (co == ci0 + 1) s1 += dk; if (co == ci0 + 2) s2 += dk; if (co == ci0 + 3) s3 += dk;
                *(f32x4*)(Kt + ((j << 8) | (co << 4) | ci0)) = (f32x4){s0, s1, s2, s3}; }
            __syncthreads();
            bf16_t* KmT = (bf16_t*)(ws + OFF_KMT) + (size_t)g * 512 * 640;
            for (int q = tid; q < 128 * 80; q += NTHR) { const int nn = q / 80, kc = q % 80, k0 = kc * 8, t = nn >> 2, co = cq * 4 + (nn & 3), n = t * 16 + co; float v[8];
                if (k0 < 512) { const int s = k0 >> 4, ci0 = k0 & 15;
#pragma unroll
                    for (int i = 0; i < 8; ++i) v[i] = (t >= s) ? Kt[((t - s) * 16 + co) * 16 + ci0 + i] : 0.f;
                } else { const int kk0 = k0 - 512, ri = kk0 >> 6, p0 = kk0 & 63;
#pragma unroll
                    for (int i = 0; i < 8; ++i) { const f32x2 c = Cc[co * 64 + p0 + i], a = apow[(t + 1) * 64 + p0 + i]; v[i] = (ri == 0) ? (c.x * a.x - c.y * a.y) : -(c.x * a.y + c.y * a.x); } }
                u32x4 o; o.x = pk2(v[0], v[1]); o.y = pk2(v[2], v[3]); o.z = pk2(v[4], v[5]); o.w = pk2(v[6], v[7]); *(u32x4*)(KmT + (size_t)n * 640 + k0) = o; }
            bf16_t* WzT = (bf16_t*)(ws + OFF_WZT) + (size_t)g * 128 * 512;
            for (int q = tid; q < 32 * 64; q += NTHR) { const int n = cq * 32 + (q >> 6), kc = q & 63, k0 = kc * 8, s = k0 >> 4, ci0 = k0 & 15, ri = n >> 6, pp = n & 63; float v[8];
                const f32x2 a = apow[(31 - s) * 64 + pp];
#pragma unroll
                for (int i = 0; i < 8; ++i) { const f32x2 b = Bb[pp * 16 + ci0 + i]; v[i] = (ri == 0) ? (a.x * b.x - a.y * b.y) : (a.x * b.y + a.y * b.x); }
                u32x4 o; o.x = pk2(v[0], v[1]); o.y = pk2(v[2], v[3]); o.z = pk2(v[4], v[5]); o.w = pk2(v[6], v[7]); *(u32x4*)(WzT + (size_t)n * 512 + k0) = o; }
            if (cq == 0 && tid < 64) ((f32x2*)(ws + OFF_AL))[g * 64 + tid] = apow[32 * 64 + tid];
            __syncthreads();
        }
    }
    P0_MARK(4)
}


__device__ __forceinline__ void finalize_row(const float* nope, const float* ra, const float* rb, float rn, float rnr, const float* __restrict__ gain, const _Float16* cs, const _Float16* sn, bf16_t* dst) {
#pragma unroll
    for (int j = 0; j < 8; ++j) { const f32x4 a = __builtin_bit_cast(f32x4, *(const u32x4*)(nope + 8 * j)), c = __builtin_bit_cast(f32x4, *(const u32x4*)(nope + 8 * j + 4));
        u32x4 o; o.x = pk2(a.x * rn * gain[8 * j], a.y * rn * gain[8 * j + 1]); o.y = pk2(a.z * rn * gain[8 * j + 2], a.w * rn * gain[8 * j + 3]);
        o.z = pk2(c.x * rn * gain[8 * j + 4], c.y * rn * gain[8 * j + 5]); o.w = pk2(c.z * rn * gain[8 * j + 6], c.w * rn * gain[8 * j + 7]); *(u32x4*)(dst + 8 * j) = o; }
#pragma unroll
    for (int j = 0; j < 2; ++j) { float o1[8], o2[8];
#pragma unroll
        for (int i = 0; i < 8; ++i) { const int f = 8 * j + i; const float x1 = ra[f] * rnr * gain[64 + f], x2 = rb[f] * rnr * gain[80 + f]; const float cf = (float)cs[f], sf = (float)sn[f]; o1[i] = x1 * cf - x2 * sf; o2[i] = x2 * cf + x1 * sf; }
        u32x4 o; o.x = pk2(o1[0], o1[1]); o.y = pk2(o1[2], o1[3]); o.z = pk2(o1[4], o1[5]); o.w = pk2(o1[6], o1[7]); *(u32x4*)(dst + 64 + 8 * j) = o;
        o.x = pk2(o2[0], o2[1]); o.y = pk2(o2[2], o2[3]); o.z = pk2(o2[4], o2[5]); o.w = pk2(o2[6], o2[7]); *(u32x4*)(dst + 80 + 8 * j) = o; }
}
constexpr int CT_BYTES = 128 * CSTR * 4;
constexpr int SM_OFF = 147456;
constexpr int P1_RSQ = SM_OFF, P1_RSKV = P1_RSQ + 512, P1_CS = P1_RSKV + 512, P1_SN = P1_CS + 4096;

__device__ void phase1(const Params& p, unsigned char* lds) {
    const int tid = threadIdx.x, lane = tid & 63, wid = __builtin_amdgcn_readfirstlane(tid >> 6);
    unsigned char* ws = p.ws;
    bf16_t* hbuf = (bf16_t*)(ws + OFF_HBUF); bf16_t* proj2 = (bf16_t*)(ws + OFF_PROJ2); bf16_t* ubuf = (bf16_t*)(ws + OFF_UBUF);
    float* rsq = (float*)(lds + P1_RSQ); float* rskv = (float*)(lds + P1_RSKV); _Float16* cst = (_Float16*)(lds + P1_CS); _Float16* snt = (_Float16*)(lds + P1_SN);
    for (int tile = blockIdx.x; tile < 256; tile += gridDim.x) {
        const int row0 = tile * 128, b = row0 >> 11;
        float* mod = (float*)(ws + OFF_MODT) + (size_t)tile * 6144 - (size_t)b * 6144;
        for (int i = tid; i < 6144; i += NTHR) { float s = p.b_ada[i]; const float* pp = (const float*)(ws + OFF_PART) + (size_t)b * 6144 + i;
            for (int ks = 0; ks < 16; ++ks) s += pp[(size_t)ks * 16 * 6144]; mod[b * 6144 + i] = s; }
        for (int i = tid; i < 2048; i += NTHR) { const int r = i >> 4, f = i & 15; const float ang = (float)p.pos[row0 + r] * exp2f(-(float)f * (13.287712379549449f / 16.0f));
            float sn, cs; sincosf(ang, &sn, &cs); cst[i] = (_Float16)cs; snt[i] = (_Float16)sn; }
        __threadfence_block(); __syncthreads();
        for (int rp1a = 0; rp1a < ((PROBE_REP & 8192) ? 2 : 1); ++rp1a) {
        {   f32x4 mg[4], msh[4];
#pragma unroll
            for (int j = 0; j < 4; ++j) { const int col = 4 * (lane + 64 * j); const f32x4 g = *(const f32x4*)(p.norm_mix + col), sc = *(const f32x4*)(mod + b * 6144 + 1024 + col);
                mg[j] = (f32x4){g.x * (1.f + sc.x), g.y * (1.f + sc.y), g.z * (1.f + sc.z), g.w * (1.f + sc.w)}; msh[j] = *(const f32x4*)(mod + b * 6144 + col); }
#pragma unroll 1
            for (int r4 = 0; r4 < 4; ++r4) {
                f32x4 v[4][4];
#pragma unroll
                for (int u = 0; u < 4; ++u)
#pragma unroll
                    for (int j = 0; j < 4; ++j) v[u][j] = ((const f32x4*)(p.x + (size_t)(row0 + r4 * 32 + u * 8 + wid) * 1024))[lane + 64 * j];
#pragma unroll
                for (int u = 0; u < 4; ++u) { float ss = 0.f;
#pragma unroll
                    for (int j = 0; j < 4; ++j) ss += v[u][j].x * v[u][j].x + v[u][j].y * v[u][j].y + v[u][j].z * v[u][j].z + v[u][j].w * v[u][j].w;
                    const float rs = rsqrtf(wave_sum(ss) * (1.0f / 1024.0f) + EPS);
#pragma unroll
                    for (int j = 0; j < 4; ++j) { const int col = 4 * (lane + 64 * j);
                        u32x2 o; o.x = pk2(v[u][j].x * rs * mg[j].x + msh[j].x, v[u][j].y * rs * mg[j].y + msh[j].y); o.y = pk2(v[u][j].z * rs * mg[j].z + msh[j].z, v[u][j].w * rs * mg[j].w + msh[j].w);
                        *(u32x2*)(hbuf + (size_t)(row0 + r4 * 32 + u * 8 + wid) * 1024 + col) = o; } }
            }
        }
        __threadfence_block(); __syncthreads();
        }
        for (int rp1b = 0; rp1b < ((PROBE_REP & 16384) ? 2 : 1); ++rp1b) {
        const ARow ah{hbuf + (size_t)row0 * 1024, 1024};
        for (int nc_ = 0; nc_ < 4; ++nc_) { const int nc = (nc_ + 2 * (((int)blockIdx.x >> 7) & 1)) & 3;
            const bf16_t* Bt = (const bf16_t*)(ws + OFF_WINT) + (size_t)nc * 256 * 1024;
            if (nc < 2) gemm_128<2, 1, 0, 3>(ah, Bt, 1024, 1024, lds, nullptr, [&](const float* Ct) {
                    const int ln = opq_v(lane), r0u = opq_s(row0), ncu = opq_s(nc); bf16_t* ub = opq_p(ubuf);
                    for (int tk = wid; tk < 32; tk += NWAVE) { const int gi = tk >> 1, r = (tk & 1) * 64 + ln, g = ncu * 16 + gi, tok = r0u + r;
                        const float* c = Ct + r * CSTR + gi * 16; const f32x4 a0 = *(const f32x4*)c, a1 = *(const f32x4*)(c + 4), a2 = *(const f32x4*)(c + 8), a3 = *(const f32x4*)(c + 12);
                        bf16_t* d = ub + ((size_t)g * 1024 + (tok >> 5)) * 640 + (tok & 31) * 16;
                        *(u32x4*)d = (u32x4){pk2(a0.x, a0.y), pk2(a0.z, a0.w), pk2(a1.x, a1.y), pk2(a1.z, a1.w)}; *(u32x4*)(d + 8) = (u32x4){pk2(a2.x, a2.y), pk2(a2.z, a2.w), pk2(a3.x, a3.y), pk2(a3.z, a3.w)}; } });
            else if (nc == 2) gemm_128<2, 1, 0, 3>(ah, Bt, 1024, 1024, lds, nullptr, [&](const float* Ct) {
                    const int ln = opq_v(lane), r0u = opq_s(row0); bf16_t* pj = opq_p(proj2);
                    for (int r = wid; r < 128; r += NWAVE) { const f32x4 v = *(const f32x4*)(Ct + r * CSTR + ln * 4);
                        const float sq = wave_sum(v.x * v.x + v.y * v.y + v.z * v.z + v.w * v.w); if (ln == 0) rsq[r] = rsqrtf(sq * (1.0f / 256.0f) + EPS);
                        *(u32x2*)(pj + (size_t)(r0u + r) * 512 + ln * 4) = (u32x2){pk2(v.x, v.y), pk2(v.z, v.w)}; } });
            else gemm_128<2, 1, 0, 3>(ah, Bt, 1024, 1024, lds, nullptr, [&](const float* Ct) {
                    const int ln = opq_v(lane), r0u = opq_s(row0); bf16_t* pj = opq_p(proj2);
                    for (int r = wid; r < 128; r += NWAVE) { const f32x4 v = (ln < 40) ? *(const f32x4*)(Ct + r * CSTR + ln * 4) : (f32x4){0.f, 0.f, 0.f, 0.f};
                        const float sq = wave_sum((ln < 32) ? (v.x * v.x + v.y * v.y + v.z * v.z + v.w * v.w) : 0.f); if (ln == 0) rskv[r] = rsqrtf(sq * (1.0f / 128.0f) + EPS);
                        const u32x2 o = (u32x2){pk2(v.x, v.y), pk2(v.z, v.w)};
                        if (ln < 32) *(u32x2*)(pj + (size_t)(r0u + r) * 512 + 256 + ln * 4) = o; else if (ln < 40) *(u32x2*)(pj + (size_t)(r0u + r) * 512 + 384 + (ln - 32) * 4) = o; } });
        }
        }
        for (int rp1d = 0; rp1d < ((PROBE_REP & 32768) ? 2 : 1); ++rp1d) {
        const ARow aq{proj2 + (size_t)row0 * 512, 512};
        for (int nc_ = 0; nc_ < 4; ++nc_) { const int nc = (nc_ + ((int)blockIdx.x >> 5)) & 3;
            gemm_128<2, 1, 0, 3>(aq, (const bf16_t*)(ws + OFF_WUQT) + (size_t)nc * 256 * 256, 256, 256, lds, nullptr, [&](const float* Ct) {
                const int tq = opq_v(tid); const float* gq = opq_p(p.q_norm);
                if (tq < 256) { const int row = tq & 127, hh = tq >> 7, h = opq_s(nc) * 2 + hh; const float* q = Ct + row * CSTR + hh * 96; float ss = 0.f;
#pragma unroll
                    for (int j = 0; j < 24; ++j) { const f32x4 t4 = *(const f32x4*)(q + 4 * j); ss += t4.x * t4.x + t4.y * t4.y + t4.z * t4.z + t4.w * t4.w; }
                    const float rq = rsq[row], rn = rsqrtf(ss * rq * rq * (1.0f / 96.0f) + EPS) * rq * QSCALE;
                    finalize_row(q, q + 64, q + 80, rn, rn, gq, cst + row * 16, snt + row * 16, (bf16_t*)const_cast<float*>(q)); }
                __syncthreads();
                {   const int r0q = opq_s(row0), ncq = opq_s(nc);
#pragma unroll
                    for (int hh = 0; hh < 2; ++hh) { bf16_t* qb_ = (bf16_t*)(ws + OFF_Q) + ((size_t)((r0q >> 11) * 8 + ncq * 2 + hh) * 2048 + (r0q & 2047)) * 96;
#pragma unroll
                        for (int u = 0; u < 3; ++u) { const int pc = tq + NTHR * u, r = pc / 12, c = pc - r * 12;
                            *(u32x4*)(qb_ + (size_t)pc * 8) = *(const u32x4*)((const unsigned char*)Ct + r * (CSTR * 4) + hh * 384 + c * 16); } } } }); }
        }
        for (int rp1e = 0; rp1e < ((PROBE_REP & 65536) ? 2 : 1); ++rp1e) {
        const ARow akv{proj2 + (size_t)row0 * 512 + 256, 512};
        for (int nc_ = 0; nc_ < 4; ++nc_) { const int nc = (nc_ + ((int)blockIdx.x >> 5)) & 3;
            gemm_128<2, 1, 0, 3>(akv, (const bf16_t*)(ws + OFF_WUKVT) + (size_t)nc * 256 * 128, 128, 128, lds, nullptr, [&](const float* Ct) {
                const int tq = opq_v(tid); const float* gk = opq_p(p.k_norm); const int r0k = opq_s(row0), nck = opq_s(nc);
                if (tq < 256) { const int row = tq & 127, hh = tq >> 7, h = nck * 2 + hh; const float* kp = Ct + row * CSTR + hh * 128; float ss = 0.f, sr = 0.f; float rp[32];
#pragma unroll
                    for (int j = 0; j < 16; ++j) { const f32x4 t4 = *(const f32x4*)(kp + 4 * j); ss += t4.x * t4.x + t4.y * t4.y + t4.z * t4.z + t4.w * t4.w; }
#pragma unroll
                    for (int j = 0; j < 4; ++j) { const u32x4 w = *(const u32x4*)(proj2 + (size_t)(r0k + row) * 512 + 384 + 8 * j);
                        rp[8 * j] = bflo(w.x); rp[8 * j + 1] = bfhi(w.x); rp[8 * j + 2] = bflo(w.y); rp[8 * j + 3] = bfhi(w.y); rp[8 * j + 4] = bflo(w.z); rp[8 * j + 5] = bfhi(w.z); rp[8 * j + 6] = bflo(w.w); rp[8 * j + 7] = bfhi(w.w); }
#pragma unroll
                    for (int d = 0; d < 32; ++d) sr += rp[d] * rp[d];
                    const float rk = rskv[row], rn = rsqrtf((ss * rk * rk + sr) * (1.0f / 96.0f) + EPS);
                    finalize_row(kp, rp, rp + 16, rn * rk, rn, gk, cst + row * 16, snt + row * 16, (bf16_t*)const_cast<float*>(kp));
                } else { const int t = tq - 256, d = t & 63, hh = (t >> 6) & 1, rh = t >> 7, h = nck * 2 + hh;
                    bf16_t* dst = (bf16_t*)(ws + OFF_VT) + ((size_t)((r0k >> 11) * 8 + h) * 64 + d) * 2048 + (r0k & 2047) + rh * 64;
                    const float* vp = Ct + (rh * 64) * CSTR + hh * 128 + 64 + d;
#pragma unroll 2
                    for (int r8 = 0; r8 < 8; ++r8) { float v[8];
#pragma unroll
                        for (int i = 0; i < 8; ++i) v[i] = vp[(r8 * 8 + i) * CSTR] * rskv[rh * 64 + r8 * 8 + i];
                        *(u32x4*)(dst + r8 * 8) = (u32x4){pk2(v[0], v[1]), pk2(v[2], v[3]), pk2(v[4], v[5]), pk2(v[6], v[7])}; } }
                __syncthreads();
#pragma unroll
                for (int hh = 0; hh < 2; ++hh) { bf16_t* kb_ = (bf16_t*)(ws + OFF_K) + ((size_t)((r0k >> 11) * 8 + nck * 2 + hh) * 2048 + (r0k & 2047)) * 96;
#pragma unroll
                    for (int u = 0; u < 3; ++u) { const int pc = tq + NTHR * u, r = pc / 12, c = pc - r * 12;
                        *(u32x4*)(kb_ + (size_t)pc * 8) = *(const u32x4*)((const unsigned char*)Ct + r * (CSTR * 4) + hh * 512 + c * 16); } } }); }
        }
    }
}

__device__ void s5_item(const Params& p, unsigned char* lds, int g, int bp) {
    const int tid = threadIdx.x;
    unsigned char* ws = p.ws;
    bf16_t* A = (bf16_t*)(ws + OFF_UBUF) + ((size_t)g * 1024 + bp * 128) * 640;
    float* Z = (float*)(lds + 73728);
    const ARow au{A, 640};
    gemm_128<1, 0, 0, 2>(au, (const bf16_t*)(ws + OFF_WZT) + (size_t)g * 128 * 512, 512, 512, lds, nullptr, [&](int row, int col, float v) { Z[row * 129 + col] = v; });
    __syncthreads();
    if (tid < 128) {
        const int bs = tid >> 6, pp = tid & 63; const f32x2 aL = ((const f32x2*)(ws + OFF_AL))[g * 64 + pp]; float xr = 0.f, xi = 0.f;
        for (int k = 0; k < 64; ++k) { const int row = bs * 64 + k; bf16_t* xin = A + (size_t)row * 640 + 512;
            xin[pp] = (bf16_t)f2bf(xr); xin[64 + pp] = (bf16_t)f2bf(xi);
            const float zr = Z[row * 129 + pp], zi = Z[row * 129 + 64 + pp], nr = aL.x * xr - aL.y * xi + zr, ni = aL.x * xi + aL.y * xr + zi; xr = nr; xi = ni; }
    }
    __threadfence_block(); __syncthreads();
    bf16_t* ybT = (bf16_t*)(ws + OFF_YBUF) + (size_t)g * T_TOK * 16;
        gemm_128w<0>(au, (const bf16_t*)(ws + OFF_KMT) + (size_t)g * 512 * 640, 640, 640, lds, nullptr, [&](const float* Ct, int nc) {
#pragma unroll
            for (int i = 0; i < 4; ++i) { const int pidx = tid + NTHR * i, row = pidx >> 4, tt = pidx & 15; const float* c = Ct + row * CSTR + tt * 16;
                const f32x4 a0 = *(const f32x4*)c, a1 = *(const f32x4*)(c + 4), a2 = *(const f32x4*)(c + 8), a3 = *(const f32x4*)(c + 12);
                bf16_t* d = ybT + ((size_t)(bp * 128 + row) * 32 + nc * 16 + tt) * 16;
                *(u32x4*)d = (u32x4){pk2(gelu_tanh(a0.x), gelu_tanh(a0.y)), pk2(gelu_tanh(a0.z), gelu_tanh(a0.w)), pk2(gelu_tanh(a1.x), gelu_tanh(a1.y)), pk2(gelu_tanh(a1.z), gelu_tanh(a1.w))};
                *(u32x4*)(d + 8) = (u32x4){pk2(gelu_tanh(a2.x), gelu_tanh(a2.y)), pk2(gelu_tanh(a2.z), gelu_tanh(a2.w)), pk2(gelu_tanh(a3.x), gelu_tanh(a3.y)), pk2(gelu_tanh(a3.z), gelu_tanh(a3.w))}; } });
}

constexpr int AT_KSTR = 208, AT_VSTR = 264, AT_KB = 128 * AT_KSTR, AT_VB = 64 * AT_VSTR, AT_STAGE = AT_KB + AT_VB;

__device__ __forceinline__ void attn_preload(const Params& p, int bh, int qb, bf16x8 (&qf)[6], u32x4 (&rk)[3], u32x4 (&rv)[2]) {
    const int tid = threadIdx.x, lane = tid & 63, wid = __builtin_amdgcn_readfirstlane(tid >> 6), r32 = lane & 31, hi = lane >> 5;
    const bf16_t* Qp = (const bf16_t*)(p.ws + OFF_Q) + ((size_t)bh * 2048 + qb * 256 + wid * 32) * 96;
    const bf16_t* Kp = (const bf16_t*)(p.ws + OFF_K) + (size_t)bh * 2048 * 96;
    const bf16_t* Vp = (const bf16_t*)(p.ws + OFF_VT) + (size_t)bh * 64 * 2048;
#pragma unroll
    for (int ks = 0; ks < 6; ++ks) qf[ks] = *(const bf16x8*)(Qp + r32 * 96 + ks * 16 + hi * 8);
#pragma unroll
    for (int i = 0; i < 3; ++i) { const int pc = tid + NTHR * i; rk[i] = *(const u32x4*)(Kp + (size_t)(pc / 12) * 96 + (pc % 12) * 8); }
#pragma unroll
    for (int i = 0; i < 2; ++i) rv[i] = *(const u32x4*)(Vp + (size_t)((tid >> 4) + 32 * i) * 2048 + (tid & 15) * 8);
}
__device__ void attn_item(const Params& p, unsigned char* lds, int bh, int qb, int qb_next, bf16x8 (&qf)[6], u32x4 (&rk)[3], u32x4 (&rv)[2]) {
    const int tid = threadIdx.x, lane = tid & 63, wid = __builtin_amdgcn_readfirstlane(tid >> 6), r32 = lane & 31, hi = lane >> 5;
    unsigned char* ws = p.ws;
    const int q0 = qb * 256, qw0 = q0 + wid * 32, qg = qw0 + r32;
    const bf16_t* Kp = (const bf16_t*)(ws + OFF_K) + (size_t)bh * 2048 * 96;
    const bf16_t* Vp = (const bf16_t*)(ws + OFF_VT) + (size_t)bh * 64 * 2048;
    bf16x8 qn[6];
#pragma unroll
    for (int ks = 0; ks < 6; ++ks) qn[ks] = qf[ks];
    f32x16 ot[2];
#pragma unroll
    for (int r = 0; r < 16; ++r) { ot[0][r] = 0.f; ot[1][r] = 0.f; }
    float m = -INFINITY, l = 0.f;
    const int nst = (q0 + 256) / 128;
    int kro[3], kco[3];
#pragma unroll
    for (int i = 0; i < 3; ++i) { const int pc = tid + NTHR * i; kro[i] = pc / 12; kco[i] = pc % 12; }
    const int vd0 = tid >> 4, vc = tid & 15;
#pragma unroll
    for (int i = 0; i < 3; ++i) *(u32x4*)(lds + kro[i] * AT_KSTR + kco[i] * 16) = rk[i];
#pragma unroll
    for (int i = 0; i < 2; ++i) { u32x2* d = (u32x2*)(lds + AT_KB + (vd0 + 32 * i) * AT_VSTR + vc * 16); d[0] = (u32x2){rv[i].x, rv[i].y}; d[1] = (u32x2){rv[i].z, rv[i].w}; }
    __syncthreads();
    for (int t = 0; t < nst; ++t) {
        const unsigned char* st = lds + (t & 1) * AT_STAGE;
        if (t + 1 < nst) {
            const int kn = (t + 1) * 128;
#pragma unroll
            for (int i = 0; i < 3; ++i) rk[i] = *(const u32x4*)(Kp + (size_t)(kn + kro[i]) * 96 + kco[i] * 8);
#pragma unroll
            for (int i = 0; i < 2; ++i) rv[i] = *(const u32x4*)(Vp + (size_t)(vd0 + 32 * i) * 2048 + kn + vc * 8);
        } else if (qb_next >= 0) {
            attn_preload(p, bh, qb_next, qn, rk, rv);
        }
#pragma unroll
        for (int sub = 0; sub < 2; ++sub) {
            const int kv0 = t * 128 + sub * 64;
            if (kv0 <= qw0 + 31) {
                f32x16 s0, s1;
#pragma unroll
                for (int r = 0; r < 16; ++r) { s0[r] = 0.f; s1[r] = 0.f; }
                const unsigned char* kb = st + (sub * 64 + r32) * AT_KSTR + hi * 16;
#pragma unroll
                for (int ks = 0; ks < 6; ++ks) {
                    const bf16x8 k0f = *(const bf16x8*)(kb + ks * 32);
                    const bf16x8 k1f = *(const bf16x8*)(kb + 32 * AT_KSTR + ks * 32);
                    s0 = __builtin_amdgcn_mfma_f32_32x32x16_bf16(k0f, qf[ks], s0, 0, 0, 0);
                    s1 = __builtin_amdgcn_mfma_f32_32x32x16_bf16(k1f, qf[ks], s1, 0, 0, 0);
                }
                if (kv0 + 63 > qw0) {
#pragma unroll
                    for (int r = 0; r < 16; ++r) { const int key = kv0 + crow(r, hi); if (key > qg) s0[r] = -INFINITY; if (key + 32 > qg) s1[r] = -INFINITY; }
                }
                float mx = fmaxf(s0[0], s1[0]);
#pragma unroll
                for (int r = 1; r < 16; ++r) mx = fmaxf(mx, fmaxf(s0[r], s1[r]));
                mx = fmaxf(mx, __shfl_xor(mx, 32));
                const float mn = fmaxf(m, mx), alpha = __builtin_amdgcn_exp2f(m - mn);
                float ps = 0.f;
#pragma unroll
                for (int r = 0; r < 16; ++r) { s0[r] = __builtin_amdgcn_exp2f(s0[r] - mn); s1[r] = __builtin_amdgcn_exp2f(s1[r] - mn); ps += s0[r] + s1[r]; }
                l = l * alpha + ps; m = mn;
#pragma unroll
                for (int r = 0; r < 16; ++r) { ot[0][r] *= alpha; ot[1][r] *= alpha; }
                const unsigned char* vb = st + AT_KB + r32 * AT_VSTR + sub * 128 + hi * 8;
#pragma unroll
                for (int kt2 = 0; kt2 < 2; ++kt2)
#pragma unroll
                    for (int s = 0; s < 2; ++s) {
                        u32x4 pw;
                        if (kt2 == 0) { pw.x = pk2(s0[8 * s], s0[8 * s + 1]); pw.y = pk2(s0[8 * s + 2], s0[8 * s + 3]); pw.z = pk2(s0[8 * s + 4], s0[8 * s + 5]); pw.w = pk2(s0[8 * s + 6], s0[8 * s + 7]); }
                        else { pw.x = pk2(s1[8 * s], s1[8 * s + 1]); pw.y = pk2(s1[8 * s + 2], s1[8 * s + 3]); pw.z = pk2(s1[8 * s + 4], s1[8 * s + 5]); pw.w = pk2(s1[8 * s + 6], s1[8 * s + 7]); }
                        const bf16x8 pf = __builtin_bit_cast(bf16x8, pw);
#pragma unroll
                        for (int dt = 0; dt < 2; ++dt) {
                            const unsigned char* a = vb + dt * 32 * AT_VSTR + (kt2 * 32 + 16 * s) * 2;
                            const u32x2 lo = *(const u32x2*)a, hh = *(const u32x2*)(a + 16);
                            const bf16x8 vf = __builtin_bit_cast(bf16x8, (u32x4){lo.x, lo.y, hh.x, hh.y});
                            ot[dt] = __builtin_amdgcn_mfma_f32_32x32x16_bf16(vf, pf, ot[dt], 0, 0, 0);
                        }
                    }
            }
        }
        if (t + 1 < nst) {
            unsigned char* sn = lds + ((t + 1) & 1) * AT_STAGE;
#pragma unroll
            for (int i = 0; i < 3; ++i) *(u32x4*)(sn + kro[i] * AT_KSTR + kco[i] * 16) = rk[i];
#pragma unroll
            for (int i = 0; i < 2; ++i) { u32x2* d = (u32x2*)(sn + AT_KB + (vd0 + 32 * i) * AT_VSTR + vc * 16); d[0] = (u32x2){rv[i].x, rv[i].y}; d[1] = (u32x2){rv[i].z, rv[i].w}; }
        }
        __syncthreads();
    }
    l += __shfl_xor(l, 32);
    const float inv = 1.0f / l;
    bf16_t* dst = (bf16_t*)(ws + OFF_HBUF) + ((size_t)(bh >> 3) * 2048 + qg) * 1024 + 512 + (bh & 7) * 64;
    {
        float ssq = 0.f;
#pragma unroll
        for (int r = 0; r < 16; ++r) { const float a = ot[0][r] * inv, c = ot[1][r] * inv; ssq += a * a + c * c; }
        ssq += __shfl_xor(ssq, 32);
        if (hi == 0) ((float*)(ws + OFF_G))[((size_t)(bh >> 3) * 2048 + qg) * 8 + (bh & 7)] = ssq;
    }
#pragma unroll
    for (int dt = 0; dt < 2; ++dt)
#pragma unroll
        for (int g4 = 0; g4 < 4; ++g4) { u32x2 o; o.x = pk2(ot[dt][4 * g4] * inv, ot[dt][4 * g4 + 1] * inv); o.y = pk2(ot[dt][4 * g4 + 2] * inv, ot[dt][4 * g4 + 3] * inv);
            *(u32x2*)(dst + dt * 32 + 8 * g4 + 4 * hi) = o; }
#pragma unroll
    for (int ks = 0; ks < 6; ++ks) qf[ks] = qn[ks];
}

__device__ void phase2(const Params& p, unsigned char* lds) {
    const int G8 = (gridDim.x % 8 == 0) ? (int)gridDim.x / 8 : 0, vb0 = G8 ? ((int)blockIdx.x & 7) * G8 + ((int)blockIdx.x >> 3) : (int)blockIdx.x;
    for (int rp = 0; rp < ((PROBE_REP & 131072) ? 2 : 1); ++rp)
    for (int it = vb0; it < 256; it += gridDim.x) s5_item(p, lds, it >> 3, it & 7);
    for (int rp2 = 0; rp2 < ((PROBE_REP & 262144) ? 2 : 1); ++rp2)
    for (int v = vb0; v < 256; v += gridDim.x) {
        const int bh = v >> 1;
        bf16x8 qf[6]; u32x4 rk[3], rv[2];
        const int qbs = (v & 1) ? 0x2516 : 0x3407;
        attn_preload(p, bh, qbs & 15, qf, rk, rv);
#pragma unroll 1
        for (int i = 0; i < 4; ++i) { const int qb = (qbs >> (4 * i)) & 15, qbn = (i < 3) ? ((qbs >> (4 * i + 4)) & 15) : -1; attn_item(p, lds, bh, qb, qbn, qf, rk, rv); }
    }
}

__device__ __forceinline__ void cex_desc(float& a, float& b) { const float mx = fmaxf(a, b), mn = fminf(a, b); a = mx; b = mn; }
__device__ __forceinline__ void sort16_desc(float (&v)[16]) {
    cex_desc(v[0], v[13]); cex_desc(v[1], v[12]); cex_desc(v[2], v[15]); cex_desc(v[3], v[14]); cex_desc(v[4], v[8]); cex_desc(v[5], v[6]); cex_desc(v[7], v[11]); cex_desc(v[9], v[10]);
    cex_desc(v[0], v[5]); cex_desc(v[1], v[7]); cex_desc(v[2], v[9]); cex_desc(v[3], v[4]); cex_desc(v[6], v[13]); cex_desc(v[8], v[14]); cex_desc(v[10], v[15]); cex_desc(v[11], v[12]);
    cex_desc(v[0], v[1]); cex_desc(v[2], v[3]); cex_desc(v[4], v[5]); cex_desc(v[6], v[8]); cex_desc(v[7], v[9]); cex_desc(v[10], v[11]); cex_desc(v[12], v[13]); cex_desc(v[14], v[15]);
    cex_desc(v[0], v[2]); cex_desc(v[1], v[3]); cex_desc(v[4], v[10]); cex_desc(v[5], v[11]); cex_desc(v[6], v[7]); cex_desc(v[8], v[9]); cex_desc(v[12], v[14]); cex_desc(v[13], v[15]);
    cex_desc(v[1], v[2]); cex_desc(v[3], v[12]); cex_desc(v[4], v[6]); cex_desc(v[5], v[7]); cex_desc(v[8], v[10]); cex_desc(v[9], v[11]); cex_desc(v[13], v[14]);
    cex_desc(v[1], v[4]); cex_desc(v[2], v[6]); cex_desc(v[5], v[8]); cex_desc(v[7], v[10]); cex_desc(v[9], v[13]); cex_desc(v[11], v[14]);
    cex_desc(v[2], v[4]); cex_desc(v[3], v[6]); cex_desc(v[9], v[12]); cex_desc(v[11], v[13]);
    cex_desc(v[3], v[5]); cex_desc(v[6], v[8]); cex_desc(v[7], v[9]); cex_desc(v[10], v[12]);
    cex_desc(v[3], v[4]); cex_desc(v[5], v[6]); cex_desc(v[7], v[8]); cex_desc(v[9], v[10]); cex_desc(v[11], v[12]);
    cex_desc(v[6], v[7]); cex_desc(v[8], v[9]);
}
__device__ __forceinline__ void merge16(float (&top)[16], const float (&c)[16]) {
#pragma unroll
    for (int i = 0; i < 16; ++i) top[i] = fmaxf(top[i], c[15 - i]);
#pragma unroll
    for (int j = 8; j > 0; j >>= 1)
#pragma unroll
        for (int i = 0; i < 16; ++i) { const int l = i ^ j; if (l > i) cex_desc(top[i], top[l]); }
}
__device__ __forceinline__ float mkc(float a, float b, unsigned code) { return __uint_as_float((__float_as_uint(a + b) & 0xFFFFFF00u) | code); }


struct RowBuf { u32x4 d[4], u[4]; };
__device__ __forceinline__ void g_load(RowBuf& B, const unsigned char* __restrict__ E8, int idv, int kbase, int lane) {
#pragma unroll
    for (int j = 0; j < 4; ++j) { const int e = __builtin_amdgcn_readlane(idv, kbase + j);
        B.d[j] = *(const u32x4*)(E8 + (size_t)e * 1024 + lane * 16); B.u[j] = *(const u32x4*)(E8 + (size_t)(16384 + e) * 1024 + lane * 16); }
}
__device__ __forceinline__ float dpp_add(float t, const int ctrl_sel) {
    if (ctrl_sel == 0) return t + __int_as_float(__builtin_amdgcn_update_dpp(0, __float_as_int(t), 0xB1, 0xF, 0xF, false));
    if (ctrl_sel == 1) return t + __int_as_float(__builtin_amdgcn_update_dpp(0, __float_as_int(t), 0x4E, 0xF, 0xF, false));
    if (ctrl_sel == 2) return t + __int_as_float(__builtin_amdgcn_update_dpp(0, __float_as_int(t), 0x141, 0xF, 0xF, false));
    return t + __int_as_float(__builtin_amdgcn_update_dpp(0, __float_as_int(t), 0x140, 0xF, 0xF, false));
}
__device__ __forceinline__ void g_compute(const RowBuf& B, const f32x2 (&hv)[8], f32x2 (&acc)[8], float sdv, float gwv, int kbase, int lane) {
    float s[4];
#pragma unroll
    for (int j = 0; j < 4; ++j) { f32x2 a = {0.f, 0.f};
#pragma unroll
        for (int q = 0; q < 4; ++q) { const int w = (int)B.d[j][q]; const f32x2 lo = __builtin_amdgcn_cvt_pk_f32_fp8(w, false), hi = __builtin_amdgcn_cvt_pk_f32_fp8(w, true);
            a = __builtin_elementwise_fma(lo, hv[2 * q], a); a = __builtin_elementwise_fma(hi, hv[2 * q + 1], a); }
        s[j] = a.x + a.y; }
    auto r0 = __builtin_amdgcn_permlane32_swap(__float_as_uint(s[0]), __float_as_uint(s[1]), false, false);
    auto r1 = __builtin_amdgcn_permlane32_swap(__float_as_uint(s[2]), __float_as_uint(s[3]), false, false);
    const float r01 = __uint_as_float(r0[0]) + __uint_as_float(r0[1]), r23 = __uint_as_float(r1[0]) + __uint_as_float(r1[1]);
    auto r2 = __builtin_amdgcn_permlane16_swap(__float_as_uint(r01), __float_as_uint(r23), false, false);
    float t = __uint_as_float(r2[0]) + __uint_as_float(r2[1]);
    t = dpp_add(t, 0); t = dpp_add(t, 1); t = dpp_add(t, 2); t = dpp_add(t, 3);
    const int jl = kbase + ((lane >> 4) & 1) * 2 + (lane >> 5);
    const float sdl = __shfl(sdv, jl), gwl = __shfl(gwv, jl);
    const float w = gwl * gelu_tanh(sdl * t);
    float wj[4];
    wj[0] = __int_as_float(__builtin_amdgcn_readlane(__float_as_int(w), 0)); wj[1] = __int_as_float(__builtin_amdgcn_readlane(__float_as_int(w), 32));
    wj[2] = __int_as_float(__builtin_amdgcn_readlane(__float_as_int(w), 16)); wj[3] = __int_as_float(__builtin_amdgcn_readlane(__float_as_int(w), 48));
#pragma unroll
    for (int j = 0; j < 4; ++j) { const f32x2 ws = {wj[j], wj[j]};
#pragma unroll
        for (int q = 0; q < 4; ++q) { const int w2 = (int)B.u[j][q]; const f32x2 lo = __builtin_amdgcn_cvt_pk_f32_fp8(w2, false), hi = __builtin_amdgcn_cvt_pk_f32_fp8(w2, true);
            acc[2 * q] = __builtin_elementwise_fma(lo, ws, acc[2 * q]); acc[2 * q + 1] = __builtin_elementwise_fma(hi, ws, acc[2 * q + 1]); } }
}

constexpr int QP_STR = 528, S_OFF = 128 * QP_STR, S_STR = 132, L_OFF = S_OFF + 128 * S_STR * 4;

__device__ void phase3(const Params& p, unsigned char* lds) {
    const int tid = threadIdx.x, lane = tid & 63, wid = __builtin_amdgcn_readfirstlane(tid >> 6), r32 = lane & 31, hi = lane >> 5, wm = wid >> 2, wn = wid & 3;
    unsigned char* ws = p.ws;
    bf16_t* hbuf = (bf16_t*)(ws + OFF_HBUF); const bf16_t* ybuf = (const bf16_t*)(ws + OFF_YBUF); bf16_t* x1b = (bf16_t*)(ws + OFF_X1);
    int* idxb = (int*)(ws + OFF_IDX); float* gb = (float*)(ws + OFF_G);
    for (int tile = blockIdx.x; tile < 256; tile += gridDim.x) {
        const int row0 = tile * 128, b = row0 >> 11;
        const float* mod = (const float*)(ws + OFF_MODT) + (size_t)tile * 6144 - (size_t)b * 6144;
        float* ssum = (float*)(lds + SM_OFF); float* ratio = ssum + 128; float* rsat = ratio + 128; float* ss1 = rsat + 128;
        const bf16_t* ybT = ybuf + (size_t)row0 * 16;
        for (int rp3a = 0; rp3a < ((PROBE_REP & 16) ? 2 : 1); ++rp3a) {
            gemm_128w<0>(AGrp{ybT}, (const bf16_t*)(ws + OFF_WGLUT), 512, 512, lds, nullptr, [&](const float* Ct, int nc) {
#pragma unroll 2
                for (int i = 0; i < 8; ++i) { const int pidx = tid + NTHR * i, row = pidx >> 5, c8 = (pidx & 31) * 8, col = nc * 256 + c8;
                    const f32x4 a0 = *(const f32x4*)(Ct + row * CSTR + c8), a1 = *(const f32x4*)(Ct + row * CSTR + c8 + 4);
                    const u32x4 yw = *(const u32x4*)(ybT + ((size_t)(col >> 4) * T_TOK + row) * 16 + (col & 15));
                    const f32x4 b0 = *(const f32x4*)(p.b_glu + col), b1 = *(const f32x4*)(p.b_glu + col + 4);
                    float o[8];
                    o[0] = bflo(yw.x) * sigmoidf_(a0.x + b0.x); o[1] = bfhi(yw.x) * sigmoidf_(a0.y + b0.y); o[2] = bflo(yw.y) * sigmoidf_(a0.z + b0.z); o[3] = bfhi(yw.y) * sigmoidf_(a0.w + b0.w);
                    o[4] = bflo(yw.z) * sigmoidf_(a1.x + b1.x); o[5] = bfhi(yw.z) * sigmoidf_(a1.y + b1.y); o[6] = bflo(yw.w) * sigmoidf_(a1.z + b1.z); o[7] = bfhi(yw.w) * sigmoidf_(a1.w + b1.w);
                    float ss = 0.f;
#pragma unroll
                    for (int k = 0; k < 8; ++k) ss += o[k] * o[k];
                    *(u32x4*)(hbuf + (size_t)(row0 + row) * 1024 + col) = (u32x4){pk2(o[0], o[1]), pk2(o[2], o[3]), pk2(o[4], o[5]), pk2(o[6], o[7])};
#pragma unroll
                    for (int of = 1; of < 32; of <<= 1) ss += __shfl_xor(ss, of);
                    if ((lane & 31) == 0) { if (nc == 0) ssum[row] = ss; else ssum[row] += ss; } } });
        }
        if (tid < 128) { const f32x4* sp = (const f32x4*)((const float*)(ws + OFF_G) + (size_t)(row0 + tid) * 8); const f32x4 a = sp[0], c = sp[1];
            const float ss = ((a.x + a.y) + (a.z + a.w)) + ((c.x + c.y) + (c.z + c.w));
            const float ra = rsqrtf(ss * (1.0f / 512.0f) + EPS), rs = rsqrtf(ssum[tid] * (1.0f / 512.0f) + EPS); rsat[tid] = ra; ratio[tid] = rs / ra; }
        __threadfence_block(); __syncthreads();
        for (int rep_c = 0; rep_c < ((PROBE_REP & 128) ? 2 : 1); ++rep_c)
        if (tid < 128) ss1[tid] = 0.f;
        __syncthreads();
        for (int nc2_ = 0; nc2_ < 2; ++nc2_) { const int nc2 = nc2_ ^ (((int)blockIdx.x >> 7) & 1);
            gemm_128w<16>(ARow{hbuf + (size_t)row0 * 1024, 1024}, (const bf16_t*)(ws + OFF_WOUTT) + (size_t)nc2 * 512 * 1024, 1024, 1024, lds, ratio, [&](const float* Ct, int half) {
                const int nc = nc2 * 2 + half; const f32x4 gm = *(const f32x4*)(mod + b * 6144 + 2048 + nc * 256 + lane * 4);
#pragma unroll 1
                for (int i8 = 0; i8 < 16; i8 += 8) { f32x4 xq[8];
#pragma unroll
                for (int u = 0; u < 8; ++u) xq[u] = *(const f32x4*)(p.x + (size_t)(row0 + wid + NWAVE * (i8 + u)) * 1024 + nc * 256 + lane * 4);
#pragma unroll
                for (int u = 0; u < 8; ++u) { const int row = wid + NWAVE * (i8 + u), col = nc * 256 + lane * 4; const size_t o = (size_t)(row0 + row) * 1024 + col;
                    const f32x4 v = *(const f32x4*)(Ct + row * CSTR + lane * 4), xv = xq[u]; const float ra = rsat[row];
                    f32x4 r; r.x = xv.x + gm.x * v.x * ra; r.y = xv.y + gm.y * v.y * ra; r.z = xv.z + gm.z * v.z * ra; r.w = xv.w + gm.w * v.w * ra;
                    *(u32x2*)(x1b + o) = (u32x2){pk2(r.x, r.y), pk2(r.z, r.w)};
                    const float ss = wave_sum(r.x * r.x + r.y * r.y + r.z * r.z + r.w * r.w);
                    if (lane == 0) ss1[row] += ss; } } }); }
        __threadfence_block(); __syncthreads();
        for (int rp3d = 0; rp3d < ((PROBE_REP & 4096) ? 2 : 1); ++rp3d) {
        {   f32x4 mg[4], msh[4];
#pragma unroll
            for (int j = 0; j < 4; ++j) { const int col = 4 * (lane + 64 * j); const f32x4 g = *(const f32x4*)(p.norm_ffn + col), sc = *(const f32x4*)(mod + b * 6144 + 4096 + col);
                mg[j] = (f32x4){g.x * (1.f + sc.x), g.y * (1.f + sc.y), g.z * (1.f + sc.z), g.w * (1.f + sc.w)}; msh[j] = *(const f32x4*)(mod + b * 6144 + 3072 + col); }
            u32x2 w[4][4][4];
#define D3_LOAD(bt) { _Pragma("unroll") for (int u = 0; u < 4; ++u) _Pragma("unroll") for (int j = 0; j < 4; ++j) w[bt][u][j] = ((const u32x2*)(x1b + (size_t)(row0 + (bt) * 32 + u * 8 + wid) * 1024))[lane + 64 * j]; }
#define D3_COMP(bt) { _Pragma("unroll") for (int u = 0; u < 4; ++u) { const int r = (bt) * 32 + u * 8 + wid; const float rs = rsqrtf(ss1[r] * (1.0f / 1024.0f) + EPS); \
                    _Pragma("unroll") for (int j = 0; j < 4; ++j) { const int col = 4 * (lane + 64 * j); const u32x2 ww = w[bt][u][j]; \
                        u32x2 o; o.x = pk2(bflo(ww.x) * rs * mg[j].x + msh[j].x, bfhi(ww.x) * rs * mg[j].y + msh[j].y); o.y = pk2(bflo(ww.y) * rs * mg[j].z + msh[j].z, bfhi(ww.y) * rs * mg[j].w + msh[j].w); \
                        *(u32x2*)(hbuf + (size_t)(row0 + r) * 1024 + col) = o; } } }
            D3_LOAD(0) D3_LOAD(1) __builtin_amdgcn_sched_barrier(0);
            D3_COMP(0) __builtin_amdgcn_sched_barrier(0); D3_LOAD(2) __builtin_amdgcn_sched_barrier(0);
            D3_COMP(1) __builtin_amdgcn_sched_barrier(0); D3_LOAD(3) __builtin_amdgcn_sched_barrier(0);
            D3_COMP(2) D3_COMP(3)
#undef D3_LOAD
#undef D3_COMP
        }
        __threadfence_block(); __syncthreads();
        }
        if (PROBE_REP & (524288 | 1048576)) { struct ARowM { const bf16_t* A; int lda; int mask; __device__ __forceinline__ const bf16_t* operator()(int row, int k) const { return A + (size_t)row * lda + (k & mask); } };
            for (int h = 0; h < 8; ++h) gemm_128<2, 0, 0, 3>(ARowM{hbuf + (size_t)row0 * 1024, 1024, (PROBE_REP & 524288) ? 63 : 1023}, (const bf16_t*)(ws + OFF_WQT) + (size_t)h * 256 * 1024, 1024, 1024, lds, nullptr, [&](int row, int col, float v) { asm volatile("" :: "v"(v), "v"(row), "v"(col)); });
            __syncthreads(); }
        for (int rep_e = 0; rep_e < ((PROBE_REP & 32) ? 2 : 1); ++rep_e) {
        float* Ls = (float*)(lds + CT_BYTES);
        for (int hp_ = 0; hp_ < 4; ++hp_) { const int hp = (hp_ + (((int)blockIdx.x >> 3) & 3)) & 3;
            gemm_128w<0>(ARow{hbuf + (size_t)row0 * 1024, 1024}, (const bf16_t*)(ws + OFF_WQT) + (size_t)hp * 512 * 1024, 1024, 1024, lds, nullptr, [&](const float* Ct, int half) {
                const int h = opq_s(hp) * 2 + half;
                {
                    const int ph = wid >> 2, t = tid & 255, row = t >> 1, hf = t & 1; float top[16];
#pragma unroll
                    for (int c2 = 0; c2 < 4; ++c2) { float c[16];
#pragma unroll
                        for (int q = 0; q < 4; ++q) { const int kb = hf * 64 + c2 * 16 + 4 * q; const f32x4 t4 = *(const f32x4*)(Ct + row * CSTR + ph * 128 + kb);
                            c[4 * q] = __uint_as_float((__float_as_uint(t4.x) & 0xFFFFFF80u) | (unsigned)(127 - kb));
                            c[4 * q + 1] = __uint_as_float((__float_as_uint(t4.y) & 0xFFFFFF80u) | (unsigned)(126 - kb));
                            c[4 * q + 2] = __uint_as_float((__float_as_uint(t4.z) & 0xFFFFFF80u) | (unsigned)(125 - kb));
                            c[4 * q + 3] = __uint_as_float((__float_as_uint(t4.w) & 0xFFFFFF80u) | (unsigned)(124 - kb)); }
                        sort16_desc(c);
                        if (c2 == 0) {
#pragma unroll
                            for (int k = 0; k < 16; ++k) top[k] = c[k];
                        } else merge16(top, c); }
                    { float o[16];
#pragma unroll
                      for (int k = 0; k < 16; ++k) o[k] = __int_as_float(__builtin_amdgcn_update_dpp(0, __float_as_int(top[k]), 0xB1, 0xF, 0xF, false));
                      merge16(top, o); }
                    if (hf == 0) {
#pragma unroll
                        for (int q = 0; q < 4; ++q) *(f32x4*)(Ls + (ph * 128 + row) * 16 + 4 * q) = (f32x4){top[4 * q], top[4 * q + 1], top[4 * q + 2], top[4 * q + 3]}; }
                }
                __syncthreads();
            if (wid < 4) {
                const int row = (wid * 64 + lane) >> 1, par = lane & 1; float a1[16], a2[16], top[16];
#pragma unroll
                for (int k = 0; k < 16; ++k) { a1[k] = __uint_as_float(__float_as_uint(Ls[row * 16 + k]) & 0xFFFFFF80u); a2[k] = __uint_as_float(__float_as_uint(Ls[(128 + row) * 16 + k]) & 0xFFFFFF80u); }
                float b1[8];
#pragma unroll
                for (int k = 0; k < 8; ++k) { float ev = a1[2 * k], od = a1[2 * k + 1]; asm volatile("" : "+v"(ev), "+v"(od)); b1[k] = par ? od : ev; }
                const unsigned cof = par ? 16u : 0u; const float NEG = -3.0e38f;
                top[0] = mkc(b1[0], a2[0], 255u - cof);
                top[1] = mkc(b1[0], a2[1], 254u - cof);
                top[2] = mkc(b1[0], a2[2], 253u - cof);
                top[3] = mkc(b1[0], a2[3], 252u - cof);
                top[4] = mkc(b1[0], a2[4], 251u - cof);
                top[5] = mkc(b1[0], a2[5], 250u - cof);
                top[6] = mkc(b1[0], a2[6], 249u - cof);
                top[7] = mkc(b1[0], a2[7], 248u - cof);
                top[8] = (par ? NEG : mkc(b1[0], a2[8], 247u - cof));
                top[9] = (par ? NEG : mkc(b1[0], a2[9], 246u - cof));
                top[10] = (par ? NEG : mkc(b1[0], a2[10], 245u - cof));
                top[11] = (par ? NEG : mkc(b1[0], a2[11], 244u - cof));
                top[12] = (par ? NEG : mkc(b1[0], a2[12], 243u - cof));
                top[13] = (par ? NEG : mkc(b1[0], a2[13], 242u - cof));
                top[14] = (par ? NEG : mkc(b1[0], a2[14], 241u - cof));
                top[15] = (par ? NEG : mkc(b1[0], a2[15], 240u - cof));
                { float c[16];
                  c[0] = mkc(b1[1], a2[0], 223u - cof);
                  c[1] = mkc(b1[1], a2[1], 222u - cof);
                  c[2] = mkc(b1[1], a2[2], 221u - cof);
                  c[3] = mkc(b1[1], a2[3], 220u - cof);
                  c[4] = (par ? NEG : mkc(b1[1], a2[4], 219u - cof));
                  c[5] = mkc(b1[2], a2[0], 191u - cof);
                  c[6] = mkc(b1[2], a2[1], 190u - cof);
                  c[7] = (par ? NEG : mkc(b1[2], a2[2], 189u - cof));
                  c[8] = mkc(b1[3], a2[0], 159u - cof);
                  c[9] = mkc(b1[3], a2[1], 158u - cof);
                  c[10] = mkc(b1[4], a2[0], 127u - cof);
                  c[11] = mkc(b1[5], a2[0], 95u - cof);
                  c[12] = mkc(b1[6], a2[0], 63u - cof);
                  c[13] = mkc(b1[7], a2[0], 31u - cof);
                  c[14] = NEG; c[15] = NEG;
                  sort16_desc(c); merge16(top, c); }
                { float o[16];
#pragma unroll
                  for (int k = 0; k < 16; ++k) o[k] = __int_as_float(__builtin_amdgcn_update_dpp(0, __float_as_int(top[k]), 0xB1, 0xF, 0xF, false));
                  merge16(top, o); }
                float e[16], es = 0.f; const float m0 = __uint_as_float(__float_as_uint(top[0]) & 0xFFFFFF00u);
#pragma unroll
                for (int k = 0; k < 16; ++k) { e[k] = __expf(__uint_as_float(__float_as_uint(top[k]) & 0xFFFFFF00u) - m0); es += e[k]; }
                const float inv = 1.0f / es; const size_t ob = (size_t)(row0 + row) * 128 + h * 16 + par * 8;
#pragma unroll
                for (int k = 0; k < 8; ++k) { float t0_ = top[k], t1_ = top[8 + k], e0_ = e[k], e1_ = e[8 + k]; asm volatile("" : "+v"(t0_), "+v"(t1_), "+v"(e0_), "+v"(e1_)); const float tk = par ? t1_ : t0_, ek = par ? e1_ : e0_;
                    const unsigned code = 255u - (__float_as_uint(tk) & 0xFFu); const int i = code >> 4, j = code & 15;
                    const int i1 = 127 - (int)(__float_as_uint(Ls[row * 16 + i]) & 0x7Fu), i2 = 127 - (int)(__float_as_uint(Ls[(128 + row) * 16 + j]) & 0x7Fu);
                    idxb[ob + k] = (i1 * 128 + i2) | (int)((unsigned)__builtin_bit_cast(unsigned short, (_Float16)(ek * inv)) << 16); }
            } });
        }
        }
        __syncthreads();
    }
}

#ifndef P4_NSL
#define P4_NSL 8
#endif
constexpr int P4_SHIFT = (P4_NSL == 8) ? 11 : (P4_NSL == 16) ? 10 : (P4_NSL == 32) ? 9 : 8;
constexpr int P4_LIST = 128;
constexpr int P4_WLDS = 8 * (P4_LIST * 4 + P4_LIST * 4 + P4_LIST * 4);
typedef _Float16 f16x2 __attribute__((ext_vector_type(2)));
typedef _Float16 f16x32 __attribute__((ext_vector_type(32)));
struct TokState { f16x2 acc[8]; u32x4 hq; int offv; };

struct Rows4 { u32x4 r[4]; };
struct Rows4u { u32x3 r[4]; };
__device__ __forceinline__ void rows_load(Rows4& D, Rows4u& U, __amdgpu_buffer_rsrc_t rd, __amdgpu_buffer_rsrc_t ru, const unsigned* offp, int lane16, int lane12) {
    const unsigned ov = *offp;
    const int o0 = __builtin_amdgcn_readlane((int)ov, 0), o1 = __builtin_amdgcn_readlane((int)ov, 32), o2 = __builtin_amdgcn_readlane((int)ov, 16), o3 = __builtin_amdgcn_readlane((int)ov, 48);
    D.r[0] = __builtin_amdgcn_raw_buffer_load_b128(rd, lane16, o0, 0); D.r[1] = __builtin_amdgcn_raw_buffer_load_b128(rd, lane16, o1, 0);
    D.r[2] = __builtin_amdgcn_raw_buffer_load_b128(rd, lane16, o2, 0); D.r[3] = __builtin_amdgcn_raw_buffer_load_b128(rd, lane16, o3, 0);
    U.r[0] = __builtin_amdgcn_raw_buffer_load_b96(ru, lane12, o0, 0); U.r[2] = __builtin_amdgcn_raw_buffer_load_b96(ru, lane12, o2, 0);
    { const unsigned a1 = __builtin_amdgcn_raw_buffer_load_b32(ru, lane12, o1, 0); const u32x2 b1 = __builtin_amdgcn_raw_buffer_load_b64(ru, lane12 + 4, o1, 0); U.r[1] = (u32x3){a1, b1.x, b1.y}; }
    { const unsigned a3 = __builtin_amdgcn_raw_buffer_load_b32(ru, lane12, o3, 0); const u32x2 b3 = __builtin_amdgcn_raw_buffer_load_b64(ru, lane12 + 4, o3, 0); U.r[3] = (u32x3){a3, b3.x, b3.y}; }
}
__device__ __forceinline__ unsigned dpp_maxu(unsigned t, const int ctrl_sel) {
    unsigned o;
    if (ctrl_sel == 0) o = (unsigned)__builtin_amdgcn_update_dpp(0, (int)t, 0xB1, 0xF, 0xF, false);
    else if (ctrl_sel == 1) o = (unsigned)__builtin_amdgcn_update_dpp(0, (int)t, 0x4E, 0xF, 0xF, false);
    else if (ctrl_sel == 2) o = (unsigned)__builtin_amdgcn_update_dpp(0, (int)t, 0x141, 0xF, 0xF, false);
    else o = (unsigned)__builtin_amdgcn_update_dpp(0, (int)t, 0x140, 0xF, 0xF, false);
    return t > o ? t : o;
}
__device__ __forceinline__ float dpp_maxf(float t, const int ctrl_sel) {
    const int ti = (int)__float_as_uint(t); int o;
    if (ctrl_sel == 0) o = __builtin_amdgcn_update_dpp(0, ti, 0xB1, 0xF, 0xF, false);
    else if (ctrl_sel == 1) o = __builtin_amdgcn_update_dpp(0, ti, 0x4E, 0xF, 0xF, false);
    else if (ctrl_sel == 2) o = __builtin_amdgcn_update_dpp(0, ti, 0x141, 0xF, 0xF, false);
    else o = __builtin_amdgcn_update_dpp(0, ti, 0x140, 0xF, 0xF, false);
    return fmaxf(t, __uint_as_float((unsigned)o));
}
__device__ __forceinline__ unsigned wave_iscan(unsigned v) {
    v += (unsigned)__builtin_amdgcn_update_dpp(0, (int)v, 0x111, 0xF, 0xF, false);
    v += (unsigned)__builtin_amdgcn_update_dpp(0, (int)v, 0x112, 0xF, 0xF, false);
    v += (unsigned)__builtin_amdgcn_update_dpp(0, (int)v, 0x114, 0xF, 0xF, false);
    v += (unsigned)__builtin_amdgcn_update_dpp(0, (int)v, 0x118, 0xF, 0xF, false);
    v += (unsigned)__builtin_amdgcn_update_dpp(0, (int)v, 0x142, 0xA, 0xF, false);
    v += (unsigned)__builtin_amdgcn_update_dpp(0, (int)v, 0x143, 0xC, 0xF, false);
    return v;
}
static_assert(P4_NSL == 8 && P4_SHIFT == 11, "the packed-counter slice sort assumes 8 slices of 2048 experts");
__device__ __forceinline__ int wlane_(int val, int lane, int old) { asm("s_mov_b32 m0, %2\n\ts_nop 0\n\tv_writelane_b32 %0, %1, m0" : "+v"(old) : "s"(val), "s"(lane) : "m0"); return old; }
__device__ __forceinline__ int dpp_addi(int t, const int ctrl_sel) {
    if (ctrl_sel == 0) return t + __builtin_amdgcn_update_dpp(0, t, 0xB1, 0xF, 0xF, false);
    if (ctrl_sel == 1) return t + __builtin_amdgcn_update_dpp(0, t, 0x4E, 0xF, 0xF, false);
    if (ctrl_sel == 2) return t + __builtin_amdgcn_update_dpp(0, t, 0x141, 0xF, 0xF, false);
    return t + __builtin_amdgcn_update_dpp(0, t, 0x140, 0xF, 0xF, false);
}
__device__ __forceinline__ int dot4_first(unsigned a, unsigned b) { int r; asm("v_dot4_i32_i8 %0, %1, %2, 0" : "=v"(r) : "v"(a), "v"(b)); return r; }
__device__ __forceinline__ void g_compute2(const Rows4& D, const Rows4u& U, TokState& T, float sdl, float gwl) {
    int s[4];
#pragma unroll
    for (int j = 0; j < 4; ++j) { int a = dot4_first(D.r[j][0], T.hq[0]);
#pragma unroll
        for (int q = 1; q < 4; ++q) a = __builtin_amdgcn_sdot4((int)D.r[j][q], (int)T.hq[q], a, false);
        s[j] = a; }
    auto r0 = __builtin_amdgcn_permlane32_swap((unsigned)s[0], (unsigned)s[1], false, false);
    auto r1 = __builtin_amdgcn_permlane32_swap((unsigned)s[2], (unsigned)s[3], false, false);
    const int r01 = (int)r0[0] + (int)r0[1], r23 = (int)r1[0] + (int)r1[1];
    auto r2 = __builtin_amdgcn_permlane16_swap((unsigned)r01, (unsigned)r23, false, false);
    int ti = (int)r2[0] + (int)r2[1];
    ti = dpp_addi(ti, 0); ti = dpp_addi(ti, 1); ti = dpp_addi(ti, 2); ti = dpp_addi(ti, 3);
    const float t = sdl * (float)ti, u = t * t, pz = __builtin_fmaf(u, 0.044715f * 2.3022082f, 2.3022082f), e = __builtin_amdgcn_exp2f(-(t * pz));
    const float w = (gwl * t) * __builtin_amdgcn_rcpf(1.0f + e);
    const unsigned wp = __builtin_bit_cast(unsigned, __builtin_amdgcn_cvt_pkrtz(w, w));
    const unsigned w0 = (unsigned)__builtin_amdgcn_readlane((int)wp, 0), w1 = (unsigned)__builtin_amdgcn_readlane((int)wp, 32), w2 = (unsigned)__builtin_amdgcn_readlane((int)wp, 16), w3 = (unsigned)__builtin_amdgcn_readlane((int)wp, 48);
    const f16x2 wsa = __builtin_bit_cast(f16x2, w0), wsb = __builtin_bit_cast(f16x2, w1), wsc = __builtin_bit_cast(f16x2, w2), wsd = __builtin_bit_cast(f16x2, w3);
    {
        const u32x6 c = {U.r[0].x, U.r[0].y, U.r[0].z, U.r[1].x, U.r[1].y, U.r[1].z};
        const f16x32 v = __builtin_amdgcn_cvt_scalef32_pk32_f16_fp6(c, 1.0f);
#pragma unroll
        for (int i = 0; i < 8; ++i) { const f16x2 va = {v[2 * i], v[2 * i + 1]}; T.acc[i] = __builtin_elementwise_fma(va, wsa, T.acc[i]); }
#pragma unroll
        for (int i = 0; i < 8; ++i) { const f16x2 vb = {v[16 + 2 * i], v[16 + 2 * i + 1]}; T.acc[i] = __builtin_elementwise_fma(vb, wsb, T.acc[i]); }
    }
    __builtin_amdgcn_sched_barrier(0);
    {
        const u32x6 c = {U.r[2].x, U.r[2].y, U.r[2].z, U.r[3].x, U.r[3].y, U.r[3].z};
        const f16x32 v = __builtin_amdgcn_cvt_scalef32_pk32_f16_fp6(c, 1.0f);
#pragma unroll
        for (int i = 0; i < 8; ++i) { const f16x2 va = {v[2 * i], v[2 * i + 1]}; T.acc[i] = __builtin_elementwise_fma(va, wsc, T.acc[i]); }
#pragma unroll
        for (int i = 0; i < 8; ++i) { const f16x2 vb = {v[16 + 2 * i], v[16 + 2 * i + 1]}; T.acc[i] = __builtin_elementwise_fma(vb, wsd, T.acc[i]); }
    }
    __builtin_amdgcn_sched_barrier(0);
}

template <int FAKE> __device__ void phase4(const Params& p, unsigned char* lds) {
    const int tid = threadIdx.x, lane = tid & 63, wid = __builtin_amdgcn_readfirstlane(tid >> 6);
    unsigned char* ws = p.ws;
    const bf16_t* hbuf = (const bf16_t*)(ws + OFF_HBUF); const int* idxb = (const int*)(ws + OFF_IDX); const float* gb = (const float*)(ws + OFF_G);
    const float* esc = (const float*)(ws + OFF_ESC);
    const __amdgpu_buffer_rsrc_t erd = __builtin_amdgcn_make_buffer_rsrc((void*)(ws + OFF_E8), 0, 16 << 20, 0x00020000), eru = __builtin_amdgcn_make_buffer_rsrc((void*)(ws + OFF_E8 + (16u << 20)), 0, 16 << 20, 0x00020000);
    const int lane16 = lane * 16, lane12 = lane * 12;
    unsigned char* wl = lds + wid * P4_WLDS;
    unsigned* sid = (unsigned*)wl; float* sgw = (float*)(wl + 8 * P4_LIST * 4); float* ssd = sgw + 8 * P4_LIST;
    const int jl = ((lane >> 4) & 1) * 2 + (lane >> 5);
    for (int tile = blockIdx.x; tile < 256; tile += gridDim.x) {
        const int row0 = tile * 128;
        const float* gf = (const float*)(ws + OFF_MODT) + (size_t)tile * 6144 + 5120 + lane * 16;
#pragma unroll 1
        for (int st = 0; st < 2; ++st) {
            const int tokb = row0 + st * 64 + wid * 8;
            TokState T0, T1, T2, T3, T4, T5, T6, T7;
            unsigned nig0 = (unsigned)idxb[(size_t)tokb * 128 + lane], nig1 = (unsigned)idxb[(size_t)tokb * 128 + 64 + lane];
#define P4_PRO(T, j) { const size_t tok = tokb + (j); float shj; \
                const unsigned ig0 = nig0, ig1 = nig1; if ((j) < 7) { nig0 = (unsigned)idxb[(tok + 1) * 128 + lane]; nig1 = (unsigned)idxb[(tok + 1) * 128 + 64 + lane]; }     \
                int id0 = (int)(ig0 & 0xFFFFu), id1 = (int)(ig1 & 0xFFFFu); \
                const float g0_ = (float)__builtin_bit_cast(_Float16, (unsigned short)(ig0 >> 16)), g1_ = (float)__builtin_bit_cast(_Float16, (unsigned short)(ig1 >> 16)); \
                if (FAKE) { id0 = (id0 & ~1023) | (id0 & 31); id1 = (id1 & ~1023) | (id1 & 31); } \
                const f32x2 es0 = ((const f32x2*)esc)[id0], es1 = ((const f32x2*)esc)[id1];     \
                const float sd0 = es0.x, sd1 = es1.x, gw0 = g0_ * es0.y * 64.0f, gw1 = g1_ * es1.y * 64.0f;     \
                _Pragma("unroll") for (int i = 0; i < 8; ++i) T.acc[i] = (f16x2){(_Float16)0.f, (_Float16)0.f}; \
                { const u32x4 w0 = *(const u32x4*)(hbuf + tok * 1024 + lane * 16), w1 = *(const u32x4*)(hbuf + tok * 1024 + lane * 16 + 8); \
                  float hv[16] = {bflo(w0.x), bfhi(w0.x), bflo(w0.y), bfhi(w0.y), bflo(w0.z), bfhi(w0.z), bflo(w0.w), bfhi(w0.w), bflo(w1.x), bfhi(w1.x), bflo(w1.y), bfhi(w1.y), bflo(w1.z), bfhi(w1.z), bflo(w1.w), bfhi(w1.w)}; \
                  float am = 0.f; _Pragma("unroll") for (int i = 0; i < 16; ++i) am = fmaxf(am, fabsf(hv[i])); \
                  { unsigned au = __float_as_uint(am);     \
                    au = dpp_maxu(au, 0); au = dpp_maxu(au, 1); au = dpp_maxu(au, 2); au = dpp_maxu(au, 3);     \
                    auto q1 = __builtin_amdgcn_permlane16_swap(au, au, false, false); au = q1[0] > q1[1] ? q1[0] : q1[1]; \
                    auto q2 = __builtin_amdgcn_permlane32_swap(au, au, false, false); au = q2[0] > q2[1] ? q2[0] : q2[1]; am = __uint_as_float(au); }     \
                  const float sc = (am > 0.f) ? am * (1.0f / 127.0f) : 1.0f, inv = __builtin_amdgcn_rcpf(sc); shj = sc; \
                    \
                  _Pragma("unroll") for (int q = 0; q < 4; ++q) { const unsigned f0 = __float_as_uint(__builtin_fmaf(hv[4 * q], inv, 12582912.0f)), f1 = __float_as_uint(__builtin_fmaf(hv[4 * q + 1], inv, 12582912.0f)), \
                          f2 = __float_as_uint(__builtin_fmaf(hv[4 * q + 2], inv, 12582912.0f)), f3 = __float_as_uint(__builtin_fmaf(hv[4 * q + 3], inv, 12582912.0f)); \
                      T.hq[q] = __builtin_amdgcn_perm(__builtin_amdgcn_perm(f3, f2, 0x0c0c0400u), __builtin_amdgcn_perm(f1, f0, 0x0c0c0400u), 0x05040100u); } } \
                const int sl0 = id0 >> P4_SHIFT, sl1 = id1 >> P4_SHIFT; int pos0, pos1; \
                {     \
                    const unsigned sh0 = (unsigned)(sl0 & 3) * 8u, sh1 = (unsigned)(sl1 & 3) * 8u, b0 = 1u << sh0, b1 = 1u << sh1; \
                    const unsigned e0lo = sl0 < 4 ? b0 : 0u, e0hi = sl0 < 4 ? 0u : b0, e1lo = sl1 < 4 ? b1 : 0u, e1hi = sl1 < 4 ? 0u : b1; \
                    const unsigned clo = e0lo + e1lo, chi = e0hi + e1hi, ilo = wave_iscan(clo), ihi = wave_iscan(chi); \
                    const unsigned tlo = (unsigned)__builtin_amdgcn_readlane((int)ilo, 63), thi = (unsigned)__builtin_amdgcn_readlane((int)ihi, 63); \
                    const unsigned blo = tlo * 0x01010100u, bhi = thi * 0x01010100u + ((tlo * 0x01010101u) >> 24) * 0x01010101u;     \
                    const unsigned slo = blo + ilo - clo, shi = bhi + ihi - chi; \
                    pos0 = (int)(((sl0 < 4 ? slo : shi) >> sh0) & 0xFFu); \
                    pos1 = (int)(((sl1 < 4 ? slo + e0lo : shi + e0hi) >> sh1) & 0xFFu); \
                    const unsigned ob = (((lane & 4) ? bhi : blo) >> ((unsigned)(lane & 3) * 8u)) & 0xFFu; \
                    T.offv = (lane == P4_NSL) ? 128 : (int)((ob + 3u) & ~3u); } \
                sid[(j) * P4_LIST + pos0] = (unsigned)id0 << 10; sgw[(j) * P4_LIST + pos0] = gw0; ssd[(j) * P4_LIST + pos0] = sd0 * shj; \
                sid[(j) * P4_LIST + pos1] = (unsigned)id1 << 10; sgw[(j) * P4_LIST + pos1] = gw1; ssd[(j) * P4_LIST + pos1] = sd1 * shj; }
            P4_PRO(T0, 0) P4_PRO(T1, 1) P4_PRO(T2, 2) P4_PRO(T3, 3) P4_PRO(T4, 4) P4_PRO(T5, 5) P4_PRO(T6, 6) P4_PRO(T7, 7)
#undef P4_PRO
            asm volatile("s_waitcnt lgkmcnt(0)" ::: "memory");
#define P4_ITEM(T, j) { const int st_ = __builtin_amdgcn_readlane(T.offv, s), en_ = __builtin_amdgcn_readlane(T.offv, s + 1); \
                _Pragma("unroll 1") for (int i = st_; i < en_; i += 4) { Rows4 D; Rows4u U; rows_load(D, U, erd, eru, sid + (j) * P4_LIST + i + jl, lane16, lane12); \
                    g_compute2(D, U, T, ssd[(j) * P4_LIST + i + jl], sgw[(j) * P4_LIST + i + jl]); } }
#pragma unroll 1
            for (int s_ = 0; s_ < P4_NSL; ++s_) { const int s = (st & 1) ? (P4_NSL - 1 - s_) : s_;
                P4_ITEM(T0, 0) P4_ITEM(T1, 1) P4_ITEM(T2, 2) P4_ITEM(T3, 3) P4_ITEM(T4, 4) P4_ITEM(T5, 5) P4_ITEM(T6, 6) P4_ITEM(T7, 7) }
#undef P4_ITEM
            {
                f32x4 gg[4];
#pragma unroll
                for (int q = 0; q < 4; ++q) { const f32x4 g_ = *(const f32x4*)(gf + 4 * q); gg[q] = (f32x4){g_.x * (1.0f / 64.0f), g_.y * (1.0f / 64.0f), g_.z * (1.0f / 64.0f), g_.w * (1.0f / 64.0f)}; }
                u32x4 xr[8][2];
#pragma unroll
                for (int j = 0; j < 8; ++j) { const bf16_t* xrow = (const bf16_t*)(ws + OFF_X1) + (size_t)(tokb + j) * 1024 + lane * 16; xr[j][0] = *(const u32x4*)xrow; xr[j][1] = *(const u32x4*)(xrow + 8); }
#define P4_EPI(T, j) { float* orow = p.out + (size_t)(tokb + (j)) * 1024 + lane * 16; const unsigned xw[8] = {xr[j][0].x, xr[j][0].y, xr[j][0].z, xr[j][0].w, xr[j][1].x, xr[j][1].y, xr[j][1].z, xr[j][1].w}; \
                _Pragma("unroll") for (int q = 0; q < 4; ++q) { f32x4 o = {bflo(xw[2 * q]), bfhi(xw[2 * q]), bflo(xw[2 * q + 1]), bfhi(xw[2 * q + 1])}; \
                    o.x += gg[q].x * (float)T.acc[2 * q].x; o.y += gg[q].y * (float)T.acc[2 * q].y; o.z += gg[q].z * (float)T.acc[2 * q + 1].x; o.w += gg[q].w * (float)T.acc[2 * q + 1].y; \
                    if (FAKE) asm volatile("" :: "v"(o.x), "v"(o.y), "v"(o.z), "v"(o.w)); else *(f32x4*)(orow + 4 * q) = o; } }
                P4_EPI(T0, 0) P4_EPI(T1, 1) P4_EPI(T2, 2) P4_EPI(T3, 3) P4_EPI(T4, 4) P4_EPI(T5, 5) P4_EPI(T6, 6) P4_EPI(T7, 7)
#undef P4_EPI
            }
        }
    }
}

#define LAS __attribute__((address_space(3)))
#define XB_TMO      128
#define XB_XCNT(j)  (256  + 64 * (j))
#define XB_XSUB(j)  (1280 + 64 * (j))
#define XB_XGEN(j)  (2304 + 64 * (j))
#define XB_TOP      3328
#define XB_TOPGEN   3392
#define XCD_BAR_WORDS 3456
#define XB_SPIN_CAP (1u << 18)

__device__ __forceinline__ unsigned xb_ld(unsigned* p)              { return __hip_atomic_load(p, __ATOMIC_RELAXED, __HIP_MEMORY_SCOPE_AGENT); }
__device__ __forceinline__ unsigned xb_add(unsigned* p, unsigned v) { return __hip_atomic_fetch_add(p, v, __ATOMIC_RELAXED, __HIP_MEMORY_SCOPE_AGENT); }
__device__ __forceinline__ unsigned xb_xcc_id() { return (unsigned)__builtin_amdgcn_s_getreg((3 << 11) | 20) & 0xFu; }
#define XB_SPIN(cond, bar) do { unsigned _sp = 0; while (cond) { __builtin_amdgcn_s_sleep(1); \
    if ((++_sp & 255u) == 0u) { if (xb_ld(&(bar)[XB_TMO])) break; if (_sp > XB_SPIN_CAP) { atomicAdd(&(bar)[XB_TMO], 1u); break; } } } } while (0)

struct XcdBarrier {
    unsigned* bar; unsigned x;
    volatile LAS unsigned* st;
};

__device__ __forceinline__ XcdBarrier xcd_barrier_post(unsigned* bar, volatile LAS unsigned* st) {
    XcdBarrier b; b.bar = bar; b.x = xb_xcc_id(); b.st = st;
    if (threadIdx.x == 0) (void)xb_add(&bar[XB_XCNT(b.x)], 1u);
    return b;
}
__device__ __forceinline__ void xcd_barrier_complete(unsigned* bar, unsigned x, unsigned& nloc, unsigned& nx) {
    const unsigned G = gridDim.x * gridDim.y * gridDim.z;
    unsigned sum, cnt, mine, sp = 0u;
    for (;;) {
        sum = 0u; cnt = 0u; mine = 0u;
#pragma unroll
        for (unsigned j = 0; j < 16; ++j) { const unsigned c = xb_ld(&bar[XB_XCNT(j)]); sum += c; cnt += (c > 0u) ? 1u : 0u; mine = (j == x) ? c : mine; }
        if (sum == G) break;
        __builtin_amdgcn_s_sleep(1);
        if ((++sp & 255u) == 0u) { if (xb_ld(&bar[XB_TMO])) break; if (sp > XB_SPIN_CAP) { atomicAdd(&bar[XB_TMO], 1u); break; } }
    }
    nloc = mine > 0u ? mine : 1u; nx = cnt > 0u ? cnt : 1u;
}

__device__ __forceinline__ void xcd_barrier(const XcdBarrier& b) {
    asm volatile("s_waitcnt vmcnt(0)" ::: "memory");
    __syncthreads();
    if (threadIdx.x == 0) {
        unsigned* bar = b.bar;
        __builtin_amdgcn_s_waitcnt(0);
        unsigned nloc = b.st[0], nx = b.st[1];
        if (nloc == 0u) { xcd_barrier_complete(bar, b.x, nloc, nx); b.st[0] = nloc; b.st[1] = nx; }
        const unsigned old = xb_add(&bar[XB_XSUB(b.x)], 1u);
        const unsigned gen = old / nloc;
        if (old + 1u == (gen + 1u) * nloc) {
            __builtin_amdgcn_fence(__ATOMIC_RELEASE, "agent");
            asm volatile("s_waitcnt vmcnt(0)" ::: "memory");
            const unsigned og = xb_add(&bar[XB_TOP], 1u);
            const unsigned tg = og / nx;
            if (og + 1u == (tg + 1u) * nx) xb_add(&bar[XB_TOPGEN], 1u);
            else XB_SPIN(xb_ld(&bar[XB_TOPGEN]) == tg, bar);
            __builtin_amdgcn_fence(__ATOMIC_ACQUIRE, "agent");
            xb_add(&bar[XB_XGEN(b.x)], 1u);
            asm volatile("s_waitcnt vmcnt(0)" ::: "memory");
        } else {
            XB_SPIN(xb_ld(&bar[XB_XGEN(b.x)]) == gen, bar);
            __builtin_amdgcn_fence(__ATOMIC_ACQUIRE, "agent");
            asm volatile("s_waitcnt vmcnt(0)" ::: "memory");
        }
    }
    __syncthreads();
}

__global__ void __launch_bounds__(NTHR, 2) fwd_kernel(Params p) {
    extern __shared__ __attribute__((aligned(16))) unsigned char lds[];
#if MK_COOP
    volatile LAS unsigned* bst = (volatile LAS unsigned*)(lds + LDS_BYTES - 16);
    if (threadIdx.x < 2) bst[threadIdx.x] = 0u;
    __syncthreads();
    const XcdBarrier xbar = xcd_barrier_post((unsigned*)(p.ws + OFF_BAR), bst);
#endif
    unsigned long long tsv[6]; if (PROBE_TS) tsv[0] = __builtin_amdgcn_s_memrealtime();
    if (p.ph_lo <= 0 && 0 < p.ph_hi) { phase0(p, lds); if (PROBE_REP & 1) { __syncthreads(); phase0(p, lds); } }
#if MK_COOP
    if (p.ph_lo <= 0 && 1 < p.ph_hi) { if (p.ph_hi > 64) cg::this_grid().sync(); else xcd_barrier(xbar); }
#endif
    if (PROBE_TS) tsv[1] = __builtin_amdgcn_s_memrealtime();
    if (p.ph_lo <= 1 && 1 < p.ph_hi) { phase1(p, lds); if (PROBE_REP & 2) { __syncthreads(); phase1(p, lds); } }
#if MK_COOP
    if (p.ph_lo <= 1 && 2 < p.ph_hi) { xcd_barrier(xbar); if (PROBE_REP & 2097152) { for (int q = 0; q < 8; ++q) xcd_barrier(xbar); } if (PROBE_REP & 4194304) { for (int q = 0; q < 4; ++q) cg::this_grid().sync(); } }
#endif
    if (PROBE_TS) tsv[2] = __builtin_amdgcn_s_memrealtime();
    if (p.ph_lo <= 2 && 2 < p.ph_hi) { phase2(p, lds); if (PROBE_REP & 4) { __syncthreads(); phase2(p, lds); } }
#if MK_COOP
    if (p.ph_lo <= 2 && 3 < p.ph_hi) xcd_barrier(xbar);
#endif
    if (PROBE_TS) tsv[3] = __builtin_amdgcn_s_memrealtime();
    if (p.ph_lo <= 3 && 3 < p.ph_hi) phase3(p, lds);
#if MK_COOP
    if (p.ph_lo <= 3 && 4 < p.ph_hi) { __threadfence_block(); __syncthreads(); }
#endif
    if (PROBE_TS) tsv[4] = __builtin_amdgcn_s_memrealtime();
    if (p.ph_lo <= 4 && 4 < p.ph_hi) { if (PROBE_REP & 2048) { phase4<1>(p, lds); __syncthreads(); } phase4<0>(p, lds); }
    if (PROBE_TS) { __syncthreads(); tsv[5] = __builtin_amdgcn_s_memrealtime(); if (blockIdx.x == 0 && threadIdx.x == 0) { asm volatile("s_waitcnt vmcnt(0)" ::: "memory");
        const unsigned long long d = (PROBE_TS == 6) ? (tsv[5] - tsv[0]) : (tsv[PROBE_TS] - tsv[PROBE_TS - 1]); p.out[0] += (float)d * 1e-3f; } }
    if (PROBE_P0) { __syncthreads(); if (blockIdx.x == 0 && threadIdx.x == 0) { asm volatile("s_waitcnt vmcnt(0)" ::: "memory"); p.out[0] += (float)__hip_atomic_load((unsigned*)(p.ws + OFF_BAR + 16000), __ATOMIC_RELAXED, __HIP_MEMORY_SCOPE_AGENT) * 1e-3f; } }
}

extern "C" void kernel_launch(void* const* d_in, const int* in_sizes, int n_in, void* d_out, int out_size, void* d_ws, size_t ws_size, hipStream_t stream) {
    static int grid = 0;
    if (grid == 0) {
        if (n_in != 31 || ws_size < WS_NEED) { fprintf(stderr, "kernel_launch: bad inputs (n_in %d, ws %zu < %zu)\n", n_in, ws_size, (size_t)WS_NEED); grid = -1; return; }
        int dev = 0, cus = 0, per_cu = 0;
        hipGetDevice(&dev); hipDeviceGetAttribute(&cus, hipDeviceAttributeMultiprocessorCount, dev);
        if (hipFuncSetAttribute((const void*)fwd_kernel, hipFuncAttributeMaxDynamicSharedMemorySize, LDS_BYTES) != hipSuccess) { fprintf(stderr, "kernel_launch: hipFuncSetAttribute failed\n"); grid = -1; return; }
        hipOccupancyMaxActiveBlocksPerMultiprocessor(&per_cu, (const void*)fwd_kernel, NTHR, LDS_BYTES);
        if (per_cu < 1) { fprintf(stderr, "kernel_launch: occupancy query says %d blocks/CU\n", per_cu); per_cu = 1; }
        grid = cus;
        (void)hipGetLastError();
    }
    if (grid < 0) return;
    (void)hipMemsetAsync((char*)d_ws + OFF_BAR, 0, 16384, stream);
    Params p{};
    const float** f = (const float**)&p;
    for (int i = 0; i < 31; ++i) f[i] = (const float*)d_in[i];
    p.out = (float*)d_out; p.ws = (unsigned char*)d_ws;
#if MK_COOP
    p.ph_lo = 0; p.ph_hi = 5;
    void* args[] = {&p};
    hipError_t e = hipLaunchCooperativeKernel((const void*)fwd_kernel, dim3(grid), dim3(NTHR), args, LDS_BYTES, stream);
    if (e != hipSuccess) fprintf(stderr, "cooperative launch failed: %s (grid %d)\n", hipGetErrorString(e), grid);
#else
    for (int ph = 0; ph < 5; ++ph) { p.ph_lo = ph; p.ph_hi = ph + 1; hipLaunchKernelGGL(fwd_kernel, dim3(grid), dim3(NTHR), LDS_BYTES, stream, p); }
#endif
}
```
